# Optimizing an MI355X kernel written in HIP

```python
import math
import jax, jax.numpy as jnp
from jax import lax
import numpy as np

D_MODEL = 1024
BATCH = 4
SEQ = 8192
DEPTH = 1
DEC_BATCH = 8
DEC_SEQ = 2048
PAST_LEN = 128

HEAD_DIM = 64
A_HEADS = 4
A_VDIM = 2 * HEAD_DIM
A_WIDTH = A_HEADS * A_VDIM
A_Q_COLS = A_HEADS * 2 * HEAD_DIM
A_K_COLS = A_HEADS * 2 * HEAD_DIM
A_V_COLS = A_HEADS * A_VDIM
B_HEADS = 8
B_KV_HEADS = 2
B_GROUP = B_HEADS // B_KV_HEADS
B_WIDTH = B_HEADS * HEAD_DIM
B_Q_COLS = B_HEADS * HEAD_DIM
B_K_COLS = B_KV_HEADS * HEAD_DIM
B_V_COLS = B_KV_HEADS * HEAD_DIM
MIX_WIDTH = A_WIDTH + B_WIDTH
IN_COLS = A_Q_COLS + A_K_COLS + A_V_COLS + B_Q_COLS + B_K_COLS + B_V_COLS
D_FF = 4 * D_MODEL
PLE_DIM = 256
GRID_W = 64
Q_BLOCK = 128
ROPE_THETA = 10000.0
ROPE_HALF = HEAD_DIM // 2
NORM_EPS = 1e-6
SUBLN_EPS = 1e-5

kernel_name = "hymba_diffattn_axialgqa_encoder"


def _rms_norm(x, g, eps):
    xf = x.astype(jnp.float32)
    y = xf * lax.rsqrt(jnp.mean(xf * xf, axis=-1, keepdims=True) + eps)
    return (y * g.astype(jnp.float32)).astype(x.dtype)


def _alibi_slopes():
    return jnp.asarray([2.0 ** (-8.0 * (h + 1) / A_HEADS) for h in range(A_HEADS)], dtype=jnp.float32)


def _lambda_init(layer_idx):
    return 0.8 - 0.6 * math.exp(-0.3 * layer_idx)


def _to_blocks(t):
    b, s = t.shape[0], t.shape[1]
    return jnp.moveaxis(t.reshape((b, s // Q_BLOCK, Q_BLOCK) + t.shape[2:]), 1, 0)


def _from_blocks(t):
    t = jnp.moveaxis(t, 0, 1)
    return t.reshape((t.shape[0], t.shape[1] * t.shape[2]) + t.shape[3:])


def _diff_attention(q, k, v, lam, slopes):
    s_len = q.shape[1]
    scale = HEAD_DIM ** -0.5
    kpos = jnp.arange(s_len)
    nblk = s_len // Q_BLOCK

    def blk(args):
        qb, i = args
        qpos = i * Q_BLOCK + jnp.arange(Q_BLOCK)
        dist = jnp.abs(qpos[:, None] - kpos[None, :]).astype(jnp.float32)
        sc = jnp.einsum('bqhcd,bkhcd->bhcqk', qb, k) * scale
        sc = sc - slopes[None, :, None, None, None] * dist[None, None, None]
        pr = jax.nn.softmax(sc, axis=-1)
        w = pr[:, :, 0] - lam * pr[:, :, 1]
        return jnp.einsum('bhqk,bkhe->bqhe', w, v)

    out = lax.map(blk, (_to_blocks(q), jnp.arange(nblk)))
    return _from_blocks(out)


def _gqa_attention(q, k, v):
    scale = HEAD_DIM ** -0.5

    def blk(qb):
        sc = jnp.einsum('bqngd,bknd->bngqk', qb, k) * scale
        pr = jax.nn.softmax(sc, axis=-1)
        return jnp.einsum('bngqk,bknd->bqngd', pr, v)

    return _from_blocks(lax.map(blk, _to_blocks(q)))


def _rope_1d(x, ang):
    f = ang.shape[-1]
    x1, x2 = x[..., :f], x[..., f:]
    c = jnp.cos(ang)[:, None, :]
    s = jnp.sin(ang)[:, None, :]
    return jnp.concatenate([x1 * c - x2 * s, x1 * s + x2 * c], axis=-1)


def _axial_angles(s_len):
    rows = s_len // GRID_W
    row_idx = jnp.repeat(jnp.arange(rows), GRID_W).astype(jnp.float32)
    col_idx = jnp.tile(jnp.arange(GRID_W), rows).astype(jnp.float32)
    inv_freq = ROPE_THETA ** (-jnp.arange(0, ROPE_HALF, 2, dtype=jnp.float32) / ROPE_HALF)
    return row_idx[:, None] * inv_freq[None], col_idx[:, None] * inv_freq[None]


def _axial_rope(x, ang_r, ang_c):
    return jnp.concatenate([_rope_1d(x[..., :ROPE_HALF], ang_r), _rope_1d(x[..., ROPE_HALF:], ang_c)], axis=-1)


def _layer(h, p_l, layer_idx, w_in, g_mix, lambda_q1, lambda_k1, lambda_q2, lambda_k2, g_subln,
           g_qnorm, g_knorm, w_out, g_mlp, w_ff1, w_ff2, g_ple, w_ple_gate, w_ple_proj):
    bsz, s_len, _ = h.shape
    f32 = jnp.float32
    n = _rms_norm(h, g_mix, NORM_EPS)
    z = jnp.einsum('bsd,dc->bsc', n, w_in).astype(f32)
    cuts = np.cumsum([A_Q_COLS, A_K_COLS, A_V_COLS, B_Q_COLS, B_K_COLS]).tolist()
    qa, ka, va, qb, kb, vb = jnp.split(z, cuts, axis=-1)

    lam_init = _lambda_init(layer_idx)
    lam = (jnp.exp(jnp.sum(lambda_q1.astype(f32) * lambda_k1.astype(f32)))
           - jnp.exp(jnp.sum(lambda_q2.astype(f32) * lambda_k2.astype(f32))) + lam_init)
    qa = qa.reshape(bsz, s_len, A_HEADS, 2, HEAD_DIM)
    ka = ka.reshape(bsz, s_len, A_HEADS, 2, HEAD_DIM)
    va = va.reshape(bsz, s_len, A_HEADS, A_VDIM)
    oa = _diff_attention(qa, ka, va, lam, _alibi_slopes())
    oa = _rms_norm(oa, g_subln, SUBLN_EPS) * (1.0 - lam_init)
    oa = oa.reshape(bsz, s_len, A_WIDTH)

    ang_r, ang_c = _axial_angles(s_len)
    qb = _rms_norm(qb.reshape(bsz, s_len, B_HEADS, HEAD_DIM), g_qnorm, NORM_EPS)
    kb = _rms_norm(kb.reshape(bsz, s_len, B_KV_HEADS, HEAD_DIM), g_knorm, NORM_EPS)
    qb = _axial_rope(qb, ang_r, ang_c).reshape(bsz, s_len, B_KV_HEADS, B_GROUP, HEAD_DIM)
    kb = _axial_rope(kb, ang_r, ang_c)
    vb = vb.reshape(bsz, s_len, B_KV_HEADS, HEAD_DIM)
    ob = _gqa_attention(qb, kb, vb).reshape(bsz, s_len, B_WIDTH)

    mixed = jnp.concatenate([oa, ob], axis=-1).astype(h.dtype)
    h = h + jnp.einsum('bsc,cd->bsd', mixed, w_out)

    n2 = _rms_norm(h, g_mlp, NORM_EPS)
    a = jax.nn.relu(jnp.einsum('bsd,df->bsf', n2, w_ff1))
    h = h + jnp.einsum('bsf,fd->bsd', a * a, w_ff2)

    gate = jax.nn.sigmoid(jnp.einsum('bsd,de->bse', _rms_norm(h, g_ple, NORM_EPS), w_ple_gate))
    h = h + gate * jnp.einsum('bsp,pd->bsd', p_l, w_ple_proj)
    return h


def _trunk(x, p, w_in, g_mix, lambda_q1, lambda_k1, lambda_q2, lambda_k2, g_subln, g_qnorm, g_knorm,
           w_out, g_mlp, w_ff1, w_ff2, g_ple, w_ple_gate, w_ple_proj, g_final):
    h = x
    for l in range(DEPTH):
        h = _layer(h, p[l], l, w_in[l], g_mix[l], lambda_q1[l], lambda_k1[l], lambda_q2[l], lambda_k2[l],
                   g_subln[l], g_qnorm[l], g_knorm[l], w_out[l], g_mlp[l], w_ff1[l], w_ff2[l],
                   g_ple[l], w_ple_gate[l], w_ple_proj[l])
    return _rms_norm(h, g_final, NORM_EPS)


def setup_inputs(seed: int = 0) -> dict:
    key = jax.random.key(seed)
    ks = jax.random.split(key, 24)
    f32 = jnp.float32

    def nrm(k, shape, scale):
        return jax.random.normal(k, shape, f32) * scale

    def gain(k, shape):
        return 1.0 + 0.02 * jax.random.normal(k, shape, f32)

    return {
        "x_prompt": nrm(ks[0], (BATCH, SEQ, D_MODEL), 1.0),
        "x_sample": nrm(ks[1], (DEC_BATCH, DEC_SEQ, D_MODEL), 1.0),
        "p_prompt": nrm(ks[2], (DEPTH, BATCH, SEQ, PLE_DIM), 1.0),
        "p_sample": nrm(ks[3], (DEPTH, DEC_BATCH, DEC_SEQ, PLE_DIM), 1.0),
        "w_in": nrm(ks[4], (DEPTH, D_MODEL, IN_COLS), D_MODEL ** -0.5),
        "g_mix": gain(ks[5], (DEPTH, D_MODEL)),
        "lambda_q1": nrm(ks[6], (DEPTH, HEAD_DIM), 0.1),
        "lambda_k1": nrm(ks[7], (DEPTH, HEAD_DIM), 0.1),
        "lambda_q2": nrm(ks[8], (DEPTH, HEAD_DIM), 0.1),
        "lambda_k2": nrm(ks[9], (DEPTH, HEAD_DIM), 0.1),
        "g_subln": gain(ks[10], (DEPTH, A_VDIM)),
        "g_qnorm": gain(ks[11], (DEPTH, HEAD_DIM)),
        "g_knorm": gain(ks[12], (DEPTH, HEAD_DIM)),
        "w_out": nrm(ks[13], (DEPTH, MIX_WIDTH, D_MODEL), MIX_WIDTH ** -0.5),
        "g_mlp": gain(ks[14], (DEPTH, D_MODEL)),
        "w_ff1": nrm(ks[15], (DEPTH, D_MODEL, D_FF), D_MODEL ** -0.5),
        "w_ff2": nrm(ks[16], (DEPTH, D_FF, D_MODEL), D_FF ** -0.5),
        "g_ple": gain(ks[17], (DEPTH, D_MODEL)),
        "w_ple_gate": nrm(ks[18], (DEPTH, D_MODEL, D_MODEL), D_MODEL ** -0.5),
        "w_ple_proj": nrm(ks[19], (DEPTH, PLE_DIM, D_MODEL), PLE_DIM ** -0.5),
        "g_final": gain(ks[20], (D_MODEL,)),
    }


def reference(x_prompt, x_sample, p_prompt, p_sample, w_in, g_mix, lambda_q1, lambda_k1, lambda_q2, lambda_k2,
              g_subln, g_qnorm, g_knorm, w_out, g_mlp, w_ff1, w_ff2, g_ple, w_ple_gate, w_ple_proj, g_final):
    y_prompt = _trunk(x_prompt, p_prompt, w_in, g_mix, lambda_q1, lambda_k1, lambda_q2, lambda_k2, g_subln,
                      g_qnorm, g_knorm, w_out, g_mlp, w_ff1, w_ff2, g_ple, w_ple_gate, w_ple_proj, g_final)
    y_sample = _trunk(x_sample, p_sample, w_in, g_mix, lambda_q1, lambda_k1, lambda_q2, lambda_k2, g_subln,
                      g_qnorm, g_knorm, w_out, g_mlp, w_ff1, w_ff2, g_ple, w_ple_gate, w_ple_proj, g_final)
    return (y_prompt, y_sample)
```

```cpp
#include <hip/hip_runtime.h>
#include <hip/hip_bf16.h>
#include <hip/hip_cooperative_groups.h>
#include <cstdio>
#include <cstdint>
namespace cg = cooperative_groups;

namespace pg8 {
#define PG8_LAS __attribute__((address_space(3)))
typedef unsigned short bf16_t;
typedef short bf16x8 __attribute__((ext_vector_type(8)));
typedef float f32x4 __attribute__((ext_vector_type(4)));
typedef unsigned u32x4 __attribute__((ext_vector_type(4)));
constexpr int BM = 256, BK = 64, HALF = 128, HTB = HALF * BK * 2  , STAGE_BYTES = 8 * HTB, NXCD = 8, WGM = 8;

__host__ __device__ __forceinline__ int lds_byte(int r, int c) { const int st = (r >> 4) * 2 + (c >> 5), rr = r & 15, cc = c & 31, ob = rr * 64 + cc * 2; return st * 1024 + (ob ^ (((ob >> 9) & 1) << 5)); }
__host__ __device__ __forceinline__ void stage_rc(int b, int& R, int& C) { const int st = b / 1024, sb = b % 1024, swz = sb ^ (((sb >> 9) & 1) << 5); R = (st >> 1) * 16 + swz / 64; C = (st & 1) * 32 + (swz % 64) / 2; }
__host__ __device__ __forceinline__ int perm32(int rho) { const int n = rho >> 4, i = rho & 15; return 8 * (i >> 2) + 4 * n + (i & 3); }

struct Unit { int pm, pn; };
struct Gemm { const bf16_t* A; const bf16_t* Bt; int M, N, K; };

struct StaticOrder {
    int nM, nN, nwg, G, c;
    __host__ __device__ void init(int M, int N, int G_, int c_) { nM = M / BM; nN = N / BM; nwg = nM * nN; G = G_; c = c_; }
    __host__ __device__ bool next(int i, Unit& u) const {
        const long L = (long)i * G + c; if (L >= nwg) return false;
        int wgid = (int)L; { const int q = nwg / NXCD, r = nwg % NXCD, xcd = wgid % NXCD, off = wgid / NXCD; wgid = (xcd < r ? xcd * (q + 1) : r * (q + 1) + (xcd - r) * q) + off; }
        const int nig = WGM * nN, gid = wgid / nig, fm = gid * WGM, gsz = (nM - fm) < WGM ? (nM - fm) : WGM;
        u.pm = fm + ((wgid % nig) % gsz); u.pn = (wgid % nig) / gsz; return true;
    }
    __device__ __forceinline__ void a_ready(const Unit&) const {}
    __device__ __forceinline__ void done(const Unit&) const {}
};

__device__ __forceinline__ unsigned cvt_pk_bf16(float lo, float hi) { unsigned r; asm volatile("v_cvt_pk_bf16_f32 %0, %1, %2" : "=v"(r) : "v"(lo), "v"(hi)); return r; }
typedef float f32x2 __attribute__((ext_vector_type(2)));
typedef unsigned u32x2 __attribute__((ext_vector_type(2)));
__device__ __forceinline__ float rs16(const float* p) {
    const f32x4 a = *(const f32x4*)p, b = *(const f32x4*)(p + 4), c = *(const f32x4*)(p + 8), d = *(const f32x4*)(p + 12);
    return (((a[0] + a[1]) + (a[2] + a[3])) + ((b[0] + b[1]) + (b[2] + b[3]))) + (((c[0] + c[1]) + (c[2] + c[3])) + ((d[0] + d[1]) + (d[2] + d[3])));
}
struct EpiBf {
    static constexpr bool PERM = true, AFTER_DRAIN = false;
    bf16_t* O; int ldc; float scale_q; int nq_tiles;
    __device__ __forceinline__ void operator()(const f32x4 (&acc)[2][2][4][2], const Unit& u, int wr, int wc, int fr, int fq) const {
        const int row0 = u.pm * BM + wr * 64 + fr, col0 = u.pn * BM + wc * 32 + 8 * fq; const float sc = (u.pn < nq_tiles) ? scale_q : 1.f;
#pragma unroll
        for (int ai = 0; ai < 2; ++ai)
#pragma unroll
            for (int m = 0; m < 4; ++m) { bf16_t* rowp = O + (size_t)(row0 + ai * HALF + m * 16) * ldc + col0;
#pragma unroll
                for (int bj = 0; bj < 2; ++bj) { const f32x4 v0 = acc[ai][bj][m][0] * sc, v1 = acc[ai][bj][m][1] * sc;
                    u32x4 w; w.x = cvt_pk_bf16(v0[0], v0[1]); w.y = cvt_pk_bf16(v0[2], v0[3]); w.z = cvt_pk_bf16(v1[0], v1[1]); w.w = cvt_pk_bf16(v1[2], v1[3]);
                    *(u32x4*)(rowp + bj * HALF) = w; } }
    }
};
template <bool BASE_BF16> struct EpiRes {
    static constexpr bool PERM = false, AFTER_DRAIN = false;
    const float* base0; const float* base1; int split_row; bf16_t* hb; float* rsp; int row_off;
    __device__ __forceinline__ void operator()(const f32x4 (&acc)[2][2][4][2], const Unit& u, int wr, int wc, int fr, int fq) const {
        const int col0 = u.pn * BM + wc * 32 + 4 * fq;
#pragma unroll
        for (int ai = 0; ai < 2; ++ai)
#pragma unroll
            for (int m = 0; m < 4; ++m) { const int row = row_off + u.pm * BM + ai * HALF + wr * 64 + m * 16 + fr;
                const float* bp = row < split_row ? base0 + (size_t)row * 1024 : base1 + (size_t)(row - split_row) * 1024;
                bf16_t* hp = hb + (size_t)row * 1024; float s = 0.f;
#pragma unroll
                for (int bj = 0; bj < 2; ++bj)
#pragma unroll
                    for (int n = 0; n < 2; ++n) { const int c = col0 + bj * HALF + n * 16; f32x4 b;
                        if constexpr (BASE_BF16) { const u32x2 pw = *(const u32x2*)(hp + c);
                            b[0] = __uint_as_float(pw.x << 16); b[1] = __uint_as_float(pw.x & 0xffff0000u); b[2] = __uint_as_float(pw.y << 16); b[3] = __uint_as_float(pw.y & 0xffff0000u); }
                        else b = *(const f32x4*)(bp + c);
                        const f32x4 v = b + acc[ai][bj][m][n];
                        s += (v[0] * v[0] + v[1] * v[1]) + (v[2] * v[2] + v[3] * v[3]);
                        u32x2 w; w.x = cvt_pk_bf16(v[0], v[1]); w.y = cvt_pk_bf16(v[2], v[3]); *(u32x2*)(hp + c) = w; }
                s += __shfl_xor(s, 16); s += __shfl_xor(s, 32);
                if (fq == 0) rsp[(size_t)row * 16 + u.pn * 4 + wc] = s; }
    }
};
struct EpiFF1 {
    static constexpr bool PERM = true, AFTER_DRAIN = false;
    const float* rsp; bf16_t* H; int row_off;
    __device__ __forceinline__ void operator()(const f32x4 (&acc)[2][2][4][2], const Unit& u, int wr, int wc, int fr, int fq) const {
        const int col0 = u.pn * BM + wc * 32 + 8 * fq;
#pragma unroll
        for (int ai = 0; ai < 2; ++ai)
#pragma unroll
            for (int m = 0; m < 4; ++m) { const int lrow = u.pm * BM + ai * HALF + wr * 64 + m * 16 + fr;
                const float rstd = 1.0f / sqrtf(rs16(rsp + (size_t)(row_off + lrow) * 16) * (1.0f / 1024.0f) + 1e-6f);
                bf16_t* rowp = H + (size_t)lrow * 4096 + col0;
#pragma unroll
                for (int bj = 0; bj < 2; ++bj) { f32x4 v0 = acc[ai][bj][m][0] * rstd, v1 = acc[ai][bj][m][1] * rstd;
#pragma unroll
                    for (int e = 0; e < 4; ++e) { const float a = fmaxf(v0[e], 0.f), b = fmaxf(v1[e], 0.f); v0[e] = a * a; v1[e] = b * b; }
                    u32x4 w; w.x = cvt_pk_bf16(v0[0], v0[1]); w.y = cvt_pk_bf16(v0[2], v0[3]); w.z = cvt_pk_bf16(v1[0], v1[1]); w.w = cvt_pk_bf16(v1[2], v1[3]);
                    *(u32x4*)(rowp + bj * HALF) = w; }
                asm volatile("" ::: "memory"); }
    }
};
struct EpiGate {
    static constexpr bool PERM = false, AFTER_DRAIN = false;
    const float* rsp_in; const bf16_t* proj; const bf16_t* hb_in; bf16_t* hb_out; float* rsp_out;
    __device__ __forceinline__ void operator()(const f32x4 (&acc)[2][2][4][2], const Unit& u, int wr, int wc, int fr, int fq) const {
        const int col0 = u.pn * BM + wc * 32 + 4 * fq;
#pragma unroll
        for (int ai = 0; ai < 2; ++ai)
#pragma unroll
            for (int m = 0; m < 4; ++m) { const int row = u.pm * BM + ai * HALF + wr * 64 + m * 16 + fr;
                const float rstd = 1.0f / sqrtf(rs16(rsp_in + (size_t)row * 16) * (1.0f / 1024.0f) + 1e-6f);
                const bf16_t* ip = hb_in + (size_t)row * 1024; bf16_t* op = hb_out + (size_t)row * 1024; const bf16_t* pp = proj + (size_t)row * 1024; float s = 0.f;
#pragma unroll
                for (int bj = 0; bj < 2; ++bj)
#pragma unroll
                    for (int n = 0; n < 2; ++n) { const int c = col0 + bj * HALF + n * 16; const f32x4 a = acc[ai][bj][m][n] * rstd;
                        const u32x2 pw = *(const u32x2*)(pp + c), hw = *(const u32x2*)(ip + c);
                        f32x4 pr, h2; pr[0] = __uint_as_float(pw.x << 16); pr[1] = __uint_as_float(pw.x & 0xffff0000u); pr[2] = __uint_as_float(pw.y << 16); pr[3] = __uint_as_float(pw.y & 0xffff0000u);
                        h2[0] = __uint_as_float(hw.x << 16); h2[1] = __uint_as_float(hw.x & 0xffff0000u); h2[2] = __uint_as_float(hw.y << 16); h2[3] = __uint_as_float(hw.y & 0xffff0000u);
                        f32x4 g;
#pragma unroll
                        for (int e2 = 0; e2 < 4; ++e2) g[e2] = __builtin_amdgcn_rcpf(1.0f + __builtin_amdgcn_exp2f(-1.4426950408889634f * a[e2]));
                        const f32x4 v = h2 + g * pr;
                        s += (v[0] * v[0] + v[1] * v[1]) + (v[2] * v[2] + v[3] * v[3]);
                        u32x2 w; w.x = cvt_pk_bf16(v[0], v[1]); w.y = cvt_pk_bf16(v[2], v[3]); *(u32x2*)(op + c) = w; }
                s += __shfl_xor(s, 16); s += __shfl_xor(s, 32);
                if (fq == 0) rsp_out[(size_t)row * 16 + u.pn * 4 + wc] = s;
                asm volatile("" ::: "memory"); }
    }
};
template <class Epi, class Sched, bool ALIGN_EPI = false, bool SP2 = false>
__device__ __forceinline__ void gemm_phase(PG8_LAS unsigned char* lds, const Gemm g, const Sched& S, const Epi& E) {
    int tid_ = threadIdx.x; asm volatile("" : "+v"(tid_));
    const int tid = tid_, wid = __builtin_amdgcn_readfirstlane(tid >> 6), lane = tid & 63, wr = wid >> 2, wc = wid & 3, fr = lane & 15, fq = lane >> 4;
    const int K = g.K, nt = K / BK;
    unsigned voffA[2], voffB[2];
#pragma unroll
    for (int i = 0; i < 2; ++i) { int R, C; stage_rc(tid * 16 + i * 8192, R, C); const int Rb = Epi::PERM ? ((R & ~31) + perm32(R & 31)) : R;
        voffA[i] = (unsigned)(R * K + C) * 2u; voffB[i] = (unsigned)(Rb * K + C) * 2u; }
    const size_t kstep = (size_t)(BK * 2);
    const size_t hstep = (size_t)HALF * K * 2;
    const size_t tstep = 2 * hstep;
    const unsigned ldsw = (unsigned)wid * 1024u;
    const int aoff = lds_byte(wr * 64 + fr, fq * 8), boff = lds_byte(wc * 32 + fr, fq * 8);
#define PG8_SA(b, h) (((b) * 2 + (h)) * HTB)
#define PG8_SB(b, h) ((4 + (b) * 2 + (h)) * HTB)
#define PG8_STAGE(bufoff, gbase, voff) do { _Pragma("unroll") for (int _i = 0; _i < 2; ++_i) \
        __builtin_amdgcn_global_load_lds((const unsigned*)((const char*)(gbase) + (voff)[_i]), (PG8_LAS unsigned*)(lds + (bufoff) + ldsw + _i * 8192), 16, 0, 0); } while (0)
#define PG8_LDA(dst, b, h) do { _Pragma("unroll") for (int m = 0; m < 4; ++m) _Pragma("unroll") for (int k = 0; k < 2; ++k) dst[m][k] = *(const PG8_LAS bf16x8*)(lds + PG8_SA(b, h) + aoff + m * 2048 + k * 1024); } while (0)
#define PG8_LDB(dst, b, h) do { _Pragma("unroll") for (int n = 0; n < 2; ++n) _Pragma("unroll") for (int k = 0; k < 2; ++k) dst[n][k] = *(const PG8_LAS bf16x8*)(lds + PG8_SB(b, h) + boff + n * 2048 + k * 1024); } while (0)
#define PG8_MMA(ai, bj, At, Bt) do { __builtin_amdgcn_s_setprio(1); _Pragma("unroll") for (int m = 0; m < 4; ++m) _Pragma("unroll") for (int n = 0; n < 2; ++n) _Pragma("unroll") for (int k = 0; k < 2; ++k) \
        acc[ai][bj][m][n] = __builtin_amdgcn_mfma_f32_16x16x32_bf16(Bt[n][k], At[m][k], acc[ai][bj][m][n], 0, 0, 0); __builtin_amdgcn_s_setprio(0); } while (0)
#define PG8_WAIT_V(n) asm volatile("s_waitcnt vmcnt(" #n ")" ::: "memory")
#define PG8_WAIT_L(n) asm volatile("s_waitcnt lgkmcnt(" #n ")" ::: "memory")
#define PG8_BAR __builtin_amdgcn_s_barrier()
#define PG8_SCHED __builtin_amdgcn_sched_barrier(0)
    Unit cur, nxt; int ui = 0;
    if (!S.next(0, cur)) return;
    f32x4 acc[2][2][4][2];
#pragma unroll
    for (int a = 0; a < 2; ++a)
#pragma unroll
        for (int b = 0; b < 2; ++b)
#pragma unroll
            for (int m = 0; m < 4; ++m)
#pragma unroll
                for (int n = 0; n < 2; ++n) acc[a][b][m][n] = (f32x4){0.f, 0.f, 0.f, 0.f};
    bf16x8 At[4][2], B0[2][2], B1[2][2];
    const char* cA = (const char*)g.A + (size_t)cur.pm * tstep; const char* cB = (const char*)g.Bt + (size_t)cur.pn * tstep;
    S.a_ready(cur);
    if constexpr (SP2) {
        PG8_STAGE(PG8_SB(0, 0), cB, voffB); PG8_STAGE(PG8_SB(0, 1), cB + hstep, voffB); PG8_STAGE(PG8_SA(0, 0), cA, voffA); PG8_STAGE(PG8_SA(0, 1), cA + hstep, voffA);
        if (wr == 1) PG8_BAR;
        PG8_WAIT_V(2); PG8_BAR;
        PG8_STAGE(PG8_SB(1, 0), cB + kstep, voffB); PG8_STAGE(PG8_SA(1, 0), cA + kstep, voffA); PG8_STAGE(PG8_SB(1, 1), cB + hstep + kstep, voffB);
        PG8_WAIT_V(6); PG8_BAR;
    } else {
        PG8_STAGE(PG8_SB(0, 0), cB, voffB); PG8_STAGE(PG8_SA(0, 0), cA, voffA); PG8_STAGE(PG8_SB(0, 1), cB + hstep, voffB); PG8_STAGE(PG8_SA(0, 1), cA + hstep, voffA);
        if (wr == 1) PG8_BAR;
        PG8_WAIT_V(4); PG8_BAR;
        PG8_STAGE(PG8_SB(1, 0), cB + kstep, voffB); PG8_STAGE(PG8_SA(1, 0), cA + kstep, voffA); PG8_STAGE(PG8_SB(1, 1), cB + hstep + kstep, voffB);
        PG8_WAIT_V(6); PG8_BAR;
    }
    for (;;) {
        const bool has_next = S.next(ui + 1, nxt);
        const char* nA = has_next ? (const char*)g.A + (size_t)nxt.pm * tstep : cA; const char* nB = has_next ? (const char*)g.Bt + (size_t)nxt.pn * tstep : cB;
        for (int t = 0; t < nt; t += 2) {
            const bool last = (t == nt - 2);
            const char* a1 = cA + (size_t)(t + 1) * kstep;
            const char* a2 = last ? nA : cA + (size_t)(t + 2) * kstep; const char* b2 = last ? nB : cB + (size_t)(t + 2) * kstep;
            const char* a3 = a2 + kstep; const char* b3 = b2 + kstep;
            if (last && has_next) S.a_ready(nxt);
            if constexpr (SP2) {
            PG8_LDB(B0, 0, 0); PG8_LDB(B1, 0, 1); PG8_SCHED; PG8_LDA(At, 0, 0); PG8_STAGE(PG8_SA(1, 1), a1 + hstep, voffA);
            PG8_WAIT_V(8); PG8_WAIT_L(0); PG8_BAR; PG8_MMA(0, 0, At, B0); PG8_MMA(0, 1, At, B1); PG8_BAR; PG8_SCHED;
            PG8_LDA(At, 0, 1); PG8_STAGE(PG8_SB(0, 0), b2, voffB); PG8_STAGE(PG8_SB(0, 1), b2 + hstep, voffB); PG8_STAGE(PG8_SA(0, 0), a2, voffA);
            PG8_WAIT_V(8); PG8_WAIT_L(0); PG8_BAR; PG8_MMA(1, 0, At, B0); PG8_MMA(1, 1, At, B1); PG8_BAR; PG8_SCHED;
            PG8_LDB(B0, 1, 0); PG8_LDB(B1, 1, 1); PG8_SCHED; PG8_LDA(At, 1, 0); PG8_STAGE(PG8_SA(0, 1), a2 + hstep, voffA);
            PG8_WAIT_V(8); PG8_WAIT_L(0); PG8_BAR; PG8_MMA(0, 0, At, B0); PG8_MMA(0, 1, At, B1); PG8_BAR; PG8_SCHED;
            PG8_LDA(At, 1, 1); PG8_STAGE(PG8_SB(1, 0), b3, voffB); PG8_STAGE(PG8_SB(1, 1), b3 + hstep, voffB); PG8_STAGE(PG8_SA(1, 0), a3, voffA);
            PG8_WAIT_V(8); PG8_WAIT_L(0); PG8_BAR; PG8_MMA(1, 0, At, B0); PG8_MMA(1, 1, At, B1); PG8_BAR; PG8_SCHED;
            } else {
            PG8_LDB(B0, 0, 0); PG8_SCHED; PG8_LDA(At, 0, 0); PG8_STAGE(PG8_SA(1, 1), a1 + hstep, voffA);
            PG8_WAIT_L(8); PG8_BAR; PG8_WAIT_L(0); PG8_MMA(0, 0, At, B0); PG8_BAR; PG8_SCHED;
            PG8_LDB(B1, 0, 1); PG8_STAGE(PG8_SB(0, 0), b2, voffB);
            PG8_BAR; PG8_WAIT_L(0); PG8_MMA(0, 1, At, B1); PG8_BAR;
            PG8_LDA(At, 0, 1); PG8_STAGE(PG8_SA(0, 0), a2, voffA);
            PG8_BAR; PG8_WAIT_L(0); PG8_MMA(1, 0, At, B0); PG8_BAR; PG8_SCHED;
            PG8_STAGE(PG8_SB(0, 1), b2 + hstep, voffB);
            PG8_WAIT_V(6); PG8_BAR; PG8_MMA(1, 1, At, B1); PG8_BAR;
            PG8_LDB(B0, 1, 0); PG8_SCHED; PG8_LDA(At, 1, 0); PG8_STAGE(PG8_SA(0, 1), a2 + hstep, voffA);
            PG8_WAIT_L(8); PG8_BAR; PG8_WAIT_L(0); PG8_MMA(0, 0, At, B0); PG8_BAR; PG8_SCHED;
            PG8_LDB(B1, 1, 1); PG8_STAGE(PG8_SB(1, 0), b3, voffB);
            PG8_BAR; PG8_WAIT_L(0); PG8_MMA(0, 1, At, B1); PG8_BAR;
            PG8_LDA(At, 1, 1); PG8_STAGE(PG8_SA(1, 0), a3, voffA);
            PG8_BAR; PG8_WAIT_L(0); PG8_MMA(1, 0, At, B0); PG8_BAR; PG8_SCHED;
            PG8_STAGE(PG8_SB(1, 1), b3 + hstep, voffB);
            PG8_WAIT_V(6); PG8_BAR; PG8_MMA(1, 1, At, B1); PG8_BAR;
            }
        }
        if constexpr (ALIGN_EPI) { if (wr == 0) PG8_BAR; }
        if constexpr (!Epi::AFTER_DRAIN) { E(acc, cur, wr, wc, fr, fq); S.done(cur); }
        if (!has_next) break;
#pragma unroll
        for (int a = 0; a < 2; ++a)
#pragma unroll
            for (int b = 0; b < 2; ++b)
#pragma unroll
                for (int m = 0; m < 4; ++m)
#pragma unroll
                    for (int n = 0; n < 2; ++n) acc[a][b][m][n] = (f32x4){0.f, 0.f, 0.f, 0.f};
        cur = nxt; cA = nA; cB = nB; ++ui;
        if constexpr (ALIGN_EPI) { if (wr == 1) PG8_BAR; }
    }
    PG8_WAIT_V(0);
    if constexpr (!ALIGN_EPI) { if (wr == 0) PG8_BAR; }
    PG8_BAR;
    if constexpr (Epi::AFTER_DRAIN) { E.fused(acc, cur, wr, wc, fr, fq, lds, wid, lane); S.done(cur); }
#undef PG8_SA
#undef PG8_SB
#undef PG8_STAGE
#undef PG8_LDA
#undef PG8_LDB
#undef PG8_MMA
#undef PG8_WAIT_V
#undef PG8_WAIT_L
#undef PG8_BAR
#undef PG8_SCHED
}
}
namespace att {
typedef unsigned short bf16_t;
using bf16x8 = __attribute__((ext_vector_type(8))) short;
using s16x4  = __attribute__((ext_vector_type(4))) short;
using f32x16 = __attribute__((ext_vector_type(16))) float;
using u32x4  = __attribute__((ext_vector_type(4))) unsigned;
constexpr int LDZ = 2368;
constexpr int SHM_V = 16384, SHM_K = 8192;
constexpr int ATTN_LDS = 2 * SHM_V + 2 * SHM_K + 8 * 64 * 4;
constexpr float THR2 = 8.0f;
#define KSWZ64(row, colB) ((row) * 128 + ((colB) ^ ((((row) >> 1) & 7) << 4)))
#define SBAR() __builtin_amdgcn_sched_barrier(0)
__device__ __forceinline__ int crow(int r, int hi) { return (r & 3) + 8 * (r >> 2) + 4 * hi; }
__device__ __forceinline__ unsigned cvtpk(float lo, float hi) { unsigned r; asm volatile("v_cvt_pk_bf16_f32 %0, %1, %2" : "=v"(r) : "v"(lo), "v"(hi)); return r; }
__device__ __forceinline__ unsigned short f2bf(float f) { unsigned u = __builtin_bit_cast(unsigned, f); return (unsigned short)((u + 0x7fffu + ((u >> 16) & 1u)) >> 16); }

template <bool ALIBI>
__device__ __forceinline__ void partialSM(f32x16& p0, f32x16& p1, float& m_reg, float& alpha, float dq, float sl2) {
  if constexpr (ALIBI) {
#pragma unroll
    for (int r = 0; r < 16; ++r) { const float t0 = dq - (float)((r & 3) + 8 * (r >> 2)); const float t1 = t0 - 32.f;
      p0[r] = fmaf(-sl2, fabsf(t0), p0[r]); p1[r] = fmaf(-sl2, fabsf(t1), p1[r]); }
  }
  float pmax = p0[0];
#pragma unroll
  for (int r = 1; r < 16; ++r) pmax = fmaxf(pmax, p0[r]);
#pragma unroll
  for (int r = 0; r < 16; ++r) pmax = fmaxf(pmax, p1[r]);
  { auto rr = __builtin_amdgcn_permlane32_swap(__float_as_uint(pmax), __float_as_uint(pmax), false, false);
    pmax = fmaxf(__uint_as_float(rr[0]), __uint_as_float(rr[1])); }
  float mn;
  if (__builtin_expect(__all(pmax - m_reg <= THR2), 1)) { mn = m_reg; alpha = 1.f; }
  else { mn = fmaxf(m_reg, pmax); alpha = __builtin_amdgcn_exp2f(m_reg - mn); m_reg = mn; }
#pragma unroll
  for (int r = 0; r < 16; ++r) { p0[r] -= mn; p1[r] -= mn; }
#pragma unroll
  for (int r = 0; r < 16; ++r) p0[r] = __builtin_amdgcn_exp2f(p0[r]);
}
__device__ __forceinline__ void finishSM(f32x16& p0, f32x16& p1, float alpha, float& l_reg, bf16x8& pa0, bf16x8& pa1, bf16x8& pa2, bf16x8& pa3) {
#pragma unroll
  for (int r = 0; r < 16; ++r) p1[r] = __builtin_amdgcn_exp2f(p1[r]);
  float ps = 0;
#pragma unroll
  for (int r = 0; r < 16; ++r) ps += p0[r];
#pragma unroll
  for (int r = 0; r < 16; ++r) ps += p1[r];
  { auto rr = __builtin_amdgcn_permlane32_swap(__float_as_uint(ps), __float_as_uint(ps), false, false);
    ps = __uint_as_float(rr[0]) + __uint_as_float(rr[1]); }
  l_reg = l_reg * alpha + ps;
#define PK4(P, BASE, OUT) do { unsigned a0 = cvtpk(P[BASE + 0], P[BASE + 1]), a1 = cvtpk(P[BASE + 2], P[BASE + 3]);   \
    unsigned b0 = cvtpk(P[BASE + 4], P[BASE + 5]), b1 = cvtpk(P[BASE + 6], P[BASE + 7]);                              \
    auto r0 = __builtin_amdgcn_permlane32_swap(a0, b0, false, false); auto r1 = __builtin_amdgcn_permlane32_swap(a1, b1, false, false); \
    u32x4 w = {r0[0], r1[0], r0[1], r1[1]}; OUT = *reinterpret_cast<bf16x8*>(&w); } while (0)
  PK4(p0, 0, pa0); PK4(p0, 8, pa1); PK4(p1, 0, pa2); PK4(p1, 8, pa3);
#undef PK4
}
__device__ __forceinline__ void qkt(f32x16& p0, f32x16& p1, const char* Ks, const bf16x8* qr, int r32, int hi) {
  p0 = f32x16{}; p1 = f32x16{};
#pragma unroll
  for (int d0 = 0; d0 < 4; ++d0) { const int cb = (d0 * 16 + hi * 8) * 2;
    const bf16x8 b0 = *reinterpret_cast<const bf16x8*>(Ks + KSWZ64(r32, cb));
    const bf16x8 b1 = *reinterpret_cast<const bf16x8*>(Ks + 4096 + KSWZ64(r32, cb));
    p0 = __builtin_amdgcn_mfma_f32_32x32x16_bf16(b0, qr[d0], p0, 0, 0, 0);
    p1 = __builtin_amdgcn_mfma_f32_32x32x16_bf16(b1, qr[d0], p1, 0, 0, 0); }
}
template <int NCB> __device__ __forceinline__ int v_st(int k, int c) { const int kk = (k & ~0xC) | ((k & 4) << 1) | ((k & 8) >> 1); return ((kk >> 3) * NCB + (c >> 5)) * 512 + ((kk & 7) * 32 + (c & 31)) * 2; }
__device__ __forceinline__ int v_rd_base(int lane) { return ((lane & 3) << 3) | (((lane >> 2) & 3) << 6) | (((lane >> 4) & 1) << 5) | (((lane >> 5) & 1) << 8); }
template <int OFF> __device__ __forceinline__ s16x4 tr_read(int vb) {
  s16x4 r; asm volatile("ds_read_b64_tr_b16 %0, %1 offset:%2" : "=&v"(r) : "v"(vb), "i"(OFF) : "memory"); return r;
}
template <int NCB, int D0> __device__ __forceinline__ void pv_one(f32x16& od, int vb, bf16x8 pa0, bf16x8 pa1, bf16x8 pa2, bf16x8 pa3) {
  constexpr int KS = NCB * 1024, HF = NCB * 512, B0 = D0 * 512;
  const s16x4 l0 = tr_read<B0>(vb), h0 = tr_read<B0 + HF>(vb), l1 = tr_read<B0 + KS>(vb), h1 = tr_read<B0 + KS + HF>(vb);
  const s16x4 l2 = tr_read<B0 + 2 * KS>(vb), h2 = tr_read<B0 + 2 * KS + HF>(vb), l3 = tr_read<B0 + 3 * KS>(vb), h3 = tr_read<B0 + 3 * KS + HF>(vb);
  asm volatile("s_waitcnt lgkmcnt(0)" ::: "memory"); SBAR();
#define PK(L, H) (bf16x8){L[0], L[1], L[2], L[3], H[0], H[1], H[2], H[3]}
  od = __builtin_amdgcn_mfma_f32_32x32x16_bf16(pa0, PK(l0, h0), od, 0, 0, 0);
  od = __builtin_amdgcn_mfma_f32_32x32x16_bf16(pa1, PK(l1, h1), od, 0, 0, 0);
  od = __builtin_amdgcn_mfma_f32_32x32x16_bf16(pa2, PK(l2, h2), od, 0, 0, 0);
  od = __builtin_amdgcn_mfma_f32_32x32x16_bf16(pa3, PK(l3, h3), od, 0, 0, 0);
#undef PK
}
template <int NCB> __device__ __forceinline__ void pv_all(f32x16* o, int vb, bf16x8 pa0, bf16x8 pa1, bf16x8 pa2, bf16x8 pa3) {
  pv_one<NCB, 0>(o[0], vb, pa0, pa1, pa2, pa3); pv_one<NCB, 1>(o[1], vb, pa0, pa1, pa2, pa3);
  if constexpr (NCB == 4) { pv_one<NCB, 2>(o[2], vb, pa0, pa1, pa2, pa3); pv_one<NCB, 3>(o[3], vb, pa0, pa1, pa2, pa3); }
}
__device__ __forceinline__ void store_o(float* p, float v) { *p = v; }
__device__ __forceinline__ void store_o(bf16_t* p, float v) { *p = f2bf(v); }

template <int DV, bool ALIBI, typename TO>
__device__ __forceinline__ void attn_unit(const bf16_t* __restrict__ Qb, const bf16_t* __restrict__ Kh, const bf16_t* __restrict__ Vh, TO* __restrict__ Ob, int seq, int qpos0, float sl2, char* lds) {
  constexpr int NCB = DV / 32;
  const int tid = threadIdx.x, wid = tid >> 6, lane = tid & 63, r32 = lane & 31, hi = lane >> 5;
  char* V_lds = lds; char* K_lds = lds + 2 * SHM_V;
  float* ws = (float*)(lds + 2 * SHM_V + 2 * SHM_K) + wid * 64; float* li_l = ws; float* al_l = ws + 32;
  float m_reg = -1e30f, l_reg = 0; f32x16 o[NCB];
#pragma unroll
  for (int d = 0; d < NCB; ++d) o[d] = f32x16{};
  bf16x8 qr[4];
  const bf16_t* Qw = Qb + (long)(wid * 32 + r32) * LDZ + hi * 8;
#pragma unroll
  for (int d0 = 0; d0 < 4; ++d0) qr[d0] = *reinterpret_cast<const bf16x8*>(Qw + d0 * 16);
  const float dq0 = (float)(qpos0 + wid * 32 + r32 - 4 * hi);
  const int kr = tid >> 3, kc = (tid & 7) * 8, kst = KSWZ64(kr, kc * 2);
  const int sr = tid >> 4, sc = (tid & 15) * 8;
  const int vst0 = (DV == 128) ? v_st<NCB>(sr, sc) : v_st<NCB>(kr, kc), vst1 = v_st<NCB>(32 + sr, sc);
  const int vb0 = (int)(uintptr_t)V_lds + v_rd_base(lane);
  bf16x8 sv0[2], sv1[2], sk[2];
#define SLOAD(i, k0) do { if constexpr (DV == 128) { sv0[i] = *reinterpret_cast<const bf16x8*>(&Vh[(long)((k0) + sr) * LDZ + sc]); sv1[i] = *reinterpret_cast<const bf16x8*>(&Vh[(long)((k0) + 32 + sr) * LDZ + sc]); } \
    else { sv0[i] = *reinterpret_cast<const bf16x8*>(&Vh[(long)((k0) + kr) * LDZ + kc]); } \
    sk[i] = *reinterpret_cast<const bf16x8*>(&Kh[(long)((k0) + kr) * LDZ + kc]); } while (0)
#define SWRITE(b, i) do { *(bf16x8*)(V_lds + (b) * SHM_V + vst0) = sv0[i]; if constexpr (DV == 128) { *(bf16x8*)(V_lds + (b) * SHM_V + vst1) = sv1[i]; } \
    *(bf16x8*)(K_lds + (b) * SHM_K + kst) = sk[i]; } while (0)
#define SWAIT() do { if constexpr (DV == 128) asm volatile("s_waitcnt vmcnt(3)" ::: "memory"); else asm volatile("s_waitcnt vmcnt(2)" ::: "memory"); } while (0)
#define RESC(a) do { if (__any((a) < 1.f)) { if (hi == 0) al_l[r32] = (a); asm volatile("s_waitcnt lgkmcnt(0)" ::: "memory"); \
    _Pragma("unroll") for (int d = 0; d < NCB; ++d) _Pragma("unroll") for (int r = 0; r < 16; ++r) o[d][r] *= al_l[crow(r, hi)]; } } while (0)
  f32x16 pA0, pA1, pB0, pB1; float alA, alB; bf16x8 pa0, pa1, pa2, pa3; const int NT = seq / 64;
  SLOAD(0, 0); asm volatile("s_waitcnt vmcnt(0)" ::: "memory"); SWRITE(0, 0); __syncthreads();
  qkt(pA0, pA1, K_lds, qr, r32, hi); partialSM<ALIBI>(pA0, pA1, m_reg, alA, dq0, sl2);
  SLOAD(1, 64); if (2 < NT) SLOAD(0, 128);
  SWAIT(); SWRITE(1, 1); __syncthreads();
  for (int j = 1; j + 1 < NT; j += 2) {
    SBAR(); qkt(pB0, pB1, K_lds + SHM_K, qr, r32, hi);
    finishSM(pA0, pA1, alA, l_reg, pa0, pa1, pa2, pa3); SBAR();
    SLOAD(1, (j + 2) * 64); SBAR();
    pv_all<NCB>(o, vb0, pa0, pa1, pa2, pa3); partialSM<ALIBI>(pB0, pB1, m_reg, alB, dq0 - 64.f * (float)j, sl2);
    __syncthreads(); SWAIT(); SWRITE(0, 0);
    RESC(alB); __syncthreads();
    SBAR(); qkt(pA0, pA1, K_lds, qr, r32, hi);
    finishSM(pB0, pB1, alB, l_reg, pa0, pa1, pa2, pa3); SBAR();
    if (j + 3 < NT) SLOAD(0, (j + 3) * 64); SBAR();
    pv_all<NCB>(o, vb0 + SHM_V, pa0, pa1, pa2, pa3); partialSM<ALIBI>(pA0, pA1, m_reg, alA, dq0 - 64.f * (float)(j + 1), sl2);
    __syncthreads(); SWAIT(); SWRITE(1, 1);
    RESC(alA); __syncthreads();
  }
  SBAR(); qkt(pB0, pB1, K_lds + SHM_K, qr, r32, hi);
  finishSM(pA0, pA1, alA, l_reg, pa0, pa1, pa2, pa3); SBAR();
  pv_all<NCB>(o, vb0, pa0, pa1, pa2, pa3); partialSM<ALIBI>(pB0, pB1, m_reg, alB, dq0 - 64.f * (float)(NT - 1), sl2);
  __syncthreads(); RESC(alB);
  finishSM(pB0, pB1, alB, l_reg, pa0, pa1, pa2, pa3); SBAR();
  pv_all<NCB>(o, vb0 + SHM_V, pa0, pa1, pa2, pa3);
  if (hi == 0) li_l[r32] = l_reg; asm volatile("s_waitcnt lgkmcnt(0)" ::: "memory");
  float rli[16];
#pragma unroll
  for (int r = 0; r < 16; ++r) rli[r] = __builtin_amdgcn_rcpf(li_l[crow(r, hi)]);
  TO* Ow = Ob + (long)(wid * 32) * 1024;
#pragma unroll
  for (int r = 0; r < 16; ++r) { const int orow = crow(r, hi);
#pragma unroll
    for (int d0 = 0; d0 < NCB; ++d0) store_o(Ow + (long)orow * 1024 + d0 * 32 + r32, o[d0][r] * rli[r]); }
  __syncthreads();
#undef SLOAD
#undef SWRITE
#undef SWAIT
#undef RESC
}
#undef SBAR
}
namespace att {
#define ALAS __attribute__((address_space(3)))
__device__ __forceinline__ void qkt_l(f32x16& p0, f32x16& p1, const ALAS unsigned char* Ks, const bf16x8* qr, int r32, int hi) {
  p0 = f32x16{}; p1 = f32x16{};
#pragma unroll
  for (int d0 = 0; d0 < 4; ++d0) { const int cb = (d0 * 16 + hi * 8) * 2;
    const bf16x8 b0 = *reinterpret_cast<const ALAS bf16x8*>(Ks + KSWZ64(r32, cb));
    const bf16x8 b1 = *reinterpret_cast<const ALAS bf16x8*>(Ks + 4096 + KSWZ64(r32, cb));
    p0 = __builtin_amdgcn_mfma_f32_32x32x16_bf16(b0, qr[d0], p0, 0, 0, 0);
    p1 = __builtin_amdgcn_mfma_f32_32x32x16_bf16(b1, qr[d0], p1, 0, 0, 0); }
}
__device__ __forceinline__ void qkt_acc(f32x16& p0, f32x16& p1, const ALAS unsigned char* Ks, const bf16x8* qr, int r32, int hi) {
  bf16x8 kb0[4], kb1[4];
#pragma unroll
  for (int d0 = 0; d0 < 4; ++d0) { const int cb = (d0 * 16 + hi * 8) * 2;
    kb0[d0] = *reinterpret_cast<const ALAS bf16x8*>(Ks + KSWZ64(r32, cb)); kb1[d0] = *reinterpret_cast<const ALAS bf16x8*>(Ks + 4096 + KSWZ64(r32, cb)); }
  __builtin_amdgcn_sched_barrier(0);
#pragma unroll
  for (int d0 = 0; d0 < 4; ++d0) {
    p0 = __builtin_amdgcn_mfma_f32_32x32x16_bf16(kb0[d0], qr[d0], p0, 0, 0, 0);
    p1 = __builtin_amdgcn_mfma_f32_32x32x16_bf16(kb1[d0], qr[d0], p1, 0, 0, 0); }
}
__device__ __forceinline__ void qkt_c(f32x16& p0, f32x16& p1, const f32x16& negm, const ALAS unsigned char* Ks, const bf16x8* qr, int r32, int hi) {
  bf16x8 kb0[4], kb1[4];
#pragma unroll
  for (int d0 = 0; d0 < 4; ++d0) { const int cb = (d0 * 16 + hi * 8) * 2;
    kb0[d0] = *reinterpret_cast<const ALAS bf16x8*>(Ks + KSWZ64(r32, cb)); kb1[d0] = *reinterpret_cast<const ALAS bf16x8*>(Ks + 4096 + KSWZ64(r32, cb)); }
  __builtin_amdgcn_sched_barrier(0);
  p0 = __builtin_amdgcn_mfma_f32_32x32x16_bf16(kb0[0], qr[0], negm, 0, 0, 0); p1 = __builtin_amdgcn_mfma_f32_32x32x16_bf16(kb1[0], qr[0], negm, 0, 0, 0);
#pragma unroll
  for (int d0 = 1; d0 < 4; ++d0) {
    p0 = __builtin_amdgcn_mfma_f32_32x32x16_bf16(kb0[d0], qr[d0], p0, 0, 0, 0);
    p1 = __builtin_amdgcn_mfma_f32_32x32x16_bf16(kb1[d0], qr[d0], p1, 0, 0, 0); }
}
template <int NCB> __device__ __forceinline__ void pv_issue0(s16x4 (&vl)[4], s16x4 (&vh)[4], int vb) {
  constexpr int KS = NCB * 1024, HF = NCB * 512;
  vl[0] = tr_read<0>(vb); vh[0] = tr_read<HF>(vb); vl[1] = tr_read<KS>(vb); vh[1] = tr_read<KS + HF>(vb);
  vl[2] = tr_read<2 * KS>(vb); vh[2] = tr_read<2 * KS + HF>(vb); vl[3] = tr_read<3 * KS>(vb); vh[3] = tr_read<3 * KS + HF>(vb);
}
template <int NCB> __device__ __forceinline__ void pv_rest(f32x16* o, const s16x4 (&vl)[4], const s16x4 (&vh)[4], int vb, bf16x8 pa0, bf16x8 pa1, bf16x8 pa2, bf16x8 pa3) {
  asm volatile("s_waitcnt lgkmcnt(0)" ::: "memory"); __builtin_amdgcn_sched_barrier(0);
#define PK(L, H) (bf16x8){L[0], L[1], L[2], L[3], H[0], H[1], H[2], H[3]}
  o[0] = __builtin_amdgcn_mfma_f32_32x32x16_bf16(pa0, PK(vl[0], vh[0]), o[0], 0, 0, 0);
  o[0] = __builtin_amdgcn_mfma_f32_32x32x16_bf16(pa1, PK(vl[1], vh[1]), o[0], 0, 0, 0);
  o[0] = __builtin_amdgcn_mfma_f32_32x32x16_bf16(pa2, PK(vl[2], vh[2]), o[0], 0, 0, 0);
  o[0] = __builtin_amdgcn_mfma_f32_32x32x16_bf16(pa3, PK(vl[3], vh[3]), o[0], 0, 0, 0);
#undef PK
  pv_one<NCB, 1>(o[1], vb, pa0, pa1, pa2, pa3);
  if constexpr (NCB == 4) { pv_one<NCB, 2>(o[2], vb, pa0, pa1, pa2, pa3); pv_one<NCB, 3>(o[3], vb, pa0, pa1, pa2, pa3); }
}
constexpr int PP_NK = 4, PP_NV = 6;
constexpr int PP_KSLOT = 8192, PP_VSLOT = 16384, PP_LK = 0, PP_LV = PP_NK * PP_KSLOT, PP_LW = PP_LV + PP_NV * PP_VSLOT, PP_LDS = PP_LW + 8 * 64 * 4;
static_assert(PP_LDS <= 139264, "attention rings (the frame keeps its control words at byte 139264 of the 144 KiB)");
#define PP_BAR() do { asm volatile("s_waitcnt lgkmcnt(0)" ::: "memory"); __builtin_amdgcn_s_barrier(); asm volatile("" ::: "memory"); } while (0)
template <int DV, bool ALIBI, typename TO>
__device__ __forceinline__ void attn_unit_pp(const bf16_t* __restrict__ Qb, const bf16_t* __restrict__ Kh, const bf16_t* __restrict__ Vh, TO* __restrict__ Ob, int NT, int qpos0, float sl2, ALAS unsigned char* ldsl) {
  constexpr int NCB = DV / 32, NVI = DV / 32;
  int tid_ = threadIdx.x; asm volatile("" : "+v"(tid_));
  const int tid = tid_, lane = tid & 63, r32 = lane & 31, hi = lane >> 5;
  const int wid = __builtin_amdgcn_readfirstlane(tid >> 6), g = wid >> 2, wq = wid & 3;
  ALAS float* li_l = (ALAS float*)(ldsl + PP_LW) + wid * 64; ALAS float* al_l = li_l + 32;
  bf16x8 qr[4];
  const bf16_t* Qw = Qb + (long)(wid * 32 + r32) * LDZ + hi * 8;
#pragma unroll
  for (int d0 = 0; d0 < 4; ++d0) qr[d0] = *reinterpret_cast<const bf16x8*>(Qw + d0 * 16);
  const float dq0 = (float)(qpos0 + wid * 32 + r32 - 4 * hi);
  unsigned doff[NVI];
#pragma unroll
  for (int i = 0; i < NVI; ++i) {
    const int Lk = (wq * 2 + (i & 1)) * 64 + lane, row = Lk >> 3, c = (Lk & 7) ^ ((row >> 1) & 7);
    const int Lv = (wq * NVI + i) * 64 + lane, st = Lv >> 5, wi = Lv & 31, kk = (st / NCB) * 8 + (wi >> 2), kv = (kk & ~0xC) | ((kk & 4) << 1) | ((kk & 8) >> 1);
    doff[i] = g ? (unsigned)(row * LDZ + c * 8) * 2u : (unsigned)(kv * LDZ + (st % NCB) * 32 + (wi & 3) * 8) * 2u; }
  const char* dbase = g ? (const char*)Kh : (const char*)Vh;
  const int dlds = g ? (PP_LK + wq * 2 * 1024) : (PP_LV + wq * NVI * 1024), dss = g ? PP_KSLOT : PP_VSLOT, ni = g ? 2 : NVI;
#define DMA_T(t, slot) do { const char* tb_ = dbase + (size_t)(t) * (64 * LDZ * 2); ALAS unsigned char* ld_ = ldsl + dlds + (slot) * dss; \
    _Pragma("unroll") for (int i_ = 0; i_ < NVI; ++i_) if (i_ < ni) __builtin_amdgcn_global_load_lds((const unsigned*)(tb_ + doff[i_]), (ALAS unsigned*)(ld_ + i_ * 1024), 16, 0, 0); } while (0)
  const int vbase = (int)(unsigned)(uintptr_t)(ldsl + PP_LV) + v_rd_base(lane);
  float m_reg = 0.f, l_reg = 0.f; f32x16 o[NCB];
  f32x16 negm = f32x16{}; const int qw = qpos0 + wid * 32;
#pragma unroll
  for (int d = 0; d < NCB; ++d) o[d] = f32x16{};
  f32x16 S0 = f32x16{}, S1 = f32x16{}; bf16x8 pa0 = bf16x8{}, pa1 = bf16x8{}, pa2 = bf16x8{}, pa3 = bf16x8{};
  if (g == 1) { _Pragma("unroll") for (int t = 0; t < PP_NK; ++t) DMA_T(t, t); asm volatile("s_waitcnt vmcnt(6)" ::: "memory"); static_assert(PP_NK == 4, "prologue wait = 2 * (NK - 1)"); }
  else { _Pragma("unroll") for (int t = 0; t < PP_NV - 2; ++t) DMA_T(t, t); }
  PP_BAR();
#define CRF(r) ((float)(((r) & 3) + 8 * ((r) >> 2)))
#define M_STEP(k) do { const int k_ = (k); s16x4 vl_[4], vh_[4]; const int vb_ = vbase + ((k_ >= 0 ? k_ : 0) % PP_NV) * PP_VSLOT; \
    if (k_ >= 0) pv_issue0<NCB>(vl_, vh_, vb_); \
    if (k_ + 1 < NT) { const int ks_ = (k_ + 1) % PP_NK; \
      if constexpr (ALIBI) { const int kt0_ = 64 * (k_ + 1); const float dq_ = dq0 - (float)kt0_; \
        if (kt0_ + 63 <= qw || kt0_ >= qw + 31) {     \
          const float ssl_ = (kt0_ + 63 <= qw) ? sl2 : -sl2; const float e0_ = -m_reg - ssl_ * dq_, e1_ = e0_ + 32.f * ssl_; \
          _Pragma("unroll") for (int r = 0; r < 16; ++r) { S0[r] = fmaf(ssl_, CRF(r), e0_); S1[r] = fmaf(ssl_, CRF(r), e1_); } \
        } else { \
          _Pragma("unroll") for (int r = 0; r < 16; ++r) { const float t0_ = dq_ - CRF(r); S0[r] = fmaf(-sl2, fabsf(t0_), -m_reg); S1[r] = fmaf(-sl2, fabsf(t0_ - 32.f), -m_reg); } \
        } \
        qkt_acc(S0, S1, ldsl + PP_LK + ks_ * PP_KSLOT, qr, r32, hi); \
      } else { qkt_c(S0, S1, negm, ldsl + PP_LK + ks_ * PP_KSLOT, qr, r32, hi); } } \
    if (k_ >= 0) pv_rest<NCB>(o, vl_, vh_, vb_, pa0, pa1, pa2, pa3); } while (0)
#define PK4(P, BASE, OUT) do { unsigned a0 = cvtpk(P[BASE + 0], P[BASE + 1]), a1 = cvtpk(P[BASE + 2], P[BASE + 3]);   \
    unsigned b0 = cvtpk(P[BASE + 4], P[BASE + 5]), b1 = cvtpk(P[BASE + 6], P[BASE + 7]);                              \
    auto r0 = __builtin_amdgcn_permlane32_swap(a0, b0, false, false); auto r1 = __builtin_amdgcn_permlane32_swap(a1, b1, false, false); \
    u32x4 w = {r0[0], r1[0], r0[1], r1[1]}; OUT = *reinterpret_cast<bf16x8*>(&w); } while (0)
#define V_STEP(k) do { const int k_ = (k); \
    { const int tt_ = k_ + (g ? PP_NK : PP_NV - 2); if (tt_ < NT) DMA_T(tt_, g ? tt_ % PP_NK : tt_ % PP_NV); } \
    float pmax = S0[0]; \
    _Pragma("unroll") for (int r = 1; r < 16; ++r) pmax = fmaxf(pmax, S0[r]); \
    _Pragma("unroll") for (int r = 0; r < 16; ++r) pmax = fmaxf(pmax, S1[r]); \
    { auto rr = __builtin_amdgcn_permlane32_swap(__float_as_uint(pmax), __float_as_uint(pmax), false, false); \
      pmax = fmaxf(__uint_as_float(rr[0]), __uint_as_float(rr[1])); } \
    if (k_ == 0 || !__builtin_expect(__all(pmax <= THR2), 1)) {       \
      const float dl = (k_ == 0) ? pmax : fmaxf(pmax, 0.f); m_reg += dl; \
      _Pragma("unroll") for (int r = 0; r < 16; ++r) { S0[r] -= dl; S1[r] -= dl; } \
      if constexpr (!ALIBI) { _Pragma("unroll") for (int r = 0; r < 16; ++r) negm[r] = -m_reg; } \
      if (k_ != 0) { const float alpha = __builtin_amdgcn_exp2f(-dl); l_reg *= alpha; \
        if (hi == 0) al_l[r32] = alpha; \
        asm volatile("s_waitcnt lgkmcnt(0)" ::: "memory"); \
        _Pragma("unroll") for (int d = 0; d < NCB; ++d) _Pragma("unroll") for (int r = 0; r < 16; ++r) o[d][r] *= al_l[crow(r, hi)]; } } \
    _Pragma("unroll") for (int r = 0; r < 16; ++r) { S0[r] = __builtin_amdgcn_exp2f(S0[r]); S1[r] = __builtin_amdgcn_exp2f(S1[r]); } \
    float ps = 0.f, ps1 = 0.f, ps2 = 0.f, ps3 = 0.f; \
    _Pragma("unroll") for (int r = 0; r < 16; r += 2) { ps += S0[r]; ps1 += S0[r + 1]; ps2 += S1[r]; ps3 += S1[r + 1]; } \
    ps = (ps + ps1) + (ps2 + ps3); \
    { auto rr = __builtin_amdgcn_permlane32_swap(__float_as_uint(ps), __float_as_uint(ps), false, false); \
      ps = __uint_as_float(rr[0]) + __uint_as_float(rr[1]); } \
    l_reg += ps; \
    PK4(S0, 0, pa0); PK4(S0, 8, pa1); PK4(S1, 0, pa2); PK4(S1, 8, pa3); } while (0)
#define WAIT_V(n) asm volatile("s_waitcnt vmcnt(" #n ")" ::: "memory")
  if (g == 0) {
    M_STEP(-1); PP_BAR();
    for (int k = 0; k < NT; ++k) {
      V_STEP(k);
      { const int no_ = NT - 1 - k;
        static_assert(PP_NV == 6, "up to NV - 2 = 4 later V tiles in flight");
        if (no_ >= 4) { if constexpr (NVI == 4) WAIT_V(16); else WAIT_V(8); } else if (no_ == 3) { if constexpr (NVI == 4) WAIT_V(12); else WAIT_V(6); }
        else if (no_ == 2) { if constexpr (NVI == 4) WAIT_V(8); else WAIT_V(4); } else if (no_ == 1) { if constexpr (NVI == 4) WAIT_V(4); else WAIT_V(2); } else WAIT_V(0); }
      PP_BAR();
      M_STEP(k); PP_BAR();
    }
    PP_BAR();
  } else {
    PP_BAR();
    for (int k = 0; k < NT; ++k) {
      M_STEP(k - 1);
      { const int no_ = NT - 2 - k;
        if (no_ >= 2) WAIT_V(4); else if (no_ == 1) WAIT_V(2); else WAIT_V(0); }
      PP_BAR();
      V_STEP(k); PP_BAR();
    }
    M_STEP(NT - 1); PP_BAR();
  }
#undef M_STEP
#undef CRF
#undef V_STEP
#undef PK4
#undef WAIT_V
  if (hi == 0) li_l[r32] = l_reg; asm volatile("s_waitcnt lgkmcnt(0)" ::: "memory");
  float rli[16];
#pragma unroll
  for (int r = 0; r < 16; ++r) rli[r] = __builtin_amdgcn_rcpf(li_l[crow(r, hi)]);
  TO* Ow = Ob + (long)(wid * 32) * 1024;
#pragma unroll
  for (int r = 0; r < 16; ++r) { const int orow = crow(r, hi);
#pragma unroll
    for (int d0 = 0; d0 < NCB; ++d0) store_o(Ow + (long)orow * 1024 + d0 * 32 + r32, o[d0][r] * rli[r]); }
#undef DMA_T
}
#undef ALAS
}
namespace attn_body {
using bf16=__hip_bfloat16;
using bf16x8=__attribute__((ext_vector_type(8)))short;
using s16x4=__attribute__((ext_vector_type(4)))short;
using f32x16=__attribute__((ext_vector_type(16)))float;
using u32x4=__attribute__((ext_vector_type(4)))unsigned;
constexpr int D=64,DMQ=2368,DMK=2368,DMV=2368,DMO=1024;
constexpr int NW=8,QBLK=32,QB=QBLK*NW,KVBLK=64;
__device__ __forceinline__ int crow(int r,int hi){return (r&3)+8*(r>>2)+4*hi;}
#define SBAR() __builtin_amdgcn_sched_barrier(0)
__device__ __forceinline__ void cmask(f32x16&p0,f32x16&p1,int jb,int qrel,int hi){
  const float NEG=-INFINITY; int kb=64*jb+4*hi;
  #pragma unroll
  for(int r=0;r<16;++r){int kv=kb+(r&3)+8*(r>>2); if(kv>qrel)p0[r]=NEG; if(kv+32>qrel)p1[r]=NEG;}
}

constexpr int NSLOT=3, SLOTB=8192;
constexpr int LDS_K=0, LDS_V=NSLOT*SLOTB, LDS_WS=2*NSLOT*SLOTB, LDS_OST=LDS_WS+NW*64*4, LDS_BYTES=LDS_OST+NW*4096;
constexpr float C2=0.125f*1.4426950408889634f;
__device__ __forceinline__ void glds16(const void*gsrc,unsigned lds_dst){unsigned keep;
  asm volatile("s_mov_b32 %0, m0\n\ts_mov_b32 m0, %2\n\ts_nop 0\n\tglobal_load_lds_dwordx4 %1, off\n\ts_mov_b32 m0, %0":"=&s"(keep):"v"(gsrc),"s"(lds_dst):"memory");}
__device__ __forceinline__ float max3f(float a,float b,float c){float r;asm("v_max3_f32 %0, %1, %2, %3":"=v"(r):"v"(a),"v"(b),"v"(c));return r;}
__device__ __forceinline__ float max2f(float a,float b){float r;asm("v_max_f32_e32 %0, %1, %2":"=v"(r):"v"(a),"v"(b));return r;}
__device__ __forceinline__ float fadd_s(float a,float b){float r;asm("v_add_f32_e32 %0, %1, %2":"=v"(r):"v"(a),"v"(b));return r;}
__device__ __forceinline__ float fsub_s(float a,float b){float r;asm("v_sub_f32_e32 %0, %1, %2":"=v"(r):"v"(a),"v"(b));return r;}
typedef float f32x2_t __attribute__((ext_vector_type(2))); typedef __bf16 bf16x2_t __attribute__((ext_vector_type(2)));
__device__ __forceinline__ unsigned cvtpk_s(float lo,float hi){f32x2_t v={lo,hi};bf16x2_t b=__builtin_convertvector(v,bf16x2_t);return __builtin_bit_cast(unsigned,b);}
#define WAIT_BAR(N) asm volatile("s_waitcnt vmcnt(" #N ") lgkmcnt(0)\n\ts_barrier":::"memory")

__device__ __forceinline__ void qkt(f32x16&p0,f32x16&p1,const char*Kslot,const bf16x8*qr,const f32x16&negm,int r32,int hi){
  const char*kb=Kslot+hi*1024+r32*16;
  #pragma unroll
  for(int d0=0;d0<4;++d0){
    const bf16x8 b0=*reinterpret_cast<const bf16x8*>(kb+d0*2048);
    const bf16x8 b1=*reinterpret_cast<const bf16x8*>(kb+d0*2048+512);
    if(d0==0){p0=__builtin_amdgcn_mfma_f32_32x32x16_bf16(b0,qr[0],negm,0,0,0);p1=__builtin_amdgcn_mfma_f32_32x32x16_bf16(b1,qr[0],negm,0,0,0);}
    else{p0=__builtin_amdgcn_mfma_f32_32x32x16_bf16(b0,qr[d0],p0,0,0,0);p1=__builtin_amdgcn_mfma_f32_32x32x16_bf16(b1,qr[d0],p1,0,0,0);}}
}
typedef __attribute__((address_space(3))) const char* lds_cptr;
typedef short v4i16_t __attribute__((ext_vector_type(4)));
__device__ __forceinline__ void kload8(bf16x8*kf,lds_cptr kp){
  kf[0]=*(const __attribute__((address_space(3))) bf16x8*)(kp);      kf[1]=*(const __attribute__((address_space(3))) bf16x8*)(kp+512);
  kf[2]=*(const __attribute__((address_space(3))) bf16x8*)(kp+2048); kf[3]=*(const __attribute__((address_space(3))) bf16x8*)(kp+2560);
  kf[4]=*(const __attribute__((address_space(3))) bf16x8*)(kp+4096); kf[5]=*(const __attribute__((address_space(3))) bf16x8*)(kp+4608);
  kf[6]=*(const __attribute__((address_space(3))) bf16x8*)(kp+6144); kf[7]=*(const __attribute__((address_space(3))) bf16x8*)(kp+6656);
}
__device__ __forceinline__ void kload2(bf16x8*kf,lds_cptr kp,int j){ kf[2*j]=*(const __attribute__((address_space(3))) bf16x8*)(kp+j*2048); kf[2*j+1]=*(const __attribute__((address_space(3))) bf16x8*)(kp+j*2048+512); }
__device__ __forceinline__ s16x4 vtr(lds_cptr p){ return __builtin_bit_cast(s16x4,__builtin_amdgcn_ds_read_tr16_b64_v4i16((__attribute__((address_space(3))) v4i16_t*)p)); }
__device__ __forceinline__ float rowmax(const f32x16&p0,const f32x16&p1){
  float a=max3f(p0[0],p0[1],p1[0]),b=max3f(p0[2],p0[3],p1[1]);a=max3f(a,p1[2],p1[3]);
  #pragma unroll
  for(int r=4;r<16;r+=4){a=max3f(a,p0[r],p0[r+1]);b=max3f(b,p0[r+2],p0[r+3]);a=max3f(a,p1[r],p1[r+1]);b=max3f(b,p1[r+2],p1[r+3]);}
  const float m=max2f(a,b);
  auto rr=__builtin_amdgcn_permlane32_swap(__float_as_uint(m),__float_as_uint(m),false,false);
  return max2f(__uint_as_float(rr[0]),__uint_as_float(rr[1]));
}
__device__ __forceinline__ void pv(f32x16*o,int vb,bf16x8 pa0,bf16x8 pa1,bf16x8 pa2,bf16x8 pa3){
  #pragma unroll
  for(int d0=0;d0<2;++d0){s16x4 lo[4],hi[4];
    #pragma unroll
    for(int ks=0;ks<4;++ks){
      asm volatile("ds_read_b64_tr_b16 %0,%1 offset:%c2":"=&v"(lo[ks]):"v"(vb),"i"(d0*4096+ks*1024):"memory");
      asm volatile("ds_read_b64_tr_b16 %0,%1 offset:%c2":"=&v"(hi[ks]):"v"(vb),"i"(d0*4096+ks*1024+512):"memory");}
    asm volatile("s_waitcnt lgkmcnt(0)":::"memory");SBAR();
    #define PK(k) (bf16x8){lo[k][0],lo[k][1],lo[k][2],lo[k][3],hi[k][0],hi[k][1],hi[k][2],hi[k][3]}
    o[d0]=__builtin_amdgcn_mfma_f32_32x32x16_bf16(pa0,PK(0),o[d0],0,0,0);
    o[d0]=__builtin_amdgcn_mfma_f32_32x32x16_bf16(pa1,PK(1),o[d0],0,0,0);
    o[d0]=__builtin_amdgcn_mfma_f32_32x32x16_bf16(pa2,PK(2),o[d0],0,0,0);
    o[d0]=__builtin_amdgcn_mfma_f32_32x32x16_bf16(pa3,PK(3),o[d0],0,0,0);
    #undef PK
  }
}

#ifndef ATTN_STORE16
#define ATTN_STORE16(p,v) (*(u32x4*)(p)=(v))
#endif
template<int THRL> __device__ __forceinline__ void attn_unit(const bf16*Qb,const bf16*__restrict__ Kh,const bf16*__restrict__ Vh,bf16*Ob,const int NT,char*shm){
  const int tid=threadIdx.x,lane=tid&63,r32=lane&31,hi=lane>>5; const int wid=__builtin_amdgcn_readfirstlane(tid>>6);
  const bf16*Qw=Qb+(long)(wid*QBLK)*DMQ;
  const unsigned lds0=(unsigned)(uintptr_t)shm;
  float*wsf=(float*)(shm+LDS_WS)+wid*64;
  const bf16*ksrc=Kh+(long)lane*DMK+wid*8;
  const bf16*vsrc=Vh+(long)(16*(wid&3)+(lane>>2))*DMV+(wid>>2)*32+(lane&3)*8;
  const unsigned kdst=lds0+LDS_K+wid*1024, vdst=lds0+LDS_V+wid*1024;
  #define DMA_K(t,slot) glds16(ksrc+(long)(t)*KVBLK*DMK,(unsigned)__builtin_amdgcn_readfirstlane(kdst+(slot)))
  #define DMA_V(t,slot) glds16(vsrc+(long)(t)*KVBLK*DMV,(unsigned)__builtin_amdgcn_readfirstlane(vdst+(slot)))
  const int vb0=(int)(lds0+LDS_V)+((lane>>4)&1)*32+(lane&3)*8+(4*hi+((lane&15)>>2))*64;
  const char*Kbase=shm+LDS_K; bf16x8 kf[8];
  const lds_cptr shm3=(lds_cptr)shm; const lds_cptr kp0=shm3+LDS_K+hi*1024+r32*16; const lds_cptr vp0=shm3+LDS_V+((lane>>4)&1)*32+(lane&3)*8+(4*hi+((lane&15)>>2))*64;
  DMA_K(0,0);DMA_V(0,0);DMA_K(1,SLOTB);
  bf16x8 qr[4];
  #pragma unroll
  for(int d0=0;d0<4;++d0)qr[d0]=*reinterpret_cast<const bf16x8*>(&Qw[(long)r32*DMQ+d0*16+hi*8]);
  float mhat=0.f,l_reg=0.f;f32x16 o[2];o[0]=f32x16{};o[1]=f32x16{};f32x16 negm=f32x16{};asm volatile("":"+v"(negm));
  #define CMASK(P0,P1,t) do{}while(0)
  bool resc=false;
  #define START(P0,P1) do{ const float rm=rowmax(P0,P1); resc=false; \
    { const float dl=rm; mhat=fadd_s(mhat,dl); \
      _Pragma("unroll") for(int r=0;r<16;++r){P0[r]=fsub_s(P0[r],dl);P1[r]=fsub_s(P1[r],dl);} \
      _Pragma("unroll") for(int r=0;r<16;++r)negm[r]=-mhat; asm volatile("":"+v"(negm)); } \
    _Pragma("unroll") for(int r=0;r<16;++r)P0[r]=__builtin_amdgcn_exp2f(P0[r]); }while(0)
  #define RESC() do{ if(resc){ asm volatile("s_waitcnt lgkmcnt(0)":::"memory"); \
      _Pragma("unroll") for(int d_=0;d_<2;++d_) _Pragma("unroll") for(int r=0;r<16;++r)o[d_][r]*=wsf[crow(r,hi)]; } }while(0)
  f32x16 pA0,pA1,pB0,pB1;
  int sl_prev=0,sl_cur=0,sl_next=SLOTB;
  #define ROT() do{sl_prev=sl_cur;sl_cur=sl_next;sl_next=(sl_next==(NSLOT-1)*SLOTB)?0:sl_next+SLOTB;}while(0)
  DMA_K(2,2*SLOTB);
  WAIT_BAR(3);
  qkt(pA0,pA1,Kbase,qr,negm,r32,hi);asm volatile("s_nop 15\n\ts_nop 7":"+v"(pA0),"+v"(pA1));CMASK(pA0,pA1,0);
  START(pA0,pA1);
  _Pragma("unroll") for(int r=0;r<16;++r)pA1[r]=__builtin_amdgcn_exp2f(pA1[r]);
  WAIT_BAR(0);
  DMA_K(3,0);DMA_V(1,SLOTB);
  ROT();
  kload8(kf,kp0+sl_cur);
  WAIT_BAR(2);
  s16x4 vlo[8],vhi[8]; u32x4 pw0,pw1,pw2,pw3;
  #define PKW(P,B) cvtpk_s(P[B],P[B+1])
  #define PAF(k) __builtin_bit_cast(bf16x8,pw##k)
  #define VFR(i) (bf16x8){vlo[i][0],vlo[i][1],vlo[i][2],vlo[i][3],vhi[i][0],vhi[i][1],vhi[i][2],vhi[i][3]}
  #define PIN(x) asm volatile("":"+v"(x))
  #define MX3(a,b,c) __builtin_fmaxf(__builtin_fmaxf((a),(b)),(c))
  #define GAPA(MF,A0,A1,A2,A3,W0,W1,PW) do{ MF; sacc+=A0; sacc+=A1; sacc+=A2; sacc+=A3; PIN(sacc); W0; W1; PIN(PW); SBAR(); }while(0)
  #define EX(v) __builtin_amdgcn_exp2f(v)
  #define GAPB(MF,X,B) do{ MF; X[B]=EX(X[B]); X[B+1]=EX(X[B+1]); X[B+2]=EX(X[B+2]); X[B+3]=EX(X[B+3]); PIN(X); SBAR(); }while(0)
  #define VRD(i) do{ vlo[i]=vtr(vp_+(((i)>>2)*4096+((i)&3)*1024)); vhi[i]=vtr(vp_+(((i)>>2)*4096+((i)&3)*1024+512)); }while(0)
  #define KRD(G,j) do{ if(G){ kload2(kf,kp0+sl_next,j); SBAR(); } }while(0)
  #define STEP(C0,C1,P0,P1,t,GK,GV,GL) do{ SBAR(); \
    const lds_cptr vp_=vp0+sl_prev; \
    VRD(0); SBAR(); float sacc=(P0[0]+P0[1]); \
    GAPA(C0=__builtin_amdgcn_mfma_f32_32x32x16_bf16(kf[0],qr[0],negm,0,0,0), P0[2],P0[3],P0[4],P0[5],     pw0[0]=PKW(P0,0), pw0[1]=PKW(P0,2), pw0); \
    VRD(4); SBAR(); GAPA(C1=__builtin_amdgcn_mfma_f32_32x32x16_bf16(kf[1],qr[0],negm,0,0,0), P0[6],P0[7],P0[8],P0[9],     pw0[2]=PKW(P0,4), pw0[3]=PKW(P0,6), pw0); \
    VRD(1); SBAR(); GAPA(C0=__builtin_amdgcn_mfma_f32_32x32x16_bf16(kf[2],qr[1],C0,0,0,0),   P0[10],P0[11],P0[12],P0[13], pw1[0]=PKW(P0,8), pw1[1]=PKW(P0,10), pw1); \
    VRD(5); SBAR(); GAPA(C1=__builtin_amdgcn_mfma_f32_32x32x16_bf16(kf[3],qr[1],C1,0,0,0),   P0[14],P0[15],P1[0],P1[1],   pw1[2]=PKW(P0,12),pw1[3]=PKW(P0,14), pw1); \
    VRD(2); SBAR(); GAPA(C0=__builtin_amdgcn_mfma_f32_32x32x16_bf16(kf[4],qr[2],C0,0,0,0),   P1[2],P1[3],P1[4],P1[5],     pw2[0]=PKW(P1,0), pw2[1]=PKW(P1,2), pw2); \
    VRD(6); SBAR(); GAPA(C1=__builtin_amdgcn_mfma_f32_32x32x16_bf16(kf[5],qr[2],C1,0,0,0),   P1[6],P1[7],P1[8],P1[9],     pw2[2]=PKW(P1,4), pw2[3]=PKW(P1,6), pw2); \
    VRD(3); SBAR(); GAPA(C0=__builtin_amdgcn_mfma_f32_32x32x16_bf16(kf[6],qr[3],C0,0,0,0),   P1[10],P1[11],P1[12],P1[13], pw3[0]=PKW(P1,8), pw3[1]=PKW(P1,10), pw3); \
    VRD(7); SBAR(); GAPA(C1=__builtin_amdgcn_mfma_f32_32x32x16_bf16(kf[7],qr[3],C1,0,0,0),   P1[14],P1[15],0.f,0.f,       pw3[2]=PKW(P1,12),pw3[3]=PKW(P1,14), pw3); \
    l_reg+=sacc; \
    if(GK){DMA_K((t)+3,sl_cur);} if(GV){DMA_V((t)+1,sl_next);} \
    CMASK(C0,C1,t); \
    { float a=MX3(C0[0],C0[1],C1[0]),b=MX3(C0[2],C0[3],C1[1]); a=MX3(a,C1[2],C1[3]); \
      _Pragma("unroll") for(int r=4;r<16;r+=4){a=MX3(a,C0[r],C0[r+1]);b=MX3(b,C0[r+2],C0[r+3]);a=MX3(a,C1[r],C1[r+1]);b=MX3(b,C1[r+2],C1[r+3]);} \
      float rm=__builtin_fmaxf(a,b); { auto rr=__builtin_amdgcn_permlane32_swap(__float_as_uint(rm),__float_as_uint(rm),false,false); rm=__builtin_fmaxf(__uint_as_float(rr[0]),__uint_as_float(rr[1])); } \
      resc=false; \
      if(__builtin_expect(__any(rm>(float)THRL),0)){ const float dl=__builtin_fmaxf(rm,0.f); mhat+=dl; \
        _Pragma("unroll") for(int r=0;r<16;++r){C0[r]-=dl;C1[r]-=dl;} \
        _Pragma("unroll") for(int r=0;r<16;++r)negm[r]=-mhat; asm volatile("":"+v"(negm)); \
        const float f=__builtin_amdgcn_exp2f(-dl); l_reg*=f; if(hi==0)wsf[r32]=f; resc=true; } } \
    SBAR(); \
    GAPB(o[0]=__builtin_amdgcn_mfma_f32_32x32x16_bf16(PAF(0),VFR(0),o[0],0,0,0), C0,0); \
    GAPB(o[1]=__builtin_amdgcn_mfma_f32_32x32x16_bf16(PAF(0),VFR(4),o[1],0,0,0), C0,4); \
    KRD(GL,0); GAPB(o[0]=__builtin_amdgcn_mfma_f32_32x32x16_bf16(PAF(1),VFR(1),o[0],0,0,0), C0,8); \
    KRD(GL,1); GAPB(o[1]=__builtin_amdgcn_mfma_f32_32x32x16_bf16(PAF(1),VFR(5),o[1],0,0,0), C0,12); \
    KRD(GL,2); GAPB(o[0]=__builtin_amdgcn_mfma_f32_32x32x16_bf16(PAF(2),VFR(2),o[0],0,0,0), C1,0); \
    KRD(GL,3); GAPB(o[1]=__builtin_amdgcn_mfma_f32_32x32x16_bf16(PAF(2),VFR(6),o[1],0,0,0), C1,4); \
    GAPB(o[0]=__builtin_amdgcn_mfma_f32_32x32x16_bf16(PAF(3),VFR(3),o[0],0,0,0), C1,8); \
    GAPB(o[1]=__builtin_amdgcn_mfma_f32_32x32x16_bf16(PAF(3),VFR(7),o[1],0,0,0), C1,12); \
    }while(0)
  int t=1;
  #undef CMASK
  #define CMASK(P0,P1,t) do{}while(0)
  for(;t+5<NT;t+=2){
    STEP(pB0,pB1,pA0,pA1,t,true,true,true);     WAIT_BAR(2); RESC(); ROT();
    STEP(pA0,pA1,pB0,pB1,t+1,true,true,true);   WAIT_BAR(2); RESC(); ROT();
  }
  #undef CMASK
  #define CMASK(P0,P1,t) do{}while(0)
  #define ENDW(tt) do{ if((tt)+3<NT){WAIT_BAR(2);} else if((tt)+2<NT){WAIT_BAR(1);} else {WAIT_BAR(0);} }while(0)
  for(;t+1<NT;t+=2){
    STEP(pB0,pB1,pA0,pA1,t,(t+3<NT),(t+1<NT),(t+1<NT));       ENDW(t);   RESC(); ROT();
    STEP(pA0,pA1,pB0,pB1,t+1,(t+4<NT),(t+2<NT),(t+2<NT));     ENDW(t+1); RESC(); ROT();
  }
  STEP(pB0,pB1,pA0,pA1,NT-1,false,false,false); RESC();
  { float sacc=pB0[0]+pB0[1]; _Pragma("unroll") for(int r=2;r<16;++r)sacc+=pB0[r]; _Pragma("unroll") for(int r=0;r<16;++r)sacc+=pB1[r]; l_reg+=sacc;
    pw0=(u32x4){PKW(pB0,0),PKW(pB0,2),PKW(pB0,4),PKW(pB0,6)};pw1=(u32x4){PKW(pB0,8),PKW(pB0,10),PKW(pB0,12),PKW(pB0,14)};pw2=(u32x4){PKW(pB1,0),PKW(pB1,2),PKW(pB1,4),PKW(pB1,6)};pw3=(u32x4){PKW(pB1,8),PKW(pB1,10),PKW(pB1,12),PKW(pB1,14)};
    SBAR(); pv(o,vb0+sl_cur,PAF(0),PAF(1),PAF(2),PAF(3)); }
  #undef PKW
  #undef PAF
  #undef VFR
  #undef PIN
  #undef MX3
  #undef GAPA
  #undef GAPB
  #undef EX
  #undef VRD
  #undef KRD
  #undef STEP
  #undef ENDW
  {auto rr=__builtin_amdgcn_permlane32_swap(__float_as_uint(l_reg),__float_as_uint(l_reg),false,false);l_reg=__uint_as_float(rr[0])+__uint_as_float(rr[1]);}
  if(hi==0)wsf[32+r32]=l_reg;asm volatile("s_waitcnt lgkmcnt(0)":::"memory");
  float rli[16];
  #pragma unroll
  for(int r=0;r<16;++r)rli[r]=__builtin_amdgcn_rcpf(wsf[32+crow(r,hi)]);
  bf16*Ow=Ob+(long)(wid*QBLK)*DMO;
  { bf16*stg=(bf16*)(shm+LDS_OST)+wid*2048;
    #pragma unroll
    for(int r=0;r<16;++r){const int orow=crow(r,hi);
      #pragma unroll
      for(int d0=0;d0<2;++d0)stg[orow*64+d0*32+r32]=__float2bfloat16(o[d0][r]*rli[r]);}
    asm volatile("s_waitcnt lgkmcnt(0)":::"memory");
    #pragma unroll
    for(int i=0;i<4;++i){const int row=i*8+(lane>>3),ch=lane&7; const u32x4 v=*(const u32x4*)(stg+row*64+ch*8); ATTN_STORE16(Ow+(long)row*DMO+ch*8,v);} }
  asm volatile("s_waitcnt lgkmcnt(0)\n\ts_barrier":::"memory");
  #undef DMA_K
  #undef DMA_V
  #undef CMASK
  #undef START
  #undef RESC
  #undef ROT
}
constexpr int ATTN_LDS_BYTES=LDS_BYTES;
#undef SBAR
#undef WAIT_BAR
}
typedef unsigned short bf16;
typedef unsigned v4u __attribute__((ext_vector_type(4)));
typedef float f32x4 __attribute__((ext_vector_type(4)));
#define LAS __attribute__((address_space(3)))
constexpr int NWAVES = 8;
constexpr int D = 1024, FF = 4096, NIN = 2304, PLE = 256;
constexpr int ZP = att::LDZ;
constexpr int MP = 4 * 8192, MS = 8 * 2048, M = MP + MS;
constexpr int SEQ_P = 8192, SEQ_S = 2048;
constexpr float C2 = 0.125f * 1.4426950408889634f;
constexpr float LOG2E = 1.4426950408889634f;
constexpr size_t MiB = 1u << 20;
constexpr size_t WS_RSP1 = 1 * MiB, WS_RSP2 = 4 * MiB, WS_RSP3 = 7 * MiB;
constexpr size_t WS_WIN = 10 * MiB, WS_WOUT = 15 * MiB, WS_W1 = 17 * MiB, WS_W2 = 25 * MiB, WS_WG = 33 * MiB, WS_WP = 35 * MiB;
constexpr size_t WS_PB = 36 * MiB;
constexpr size_t WS_PROJ = 60 * MiB;
constexpr size_t WS_Z = 156 * MiB;
constexpr size_t WS_HB = 156 * MiB;
constexpr size_t WS_XN = 380 * MiB;
constexpr size_t WS_H = 252 * MiB;
constexpr size_t WS_END = 512 * MiB;
static_assert(WS_XN + (size_t)M * D * 2 <= WS_END && WS_Z + (size_t)M * ZP * 2 <= WS_XN && WS_H + (size_t)16384 * FF * 2 <= WS_END && WS_HB + (size_t)M * D * 2 <= WS_H, "d_ws map");
constexpr int CW_QMAX = 3584, CW_KMAX = 3648, CW_DNEG = 3616, CW_QUEUE = 3712;
constexpr int CTL_BYTES = 32768;
constexpr float SKIP_T = 32.0f;
constexpr int LDS_BYTES = 147456;
static_assert(att::ATTN_LDS <= 131072 && attn_body::ATTN_LDS_BYTES <= 131072 && attn_body::DMQ == ZP, "attention LDS / pitches");

__device__ __forceinline__ unsigned f2bf(float f) { unsigned u = __builtin_bit_cast(unsigned, f); return (u + 0x7fffu + ((u >> 16) & 1u)) >> 16; }
__device__ __forceinline__ unsigned pk2(float lo, float hi) { return f2bf(lo) | (f2bf(hi) << 16); }
__device__ __forceinline__ float wave_sum(float v) {
#pragma unroll
    for (int o = 1; o < 64; o <<= 1) v += __shfl_xor(v, o);
    return v;
}
__device__ __forceinline__ void transpose_item(const float* W, int K, int N, const float* g, bf16* WT, LAS float* scr, int item, int lane) {
    const int nblk = N / 32, kb = item / nblk, nb = item % nblk, k0 = 64 * kb, n0 = 32 * nb;
#pragma unroll 8
    for (int i = 0; i < 32; ++i) { const int kk = 2 * i + (lane >> 5); const float gs = g ? g[k0 + kk] : 1.f; scr[kk * 33 + (lane & 31)] = W[(size_t)(k0 + kk) * N + n0 + (lane & 31)] * gs; }
    asm volatile("s_waitcnt lgkmcnt(0)" ::: "memory");
    const int c = lane & 7;
#pragma unroll
    for (int j = 0; j < 4; ++j) { const int n = (lane >> 3) + 8 * j; const LAS float* s = scr + (8 * c) * 33 + n;
        v4u o; o.x = pk2(s[0 * 33], s[1 * 33]); o.y = pk2(s[2 * 33], s[3 * 33]); o.z = pk2(s[4 * 33], s[5 * 33]); o.w = pk2(s[6 * 33], s[7 * 33]);
        *(v4u*)(WT + (size_t)(n0 + n) * K + k0 + 8 * c) = o; }
    asm volatile("s_waitcnt lgkmcnt(0)" ::: "memory");
}

#define XB_TMO      128
#define XB_XCNT(j)  (256  + 64 * (j))
#define XB_XSUB(j)  (1280 + 64 * (j))
#define XB_XGEN(j)  (2304 + 64 * (j))
#define XB_TOP      3328
#define XB_TOPGEN   3392
#define XCD_BAR_WORDS 3456
#define XB_SPIN_CAP (1u << 22)

__device__ __forceinline__ unsigned xb_ld(unsigned* p)              { return __hip_atomic_load(p, __ATOMIC_RELAXED, __HIP_MEMORY_SCOPE_AGENT); }
__device__ __forceinline__ unsigned xb_add(unsigned* p, unsigned v) { return __hip_atomic_fetch_add(p, v, __ATOMIC_RELAXED, __HIP_MEMORY_SCOPE_AGENT); }
__device__ __forceinline__ unsigned xb_xcc_id() { return (unsigned)__builtin_amdgcn_s_getreg((3 << 11) | 20) & 0xFu; }
#define XB_SPIN(cond, bar) do { unsigned _sp = 0; while (cond) { __builtin_amdgcn_s_sleep(1); \
    if ((++_sp & 255u) == 0u) { if (xb_ld(&(bar)[XB_TMO])) break; if (_sp > XB_SPIN_CAP) { atomicAdd(&(bar)[XB_TMO], 1u); break; } } } } while (0)

struct XcdBarrier {
    unsigned* bar; unsigned x;
    volatile LAS unsigned* st;
};

__device__ __forceinline__ XcdBarrier xcd_barrier_post(unsigned* bar, volatile LAS unsigned* st) {
    XcdBarrier b; b.bar = bar; b.x = xb_xcc_id(); b.st = st;
    if (threadIdx.x == 0) (void)xb_add(&bar[XB_XCNT(b.x)], 1u);
    return b;
}
__device__ __forceinline__ void xcd_barrier_complete(unsigned* bar, unsigned x, unsigned& nloc, unsigned& nx) {
    const unsigned G = gridDim.x * gridDim.y * gridDim.z;
    unsigned sum, cnt, mine, sp = 0u;
    for (;;) {
        sum = 0u; cnt = 0u; mine = 0u;
#pragma unroll
        for (unsigned j = 0; j < 16; ++j) { const unsigned c = xb_ld(&bar[XB_XCNT(j)]); sum += c; cnt += (c > 0u) ? 1u : 0u; mine = (j == x) ? c : mine; }
        if (sum == G) break;
        __builtin_amdgcn_s_sleep(1);
        if ((++sp & 255u) == 0u) { if (xb_ld(&bar[XB_TMO])) break; if (sp > XB_SPIN_CAP) { atomicAdd(&bar[XB_TMO], 1u); break; } }
    }
    nloc = mine > 0u ? mine : 1u; nx = cnt > 0u ? cnt : 1u;
}

__device__ __forceinline__ void xcd_barrier(const XcdBarrier& b) {
    asm volatile("s_waitcnt vmcnt(0)" ::: "memory");
    __syncthreads();
    if (threadIdx.x == 0) {
        unsigned* bar = b.bar;
        __builtin_amdgcn_s_waitcnt(0);
        unsigned nloc = b.st[0], nx = b.st[1];
        if (nloc == 0u) { xcd_barrier_complete(bar, b.x, nloc, nx); b.st[0] = nloc; b.st[1] = nx; }
        const unsigned old = xb_add(&bar[XB_XSUB(b.x)], 1u);
        const unsigned gen = old / nloc;
        if (old + 1u == (gen + 1u) * nloc) {
            __builtin_amdgcn_fence(__ATOMIC_RELEASE, "agent");
            asm volatile("s_waitcnt vmcnt(0)" ::: "memory");
            const unsigned og = xb_add(&bar[XB_TOP], 1u);
            const unsigned tg = og / nx;
            if (og + 1u == (tg + 1u) * nx) xb_add(&bar[XB_TOPGEN], 1u);
            else XB_SPIN(xb_ld(&bar[XB_TOPGEN]) == tg, bar);
            __builtin_amdgcn_fence(__ATOMIC_ACQUIRE, "agent");
            xb_add(&bar[XB_XGEN(b.x)], 1u);
            asm volatile("s_waitcnt vmcnt(0)" ::: "memory");
        } else {
            XB_SPIN(xb_ld(&bar[XB_XGEN(b.x)]) == gen, bar);
            __builtin_amdgcn_fence(__ATOMIC_ACQUIRE, "agent");
            asm volatile("s_waitcnt vmcnt(0)" ::: "memory");
        }
    }
    __syncthreads();
}

struct Args { const float* in[21]; float* out; unsigned char* ws; };

__global__ void __launch_bounds__(NWAVES * 64, 2) fwd_mega(Args args) {
    extern __shared__ __attribute__((aligned(16))) unsigned char lds[];
    cg::grid_group grid = cg::this_grid();
#define PHASE_IDS() int tid_p = threadIdx.x; asm volatile("" : "+v"(tid_p)); const int tid = tid_p, lane = tid & 63, wave = __builtin_amdgcn_readfirstlane(tid >> 6); const int gw = bx * NWAVES + wave; (void)lane; (void)gw; (void)tid
    const int G = gridDim.x, bx = blockIdx.x;
    const int NGW = G * NWAVES;
    unsigned char* ws = args.ws;
    const float* x_p = args.in[0]; const float* x_s = args.in[1]; const float* p_p = args.in[2]; const float* p_s = args.in[3];
    const float* w_in = args.in[4]; const float* g_mix = args.in[5];
    const float* lq1 = args.in[6]; const float* lk1 = args.in[7]; const float* lq2 = args.in[8]; const float* lk2 = args.in[9];
    const float* g_subln = args.in[10]; const float* g_qn = args.in[11]; const float* g_kn = args.in[12];
    const float* w_out = args.in[13]; const float* g_mlp = args.in[14]; const float* w_ff1 = args.in[15]; const float* w_ff2 = args.in[16];
    const float* g_ple = args.in[17]; const float* w_gate = args.in[18]; const float* w_proj = args.in[19]; const float* g_final = args.in[20];
    float* out = args.out;
    float* RSP1 = (float*)(ws + WS_RSP1); float* RSP2 = (float*)(ws + WS_RSP2); float* RSP3 = (float*)(ws + WS_RSP3);
    bf16* WinT = (bf16*)(ws + WS_WIN); bf16* WoutT = (bf16*)(ws + WS_WOUT); bf16* W1T = (bf16*)(ws + WS_W1); bf16* W2T = (bf16*)(ws + WS_W2); bf16* WgT = (bf16*)(ws + WS_WG); bf16* WpT = (bf16*)(ws + WS_WP);
    bf16* PB = (bf16*)(ws + WS_PB); bf16* PROJ = (bf16*)(ws + WS_PROJ); bf16* Z = (bf16*)(ws + WS_Z); bf16* HB = (bf16*)(ws + WS_HB);
    bf16* XN = (bf16*)(ws + WS_XN); bf16* MIX = XN; bf16* HH = (bf16*)(ws + WS_H);
    LAS unsigned char* ldsl = (LAS unsigned char*)lds;
    volatile LAS unsigned* bst = (volatile LAS unsigned*)(ldsl + 139264);
    if (threadIdx.x < 2) bst[threadIdx.x] = 0u;
    __syncthreads();
    const XcdBarrier bar = xcd_barrier_post((unsigned*)ws, bst);
    if (ws == nullptr) grid.sync();

#ifndef NO_P0
#ifdef PROBE_EW2
    for (int rep = 0; rep < 2; ++rep)
#endif
    {
        PHASE_IDS();
        LAS float* scr = (LAS float*)(ldsl + wave * 16384);
        constexpr int I_IN = (D / 64) * (NIN / 32), I_OUT = (D / 64) * (D / 32), I_1 = (D / 64) * (FF / 32), I_2 = (FF / 64) * (D / 32), I_G = I_OUT, I_P = (PLE / 64) * (D / 32);
        constexpr int NITEMS = I_IN + I_OUT + I_1 + I_2 + I_G + I_P;
        for (int it = gw; it < NITEMS; it += NGW) {
            int r = it;
            if (r < I_IN) { transpose_item(w_in, D, NIN, nullptr, WinT, scr, r, lane); continue; } r -= I_IN;
            if (r < I_OUT) { transpose_item(w_out, D, D, nullptr, WoutT, scr, r, lane); continue; } r -= I_OUT;
            if (r < I_1) { transpose_item(w_ff1, D, FF, g_mlp, W1T, scr, r, lane); continue; } r -= I_1;
            if (r < I_2) { transpose_item(w_ff2, FF, D, nullptr, W2T, scr, r, lane); continue; } r -= I_2;
            if (r < I_G) { transpose_item(w_gate, D, D, g_ple, WgT, scr, r, lane); continue; } r -= I_G;
            transpose_item(w_proj, PLE, D, nullptr, WpT, scr, r, lane);
        }
        f32x4 gv[4];
#pragma unroll
        for (int j = 0; j < 4; ++j) gv[j] = *((const f32x4*)g_mix + lane + 64 * j);
        for (int m0 = gw * 2; m0 < M; m0 += NGW * 2) {
            f32x4 v[2][4], pv[2];
#pragma unroll
            for (int r = 0; r < 2; ++r) { const int m = m0 + r;
                const float* xrow = m < MP ? x_p + (size_t)m * D : x_s + (size_t)(m - MP) * D;
                const float* prow = m < MP ? p_p + (size_t)m * PLE : p_s + (size_t)(m - MP) * PLE;
#pragma unroll
                for (int j = 0; j < 4; ++j) v[r][j] = *((const f32x4*)xrow + lane + 64 * j);
                pv[r] = *((const f32x4*)prow + lane); }
#pragma unroll
            for (int r = 0; r < 2; ++r) { const int m = m0 + r; float s = 0.f;
#pragma unroll
                for (int j = 0; j < 4; ++j) s += (v[r][j].x * v[r][j].x + v[r][j].y * v[r][j].y) + (v[r][j].z * v[r][j].z + v[r][j].w * v[r][j].w);
                const float rstd = 1.0f / sqrtf(wave_sum(s) * (1.0f / D) + 1e-6f);
                unsigned long long* o8 = (unsigned long long*)(XN + (size_t)m * D) + lane;
#pragma unroll
                for (int j = 0; j < 4; ++j) { const f32x4 y = v[r][j] * rstd * gv[j]; o8[64 * j] = (unsigned long long)pk2(y.x, y.y) | ((unsigned long long)pk2(y.z, y.w) << 32); }
                *((unsigned long long*)(PB + (size_t)m * PLE) + lane) = (unsigned long long)pk2(pv[r].x, pv[r].y) | ((unsigned long long)pk2(pv[r].z, pv[r].w) << 32); }
        }
    }
#endif
    xcd_barrier(bar);

#ifndef NO_P1
#ifdef PROBE_GEMM2
    for (int rep = 0; rep < 2; ++rep)
#endif
    {
        pg8::Gemm g{XN, WinT, M, NIN, D}; pg8::StaticOrder S; S.init(M, NIN, G, bx);
        pg8::EpiBf E{Z, ZP, C2, 2};
        pg8::gemm_phase<pg8::EpiBf, pg8::StaticOrder, true, true>(ldsl, g, S, E);
    }
    {
        pg8::Gemm g{PB, WpT, M, D, PLE}; pg8::StaticOrder S; S.init(M, D, G, bx);
        pg8::EpiBf E{PROJ, D, 1.f, 0};
        pg8::gemm_phase<pg8::EpiBf, pg8::StaticOrder, true, true>(ldsl, g, S, E);
    }
#endif
    xcd_barrier(bar);

#ifndef NO_P1B
    {
        int tl = threadIdx.x; asm volatile("" : "+v"(tl));
        const long nth = (long)G * 512;
        const int j4 = (tl & 3) * 4;
        {
            float mq = 0.f, mk = 0.f, md = 0.f;
            for (long it = (long)bx * 512 + tl; it < (long)M * 32; it += nth) {
                const long item = it >> 2; const int m = (int)(item >> 3), hc = (int)(item & 7);
                const bf16* p = Z + (size_t)m * ZP + hc * 64 + j4; float sq = 0.f, sk = 0.f, sd = 0.f;
#pragma unroll
                for (int q = 0; q < 4; ++q) { const unsigned long long w = *(const unsigned long long*)(p + 16 * q), wk = *(const unsigned long long*)(p + 512 + 16 * q);
                    const unsigned lo = (unsigned)w, hi = (unsigned)(w >> 32), klo = (unsigned)wk, khi = (unsigned)(wk >> 32);
                    const float a = __uint_as_float(lo << 16), b = __uint_as_float(lo & 0xffff0000u), c = __uint_as_float(hi << 16), d = __uint_as_float(hi & 0xffff0000u);
                    const float ka = __uint_as_float(klo << 16), kb = __uint_as_float(klo & 0xffff0000u), kc = __uint_as_float(khi << 16), kd = __uint_as_float(khi & 0xffff0000u);
                    sq += (a * a + b * b) + (c * c + d * d); sk += (ka * ka + kb * kb) + (kc * kc + kd * kd); sd += (a * ka + b * kb) + (c * kc + d * kd); }
                sq += __shfl_xor(sq, 1); sq += __shfl_xor(sq, 2); sk += __shfl_xor(sk, 1); sk += __shfl_xor(sk, 2); sd += __shfl_xor(sd, 1); sd += __shfl_xor(sd, 2);
                mq = fmaxf(mq, sq); mk = fmaxf(mk, sk); md = fmaxf(md, -sd);
            }
#pragma unroll
            for (int o = 1; o < 64; o <<= 1) { mq = fmaxf(mq, __shfl_xor(mq, o)); mk = fmaxf(mk, __shfl_xor(mk, o)); md = fmaxf(md, __shfl_xor(md, o)); }
            if ((tl & 63) == 0) { atomicMax((unsigned*)ws + CW_QMAX, __float_as_uint(sqrtf(mq) * 1.0001f)); atomicMax((unsigned*)ws + CW_KMAX, __float_as_uint(sqrtf(mk) * 1.0001f));
                                  atomicMax((unsigned*)ws + CW_DNEG, __float_as_uint(md * 1.0001f + 1e-3f)); }
        }
        for (long it = (long)bx * 512 + tl; it < (long)M * 40; it += nth) {
            const long item = it >> 2;
            const int m = (int)(item / 10), hh = (int)(item % 10);
            const int t = m < MP ? (m & (SEQ_P - 1)) : ((m - MP) & (SEQ_S - 1));
            bf16* p = Z + (size_t)m * ZP + 1536 + hh * 64 + j4;
            const float* gg = (hh < 8 ? g_qn : g_kn) + j4;
            float v[4][4]; float ss = 0.f;
#pragma unroll
            for (int q = 0; q < 4; ++q) { const unsigned long long w = *(const unsigned long long*)(p + 16 * q); const unsigned lo = (unsigned)w, hi = (unsigned)(w >> 32);
                v[q][0] = __uint_as_float(lo << 16); v[q][1] = __uint_as_float(lo & 0xffff0000u); v[q][2] = __uint_as_float(hi << 16); v[q][3] = __uint_as_float(hi & 0xffff0000u);
                ss += (v[q][0] * v[q][0] + v[q][1] * v[q][1]) + (v[q][2] * v[q][2] + v[q][3] * v[q][3]); }
            ss += __shfl_xor(ss, 1); ss += __shfl_xor(ss, 2);
            const float rstd = 1.0f / sqrtf(ss * (1.0f / 64.0f) + 1e-6f);
#pragma unroll
            for (int q = 0; q < 4; ++q) { const f32x4 g4 = *(const f32x4*)(gg + 16 * q);
#pragma unroll
                for (int e = 0; e < 4; ++e) v[q][e] = v[q][e] * rstd * g4[e]; }
            const float fr = (float)(t >> 6), fc = (float)(t & 63), osc = hh < 8 ? C2 : 1.f;
#pragma unroll
            for (int e = 0; e < 4; ++e) {
                const float invf = __builtin_amdgcn_exp2f(-(float)(j4 + e) * (13.287712379549449f / 16.0f));
                const float ar = fr * invf, ac = fc * invf;
                const float cr = __cosf(ar), sr = __sinf(ar), cc = __cosf(ac), sc = __sinf(ac);
                const float a1 = v[0][e], a2 = v[1][e]; v[0][e] = (a1 * cr - a2 * sr) * osc; v[1][e] = (a1 * sr + a2 * cr) * osc;
                const float b1 = v[2][e], b2 = v[3][e]; v[2][e] = (b1 * cc - b2 * sc) * osc; v[3][e] = (b1 * sc + b2 * cc) * osc;
            }
#pragma unroll
            for (int q = 0; q < 4; ++q) *(unsigned long long*)(p + 16 * q) = (unsigned long long)pk2(v[q][0], v[q][1]) | ((unsigned long long)pk2(v[q][2], v[q][3]) << 32);
        }
    }
#endif
    xcd_barrier(bar);

#ifndef NO_P2
    {
        const float qkb = __uint_as_float(((const unsigned*)ws)[CW_QMAX]) * __uint_as_float(((const unsigned*)ws)[CW_KMAX]) + __uint_as_float(((const unsigned*)ws)[CW_DNEG]) + SKIP_T;
        PHASE_IDS();
        volatile LAS int* qslot = (volatile LAS int*)(ldsl + 139280);
        const int x0 = (int)(bar.x & 7u);
        for (int dx = 0; dx < 8; ++dx) {
            const int x = (x0 + dx) & 7;
            for (;;) {
                if (tid == 0) *qslot = (int)__hip_atomic_fetch_add((unsigned*)ws + CW_QUEUE + 64 * x, 1u, __ATOMIC_RELAXED, __HIP_MEMORY_SCOPE_AGENT);
                __syncthreads();
                const int i = *qslot;
                __syncthreads();
                if (i >= 384) break;
                int kind, h = 0, c = 0, head = 0, qb;
                if (i < 32) { kind = 0; h = 3; qb = i; }
                else if (i < 64) { kind = 0; h = 2; qb = i - 32; }
                else if (i < 192) { kind = 1; head = (x & 1) * 4 + ((i - 64) >> 5); qb = (i - 64) & 31; }
                else if (i < 224) { kind = 0; h = 1; qb = i - 192; }
                else if (i < 256) { kind = 2; h = 3 - ((i - 224) >> 4); c = ((i - 224) & 15) >> 3; qb = (i - 224) & 7; }
                else if (i < 320) { kind = 3; head = (i - 256) >> 3; qb = (i - 256) & 7; }
                else if (i < 336) { kind = 2; h = 1; c = (i - 320) >> 3; qb = (i - 320) & 7; }
                else if (i < 368) { kind = 0; h = 0; qb = i - 336; }
                else { kind = 2; h = 0; c = (i - 368) >> 3; qb = (i - 368) & 7; }
                const bool prompt = kind < 2;
                const int b = prompt ? (x >> 1) : x; if (kind == 0) c = x & 1;
                const int S = prompt ? SEQ_P : SEQ_S; const long rowbase = prompt ? (long)b * SEQ_P : (long)MP + (long)b * SEQ_S;
                const int q0 = qb * 256, NT = S / 64;
                const bf16* Zb = Z + rowbase * ZP;
                if (!(kind & 1)) {
                    const float slope = (h == 0 ? 0.25f : h == 1 ? 0.0625f : h == 2 ? 0.015625f : 0.00390625f), sl2 = LOG2E * slope;
                    const float W = qkb / sl2;
                    int t_lo = (int)floorf(fmaxf((float)q0 - W, 0.f) * (1.0f / 64.0f));
                    int t_hi = (int)fminf(floorf(((float)(q0 + 255) + W) * (1.0f / 64.0f)) + 1.0f, (float)NT);
                    if ((t_hi - t_lo) & 1) { if (t_lo > 0) --t_lo; else ++t_hi; }
                    const int hd = h * 2 + c;
                    att::attn_unit_pp<128, true, bf16>(Zb + (long)q0 * ZP + h * 128 + c * 64, Zb + (long)t_lo * 64 * ZP + 512 + h * 128 + c * 64, Zb + (long)t_lo * 64 * ZP + 1024 + h * 128,
                                                     (bf16*)out + (rowbase + q0) * 1024 + hd * 128, t_hi - t_lo, q0 - t_lo * 64, sl2, ldsl);
                } else {
                    attn_body::attn_unit<8>((const attn_body::bf16*)(Zb + (long)q0 * ZP + 1536 + head * 64), (const attn_body::bf16*)(Zb + 2048 + (head >> 2) * 64), (const attn_body::bf16*)(Zb + 2176 + (head >> 2) * 64),
                                            (attn_body::bf16*)(MIX + (rowbase + q0) * 1024 + 512 + head * 64), NT, (char*)lds);
                }
            }
        }
    }
#endif
    xcd_barrier(bar);

#ifndef NO_P2B
#ifdef PROBE_EW2
    for (int rep = 0; rep < 2; ++rep)
#endif
    {
        PHASE_IDS();
        const float d1 = wave_sum(lq1[lane] * lk1[lane]), d2 = wave_sum(lq2[lane] * lk2[lane]);
        const float lam = expf(d1) - expf(d2) + 0.2f;
        const int h = lane >> 4, e0 = (lane & 15) * 8;
        const f32x4 g0 = *(const f32x4*)(g_subln + e0), g1 = *(const f32x4*)(g_subln + e0 + 4);
        for (int m0 = gw * 4; m0 < M; m0 += NGW * 4) {
            v4u wa[4], wb[4];
#pragma unroll
            for (int r = 0; r < 4; ++r) { const bf16* o0 = (const bf16*)out + (size_t)(m0 + r) * 1024 + (h * 2) * 128 + e0; wa[r] = *(const v4u*)o0; wb[r] = *(const v4u*)(o0 + 128); }
#pragma unroll
            for (int r = 0; r < 4; ++r) {
                f32x4 a0, a1, b0, b1;
                a0.x = __uint_as_float(wa[r].x << 16); a0.y = __uint_as_float(wa[r].x & 0xffff0000u); a0.z = __uint_as_float(wa[r].y << 16); a0.w = __uint_as_float(wa[r].y & 0xffff0000u);
                a1.x = __uint_as_float(wa[r].z << 16); a1.y = __uint_as_float(wa[r].z & 0xffff0000u); a1.z = __uint_as_float(wa[r].w << 16); a1.w = __uint_as_float(wa[r].w & 0xffff0000u);
                b0.x = __uint_as_float(wb[r].x << 16); b0.y = __uint_as_float(wb[r].x & 0xffff0000u); b0.z = __uint_as_float(wb[r].y << 16); b0.w = __uint_as_float(wb[r].y & 0xffff0000u);
                b1.x = __uint_as_float(wb[r].z << 16); b1.y = __uint_as_float(wb[r].z & 0xffff0000u); b1.z = __uint_as_float(wb[r].w << 16); b1.w = __uint_as_float(wb[r].w & 0xffff0000u);
                a0 = a0 - lam * b0; a1 = a1 - lam * b1;
                float s2 = ((a0.x * a0.x + a0.y * a0.y) + (a0.z * a0.z + a0.w * a0.w)) + ((a1.x * a1.x + a1.y * a1.y) + (a1.z * a1.z + a1.w * a1.w));
                s2 += __shfl_xor(s2, 1); s2 += __shfl_xor(s2, 2); s2 += __shfl_xor(s2, 4); s2 += __shfl_xor(s2, 8);
                const float rstd = 0.8f / sqrtf(s2 * (1.0f / 128.0f) + 1e-5f);
                a0 = a0 * rstd * g0; a1 = a1 * rstd * g1;
                v4u w; w.x = pk2(a0.x, a0.y); w.y = pk2(a0.z, a0.w); w.z = pk2(a1.x, a1.y); w.w = pk2(a1.z, a1.w);
                *(v4u*)(MIX + (size_t)(m0 + r) * 1024 + h * 128 + e0) = w; }
        }
    }
#endif
    xcd_barrier(bar);

#ifndef NO_P3
#ifdef PROBE_GEMM2
    for (int rep = 0; rep < 2; ++rep)
#endif
    {
        pg8::Gemm g{MIX, WoutT, M, D, D}; pg8::StaticOrder S; S.init(M, D, G, bx);
        pg8::EpiRes<false> E{x_p, x_s, MP, HB, RSP1, 0};
        pg8::gemm_phase<pg8::EpiRes<false>, pg8::StaticOrder, true, true>(ldsl, g, S, E);
    }
#endif
    xcd_barrier(bar);

#ifndef NO_P45
    for (int ch = 0; ch < 3; ++ch) {
        const int r0 = ch * 16384;
#ifndef NO_FF1
#ifdef PROBE_GEMM2
        for (int rep = 0; rep < 2; ++rep)
#endif
        {
            pg8::Gemm g{HB + (size_t)r0 * D, W1T, 16384, FF, D}; pg8::StaticOrder S; S.init(16384, FF, G, bx);
            pg8::EpiFF1 E{RSP1, HH, r0};
            pg8::gemm_phase<pg8::EpiFF1, pg8::StaticOrder, true, true>(ldsl, g, S, E);
        }
#endif
        xcd_barrier(bar);
#ifndef NO_FF2
        {
            pg8::Gemm g{HH, W2T, 16384, D, FF}; pg8::StaticOrder S; S.init(16384, D, G, bx);
            pg8::EpiRes<true> E{nullptr, nullptr, 0, HB, RSP2, r0};
            pg8::gemm_phase<pg8::EpiRes<true>, pg8::StaticOrder, true, true>(ldsl, g, S, E);
        }
#endif
        xcd_barrier(bar);
    }

#endif
#ifndef NO_P6
    {
        pg8::Gemm g{HB, WgT, M, D, D}; pg8::StaticOrder S; S.init(M, D, G, bx);
        pg8::EpiGate E{RSP2, PROJ, HB, XN, RSP3};
        pg8::gemm_phase<pg8::EpiGate, pg8::StaticOrder, true, true>(ldsl, g, S, E);
    }
#endif
    xcd_barrier(bar);

#ifndef NO_P7
    {
        PHASE_IDS();
        f32x4 gv[4];
#pragma unroll
        for (int j = 0; j < 4; ++j) gv[j] = *((const f32x4*)g_final + lane + 64 * j);
        for (int m0 = gw * 4; m0 < M; m0 += NGW * 4) {
            unsigned long long w[4][4]; float rstd[4];
#pragma unroll
            for (int r = 0; r < 4; ++r) { const unsigned long long* hr = (const unsigned long long*)(XN + (size_t)(m0 + r) * D) + lane;
#pragma unroll
                for (int j = 0; j < 4; ++j) w[r][j] = hr[64 * j];
                rstd[r] = 1.0f / sqrtf(pg8::rs16(RSP3 + (size_t)(m0 + r) * 16) * (1.0f / D) + 1e-6f); }
#pragma unroll
            for (int r = 0; r < 4; ++r) { f32x4* xr = (f32x4*)(out + (size_t)(m0 + r) * D) + lane;
#pragma unroll
                for (int j = 0; j < 4; ++j) { const unsigned lo = (unsigned)w[r][j], hi2 = (unsigned)(w[r][j] >> 32);
                    f32x4 hv; hv.x = __uint_as_float(lo << 16); hv.y = __uint_as_float(lo & 0xffff0000u); hv.z = __uint_as_float(hi2 << 16); hv.w = __uint_as_float(hi2 & 0xffff0000u);
                    xr[64 * j] = hv * rstd[r] * gv[j]; } }
        }
    }
#endif
}

extern "C" void kernel_launch(void* const* d_in, const int* in_sizes, int n_in, void* d_out, int out_size, void* d_ws, size_t ws_size, hipStream_t stream) {
    static int grid = 0;
    if (grid == 0) {
        if (n_in != 21 || out_size != M * D || ws_size < WS_END) { fprintf(stderr, "kernel_launch: unexpected shapes (n_in %d out %d ws %zu)\n", n_in, out_size, ws_size); grid = -1; return; }
        int dev = 0, cus = 0, per_cu = 0;
        hipGetDevice(&dev); hipDeviceGetAttribute(&cus, hipDeviceAttributeMultiprocessorCount, dev);
        if (hipFuncSetAttribute((const void*)fwd_mega, hipFuncAttributeMaxDynamicSharedMemorySize, LDS_BYTES) != hipSuccess) { fprintf(stderr, "kernel_launch: hipFuncSetAttribute failed\n"); grid = -1; return; }
        if (hipOccupancyMaxActiveBlocksPerMultiprocessor(&per_cu, (const void*)fwd_mega, NWAVES * 64, LDS_BYTES) != hipSuccess || per_cu < 1) { fprintf(stderr, "kernel_launch: occupancy query gave %d\n", per_cu); per_cu = 1; }
        (void)hipGetLastError();
        grid = cus * per_cu;
    }
    if (grid < 0) return;
    if (hipMemsetAsync(d_ws, 0, CTL_BYTES, stream) != hipSuccess) { fprintf(stderr, "kernel_launch: memset failed\n"); return; }
    Args a{};
    for (int i = 0; i < 21; ++i) a.in[i] = (const float*)d_in[i];
    a.out = (float*)d_out; a.ws = (unsigned char*)d_ws;
    void* kargs[] = {&a};
    hipError_t e = hipLaunchCooperativeKernel((const void*)fwd_mega, dim3(grid), dim3(NWAVES * 64), kargs, LDS_BYTES, stream);
    if (e != hipSuccess) fprintf(stderr, "cooperative launch failed: %s (grid %d)\n", hipGetErrorString(e), grid);
}
```

```cpp
#include <hip/hip_runtime.h>
#include <hip/hip_bf16.h>
#include <hip/hip_cooperative_groups.h>
#include <cstdio>
#include <cstdint>
namespace cg = cooperative_groups;

namespace pg8 {
#define PG8_LAS __attribute__((address_space(3)))
typedef unsigned short bf16_t;
typedef short bf16x8 __attribute__((ext_vector_type(8)));
typedef float f32x4 __attribute__((ext_vector_type(4)));
typedef unsigned u32x4 __attribute__((ext_vector_type(4)));
constexpr int BM = 256, BK = 64, HALF = 128, HTB = HALF * BK * 2  , STAGE_BYTES = 8 * HTB, NXCD = 8, WGM = 8;

__host__ __device__ __forceinline__ int lds_byte(int r, int c) { const int st = (r >> 4) * 2 + (c >> 5), rr = r & 15, cc = c & 31, ob = rr * 64 + cc * 2; return st * 1024 + (ob ^ (((ob >> 9) & 1) << 5)); }
__host__ __device__ __forceinline__ void stage_rc(int b, int& R, int& C) { const int st = b / 1024, sb = b % 1024, swz = sb ^ (((sb >> 9) & 1) << 5); R = (st >> 1) * 16 + swz / 64; C = (st & 1) * 32 + (swz % 64) / 2; }
__host__ __device__ __forceinline__ int perm32(int rho) { const int n = rho >> 4, i = rho & 15; return 8 * (i >> 2) + 4 * n + (i & 3); }

struct Unit { int pm, pn; };
struct Gemm { const bf16_t* A; const bf16_t* Bt; int M, N, K; };

struct StaticOrder {
    int nM, nN, nwg, G, c;
    __host__ __device__ void init(int M, int N, int G_, int c_) { nM = M / BM; nN = N / BM; nwg = nM * nN; G = G_; c = c_; }
    __host__ __device__ bool next(int i, Unit& u) const {
        const long L = (long)i * G + c; if (L >= nwg) return false;
        int wgid = (int)L; { const int q = nwg / NXCD, r = nwg % NXCD, xcd = wgid % NXCD, off = wgid / NXCD; wgid = (xcd < r ? xcd * (q + 1) : r * (q + 1) + (xcd - r) * q) + off; }
        const int nig = WGM * nN, gid = wgid / nig, fm = gid * WGM, gsz = (nM - fm) < WGM ? (nM - fm) : WGM;
        u.pm = fm + ((wgid % nig) % gsz); u.pn = (wgid % nig) / gsz; return true;
    }
    __device__ __forceinline__ void a_ready(const Unit&) const {}
    __device__ __forceinline__ void done(const Unit&) const {}
};

__device__ __forceinline__ unsigned cvt_pk_bf16(float lo, float hi) { unsigned r; asm volatile("v_cvt_pk_bf16_f32 %0, %1, %2" : "=v"(r) : "v"(lo), "v"(hi)); return r; }
typedef float f32x2 __attribute__((ext_vector_type(2)));
typedef unsigned u32x2 __attribute__((ext_vector_type(2)));
__device__ __forceinline__ float rs16(const float* p) {
    const f32x4 a = *(const f32x4*)p, b = *(const f32x4*)(p + 4), c = *(const f32x4*)(p + 8), d = *(const f32x4*)(p + 12);
    return (((a[0] + a[1]) + (a[2] + a[3])) + ((b[0] + b[1]) + (b[2] + b[3]))) + (((c[0] + c[1]) + (c[2] + c[3])) + ((d[0] + d[1]) + (d[2] + d[3])));
}
struct EpiBf {
    static constexpr bool PERM = true, AFTER_DRAIN = false, MUT = false;
    bf16_t* O; int ldc; float scale_q; int nq_tiles;
    __device__ __forceinline__ void operator()(const f32x4 (&acc)[2][2][4][2], const Unit& u, int wr, int wc, int fr, int fq) const {
        const int row0 = u.pm * BM + wr * 64 + fr, col0 = u.pn * BM + wc * 32 + 8 * fq; const float sc = (u.pn < nq_tiles) ? scale_q : 1.f;
#pragma unroll
        for (int ai = 0; ai < 2; ++ai)
#pragma unroll
            for (int m = 0; m < 4; ++m) { bf16_t* rowp = O + (size_t)(row0 + ai * HALF + m * 16) * ldc + col0;
#pragma unroll
                for (int bj = 0; bj < 2; ++bj) { const f32x4 v0 = acc[ai][bj][m][0] * sc, v1 = acc[ai][bj][m][1] * sc;
                    u32x4 w; w.x = cvt_pk_bf16(v0[0], v0[1]); w.y = cvt_pk_bf16(v0[2], v0[3]); w.z = cvt_pk_bf16(v1[0], v1[1]); w.w = cvt_pk_bf16(v1[2], v1[3]);
                    *(u32x4*)(rowp + bj * HALF) = w; } }
    }
};
template <bool BASE_BF16> struct EpiRes {
    static constexpr bool PERM = false, AFTER_DRAIN = false, MUT = false;
    const float* base0; const float* base1; int split_row; bf16_t* hb; float* rsp; int row_off;
    __device__ __forceinline__ void operator()(const f32x4 (&acc)[2][2][4][2], const Unit& u, int wr, int wc, int fr, int fq) const {
        const int col0 = u.pn * BM + wc * 32 + 4 * fq;
#pragma unroll
        for (int ai = 0; ai < 2; ++ai)
#pragma unroll
            for (int m = 0; m < 4; ++m) { const int row = row_off + u.pm * BM + ai * HALF + wr * 64 + m * 16 + fr;
                const float* bp = row < split_row ? base0 + (size_t)row * 1024 : base1 + (size_t)(row - split_row) * 1024;
                bf16_t* hp = hb + (size_t)row * 1024; float s = 0.f;
#pragma unroll
                for (int bj = 0; bj < 2; ++bj)
#pragma unroll
                    for (int n = 0; n < 2; ++n) { const int c = col0 + bj * HALF + n * 16; f32x4 b;
                        if constexpr (BASE_BF16) { const u32x2 pw = *(const u32x2*)(hp + c);
                            b[0] = __uint_as_float(pw.x << 16); b[1] = __uint_as_float(pw.x & 0xffff0000u); b[2] = __uint_as_float(pw.y << 16); b[3] = __uint_as_float(pw.y & 0xffff0000u); }
                        else b = *(const f32x4*)(bp + c);
                        const f32x4 v = b + acc[ai][bj][m][n];
                        s += (v[0] * v[0] + v[1] * v[1]) + (v[2] * v[2] + v[3] * v[3]);
                        u32x2 w; w.x = cvt_pk_bf16(v[0], v[1]); w.y = cvt_pk_bf16(v[2], v[3]); *(u32x2*)(hp + c) = w; }
                s += __shfl_xor(s, 16); s += __shfl_xor(s, 32);
                if (fq == 0) rsp[(size_t)row * 16 + u.pn * 4 + wc] = s; }
    }
};
struct EpiFF1 {
    static constexpr bool PERM = true, AFTER_DRAIN = false, MUT = false;
    const float* rsp; bf16_t* H; int row_off;
    __device__ __forceinline__ void operator()(const f32x4 (&acc)[2][2][4][2], const Unit& u, int wr, int wc, int fr, int fq) const {
        const int col0 = u.pn * BM + wc * 32 + 8 * fq;
#pragma unroll
        for (int ai = 0; ai < 2; ++ai)
#pragma unroll
            for (int m = 0; m < 4; ++m) { const int lrow = u.pm * BM + ai * HALF + wr * 64 + m * 16 + fr;
                const float rstd = 1.0f / sqrtf(rs16(rsp + (size_t)(row_off + lrow) * 16) * (1.0f / 1024.0f) + 1e-6f);
                bf16_t* rowp = H + (size_t)lrow * 4096 + col0;
#pragma unroll
                for (int bj = 0; bj < 2; ++bj) { f32x4 v0 = acc[ai][bj][m][0] * rstd, v1 = acc[ai][bj][m][1] * rstd;
#pragma unroll
                    for (int e = 0; e < 4; ++e) { const float a = fmaxf(v0[e], 0.f), b = fmaxf(v1[e], 0.f); v0[e] = a * a; v1[e] = b * b; }
                    u32x4 w; w.x = cvt_pk_bf16(v0[0], v0[1]); w.y = cvt_pk_bf16(v0[2], v0[3]); w.z = cvt_pk_bf16(v1[0], v1[1]); w.w = cvt_pk_bf16(v1[2], v1[3]);
                    *(u32x4*)(rowp + bj * HALF) = w; }
                asm volatile("" ::: "memory"); }
    }
};
struct EpiGate {
    static constexpr bool PERM = false, AFTER_DRAIN = false, MUT = false;
    const float* rsp_in; const bf16_t* proj; const bf16_t* hb_in; bf16_t* hb_out; float* rsp_out;
    __device__ __forceinline__ void operator()(const f32x4 (&acc)[2][2][4][2], const Unit& u, int wr, int wc, int fr, int fq) const {
        const int col0 = u.pn * BM + wc * 32 + 4 * fq;
#pragma unroll
        for (int ai = 0; ai < 2; ++ai)
#pragma unroll
            for (int m = 0; m < 4; ++m) { const int row = u.pm * BM + ai * HALF + wr * 64 + m * 16 + fr;
                const float rstd = 1.0f / sqrtf(rs16(rsp_in + (size_t)row * 16) * (1.0f / 1024.0f) + 1e-6f);
                const bf16_t* ip = hb_in + (size_t)row * 1024; bf16_t* op = hb_out + (size_t)row * 1024; const bf16_t* pp = proj + (size_t)row * 1024; float s = 0.f;
#pragma unroll
                for (int bj = 0; bj < 2; ++bj)
#pragma unroll
                    for (int n = 0; n < 2; ++n) { const int c = col0 + bj * HALF + n * 16; const f32x4 a = acc[ai][bj][m][n] * rstd;
                        const u32x2 pw = *(const u32x2*)(pp + c), hw = *(const u32x2*)(ip + c);
                        f32x4 pr, h2; pr[0] = __uint_as_float(pw.x << 16); pr[1] = __uint_as_float(pw.x & 0xffff0000u); pr[2] = __uint_as_float(pw.y << 16); pr[3] = __uint_as_float(pw.y & 0xffff0000u);
                        h2[0] = __uint_as_float(hw.x << 16); h2[1] = __uint_as_float(hw.x & 0xffff0000u); h2[2] = __uint_as_float(hw.y << 16); h2[3] = __uint_as_float(hw.y & 0xffff0000u);
                        f32x4 g;
#pragma unroll
                        for (int e2 = 0; e2 < 4; ++e2) g[e2] = __builtin_amdgcn_rcpf(1.0f + __builtin_amdgcn_exp2f(-1.4426950408889634f * a[e2]));
                        const f32x4 v = h2 + g * pr;
                        s += (v[0] * v[0] + v[1] * v[1]) + (v[2] * v[2] + v[3] * v[3]);
                        u32x2 w; w.x = cvt_pk_bf16(v[0], v[1]); w.y = cvt_pk_bf16(v[2], v[3]); *(u32x2*)(op + c) = w; }
                s += __shfl_xor(s, 16); s += __shfl_xor(s, 32);
                if (fq == 0) rsp_out[(size_t)row * 16 + u.pn * 4 + wc] = s;
                asm volatile("" ::: "memory"); }
    }
};
struct EpiGateNorm {
    static constexpr bool PERM = false, AFTER_DRAIN = false, MUT = true;
    const float* rsp_in; const bf16_t* proj; const bf16_t* hb_in; float* out; const float* gfin; float* xbuf; unsigned* cnt;
    __device__ __forceinline__ void mut(f32x4 (&acc)[2][2][4][2], const Unit& u, int wr, int wc, int fr, int fq, PG8_LAS unsigned char* lds, int wid, int lane) const {
        const int col0 = u.pn * BM + wc * 32 + 4 * fq;
        PG8_LAS float* P = (PG8_LAS float*)(lds + 131072); PG8_LAS float* S = P + 1024;
#pragma unroll
        for (int ai = 0; ai < 2; ++ai)
#pragma unroll
            for (int m = 0; m < 4; ++m) { const int lr = ai * HALF + wr * 64 + m * 16 + fr; const int row = u.pm * BM + lr;
                const float rstd = 1.0f / sqrtf(rs16(rsp_in + (size_t)row * 16) * (1.0f / 1024.0f) + 1e-6f);
                const bf16_t* ip = hb_in + (size_t)row * 1024; const bf16_t* pp = proj + (size_t)row * 1024; float s = 0.f;
#pragma unroll
                for (int bj = 0; bj < 2; ++bj)
#pragma unroll
                    for (int n = 0; n < 2; ++n) { const int c = col0 + bj * HALF + n * 16; const f32x4 a = acc[ai][bj][m][n] * rstd;
                        const u32x2 pw = *(const u32x2*)(pp + c), hw = *(const u32x2*)(ip + c);
                        f32x4 pr, h2; pr[0] = __uint_as_float(pw.x << 16); pr[1] = __uint_as_float(pw.x & 0xffff0000u); pr[2] = __uint_as_float(pw.y << 16); pr[3] = __uint_as_float(pw.y & 0xffff0000u);
                        h2[0] = __uint_as_float(hw.x << 16); h2[1] = __uint_as_float(hw.x & 0xffff0000u); h2[2] = __uint_as_float(hw.y << 16); h2[3] = __uint_as_float(hw.y & 0xffff0000u);
                        f32x4 g;
#pragma unroll
                        for (int e2 = 0; e2 < 4; ++e2) g[e2] = __builtin_amdgcn_rcpf(1.0f + __builtin_amdgcn_exp2f(-1.4426950408889634f * a[e2]));
                        const f32x4 v = h2 + g * pr; acc[ai][bj][m][n] = v;
                        s += (v[0] * v[0] + v[1] * v[1]) + (v[2] * v[2] + v[3] * v[3]); }
                s += __shfl_xor(s, 16); s += __shfl_xor(s, 32);
                if (fq == 0) P[lr * 4 + wc] = s;
                asm volatile("" ::: "memory"); }
        asm volatile("s_waitcnt lgkmcnt(0)" ::: "memory"); __builtin_amdgcn_s_barrier(); asm volatile("" ::: "memory");
        const int r = wid * 32 + (lane & 31);
        if (lane < 32) { const float t = (P[r * 4 + 0] + P[r * 4 + 1]) + (P[r * 4 + 2] + P[r * 4 + 3]);
            __hip_atomic_store(xbuf + ((size_t)(u.pm * BM + r) * 4 + u.pn), t, __ATOMIC_RELAXED, __HIP_MEMORY_SCOPE_AGENT); }
        asm volatile("s_waitcnt vmcnt(0)" ::: "memory");
        if (lane == 0) __hip_atomic_fetch_add(cnt + u.pm, 1u, __ATOMIC_RELAXED, __HIP_MEMORY_SCOPE_AGENT);
        if (wid == 0) { unsigned sp = 0;
            while ((unsigned)__builtin_amdgcn_readfirstlane(__hip_atomic_load(cnt + u.pm, __ATOMIC_RELAXED, __HIP_MEMORY_SCOPE_AGENT)) < 32u && ++sp < (1u << 22)) __builtin_amdgcn_s_sleep(2);
            __builtin_amdgcn_fence(__ATOMIC_ACQUIRE, "agent"); }
        asm volatile("s_waitcnt vmcnt(0) lgkmcnt(0)" ::: "memory"); __builtin_amdgcn_s_barrier(); asm volatile("" ::: "memory");
        if (lane < 32) { const float* slot = xbuf + (size_t)(u.pm * BM + r) * 4; float t = 0.f;
#pragma unroll
            for (int q = 0; q < 4; ++q) t += __hip_atomic_load(slot + q, __ATOMIC_RELAXED, __HIP_MEMORY_SCOPE_AGENT);
            S[r] = 1.0f / sqrtf(t * (1.0f / 1024.0f) + 1e-6f); }
        asm volatile("s_waitcnt lgkmcnt(0)" ::: "memory"); __builtin_amdgcn_s_barrier(); asm volatile("" ::: "memory");
        f32x4 gf[2][2];
#pragma unroll
        for (int bj = 0; bj < 2; ++bj)
#pragma unroll
            for (int n = 0; n < 2; ++n) gf[bj][n] = *(const f32x4*)(gfin + col0 + bj * HALF + n * 16);
#pragma unroll
        for (int ai = 0; ai < 2; ++ai)
#pragma unroll
            for (int m = 0; m < 4; ++m) { const int lr = ai * HALF + wr * 64 + m * 16 + fr; const float rs = S[lr]; float* op = out + (size_t)(u.pm * BM + lr) * 1024;
#pragma unroll
                for (int bj = 0; bj < 2; ++bj)
#pragma unroll
                    for (int n = 0; n < 2; ++n) *(f32x4*)(op + col0 + bj * HALF + n * 16) = acc[ai][bj][m][n] * rs * gf[bj][n]; }
        asm volatile("s_waitcnt lgkmcnt(0)" ::: "memory");
    }
};
template <class Epi, class Sched, bool ALIGN_EPI = false, bool SP2 = false>
__device__ __forceinline__ void gemm_phase(PG8_LAS unsigned char* lds, const Gemm g, const Sched& S, const Epi& E) {
    int tid_ = threadIdx.x; asm volatile("" : "+v"(tid_));
    const int tid = tid_, wid = __builtin_amdgcn_readfirstlane(tid >> 6), lane = tid & 63, wr = wid >> 2, wc = wid & 3, fr = lane & 15, fq = lane >> 4;
    const int K = g.K, nt = K / BK;
    unsigned voffA[2], voffB[2];
#pragma unroll
    for (int i = 0; i < 2; ++i) { int R, C; stage_rc(tid * 16 + i * 8192, R, C); const int Rb = Epi::PERM ? ((R & ~31) + perm32(R & 31)) : R;
        voffA[i] = (unsigned)(R * K + C) * 2u; voffB[i] = (unsigned)(Rb * K + C) * 2u; }
    const size_t kstep = (size_t)(BK * 2);
    const size_t hstep = (size_t)HALF * K * 2;
    const size_t tstep = 2 * hstep;
    const unsigned ldsw = (unsigned)wid * 1024u;
    const int aoff = lds_byte(wr * 64 + fr, fq * 8), boff = lds_byte(wc * 32 + fr, fq * 8);
#define PG8_SA(b, h) (((b) * 2 + (h)) * HTB)
#define PG8_SB(b, h) ((4 + (b) * 2 + (h)) * HTB)
#define PG8_STAGE(bufoff, gbase, voff) do { _Pragma("unroll") for (int _i = 0; _i < 2; ++_i) \
        __builtin_amdgcn_global_load_lds((const unsigned*)((const char*)(gbase) + (voff)[_i]), (PG8_LAS unsigned*)(lds + (bufoff) + ldsw + _i * 8192), 16, 0, 0); } while (0)
#define PG8_LDA(dst, b, h) do { _Pragma("unroll") for (int m = 0; m < 4; ++m) _Pragma("unroll") for (int k = 0; k < 2; ++k) dst[m][k] = *(const PG8_LAS bf16x8*)(lds + PG8_SA(b, h) + aoff + m * 2048 + k * 1024); } while (0)
#define PG8_LDB(dst, b, h) do { _Pragma("unroll") for (int n = 0; n < 2; ++n) _Pragma("unroll") for (int k = 0; k < 2; ++k) dst[n][k] = *(const PG8_LAS bf16x8*)(lds + PG8_SB(b, h) + boff + n * 2048 + k * 1024); } while (0)
#define PG8_MMA(ai, bj, At, Bt) do { __builtin_amdgcn_s_setprio(1); _Pragma("unroll") for (int m = 0; m < 4; ++m) _Pragma("unroll") for (int n = 0; n < 2; ++n) _Pragma("unroll") for (int k = 0; k < 2; ++k) \
        acc[ai][bj][m][n] = __builtin_amdgcn_mfma_f32_16x16x32_bf16(Bt[n][k], At[m][k], acc[ai][bj][m][n], 0, 0, 0); __builtin_amdgcn_s_setprio(0); } while (0)
#define PG8_WAIT_V(n) asm volatile("s_waitcnt vmcnt(" #n ")" ::: "memory")
#define PG8_WAIT_L(n) asm volatile("s_waitcnt lgkmcnt(" #n ")" ::: "memory")
#define PG8_BAR __builtin_amdgcn_s_barrier()
#define PG8_SCHED __builtin_amdgcn_sched_barrier(0)
    Unit cur, nxt; int ui = 0;
    if (!S.next(0, cur)) return;
    f32x4 acc[2][2][4][2];
#pragma unroll
    for (int a = 0; a < 2; ++a)
#pragma unroll
        for (int b = 0; b < 2; ++b)
#pragma unroll
            for (int m = 0; m < 4; ++m)
#pragma unroll
                for (int n = 0; n < 2; ++n) acc[a][b][m][n] = (f32x4){0.f, 0.f, 0.f, 0.f};
    bf16x8 At[4][2], B0[2][2], B1[2][2];
    const char* cA = (const char*)g.A + (size_t)cur.pm * tstep; const char* cB = (const char*)g.Bt + (size_t)cur.pn * tstep;
    S.a_ready(cur);
    if constexpr (SP2) {
        PG8_STAGE(PG8_SB(0, 0), cB, voffB); PG8_STAGE(PG8_SB(0, 1), cB + hstep, voffB); PG8_STAGE(PG8_SA(0, 0), cA, voffA); PG8_STAGE(PG8_SA(0, 1), cA + hstep, voffA);
        if (wr == 1) PG8_BAR;
        PG8_WAIT_V(2); PG8_BAR;
        PG8_STAGE(PG8_SB(1, 0), cB + kstep, voffB); PG8_STAGE(PG8_SA(1, 0), cA + kstep, voffA); PG8_STAGE(PG8_SB(1, 1), cB + hstep + kstep, voffB);
        PG8_WAIT_V(6); PG8_BAR;
    } else {
        PG8_STAGE(PG8_SB(0, 0), cB, voffB); PG8_STAGE(PG8_SA(0, 0), cA, voffA); PG8_STAGE(PG8_SB(0, 1), cB + hstep, voffB); PG8_STAGE(PG8_SA(0, 1), cA + hstep, voffA);
        if (wr == 1) PG8_BAR;
        PG8_WAIT_V(4); PG8_BAR;
        PG8_STAGE(PG8_SB(1, 0), cB + kstep, voffB); PG8_STAGE(PG8_SA(1, 0), cA + kstep, voffA); PG8_STAGE(PG8_SB(1, 1), cB + hstep + kstep, voffB);
        PG8_WAIT_V(6); PG8_BAR;
    }
    for (;;) {
        const bool has_next = S.next(ui + 1, nxt);
        const char* nA = has_next ? (const char*)g.A + (size_t)nxt.pm * tstep : cA; const char* nB = has_next ? (const char*)g.Bt + (size_t)nxt.pn * tstep : cB;
        for (int t = 0; t < nt; t += 2) {
            const bool last = (t == nt - 2);
            const char* a1 = cA + (size_t)(t + 1) * kstep;
            const char* a2 = last ? nA : cA + (size_t)(t + 2) * kstep; const char* b2 = last ? nB : cB + (size_t)(t + 2) * kstep;
            const char* a3 = a2 + kstep; const char* b3 = b2 + kstep;
            if (last && has_next) S.a_ready(nxt);
            if constexpr (SP2) {
            PG8_LDB(B0, 0, 0); PG8_LDB(B1, 0, 1); PG8_SCHED; PG8_LDA(At, 0, 0); PG8_STAGE(PG8_SA(1, 1), a1 + hstep, voffA);
            PG8_WAIT_V(8); PG8_WAIT_L(0); PG8_BAR; PG8_MMA(0, 0, At, B0); PG8_MMA(0, 1, At, B1); PG8_BAR; PG8_SCHED;
            PG8_LDA(At, 0, 1); PG8_STAGE(PG8_SB(0, 0), b2, voffB); PG8_STAGE(PG8_SB(0, 1), b2 + hstep, voffB); PG8_STAGE(PG8_SA(0, 0), a2, voffA);
            PG8_WAIT_V(8); PG8_WAIT_L(0); PG8_BAR; PG8_MMA(1, 0, At, B0); PG8_MMA(1, 1, At, B1); PG8_BAR; PG8_SCHED;
            PG8_LDB(B0, 1, 0); PG8_LDB(B1, 1, 1); PG8_SCHED; PG8_LDA(At, 1, 0); PG8_STAGE(PG8_SA(0, 1), a2 + hstep, voffA);
            PG8_WAIT_V(8); PG8_WAIT_L(0); PG8_BAR; PG8_MMA(0, 0, At, B0); PG8_MMA(0, 1, At, B1); PG8_BAR; PG8_SCHED;
            PG8_LDA(At, 1, 1); PG8_STAGE(PG8_SB(1, 0), b3, voffB); PG8_STAGE(PG8_SB(1, 1), b3 + hstep, voffB); PG8_STAGE(PG8_SA(1, 0), a3, voffA);
            PG8_WAIT_V(8); PG8_WAIT_L(0); PG8_BAR; PG8_MMA(1, 0, At, B0); PG8_MMA(1, 1, At, B1); PG8_BAR; PG8_SCHED;
            } else {
            PG8_LDB(B0, 0, 0); PG8_SCHED; PG8_LDA(At, 0, 0); PG8_STAGE(PG8_SA(1, 1), a1 + hstep, voffA);
            PG8_WAIT_L(8); PG8_BAR; PG8_WAIT_L(0); PG8_MMA(0, 0, At, B0); PG8_BAR; PG8_SCHED;
            PG8_LDB(B1, 0, 1); PG8_STAGE(PG8_SB(0, 0), b2, voffB);
            PG8_BAR; PG8_WAIT_L(0); PG8_MMA(0, 1, At, B1); PG8_BAR;
            PG8_LDA(At, 0, 1); PG8_STAGE(PG8_SA(0, 0), a2, voffA);
            PG8_BAR; PG8_WAIT_L(0); PG8_MMA(1, 0, At, B0); PG8_BAR; PG8_SCHED;
            PG8_STAGE(PG8_SB(0, 1), b2 + hstep, voffB);
            PG8_WAIT_V(6); PG8_BAR; PG8_MMA(1, 1, At, B1); PG8_BAR;
            PG8_LDB(B0, 1, 0); PG8_SCHED; PG8_LDA(At, 1, 0); PG8_STAGE(PG8_SA(0, 1), a2 + hstep, voffA);
            PG8_WAIT_L(8); PG8_BAR; PG8_WAIT_L(0); PG8_MMA(0, 0, At, B0); PG8_BAR; PG8_SCHED;
            PG8_LDB(B1, 1, 1); PG8_STAGE(PG8_SB(1, 0), b3, voffB);
            PG8_BAR; PG8_WAIT_L(0); PG8_MMA(0, 1, At, B1); PG8_BAR;
            PG8_LDA(At, 1, 1); PG8_STAGE(PG8_SA(1, 0), a3, voffA);
            PG8_BAR; PG8_WAIT_L(0); PG8_MMA(1, 0, At, B0); PG8_BAR; PG8_SCHED;
            PG8_STAGE(PG8_SB(1, 1), b3 + hstep, voffB);
            PG8_WAIT_V(6); PG8_BAR; PG8_MMA(1, 1, At, B1); PG8_BAR;
            }
        }
        if constexpr (ALIGN_EPI) { if (wr == 0) PG8_BAR; }
        if constexpr (!Epi::AFTER_DRAIN) { if constexpr (Epi::MUT) E.mut(acc, cur, wr, wc, fr, fq, lds, wid, lane); else E(acc, cur, wr, wc, fr, fq); S.done(cur); }
        if (!has_next) break;
#pragma unroll
        for (int a = 0; a < 2; ++a)
#pragma unroll
            for (int b = 0; b < 2; ++b)
#pragma unroll
                for (int m = 0; m < 4; ++m)
#pragma unroll
                    for (int n = 0; n < 2; ++n) acc[a][b][m][n] = (f32x4){0.f, 0.f, 0.f, 0.f};
        cur = nxt; cA = nA; cB = nB; ++ui;
        if constexpr (ALIGN_EPI) { if (wr == 1) PG8_BAR; }
    }
    PG8_WAIT_V(0);
    if constexpr (!ALIGN_EPI) { if (wr == 0) PG8_BAR; }
    PG8_BAR;
    if constexpr (Epi::AFTER_DRAIN) { E.fused(acc, cur, wr, wc, fr, fq, lds, wid, lane); S.done(cur); }
#undef PG8_SA
#undef PG8_SB
#undef PG8_STAGE
#undef PG8_LDA
#undef PG8_LDB
#undef PG8_MMA
#undef PG8_WAIT_V
#undef PG8_WAIT_L
#undef PG8_BAR
#undef PG8_SCHED
}
}
namespace att {
typedef unsigned short bf16_t;
using bf16x8 = __attribute__((ext_vector_type(8))) short;
using s16x4  = __attribute__((ext_vector_type(4))) short;
using f32x16 = __attribute__((ext_vector_type(16))) float;
using u32x4  = __attribute__((ext_vector_type(4))) unsigned;
constexpr int LDZ = 2368;
constexpr int SHM_V = 16384, SHM_K = 8192;
constexpr int ATTN_LDS = 2 * SHM_V + 2 * SHM_K + 8 * 64 * 4;
constexpr float THR2 = 8.0f;
#define KSWZ64(row, colB) ((row) * 128 + ((colB) ^ ((((row) >> 1) & 7) << 4)))
#define SBAR() __builtin_amdgcn_sched_barrier(0)
__device__ __forceinline__ int crow(int r, int hi) { return (r & 3) + 8 * (r >> 2) + 4 * hi; }
__device__ __forceinline__ unsigned cvtpk(float lo, float hi) { unsigned r; asm volatile("v_cvt_pk_bf16_f32 %0, %1, %2" : "=v"(r) : "v"(lo), "v"(hi)); return r; }
__device__ __forceinline__ unsigned short f2bf(float f) { unsigned u = __builtin_bit_cast(unsigned, f); return (unsigned short)((u + 0x7fffu + ((u >> 16) & 1u)) >> 16); }

template <bool ALIBI>
__device__ __forceinline__ void partialSM(f32x16& p0, f32x16& p1, float& m_reg, float& alpha, float dq, float sl2) {
  if constexpr (ALIBI) {
#pragma unroll
    for (int r = 0; r < 16; ++r) { const float t0 = dq - (float)((r & 3) + 8 * (r >> 2)); const float t1 = t0 - 32.f;
      p0[r] = fmaf(-sl2, fabsf(t0), p0[r]); p1[r] = fmaf(-sl2, fabsf(t1), p1[r]); }
  }
  float pmax = p0[0];
#pragma unroll
  for (int r = 1; r < 16; ++r) pmax = fmaxf(pmax, p0[r]);
#pragma unroll
  for (int r = 0; r < 16; ++r) pmax = fmaxf(pmax, p1[r]);
  { auto rr = __builtin_amdgcn_permlane32_swap(__float_as_uint(pmax), __float_as_uint(pmax), false, false);
    pmax = fmaxf(__uint_as_float(rr[0]), __uint_as_float(rr[1])); }
  float mn;
  if (__builtin_expect(__all(pmax - m_reg <= THR2), 1)) { mn = m_reg; alpha = 1.f; }
  else { mn = fmaxf(m_reg, pmax); alpha = __builtin_amdgcn_exp2f(m_reg - mn); m_reg = mn; }
#pragma unroll
  for (int r = 0; r < 16; ++r) { p0[r] -= mn; p1[r] -= mn; }
#pragma unroll
  for (int r = 0; r < 16; ++r) p0[r] = __builtin_amdgcn_exp2f(p0[r]);
}
__device__ __forceinline__ void finishSM(f32x16& p0, f32x16& p1, float alpha, float& l_reg, bf16x8& pa0, bf16x8& pa1, bf16x8& pa2, bf16x8& pa3) {
#pragma unroll
  for (int r = 0; r < 16; ++r) p1[r] = __builtin_amdgcn_exp2f(p1[r]);
  float ps = 0;
#pragma unroll
  for (int r = 0; r < 16; ++r) ps += p0[r];
#pragma unroll
  for (int r = 0; r < 16; ++r) ps += p1[r];
  { auto rr = __builtin_amdgcn_permlane32_swap(__float_as_uint(ps), __float_as_uint(ps), false, false);
    ps = __uint_as_float(rr[0]) + __uint_as_float(rr[1]); }
  l_reg = l_reg * alpha + ps;
#define PK4(P, BASE, OUT) do { unsigned a0 = cvtpk(P[BASE + 0], P[BASE + 1]), a1 = cvtpk(P[BASE + 2], P[BASE + 3]);   \
    unsigned b0 = cvtpk(P[BASE + 4], P[BASE + 5]), b1 = cvtpk(P[BASE + 6], P[BASE + 7]);                              \
    auto r0 = __builtin_amdgcn_permlane32_swap(a0, b0, false, false); auto r1 = __builtin_amdgcn_permlane32_swap(a1, b1, false, false); \
    u32x4 w = {r0[0], r1[0], r0[1], r1[1]}; OUT = *reinterpret_cast<bf16x8*>(&w); } while (0)
  PK4(p0, 0, pa0); PK4(p0, 8, pa1); PK4(p1, 0, pa2); PK4(p1, 8, pa3);
#undef PK4
}
__device__ __forceinline__ void qkt(f32x16& p0, f32x16& p1, const char* Ks, const bf16x8* qr, int r32, int hi) {
  p0 = f32x16{}; p1 = f32x16{};
#pragma unroll
  for (int d0 = 0; d0 < 4; ++d0) { const int cb = (d0 * 16 + hi * 8) * 2;
    const bf16x8 b0 = *reinterpret_cast<const bf16x8*>(Ks + KSWZ64(r32, cb));
    const bf16x8 b1 = *reinterpret_cast<const bf16x8*>(Ks + 4096 + KSWZ64(r32, cb));
    p0 = __builtin_amdgcn_mfma_f32_32x32x16_bf16(b0, qr[d0], p0, 0, 0, 0);
    p1 = __builtin_amdgcn_mfma_f32_32x32x16_bf16(b1, qr[d0], p1, 0, 0, 0); }
}
template <int NCB> __device__ __forceinline__ int v_st(int k, int c) { const int kk = (k & ~0xC) | ((k & 4) << 1) | ((k & 8) >> 1); return ((kk >> 3) * NCB + (c >> 5)) * 512 + ((kk & 7) * 32 + (c & 31)) * 2; }
__device__ __forceinline__ int v_rd_base(int lane) { return ((lane & 3) << 3) | (((lane >> 2) & 3) << 6) | (((lane >> 4) & 1) << 5) | (((lane >> 5) & 1) << 8); }
template <int OFF> __device__ __forceinline__ s16x4 tr_read(int vb) {
  s16x4 r; asm volatile("ds_read_b64_tr_b16 %0, %1 offset:%2" : "=&v"(r) : "v"(vb), "i"(OFF) : "memory"); return r;
}
template <int NCB, int D0> __device__ __forceinline__ void pv_one(f32x16& od, int vb, bf16x8 pa0, bf16x8 pa1, bf16x8 pa2, bf16x8 pa3) {
  constexpr int KS = NCB * 1024, HF = NCB * 512, B0 = D0 * 512;
  const s16x4 l0 = tr_read<B0>(vb), h0 = tr_read<B0 + HF>(vb), l1 = tr_read<B0 + KS>(vb), h1 = tr_read<B0 + KS + HF>(vb);
  const s16x4 l2 = tr_read<B0 + 2 * KS>(vb), h2 = tr_read<B0 + 2 * KS + HF>(vb), l3 = tr_read<B0 + 3 * KS>(vb), h3 = tr_read<B0 + 3 * KS + HF>(vb);
  asm volatile("s_waitcnt lgkmcnt(0)" ::: "memory"); SBAR();
#define PK(L, H) (bf16x8){L[0], L[1], L[2], L[3], H[0], H[1], H[2], H[3]}
  od = __builtin_amdgcn_mfma_f32_32x32x16_bf16(pa0, PK(l0, h0), od, 0, 0, 0);
  od = __builtin_amdgcn_mfma_f32_32x32x16_bf16(pa1, PK(l1, h1), od, 0, 0, 0);
  od = __builtin_amdgcn_mfma_f32_32x32x16_bf16(pa2, PK(l2, h2), od, 0, 0, 0);
  od = __builtin_amdgcn_mfma_f32_32x32x16_bf16(pa3, PK(l3, h3), od, 0, 0, 0);
#undef PK
}
template <int NCB> __device__ __forceinline__ void pv_all(f32x16* o, int vb, bf16x8 pa0, bf16x8 pa1, bf16x8 pa2, bf16x8 pa3) {
  pv_one<NCB, 0>(o[0], vb, pa0, pa1, pa2, pa3); pv_one<NCB, 1>(o[1], vb, pa0, pa1, pa2, pa3);
  if constexpr (NCB == 4) { pv_one<NCB, 2>(o[2], vb, pa0, pa1, pa2, pa3); pv_one<NCB, 3>(o[3], vb, pa0, pa1, pa2, pa3); }
}
__device__ __forceinline__ void store_o(float* p, float v) { *p = v; }
__device__ __forceinline__ void store_o(bf16_t* p, float v) { *p = f2bf(v); }

template <int DV, bool ALIBI, typename TO>
__device__ __forceinline__ void attn_unit(const bf16_t* __restrict__ Qb, const bf16_t* __restrict__ Kh, const bf16_t* __restrict__ Vh, TO* __restrict__ Ob, int seq, int qpos0, float sl2, char* lds) {
  constexpr int NCB = DV / 32;
  const int tid = threadIdx.x, wid = tid >> 6, lane = tid & 63, r32 = lane & 31, hi = lane >> 5;
  char* V_lds = lds; char* K_lds = lds + 2 * SHM_V;
  float* ws = (float*)(lds + 2 * SHM_V + 2 * SHM_K) + wid * 64; float* li_l = ws; float* al_l = ws + 32;
  float m_reg = -1e30f, l_reg = 0; f32x16 o[NCB];
#pragma unroll
  for (int d = 0; d < NCB; ++d) o[d] = f32x16{};
  bf16x8 qr[4];
  const bf16_t* Qw = Qb + (long)(wid * 32 + r32) * LDZ + hi * 8;
#pragma unroll
  for (int d0 = 0; d0 < 4; ++d0) qr[d0] = *reinterpret_cast<const bf16x8*>(Qw + d0 * 16);
  const float dq0 = (float)(qpos0 + wid * 32 + r32 - 4 * hi);
  const int kr = tid >> 3, kc = (tid & 7) * 8, kst = KSWZ64(kr, kc * 2);
  const int sr = tid >> 4, sc = (tid & 15) * 8;
  const int vst0 = (DV == 128) ? v_st<NCB>(sr, sc) : v_st<NCB>(kr, kc), vst1 = v_st<NCB>(32 + sr, sc);
  const int vb0 = (int)(uintptr_t)V_lds + v_rd_base(lane);
  bf16x8 sv0[2], sv1[2], sk[2];
#define SLOAD(i, k0) do { if constexpr (DV == 128) { sv0[i] = *reinterpret_cast<const bf16x8*>(&Vh[(long)((k0) + sr) * LDZ + sc]); sv1[i] = *reinterpret_cast<const bf16x8*>(&Vh[(long)((k0) + 32 + sr) * LDZ + sc]); } \
    else { sv0[i] = *reinterpret_cast<const bf16x8*>(&Vh[(long)((k0) + kr) * LDZ + kc]); } \
    sk[i] = *reinterpret_cast<const bf16x8*>(&Kh[(long)((k0) + kr) * LDZ + kc]); } while (0)
#define SWRITE(b, i) do { *(bf16x8*)(V_lds + (b) * SHM_V + vst0) = sv0[i]; if constexpr (DV == 128) { *(bf16x8*)(V_lds + (b) * SHM_V + vst1) = sv1[i]; } \
    *(bf16x8*)(K_lds + (b) * SHM_K + kst) = sk[i]; } while (0)
#define SWAIT() do { if constexpr (DV == 128) asm volatile("s_waitcnt vmcnt(3)" ::: "memory"); else asm volatile("s_waitcnt vmcnt(2)" ::: "memory"); } while (0)
#define RESC(a) do { if (__any((a) < 1.f)) { if (hi == 0) al_l[r32] = (a); asm volatile("s_waitcnt lgkmcnt(0)" ::: "memory"); \
    _Pragma("unroll") for (int d = 0; d < NCB; ++d) _Pragma("unroll") for (int r = 0; r < 16; ++r) o[d][r] *= al_l[crow(r, hi)]; } } while (0)
  f32x16 pA0, pA1, pB0, pB1; float alA, alB; bf16x8 pa0, pa1, pa2, pa3; const int NT = seq / 64;
  SLOAD(0, 0); asm volatile("s_waitcnt vmcnt(0)" ::: "memory"); SWRITE(0, 0); __syncthreads();
  qkt(pA0, pA1, K_lds, qr, r32, hi); partialSM<ALIBI>(pA0, pA1, m_reg, alA, dq0, sl2);
  SLOAD(1, 64); if (2 < NT) SLOAD(0, 128);
  SWAIT(); SWRITE(1, 1); __syncthreads();
  for (int j = 1; j + 1 < NT; j += 2) {
    SBAR(); qkt(pB0, pB1, K_lds + SHM_K, qr, r32, hi);
    finishSM(pA0, pA1, alA, l_reg, pa0, pa1, pa2, pa3); SBAR();
    SLOAD(1, (j + 2) * 64); SBAR();
    pv_all<NCB>(o, vb0, pa0, pa1, pa2, pa3); partialSM<ALIBI>(pB0, pB1, m_reg, alB, dq0 - 64.f * (float)j, sl2);
    __syncthreads(); SWAIT(); SWRITE(0, 0);
    RESC(alB); __syncthreads();
    SBAR(); qkt(pA0, pA1, K_lds, qr, r32, hi);
    finishSM(pB0, pB1, alB, l_reg, pa0, pa1, pa2, pa3); SBAR();
    if (j + 3 < NT) SLOAD(0, (j + 3) * 64); SBAR();
    pv_all<NCB>(o, vb0 + SHM_V, pa0, pa1, pa2, pa3); partialSM<ALIBI>(pA0, pA1, m_reg, alA, dq0 - 64.f * (float)(j + 1), sl2);
    __syncthreads(); SWAIT(); SWRITE(1, 1);
    RESC(alA); __syncthreads();
  }
  SBAR(); qkt(pB0, pB1, K_lds + SHM_K, qr, r32, hi);
  finishSM(pA0, pA1, alA, l_reg, pa0, pa1, pa2, pa3); SBAR();
  pv_all<NCB>(o, vb0, pa0, pa1, pa2, pa3); partialSM<ALIBI>(pB0, pB1, m_reg, alB, dq0 - 64.f * (float)(NT - 1), sl2);
  __syncthreads(); RESC(alB);
  finishSM(pB0, pB1, alB, l_reg, pa0, pa1, pa2, pa3); SBAR();
  pv_all<NCB>(o, vb0 + SHM_V, pa0, pa1, pa2, pa3);
  if (hi == 0) li_l[r32] = l_reg; asm volatile("s_waitcnt lgkmcnt(0)" ::: "memory");
  float rli[16];
#pragma unroll
  for (int r = 0; r < 16; ++r) rli[r] = __builtin_amdgcn_rcpf(li_l[crow(r, hi)]);
  TO* Ow = Ob + (long)(wid * 32) * 1024;
#pragma unroll
  for (int r = 0; r < 16; ++r) { const int orow = crow(r, hi);
#pragma unroll
    for (int d0 = 0; d0 < NCB; ++d0) store_o(Ow + (long)orow * 1024 + d0 * 32 + r32, o[d0][r] * rli[r]); }
  __syncthreads();
#undef SLOAD
#undef SWRITE
#undef SWAIT
#undef RESC
}
#undef SBAR
}
namespace att {
#define ALAS __attribute__((address_space(3)))
__device__ __forceinline__ void qkt_l(f32x16& p0, f32x16& p1, const ALAS unsigned char* Ks, const bf16x8* qr, int r32, int hi) {
  p0 = f32x16{}; p1 = f32x16{};
#pragma unroll
  for (int d0 = 0; d0 < 4; ++d0) { const int cb = (d0 * 16 + hi * 8) * 2;
    const bf16x8 b0 = *reinterpret_cast<const ALAS bf16x8*>(Ks + KSWZ64(r32, cb));
    const bf16x8 b1 = *reinterpret_cast<const ALAS bf16x8*>(Ks + 4096 + KSWZ64(r32, cb));
    p0 = __builtin_amdgcn_mfma_f32_32x32x16_bf16(b0, qr[d0], p0, 0, 0, 0);
    p1 = __builtin_amdgcn_mfma_f32_32x32x16_bf16(b1, qr[d0], p1, 0, 0, 0); }
}
__device__ __forceinline__ void qkt_acc(f32x16& p0, f32x16& p1, const ALAS unsigned char* Ks, const bf16x8* qr, int r32, int hi) {
  bf16x8 kb0[4], kb1[4];
#pragma unroll
  for (int d0 = 0; d0 < 4; ++d0) { const int cb = (d0 * 16 + hi * 8) * 2;
    kb0[d0] = *reinterpret_cast<const ALAS bf16x8*>(Ks + KSWZ64(r32, cb)); kb1[d0] = *reinterpret_cast<const ALAS bf16x8*>(Ks + 4096 + KSWZ64(r32, cb)); }
  __builtin_amdgcn_sched_barrier(0);
#pragma unroll
  for (int d0 = 0; d0 < 4; ++d0) {
    p0 = __builtin_amdgcn_mfma_f32_32x32x16_bf16(kb0[d0], qr[d0], p0, 0, 0, 0);
    p1 = __builtin_amdgcn_mfma_f32_32x32x16_bf16(kb1[d0], qr[d0], p1, 0, 0, 0); }
}
__device__ __forceinline__ void qkt_c(f32x16& p0, f32x16& p1, const f32x16& negm, const ALAS unsigned char* Ks, const bf16x8* qr, int r32, int hi) {
  bf16x8 kb0[4], kb1[4];
#pragma unroll
  for (int d0 = 0; d0 < 4; ++d0) { const int cb = (d0 * 16 + hi * 8) * 2;
    kb0[d0] = *reinterpret_cast<const ALAS bf16x8*>(Ks + KSWZ64(r32, cb)); kb1[d0] = *reinterpret_cast<const ALAS bf16x8*>(Ks + 4096 + KSWZ64(r32, cb)); }
  __builtin_amdgcn_sched_barrier(0);
  p0 = __builtin_amdgcn_mfma_f32_32x32x16_bf16(kb0[0], qr[0], negm, 0, 0, 0); p1 = __builtin_amdgcn_mfma_f32_32x32x16_bf16(kb1[0], qr[0], negm, 0, 0, 0);
#pragma unroll
  for (int d0 = 1; d0 < 4; ++d0) {
    p0 = __builtin_amdgcn_mfma_f32_32x32x16_bf16(kb0[d0], qr[d0], p0, 0, 0, 0);
    p1 = __builtin_amdgcn_mfma_f32_32x32x16_bf16(kb1[d0], qr[d0], p1, 0, 0, 0); }
}
template <int NCB> __device__ __forceinline__ void pv_issue0(s16x4 (&vl)[4], s16x4 (&vh)[4], int vb) {
  constexpr int KS = NCB * 1024, HF = NCB * 512;
  vl[0] = tr_read<0>(vb); vh[0] = tr_read<HF>(vb); vl[1] = tr_read<KS>(vb); vh[1] = tr_read<KS + HF>(vb);
  vl[2] = tr_read<2 * KS>(vb); vh[2] = tr_read<2 * KS + HF>(vb); vl[3] = tr_read<3 * KS>(vb); vh[3] = tr_read<3 * KS + HF>(vb);
}
template <int NCB> __device__ __forceinline__ void pv_rest(f32x16* o, const s16x4 (&vl)[4], const s16x4 (&vh)[4], int vb, bf16x8 pa0, bf16x8 pa1, bf16x8 pa2, bf16x8 pa3) {
  asm volatile("s_waitcnt lgkmcnt(0)" ::: "memory"); __builtin_amdgcn_sched_barrier(0);
#define PK(L, H) (bf16x8){L[0], L[1], L[2], L[3], H[0], H[1], H[2], H[3]}
  o[0] = __builtin_amdgcn_mfma_f32_32x32x16_bf16(pa0, PK(vl[0], vh[0]), o[0], 0, 0, 0);
  o[0] = __builtin_amdgcn_mfma_f32_32x32x16_bf16(pa1, PK(vl[1], vh[1]), o[0], 0, 0, 0);
  o[0] = __builtin_amdgcn_mfma_f32_32x32x16_bf16(pa2, PK(vl[2], vh[2]), o[0], 0, 0, 0);
  o[0] = __builtin_amdgcn_mfma_f32_32x32x16_bf16(pa3, PK(vl[3], vh[3]), o[0], 0, 0, 0);
#undef PK
  pv_one<NCB, 1>(o[1], vb, pa0, pa1, pa2, pa3);
  if constexpr (NCB == 4) { pv_one<NCB, 2>(o[2], vb, pa0, pa1, pa2, pa3); pv_one<NCB, 3>(o[3], vb, pa0, pa1, pa2, pa3); }
}
constexpr int PP_NS = 5;
constexpr int PP_KSLOT = 8192, PP_VSLOT = 16384, PP_LK = 0, PP_LV = PP_NS * PP_KSLOT, PP_LW = PP_LV + PP_NS * PP_VSLOT, PP_LDS = PP_LW + 8 * 64 * 4;
static_assert(PP_LDS <= 131072, "attention rings");
#define PP_BAR() do { asm volatile("s_waitcnt lgkmcnt(0)" ::: "memory"); __builtin_amdgcn_s_barrier(); asm volatile("" ::: "memory"); } while (0)
template <int DV, bool ALIBI, typename TO>
__device__ __forceinline__ void attn_unit_pp(const bf16_t* __restrict__ Qb, const bf16_t* __restrict__ Kh, const bf16_t* __restrict__ Vh, TO* __restrict__ Ob, int NT, int qpos0, float sl2, ALAS unsigned char* ldsl) {
  constexpr int NCB = DV / 32, NVI = DV / 32;
  int tid_ = threadIdx.x; asm volatile("" : "+v"(tid_));
  const int tid = tid_, lane = tid & 63, r32 = lane & 31, hi = lane >> 5;
  const int wid = __builtin_amdgcn_readfirstlane(tid >> 6), g = wid >> 2, wq = wid & 3;
  ALAS float* li_l = (ALAS float*)(ldsl + PP_LW) + wid * 64; ALAS float* al_l = li_l + 32;
  bf16x8 qr[4];
  const bf16_t* Qw = Qb + (long)(wid * 32 + r32) * LDZ + hi * 8;
#pragma unroll
  for (int d0 = 0; d0 < 4; ++d0) qr[d0] = *reinterpret_cast<const bf16x8*>(Qw + d0 * 16);
  const float dq0 = (float)(qpos0 + wid * 32 + r32 - 4 * hi);
  unsigned doff[NVI];
#pragma unroll
  for (int i = 0; i < NVI; ++i) {
    const int Lk = (wq * 2 + (i & 1)) * 64 + lane, row = Lk >> 3, c = (Lk & 7) ^ ((row >> 1) & 7);
    const int Lv = (wq * NVI + i) * 64 + lane, st = Lv >> 5, wi = Lv & 31, kk = (st / NCB) * 8 + (wi >> 2), kv = (kk & ~0xC) | ((kk & 4) << 1) | ((kk & 8) >> 1);
    doff[i] = g ? (unsigned)(row * LDZ + c * 8) * 2u : (unsigned)(kv * LDZ + (st % NCB) * 32 + (wi & 3) * 8) * 2u; }
  const char* dbase = g ? (const char*)Kh : (const char*)Vh;
  const int dlds = g ? (PP_LK + wq * 2 * 1024) : (PP_LV + wq * NVI * 1024), dss = g ? PP_KSLOT : PP_VSLOT, ni = g ? 2 : NVI;
#define DMA_T(t, slot) do { const char* tb_ = dbase + (size_t)(t) * (64 * LDZ * 2); ALAS unsigned char* ld_ = ldsl + dlds + (slot) * dss; \
    _Pragma("unroll") for (int i_ = 0; i_ < NVI; ++i_) if (i_ < ni) __builtin_amdgcn_global_load_lds((const unsigned*)(tb_ + doff[i_]), (ALAS unsigned*)(ld_ + i_ * 1024), 16, 0, 0); } while (0)
  const int vbase = (int)(unsigned)(uintptr_t)(ldsl + PP_LV) + v_rd_base(lane);
  float m_reg = 0.f, l_reg = 0.f; f32x16 o[NCB];
  f32x16 negm = f32x16{}; const int qw = qpos0 + wid * 32;
#pragma unroll
  for (int d = 0; d < NCB; ++d) o[d] = f32x16{};
  f32x16 S0 = f32x16{}, S1 = f32x16{}; bf16x8 pa0 = bf16x8{}, pa1 = bf16x8{}, pa2 = bf16x8{}, pa3 = bf16x8{};
  if (g == 1) { _Pragma("unroll") for (int t = 0; t < PP_NS; ++t) DMA_T(t, t); asm volatile("s_waitcnt vmcnt(8)" ::: "memory"); static_assert(PP_NS == 5, "prologue wait = 2 * (NS - 1)"); }
  else { _Pragma("unroll") for (int t = 0; t < PP_NS - 2; ++t) DMA_T(t, t); }
  PP_BAR();
#define CRF(r) ((float)(((r) & 3) + 8 * ((r) >> 2)))
#define M_STEP(k) do { const int k_ = (k); s16x4 vl_[4], vh_[4]; const int vb_ = vbase + ((k_ >= 0 ? k_ : 0) % PP_NS) * PP_VSLOT; \
    if (k_ >= 0) pv_issue0<NCB>(vl_, vh_, vb_); \
    if (k_ + 1 < NT) { const int ks_ = (k_ + 1) % PP_NS; \
      if constexpr (ALIBI) { const int kt0_ = 64 * (k_ + 1); const float dq_ = dq0 - (float)kt0_; \
        if (kt0_ + 63 <= qw || kt0_ >= qw + 31) {     \
          const float ssl_ = (kt0_ + 63 <= qw) ? sl2 : -sl2; const float e0_ = -m_reg - ssl_ * dq_, e1_ = e0_ + 32.f * ssl_; \
          _Pragma("unroll") for (int r = 0; r < 16; ++r) { S0[r] = fmaf(ssl_, CRF(r), e0_); S1[r] = fmaf(ssl_, CRF(r), e1_); } \
        } else { \
          _Pragma("unroll") for (int r = 0; r < 16; ++r) { const float t0_ = dq_ - CRF(r); S0[r] = fmaf(-sl2, fabsf(t0_), -m_reg); S1[r] = fmaf(-sl2, fabsf(t0_ - 32.f), -m_reg); } \
        } \
        qkt_acc(S0, S1, ldsl + PP_LK + ks_ * PP_KSLOT, qr, r32, hi); \
      } else { qkt_c(S0, S1, negm, ldsl + PP_LK + ks_ * PP_KSLOT, qr, r32, hi); } } \
    if (k_ >= 0) pv_rest<NCB>(o, vl_, vh_, vb_, pa0, pa1, pa2, pa3); } while (0)
#define PK4(P, BASE, OUT) do { unsigned a0 = cvtpk(P[BASE + 0], P[BASE + 1]), a1 = cvtpk(P[BASE + 2], P[BASE + 3]);   \
    unsigned b0 = cvtpk(P[BASE + 4], P[BASE + 5]), b1 = cvtpk(P[BASE + 6], P[BASE + 7]);                              \
    auto r0 = __builtin_amdgcn_permlane32_swap(a0, b0, false, false); auto r1 = __builtin_amdgcn_permlane32_swap(a1, b1, false, false); \
    u32x4 w = {r0[0], r1[0], r0[1], r1[1]}; OUT = *reinterpret_cast<bf16x8*>(&w); } while (0)
#define V_STEP(k) do { const int k_ = (k); \
    { const int tt_ = k_ + (g ? PP_NS : PP_NS - 2); if (tt_ < NT) DMA_T(tt_, tt_ % PP_NS); } \
    float pmax = S0[0]; \
    _Pragma("unroll") for (int r = 1; r < 16; ++r) pmax = fmaxf(pmax, S0[r]); \
    _Pragma("unroll") for (int r = 0; r < 16; ++r) pmax = fmaxf(pmax, S1[r]); \
    { auto rr = __builtin_amdgcn_permlane32_swap(__float_as_uint(pmax), __float_as_uint(pmax), false, false); \
      pmax = fmaxf(__uint_as_float(rr[0]), __uint_as_float(rr[1])); } \
    if (k_ == 0 || !__builtin_expect(__all(pmax <= THR2), 1)) {       \
      const float dl = (k_ == 0) ? pmax : fmaxf(pmax, 0.f); m_reg += dl; \
      _Pragma("unroll") for (int r = 0; r < 16; ++r) { S0[r] -= dl; S1[r] -= dl; } \
      if constexpr (!ALIBI) { _Pragma("unroll") for (int r = 0; r < 16; ++r) negm[r] = -m_reg; } \
      if (k_ != 0) { const float alpha = __builtin_amdgcn_exp2f(-dl); l_reg *= alpha; \
        if (hi == 0) al_l[r32] = alpha; \
        asm volatile("s_waitcnt lgkmcnt(0)" ::: "memory"); \
        _Pragma("unroll") for (int d = 0; d < NCB; ++d) _Pragma("unroll") for (int r = 0; r < 16; ++r) o[d][r] *= al_l[crow(r, hi)]; } } \
    _Pragma("unroll") for (int r = 0; r < 16; ++r) { S0[r] = __builtin_amdgcn_exp2f(S0[r]); S1[r] = __builtin_amdgcn_exp2f(S1[r]); } \
    float ps = 0.f, ps1 = 0.f, ps2 = 0.f, ps3 = 0.f; \
    _Pragma("unroll") for (int r = 0; r < 16; r += 2) { ps += S0[r]; ps1 += S0[r + 1]; ps2 += S1[r]; ps3 += S1[r + 1]; } \
    ps = (ps + ps1) + (ps2 + ps3); \
    { auto rr = __builtin_amdgcn_permlane32_swap(__float_as_uint(ps), __float_as_uint(ps), false, false); \
      ps = __uint_as_float(rr[0]) + __uint_as_float(rr[1]); } \
    l_reg += ps; \
    PK4(S0, 0, pa0); PK4(S0, 8, pa1); PK4(S1, 0, pa2); PK4(S1, 8, pa3); } while (0)
#define WAIT_V(n) asm volatile("s_waitcnt vmcnt(" #n ")" ::: "memory")
  if (g == 0) {
    M_STEP(-1); PP_BAR();
    for (int k = 0; k < NT; ++k) {
      V_STEP(k);
      { const int no_ = NT - 1 - k;
        if (no_ >= 3) { if constexpr (NVI == 4) WAIT_V(12); else WAIT_V(6); } else if (no_ == 2) { if constexpr (NVI == 4) WAIT_V(8); else WAIT_V(4); }
        else if (no_ == 1) { if constexpr (NVI == 4) WAIT_V(4); else WAIT_V(2); } else WAIT_V(0); }
      PP_BAR();
      M_STEP(k); PP_BAR();
    }
    PP_BAR();
  } else {
    PP_BAR();
    for (int k = 0; k < NT; ++k) {
      M_STEP(k - 1);
      { const int no_ = NT - 2 - k;
        if (no_ >= 3) WAIT_V(6); else if (no_ == 2) WAIT_V(4); else if (no_ == 1) WAIT_V(2); else WAIT_V(0); }
      PP_BAR();
      V_STEP(k); PP_BAR();
    }
    M_STEP(NT - 1); PP_BAR();
  }
#undef M_STEP
#undef CRF
#undef V_STEP
#undef PK4
#undef WAIT_V
  if (hi == 0) li_l[r32] = l_reg; asm volatile("s_waitcnt lgkmcnt(0)" ::: "memory");
  float rli[16];
#pragma unroll
  for (int r = 0; r < 16; ++r) rli[r] = __builtin_amdgcn_rcpf(li_l[crow(r, hi)]);
  TO* Ow = Ob + (long)(wid * 32) * 1024;
#pragma unroll
  for (int r = 0; r < 16; ++r) { const int orow = crow(r, hi);
#pragma unroll
    for (int d0 = 0; d0 < NCB; ++d0) store_o(Ow + (long)orow * 1024 + d0 * 32 + r32, o[d0][r] * rli[r]); }
#undef DMA_T
}
#undef ALAS
}
namespace attn_body {
using bf16=__hip_bfloat16;
using bf16x8=__attribute__((ext_vector_type(8)))short;
using s16x4=__attribute__((ext_vector_type(4)))short;
using f32x16=__attribute__((ext_vector_type(16)))float;
using u32x4=__attribute__((ext_vector_type(4)))unsigned;
constexpr int D=64,DMQ=2368,DMK=2368,DMV=2368,DMO=1024;
constexpr int NW=8,QBLK=32,QB=QBLK*NW,KVBLK=64;
__device__ __forceinline__ int crow(int r,int hi){return (r&3)+8*(r>>2)+4*hi;}
#define SBAR() __builtin_amdgcn_sched_barrier(0)
__device__ __forceinline__ void cmask(f32x16&p0,f32x16&p1,int jb,int qrel,int hi){
  const float NEG=-INFINITY; int kb=64*jb+4*hi;
  #pragma unroll
  for(int r=0;r<16;++r){int kv=kb+(r&3)+8*(r>>2); if(kv>qrel)p0[r]=NEG; if(kv+32>qrel)p1[r]=NEG;}
}

constexpr int NSLOT=3, SLOTB=8192;
constexpr int LDS_K=0, LDS_V=NSLOT*SLOTB, LDS_WS=2*NSLOT*SLOTB, LDS_OST=LDS_WS+NW*64*4, LDS_BYTES=LDS_OST+NW*4096;
constexpr float C2=0.125f*1.4426950408889634f;
__device__ __forceinline__ void glds16(const void*gsrc,unsigned lds_dst){unsigned keep;
  asm volatile("s_mov_b32 %0, m0\n\ts_mov_b32 m0, %2\n\ts_nop 0\n\tglobal_load_lds_dwordx4 %1, off\n\ts_mov_b32 m0, %0":"=&s"(keep):"v"(gsrc),"s"(lds_dst):"memory");}
__device__ __forceinline__ float max3f(float a,float b,float c){float r;asm("v_max3_f32 %0, %1, %2, %3":"=v"(r):"v"(a),"v"(b),"v"(c));return r;}
__device__ __forceinline__ float max2f(float a,float b){float r;asm("v_max_f32_e32 %0, %1, %2":"=v"(r):"v"(a),"v"(b));return r;}
__device__ __forceinline__ float fadd_s(float a,float b){float r;asm("v_add_f32_e32 %0, %1, %2":"=v"(r):"v"(a),"v"(b));return r;}
__device__ __forceinline__ float fsub_s(float a,float b){float r;asm("v_sub_f32_e32 %0, %1, %2":"=v"(r):"v"(a),"v"(b));return r;}
typedef float f32x2_t __attribute__((ext_vector_type(2))); typedef __bf16 bf16x2_t __attribute__((ext_vector_type(2)));
__device__ __forceinline__ unsigned cvtpk_s(float lo,float hi){f32x2_t v={lo,hi};bf16x2_t b=__builtin_convertvector(v,bf16x2_t);return __builtin_bit_cast(unsigned,b);}
#define WAIT_BAR(N) asm volatile("s_waitcnt vmcnt(" #N ") lgkmcnt(0)\n\ts_barrier":::"memory")

__device__ __forceinline__ void qkt(f32x16&p0,f32x16&p1,const char*Kslot,const bf16x8*qr,const f32x16&negm,int r32,int hi){
  const char*kb=Kslot+hi*1024+r32*16;
  #pragma unroll
  for(int d0=0;d0<4;++d0){
    const bf16x8 b0=*reinterpret_cast<const bf16x8*>(kb+d0*2048);
    const bf16x8 b1=*reinterpret_cast<const bf16x8*>(kb+d0*2048+512);
    if(d0==0){p0=__builtin_amdgcn_mfma_f32_32x32x16_bf16(b0,qr[0],negm,0,0,0);p1=__builtin_amdgcn_mfma_f32_32x32x16_bf16(b1,qr[0],negm,0,0,0);}
    else{p0=__builtin_amdgcn_mfma_f32_32x32x16_bf16(b0,qr[d0],p0,0,0,0);p1=__builtin_amdgcn_mfma_f32_32x32x16_bf16(b1,qr[d0],p1,0,0,0);}}
}
typedef __attribute__((address_space(3))) const char* lds_cptr;
typedef short v4i16_t __attribute__((ext_vector_type(4)));
__device__ __forceinline__ void kload8(bf16x8*kf,lds_cptr kp){
  kf[0]=*(const __attribute__((address_space(3))) bf16x8*)(kp);      kf[1]=*(const __attribute__((address_space(3))) bf16x8*)(kp+512);
  kf[2]=*(const __attribute__((address_space(3))) bf16x8*)(kp+2048); kf[3]=*(const __attribute__((address_space(3))) bf16x8*)(kp+2560);
  kf[4]=*(const __attribute__((address_space(3))) bf16x8*)(kp+4096); kf[5]=*(const __attribute__((address_space(3))) bf16x8*)(kp+4608);
  kf[6]=*(const __attribute__((address_space(3))) bf16x8*)(kp+6144); kf[7]=*(const __attribute__((address_space(3))) bf16x8*)(kp+6656);
}
__device__ __forceinline__ void kload2(bf16x8*kf,lds_cptr kp,int j){ kf[2*j]=*(const __attribute__((address_space(3))) bf16x8*)(kp+j*2048); kf[2*j+1]=*(const __attribute__((address_space(3))) bf16x8*)(kp+j*2048+512); }
__device__ __forceinline__ s16x4 vtr(lds_cptr p){ return __builtin_bit_cast(s16x4,__builtin_amdgcn_ds_read_tr16_b64_v4i16((__attribute__((address_space(3))) v4i16_t*)p)); }
__device__ __forceinline__ float rowmax(const f32x16&p0,const f32x16&p1){
  float a=max3f(p0[0],p0[1],p1[0]),b=max3f(p0[2],p0[3],p1[1]);a=max3f(a,p1[2],p1[3]);
  #pragma unroll
  for(int r=4;r<16;r+=4){a=max3f(a,p0[r],p0[r+1]);b=max3f(b,p0[r+2],p0[r+3]);a=max3f(a,p1[r],p1[r+1]);b=max3f(b,p1[r+2],p1[r+3]);}
  const float m=max2f(a,b);
  auto rr=__builtin_amdgcn_permlane32_swap(__float_as_uint(m),__float_as_uint(m),false,false);
  return max2f(__uint_as_float(rr[0]),__uint_as_float(rr[1]));
}
__device__ __forceinline__ void pv(f32x16*o,int vb,bf16x8 pa0,bf16x8 pa1,bf16x8 pa2,bf16x8 pa3){
  #pragma unroll
  for(int d0=0;d0<2;++d0){s16x4 lo[4],hi[4];
    #pragma unroll
    for(int ks=0;ks<4;++ks){
      asm volatile("ds_read_b64_tr_b16 %0,%1 offset:%c2":"=&v"(lo[ks]):"v"(vb),"i"(d0*4096+ks*1024):"memory");
      asm volatile("ds_read_b64_tr_b16 %0,%1 offset:%c2":"=&v"(hi[ks]):"v"(vb),"i"(d0*4096+ks*1024+512):"memory");}
    asm volatile("s_waitcnt lgkmcnt(0)":::"memory");SBAR();
    #define PK(k) (bf16x8){lo[k][0],lo[k][1],lo[k][2],lo[k][3],hi[k][0],hi[k][1],hi[k][2],hi[k][3]}
    o[d0]=__builtin_amdgcn_mfma_f32_32x32x16_bf16(pa0,PK(0),o[d0],0,0,0);
    o[d0]=__builtin_amdgcn_mfma_f32_32x32x16_bf16(pa1,PK(1),o[d0],0,0,0);
    o[d0]=__builtin_amdgcn_mfma_f32_32x32x16_bf16(pa2,PK(2),o[d0],0,0,0);
    o[d0]=__builtin_amdgcn_mfma_f32_32x32x16_bf16(pa3,PK(3),o[d0],0,0,0);
    #undef PK
  }
}

#ifndef ATTN_STORE16
#define ATTN_STORE16(p,v) (*(u32x4*)(p)=(v))
#endif
template<int THRL> __device__ __forceinline__ void attn_unit(const bf16*Qb,const bf16*__restrict__ Kh,const bf16*__restrict__ Vh,bf16*Ob,const int NT,char*shm){
  const int tid=threadIdx.x,lane=tid&63,r32=lane&31,hi=lane>>5; const int wid=__builtin_amdgcn_readfirstlane(tid>>6);
  const bf16*Qw=Qb+(long)(wid*QBLK)*DMQ;
  const unsigned lds0=(unsigned)(uintptr_t)shm;
  float*wsf=(float*)(shm+LDS_WS)+wid*64;
  const bf16*ksrc=Kh+(long)lane*DMK+wid*8;
  const bf16*vsrc=Vh+(long)(16*(wid&3)+(lane>>2))*DMV+(wid>>2)*32+(lane&3)*8;
  const unsigned kdst=lds0+LDS_K+wid*1024, vdst=lds0+LDS_V+wid*1024;
  #define DMA_K(t,slot) glds16(ksrc+(long)(t)*KVBLK*DMK,(unsigned)__builtin_amdgcn_readfirstlane(kdst+(slot)))
  #define DMA_V(t,slot) glds16(vsrc+(long)(t)*KVBLK*DMV,(unsigned)__builtin_amdgcn_readfirstlane(vdst+(slot)))
  const int vb0=(int)(lds0+LDS_V)+((lane>>4)&1)*32+(lane&3)*8+(4*hi+((lane&15)>>2))*64;
  const char*Kbase=shm+LDS_K; bf16x8 kf[8];
  const lds_cptr shm3=(lds_cptr)shm; const lds_cptr kp0=shm3+LDS_K+hi*1024+r32*16; const lds_cptr vp0=shm3+LDS_V+((lane>>4)&1)*32+(lane&3)*8+(4*hi+((lane&15)>>2))*64;
  DMA_K(0,0);DMA_V(0,0);DMA_K(1,SLOTB);
  bf16x8 qr[4];
  #pragma unroll
  for(int d0=0;d0<4;++d0)qr[d0]=*reinterpret_cast<const bf16x8*>(&Qw[(long)r32*DMQ+d0*16+hi*8]);
  float mhat=0.f,l_reg=0.f;f32x16 o[2];o[0]=f32x16{};o[1]=f32x16{};f32x16 negm=f32x16{};asm volatile("":"+v"(negm));
  #define CMASK(P0,P1,t) do{}while(0)
  bool resc=false;
  #define START(P0,P1) do{ const float rm=rowmax(P0,P1); resc=false; \
    { const float dl=rm; mhat=fadd_s(mhat,dl); \
      _Pragma("unroll") for(int r=0;r<16;++r){P0[r]=fsub_s(P0[r],dl);P1[r]=fsub_s(P1[r],dl);} \
      _Pragma("unroll") for(int r=0;r<16;++r)negm[r]=-mhat; asm volatile("":"+v"(negm)); } \
    _Pragma("unroll") for(int r=0;r<16;++r)P0[r]=__builtin_amdgcn_exp2f(P0[r]); }while(0)
  #define RESC() do{ if(resc){ asm volatile("s_waitcnt lgkmcnt(0)":::"memory"); \
      _Pragma("unroll") for(int d_=0;d_<2;++d_) _Pragma("unroll") for(int r=0;r<16;++r)o[d_][r]*=wsf[crow(r,hi)]; } }while(0)
  f32x16 pA0,pA1,pB0,pB1;
  int sl_prev=0,sl_cur=0,sl_next=SLOTB;
  #define ROT() do{sl_prev=sl_cur;sl_cur=sl_next;sl_next=(sl_next==(NSLOT-1)*SLOTB)?0:sl_next+SLOTB;}while(0)
  DMA_K(2,2*SLOTB);
  WAIT_BAR(3);
  qkt(pA0,pA1,Kbase,qr,negm,r32,hi);asm volatile("s_nop 15\n\ts_nop 7":"+v"(pA0),"+v"(pA1));CMASK(pA0,pA1,0);
  START(pA0,pA1);
  _Pragma("unroll") for(int r=0;r<16;++r)pA1[r]=__builtin_amdgcn_exp2f(pA1[r]);
  WAIT_BAR(0);
  DMA_K(3,0);DMA_V(1,SLOTB);
  ROT();
  kload8(kf,kp0+sl_cur);
  WAIT_BAR(2);
  s16x4 vlo[8],vhi[8]; u32x4 pw0,pw1,pw2,pw3;
  #define PKW(P,B) cvtpk_s(P[B],P[B+1])
  #define PAF(k) __builtin_bit_cast(bf16x8,pw##k)
  #define VFR(i) (bf16x8){vlo[i][0],vlo[i][1],vlo[i][2],vlo[i][3],vhi[i][0],vhi[i][1],vhi[i][2],vhi[i][3]}
  #define PIN(x) asm volatile("":"+v"(x))
  #define MX3(a,b,c) __builtin_fmaxf(__builtin_fmaxf((a),(b)),(c))
  #define GAPA(MF,A0,A1,A2,A3,W0,W1,PW) do{ MF; sacc+=A0; sacc+=A1; sacc+=A2; sacc+=A3; PIN(sacc); W0; W1; PIN(PW); SBAR(); }while(0)
  #define EX(v) __builtin_amdgcn_exp2f(v)
  #define GAPB(MF,X,B) do{ MF; X[B]=EX(X[B]); X[B+1]=EX(X[B+1]); X[B+2]=EX(X[B+2]); X[B+3]=EX(X[B+3]); PIN(X); SBAR(); }while(0)
  #define VRD(i) do{ vlo[i]=vtr(vp_+(((i)>>2)*4096+((i)&3)*1024)); vhi[i]=vtr(vp_+(((i)>>2)*4096+((i)&3)*1024+512)); }while(0)
  #define KRD(G,j) do{ if(G){ kload2(kf,kp0+sl_next,j); SBAR(); } }while(0)
  #define STEP(C0,C1,P0,P1,t,GK,GV,GL) do{ SBAR(); \
    const lds_cptr vp_=vp0+sl_prev; \
    VRD(0); SBAR(); float sacc=(P0[0]+P0[1]); \
    GAPA(C0=__builtin_amdgcn_mfma_f32_32x32x16_bf16(kf[0],qr[0],negm,0,0,0), P0[2],P0[3],P0[4],P0[5],     pw0[0]=PKW(P0,0), pw0[1]=PKW(P0,2), pw0); \
    VRD(4); SBAR(); GAPA(C1=__builtin_amdgcn_mfma_f32_32x32x16_bf16(kf[1],qr[0],negm,0,0,0), P0[6],P0[7],P0[8],P0[9],     pw0[2]=PKW(P0,4), pw0[3]=PKW(P0,6), pw0); \
    VRD(1); SBAR(); GAPA(C0=__builtin_amdgcn_mfma_f32_32x32x16_bf16(kf[2],qr[1],C0,0,0,0),   P0[10],P0[11],P0[12],P0[13], pw1[0]=PKW(P0,8), pw1[1]=PKW(P0,10), pw1); \
    VRD(5); SBAR(); GAPA(C1=__builtin_amdgcn_mfma_f32_32x32x16_bf16(kf[3],qr[1],C1,0,0,0),   P0[14],P0[15],P1[0],P1[1],   pw1[2]=PKW(P0,12),pw1[3]=PKW(P0,14), pw1); \
    VRD(2); SBAR(); GAPA(C0=__builtin_amdgcn_mfma_f32_32x32x16_bf16(kf[4],qr[2],C0,0,0,0),   P1[2],P1[3],P1[4],P1[5],     pw2[0]=PKW(P1,0), pw2[1]=PKW(P1,2), pw2); \
    VRD(6); SBAR(); GAPA(C1=__builtin_amdgcn_mfma_f32_32x32x16_bf16(kf[5],qr[2],C1,0,0,0),   P1[6],P1[7],P1[8],P1[9],     pw2[2]=PKW(P1,4), pw2[3]=PKW(P1,6), pw2); \
    VRD(3); SBAR(); GAPA(C0=__builtin_amdgcn_mfma_f32_32x32x16_bf16(kf[6],qr[3],C0,0,0,0),   P1[10],P1[11],P1[12],P1[13], pw3[0]=PKW(P1,8), pw3[1]=PKW(P1,10), pw3); \
    VRD(7); SBAR(); GAPA(C1=__builtin_amdgcn_mfma_f32_32x32x16_bf16(kf[7],qr[3],C1,0,0,0),   P1[14],P1[15],0.f,0.f,       pw3[2]=PKW(P1,12),pw3[3]=PKW(P1,14), pw3); \
    l_reg+=sacc; \
    if(GK){DMA_K((t)+3,sl_cur);} if(GV){DMA_V((t)+1,sl_next);} \
    CMASK(C0,C1,t); \
    { float a=MX3(C0[0],C0[1],C1[0]),b=MX3(C0[2],C0[3],C1[1]); a=MX3(a,C1[2],C1[3]); \
      _Pragma("unroll") for(int r=4;r<16;r+=4){a=MX3(a,C0[r],C0[r+1]);b=MX3(b,C0[r+2],C0[r+3]);a=MX3(a,C1[r],C1[r+1]);b=MX3(b,C1[r+2],C1[r+3]);} \
      float rm=__builtin_fmaxf(a,b); { auto rr=__builtin_amdgcn_permlane32_swap(__float_as_uint(rm),__float_as_uint(rm),false,false); rm=__builtin_fmaxf(__uint_as_float(rr[0]),__uint_as_float(rr[1])); } \
      resc=false; \
      if(__builtin_expect(__any(rm>(float)THRL),0)){ const float dl=__builtin_fmaxf(rm,0.f); mhat+=dl; \
        _Pragma("unroll") for(int r=0;r<16;++r){C0[r]-=dl;C1[r]-=dl;} \
        _Pragma("unroll") for(int r=0;r<16;++r)negm[r]=-mhat; asm volatile("":"+v"(negm)); \
        const float f=__builtin_amdgcn_exp2f(-dl); l_reg*=f; if(hi==0)wsf[r32]=f; resc=true; } } \
    SBAR(); \
    GAPB(o[0]=__builtin_amdgcn_mfma_f32_32x32x16_bf16(PAF(0),VFR(0),o[0],0,0,0), C0,0); \
    GAPB(o[1]=__builtin_amdgcn_mfma_f32_32x32x16_bf16(PAF(0),VFR(4),o[1],0,0,0), C0,4); \
    KRD(GL,0); GAPB(o[0]=__builtin_amdgcn_mfma_f32_32x32x16_bf16(PAF(1),VFR(1),o[0],0,0,0), C0,8); \
    KRD(GL,1); GAPB(o[1]=__builtin_amdgcn_mfma_f32_32x32x16_bf16(PAF(1),VFR(5),o[1],0,0,0), C0,12); \
    KRD(GL,2); GAPB(o[0]=__builtin_amdgcn_mfma_f32_32x32x16_bf16(PAF(2),VFR(2),o[0],0,0,0), C1,0); \
    KRD(GL,3); GAPB(o[1]=__builtin_amdgcn_mfma_f32_32x32x16_bf16(PAF(2),VFR(6),o[1],0,0,0), C1,4); \
    GAPB(o[0]=__builtin_amdgcn_mfma_f32_32x32x16_bf16(PAF(3),VFR(3),o[0],0,0,0), C1,8); \
    GAPB(o[1]=__builtin_amdgcn_mfma_f32_32x32x16_bf16(PAF(3),VFR(7),o[1],0,0,0), C1,12); \
    }while(0)
  int t=1;
  #undef CMASK
  #define CMASK(P0,P1,t) do{}while(0)
  for(;t+5<NT;t+=2){
    STEP(pB0,pB1,pA0,pA1,t,true,true,true);     WAIT_BAR(2); RESC(); ROT();
    STEP(pA0,pA1,pB0,pB1,t+1,true,true,true);   WAIT_BAR(2); RESC(); ROT();
  }
  #undef CMASK
  #define CMASK(P0,P1,t) do{}while(0)
  #define ENDW(tt) do{ if((tt)+3<NT){WAIT_BAR(2);} else if((tt)+2<NT){WAIT_BAR(1);} else {WAIT_BAR(0);} }while(0)
  for(;t+1<NT;t+=2){
    STEP(pB0,pB1,pA0,pA1,t,(t+3<NT),(t+1<NT),(t+1<NT));       ENDW(t);   RESC(); ROT();
    STEP(pA0,pA1,pB0,pB1,t+1,(t+4<NT),(t+2<NT),(t+2<NT));     ENDW(t+1); RESC(); ROT();
  }
  STEP(pB0,pB1,pA0,pA1,NT-1,false,false,false); RESC();
  { float sacc=pB0[0]+pB0[1]; _Pragma("unroll") for(int r=2;r<16;++r)sacc+=pB0[r]; _Pragma("unroll") for(int r=0;r<16;++r)sacc+=pB1[r]; l_reg+=sacc;
    pw0=(u32x4){PKW(pB0,0),PKW(pB0,2),PKW(pB0,4),PKW(pB0,6)};pw1=(u32x4){PKW(pB0,8),PKW(pB0,10),PKW(pB0,12),PKW(pB0,14)};pw2=(u32x4){PKW(pB1,0),PKW(pB1,2),PKW(pB1,4),PKW(pB1,6)};pw3=(u32x4){PKW(pB1,8),PKW(pB1,10),PKW(pB1,12),PKW(pB1,14)};
    SBAR(); pv(o,vb0+sl_cur,PAF(0),PAF(1),PAF(2),PAF(3)); }
  #undef PKW
  #undef PAF
  #undef VFR
  #undef PIN
  #undef MX3
  #undef GAPA
  #undef GAPB
  #undef EX
  #undef VRD
  #undef KRD
  #undef STEP
  #undef ENDW
  {auto rr=__builtin_amdgcn_permlane32_swap(__float_as_uint(l_reg),__float_as_uint(l_reg),false,false);l_reg=__uint_as_float(rr[0])+__uint_as_float(rr[1]);}
  if(hi==0)wsf[32+r32]=l_reg;asm volatile("s_waitcnt lgkmcnt(0)":::"memory");
  float rli[16];
  #pragma unroll
  for(int r=0;r<16;++r)rli[r]=__builtin_amdgcn_rcpf(wsf[32+crow(r,hi)]);
  bf16*Ow=Ob+(long)(wid*QBLK)*DMO;
  { bf16*stg=(bf16*)(shm+LDS_OST)+wid*2048;
    #pragma unroll
    for(int r=0;r<16;++r){const int orow=crow(r,hi);
      #pragma unroll
      for(int d0=0;d0<2;++d0)stg[orow*64+d0*32+r32]=__float2bfloat16(o[d0][r]*rli[r]);}
    asm volatile("s_waitcnt lgkmcnt(0)":::"memory");
    #pragma unroll
    for(int i=0;i<4;++i){const int row=i*8+(lane>>3),ch=lane&7; const u32x4 v=*(const u32x4*)(stg+row*64+ch*8); ATTN_STORE16(Ow+(long)row*DMO+ch*8,v);} }
  asm volatile("s_waitcnt lgkmcnt(0)\n\ts_barrier":::"memory");
  #undef DMA_K
  #undef DMA_V
  #undef CMASK
  #undef START
  #undef RESC
  #undef ROT
}
constexpr int ATTN_LDS_BYTES=LDS_BYTES;
#undef SBAR
#undef WAIT_BAR
}
typedef unsigned short bf16;
typedef unsigned v4u __attribute__((ext_vector_type(4)));
typedef float f32x4 __attribute__((ext_vector_type(4)));
#define LAS __attribute__((address_space(3)))
constexpr int NWAVES = 8;
constexpr int D = 1024, FF = 4096, NIN = 2304, PLE = 256;
constexpr int ZP = att::LDZ;
constexpr int MP = 4 * 8192, MS = 8 * 2048, M = MP + MS;
constexpr int SEQ_P = 8192, SEQ_S = 2048;
constexpr float C2 = 0.125f * 1.4426950408889634f;
constexpr float LOG2E = 1.4426950408889634f;
constexpr size_t MiB = 1u << 20;
constexpr size_t WS_RSP1 = 1 * MiB, WS_RSP2 = 4 * MiB, WS_RSP3 = 7 * MiB;
constexpr size_t WS_WIN = 10 * MiB, WS_WOUT = 15 * MiB, WS_W1 = 17 * MiB, WS_W2 = 25 * MiB, WS_WG = 33 * MiB, WS_WP = 35 * MiB;
constexpr size_t WS_PB = 36 * MiB;
constexpr size_t WS_PROJ = 60 * MiB;
constexpr size_t WS_Z = 156 * MiB;
constexpr size_t WS_HB = 156 * MiB;
constexpr size_t WS_XN = 380 * MiB;
constexpr size_t WS_H = 252 * MiB;
constexpr size_t WS_END = 512 * MiB;
static_assert(WS_XN + (size_t)M * D * 2 <= WS_END && WS_Z + (size_t)M * ZP * 2 <= WS_XN && WS_H + (size_t)16384 * FF * 2 <= WS_END && WS_HB + (size_t)M * D * 2 <= WS_H, "d_ws map");
constexpr int CW_PANEL = 4800;
constexpr size_t WS_XBUF = 65536;
constexpr int CW_QMAX = 3584, CW_KMAX = 3648, CW_DNEG = 3616, CW_QUEUE = 3712;
constexpr int CTL_BYTES = 32768;
constexpr float SKIP_T = 32.0f;
constexpr int LDS_BYTES = 147456;
static_assert(att::ATTN_LDS <= 131072 && attn_body::ATTN_LDS_BYTES <= 131072 && attn_body::DMQ == ZP, "attention LDS / pitches");

__device__ __forceinline__ unsigned f2bf(float f) { unsigned u = __builtin_bit_cast(unsigned, f); return (u + 0x7fffu + ((u >> 16) & 1u)) >> 16; }
__device__ __forceinline__ unsigned pk2(float lo, float hi) { return f2bf(lo) | (f2bf(hi) << 16); }
__device__ __forceinline__ float wave_sum(float v) {
#pragma unroll
    for (int o = 1; o < 64; o <<= 1) v += __shfl_xor(v, o);
    return v;
}
__device__ __forceinline__ void transpose_item(const float* W, int K, int N, const float* g, bf16* WT, LAS float* scr, int item, int lane) {
    const int nblk = N / 32, kb = item / nblk, nb = item % nblk, k0 = 64 * kb, n0 = 32 * nb;
#pragma unroll 8
    for (int i = 0; i < 32; ++i) { const int kk = 2 * i + (lane >> 5); const float gs = g ? g[k0 + kk] : 1.f; scr[kk * 33 + (lane & 31)] = W[(size_t)(k0 + kk) * N + n0 + (lane & 31)] * gs; }
    asm volatile("s_waitcnt lgkmcnt(0)" ::: "memory");
    const int c = lane & 7;
#pragma unroll
    for (int j = 0; j < 4; ++j) { const int n = (lane >> 3) + 8 * j; const LAS float* s = scr + (8 * c) * 33 + n;
        v4u o; o.x = pk2(s[0 * 33], s[1 * 33]); o.y = pk2(s[2 * 33], s[3 * 33]); o.z = pk2(s[4 * 33], s[5 * 33]); o.w = pk2(s[6 * 33], s[7 * 33]);
        *(v4u*)(WT + (size_t)(n0 + n) * K + k0 + 8 * c) = o; }
    asm volatile("s_waitcnt lgkmcnt(0)" ::: "memory");
}

#define XB_TMO      128
#define XB_XCNT(j)  (256  + 64 * (j))
#define XB_XSUB(j)  (1280 + 64 * (j))
#define XB_XGEN(j)  (2304 + 64 * (j))
#define XB_TOP      3328
#define XB_TOPGEN   3392
#define XCD_BAR_WORDS 3456
#define XB_SPIN_CAP (1u << 22)

__device__ __forceinline__ unsigned xb_ld(unsigned* p)              { return __hip_atomic_load(p, __ATOMIC_RELAXED, __HIP_MEMORY_SCOPE_AGENT); }
__device__ __forceinline__ unsigned xb_add(unsigned* p, unsigned v) { return __hip_atomic_fetch_add(p, v, __ATOMIC_RELAXED, __HIP_MEMORY_SCOPE_AGENT); }
__device__ __forceinline__ unsigned xb_xcc_id() { return (unsigned)__builtin_amdgcn_s_getreg((3 << 11) | 20) & 0xFu; }
#define XB_SPIN(cond, bar) do { unsigned _sp = 0; while (cond) { __builtin_amdgcn_s_sleep(1); \
    if ((++_sp & 255u) == 0u) { if (xb_ld(&(bar)[XB_TMO])) break; if (_sp > XB_SPIN_CAP) { atomicAdd(&(bar)[XB_TMO], 1u); break; } } } } while (0)

struct XcdBarrier {
    unsigned* bar; unsigned x;
    volatile LAS unsigned* st;
};

__device__ __forceinline__ XcdBarrier xcd_barrier_post(unsigned* bar, volatile LAS unsigned* st) {
    XcdBarrier b; b.bar = bar; b.x = xb_xcc_id(); b.st = st;
    if (threadIdx.x == 0) (void)xb_add(&bar[XB_XCNT(b.x)], 1u);
    return b;
}
__device__ __forceinline__ void xcd_barrier_complete(unsigned* bar, unsigned x, unsigned& nloc, unsigned& nx) {
    const unsigned G = gridDim.x * gridDim.y * gridDim.z;
    unsigned sum, cnt, mine, sp = 0u;
    for (;;) {
        sum = 0u; cnt = 0u; mine = 0u;
#pragma unroll
        for (unsigned j = 0; j < 16; ++j) { const unsigned c = xb_ld(&bar[XB_XCNT(j)]); sum += c; cnt += (c > 0u) ? 1u : 0u; mine = (j == x) ? c : mine; }
        if (sum == G) break;
        __builtin_amdgcn_s_sleep(1);
        if ((++sp & 255u) == 0u) { if (xb_ld(&bar[XB_TMO])) break; if (sp > XB_SPIN_CAP) { atomicAdd(&bar[XB_TMO], 1u); break; } }
    }
    nloc = mine > 0u ? mine : 1u; nx = cnt > 0u ? cnt : 1u;
}

__device__ __forceinline__ void xcd_barrier(const XcdBarrier& b) {
    asm volatile("s_waitcnt vmcnt(0)" ::: "memory");
    __syncthreads();
    if (threadIdx.x == 0) {
        unsigned* bar = b.bar;
        __builtin_amdgcn_s_waitcnt(0);
        unsigned nloc = b.st[0], nx = b.st[1];
        if (nloc == 0u) { xcd_barrier_complete(bar, b.x, nloc, nx); b.st[0] = nloc; b.st[1] = nx; }
        const unsigned old = xb_add(&bar[XB_XSUB(b.x)], 1u);
        const unsigned gen = old / nloc;
        if (old + 1u == (gen + 1u) * nloc) {
            __builtin_amdgcn_fence(__ATOMIC_RELEASE, "agent");
            asm volatile("s_waitcnt vmcnt(0)" ::: "memory");
            const unsigned og = xb_add(&bar[XB_TOP], 1u);
            const unsigned tg = og / nx;
            if (og + 1u == (tg + 1u) * nx) xb_add(&bar[XB_TOPGEN], 1u);
            else XB_SPIN(xb_ld(&bar[XB_TOPGEN]) == tg, bar);
            __builtin_amdgcn_fence(__ATOMIC_ACQUIRE, "agent");
            xb_add(&bar[XB_XGEN(b.x)], 1u);
            asm volatile("s_waitcnt vmcnt(0)" ::: "memory");
        } else {
            XB_SPIN(xb_ld(&bar[XB_XGEN(b.x)]) == gen, bar);
            __builtin_amdgcn_fence(__ATOMIC_ACQUIRE, "agent");
            asm volatile("s_waitcnt vmcnt(0)" ::: "memory");
        }
    }
    __syncthreads();
}

struct Args { const float* in[21]; float* out; unsigned char* ws; };

__global__ void __launch_bounds__(NWAVES * 64, 2) fwd_mega(Args args) {
    extern __shared__ __attribute__((aligned(16))) unsigned char lds[];
    cg::grid_group grid = cg::this_grid();
#define PHASE_IDS() int tid_p = threadIdx.x; asm volatile("" : "+v"(tid_p)); const int tid = tid_p, lane = tid & 63, wave = __builtin_amdgcn_readfirstlane(tid >> 6); const int gw = bx * NWAVES + wave; (void)lane; (void)gw; (void)tid
    const int G = gridDim.x, bx = blockIdx.x;
    const int NGW = G * NWAVES;
    unsigned char* ws = args.ws;
    const float* x_p = args.in[0]; const float* x_s = args.in[1]; const float* p_p = args.in[2]; const float* p_s = args.in[3];
    const float* w_in = args.in[4]; const float* g_mix = args.in[5];
    const float* lq1 = args.in[6]; const float* lk1 = args.in[7]; const float* lq2 = args.in[8]; const float* lk2 = args.in[9];
    const float* g_subln = args.in[10]; const float* g_qn = args.in[11]; const float* g_kn = args.in[12];
    const float* w_out = args.in[13]; const float* g_mlp = args.in[14]; const float* w_ff1 = args.in[15]; const float* w_ff2 = args.in[16];
    const float* g_ple = args.in[17]; const float* w_gate = args.in[18]; const float* w_proj = args.in[19]; const float* g_final = args.in[20];
    float* out = args.out;
    float* RSP1 = (float*)(ws + WS_RSP1); float* RSP2 = (float*)(ws + WS_RSP2); float* RSP3 = (float*)(ws + WS_RSP3);
    bf16* WinT = (bf16*)(ws + WS_WIN); bf16* WoutT = (bf16*)(ws + WS_WOUT); bf16* W1T = (bf16*)(ws + WS_W1); bf16* W2T = (bf16*)(ws + WS_W2); bf16* WgT = (bf16*)(ws + WS_WG); bf16* WpT = (bf16*)(ws + WS_WP);
    bf16* PB = (bf16*)(ws + WS_PB); bf16* PROJ = (bf16*)(ws + WS_PROJ); bf16* Z = (bf16*)(ws + WS_Z); bf16* HB = (bf16*)(ws + WS_HB);
    bf16* XN = (bf16*)(ws + WS_XN); bf16* MIX = XN; bf16* HH = (bf16*)(ws + WS_H);
    LAS unsigned char* ldsl = (LAS unsigned char*)lds;
    volatile LAS unsigned* bst = (volatile LAS unsigned*)(ldsl + 139264);
    if (threadIdx.x < 2) bst[threadIdx.x] = 0u;
    __syncthreads();
    const XcdBarrier bar = xcd_barrier_post((unsigned*)ws, bst);
    if (ws == nullptr) grid.sync();

#ifndef NO_P0
#ifdef PROBE_EW2
    for (int rep = 0; rep < 2; ++rep)
#endif
    {
        PHASE_IDS();
        LAS float* scr = (LAS float*)(ldsl + wave * 16384);
        constexpr int I_IN = (D / 64) * (NIN / 32), I_OUT = (D / 64) * (D / 32), I_1 = (D / 64) * (FF / 32), I_2 = (FF / 64) * (D / 32), I_G = I_OUT, I_P = (PLE / 64) * (D / 32);
        constexpr int NITEMS = I_IN + I_OUT + I_1 + I_2 + I_G + I_P;
        for (int it = gw; it < NITEMS; it += NGW) {
            int r = it;
            if (r < I_IN) { transpose_item(w_in, D, NIN, nullptr, WinT, scr, r, lane); continue; } r -= I_IN;
            if (r < I_OUT) { transpose_item(w_out, D, D, nullptr, WoutT, scr, r, lane); continue; } r -= I_OUT;
            if (r < I_1) { transpose_item(w_ff1, D, FF, g_mlp, W1T, scr, r, lane); continue; } r -= I_1;
            if (r < I_2) { transpose_item(w_ff2, FF, D, nullptr, W2T, scr, r, lane); continue; } r -= I_2;
            if (r < I_G) { transpose_item(w_gate, D, D, g_ple, WgT, scr, r, lane); continue; } r -= I_G;
            transpose_item(w_proj, PLE, D, nullptr, WpT, scr, r, lane);
        }
        f32x4 gv[4];
#pragma unroll
        for (int j = 0; j < 4; ++j) gv[j] = *((const f32x4*)g_mix + lane + 64 * j);
        for (int m0 = gw * 2; m0 < M; m0 += NGW * 2) {
            f32x4 v[2][4], pv[2];
#pragma unroll
            for (int r = 0; r < 2; ++r) { const int m = m0 + r;
                const float* xrow = m < MP ? x_p + (size_t)m * D : x_s + (size_t)(m - MP) * D;
                const float* prow = m < MP ? p_p + (size_t)m * PLE : p_s + (size_t)(m - MP) * PLE;
#pragma unroll
                for (int j = 0; j < 4; ++j) v[r][j] = *((const f32x4*)xrow + lane + 64 * j);
                pv[r] = *((const f32x4*)prow + lane); }
#pragma unroll
            for (int r = 0; r < 2; ++r) { const int m = m0 + r; float s = 0.f;
#pragma unroll
                for (int j = 0; j < 4; ++j) s += (v[r][j].x * v[r][j].x + v[r][j].y * v[r][j].y) + (v[r][j].z * v[r][j].z + v[r][j].w * v[r][j].w);
                const float rstd = 1.0f / sqrtf(wave_sum(s) * (1.0f / D) + 1e-6f);
                unsigned long long* o8 = (unsigned long long*)(XN + (size_t)m * D) + lane;
#pragma unroll
                for (int j = 0; j < 4; ++j) { const f32x4 y = v[r][j] * rstd * gv[j]; o8[64 * j] = (unsigned long long)pk2(y.x, y.y) | ((unsigned long long)pk2(y.z, y.w) << 32); }
                *((unsigned long long*)(PB + (size_t)m * PLE) + lane) = (unsigned long long)pk2(pv[r].x, pv[r].y) | ((unsigned long long)pk2(pv[r].z, pv[r].w) << 32); }
        }
    }
#endif
    xcd_barrier(bar);

#ifndef NO_P1
#ifdef PROBE_GEMM2
    for (int rep = 0; rep < 2; ++rep)
#endif
    {
        pg8::Gemm g{XN, WinT, M, NIN, D}; pg8::StaticOrder S; S.init(M, NIN, G, bx);
        pg8::EpiBf E{Z, ZP, C2, 2};
        pg8::gemm_phase<pg8::EpiBf, pg8::StaticOrder, true, true>(ldsl, g, S, E);
    }
    {
        pg8::Gemm g{PB, WpT, M, D, PLE}; pg8::StaticOrder S; S.init(M, D, G, bx);
        pg8::EpiBf E{PROJ, D, 1.f, 0};
        pg8::gemm_phase<pg8::EpiBf, pg8::StaticOrder, true, true>(ldsl, g, S, E);
    }
#endif
    xcd_barrier(bar);

#ifndef NO_P1B
    {
        int tl = threadIdx.x; asm volatile("" : "+v"(tl));
        const long nth = (long)G * 512;
        const int j4 = (tl & 3) * 4;
        {
            float mq = 0.f, mk = 0.f, md = 0.f;
            for (long it = (long)bx * 512 + tl; it < (long)M * 32; it += nth) {
                const long item = it >> 2; const int m = (int)(item >> 3), hc = (int)(item & 7);
                const bf16* p = Z + (size_t)m * ZP + hc * 64 + j4; float sq = 0.f, sk = 0.f, sd = 0.f;
#pragma unroll
                for (int q = 0; q < 4; ++q) { const unsigned long long w = *(const unsigned long long*)(p + 16 * q), wk = *(const unsigned long long*)(p + 512 + 16 * q);
                    const unsigned lo = (unsigned)w, hi = (unsigned)(w >> 32), klo = (unsigned)wk, khi = (unsigned)(wk >> 32);
                    const float a = __uint_as_float(lo << 16), b = __uint_as_float(lo & 0xffff0000u), c = __uint_as_float(hi << 16), d = __uint_as_float(hi & 0xffff0000u);
                    const float ka = __uint_as_float(klo << 16), kb = __uint_as_float(klo & 0xffff0000u), kc = __uint_as_float(khi << 16), kd = __uint_as_float(khi & 0xffff0000u);
                    sq += (a * a + b * b) + (c * c + d * d); sk += (ka * ka + kb * kb) + (kc * kc + kd * kd); sd += (a * ka + b * kb) + (c * kc + d * kd); }
                sq += __shfl_xor(sq, 1); sq += __shfl_xor(sq, 2); sk += __shfl_xor(sk, 1); sk += __shfl_xor(sk, 2); sd += __shfl_xor(sd, 1); sd += __shfl_xor(sd, 2);
                mq = fmaxf(mq, sq); mk = fmaxf(mk, sk); md = fmaxf(md, -sd);
            }
#pragma unroll
            for (int o = 1; o < 64; o <<= 1) { mq = fmaxf(mq, __shfl_xor(mq, o)); mk = fmaxf(mk, __shfl_xor(mk, o)); md = fmaxf(md, __shfl_xor(md, o)); }
            if ((tl & 63) == 0) { atomicMax((unsigned*)ws + CW_QMAX, __float_as_uint(sqrtf(mq) * 1.0001f)); atomicMax((unsigned*)ws + CW_KMAX, __float_as_uint(sqrtf(mk) * 1.0001f));
                                  atomicMax((unsigned*)ws + CW_DNEG, __float_as_uint(md * 1.0001f + 1e-3f)); }
        }
        for (long it = (long)bx * 512 + tl; it < (long)M * 40; it += nth) {
            const long item = it >> 2;
            const int m = (int)(item / 10), hh = (int)(item % 10);
            const int t = m < MP ? (m & (SEQ_P - 1)) : ((m - MP) & (SEQ_S - 1));
            bf16* p = Z + (size_t)m * ZP + 1536 + hh * 64 + j4;
            const float* gg = (hh < 8 ? g_qn : g_kn) + j4;
            float v[4][4]; float ss = 0.f;
#pragma unroll
            for (int q = 0; q < 4; ++q) { const unsigned long long w = *(const unsigned long long*)(p + 16 * q); const unsigned lo = (unsigned)w, hi = (unsigned)(w >> 32);
                v[q][0] = __uint_as_float(lo << 16); v[q][1] = __uint_as_float(lo & 0xffff0000u); v[q][2] = __uint_as_float(hi << 16); v[q][3] = __uint_as_float(hi & 0xffff0000u);
                ss += (v[q][0] * v[q][0] + v[q][1] * v[q][1]) + (v[q][2] * v[q][2] + v[q][3] * v[q][3]); }
            ss += __shfl_xor(ss, 1); ss += __shfl_xor(ss, 2);
            const float rstd = 1.0f / sqrtf(ss * (1.0f / 64.0f) + 1e-6f);
#pragma unroll
            for (int q = 0; q < 4; ++q) { const f32x4 g4 = *(const f32x4*)(gg + 16 * q);
#pragma unroll
                for (int e = 0; e < 4; ++e) v[q][e] = v[q][e] * rstd * g4[e]; }
            const float fr = (float)(t >> 6), fc = (float)(t & 63), osc = hh < 8 ? C2 : 1.f;
#pragma unroll
            for (int e = 0; e < 4; ++e) {
                const float invf = __builtin_amdgcn_exp2f(-(float)(j4 + e) * (13.287712379549449f / 16.0f));
                const float ar = fr * invf, ac = fc * invf;
                const float cr = __cosf(ar), sr = __sinf(ar), cc = __cosf(ac), sc = __sinf(ac);
                const float a1 = v[0][e], a2 = v[1][e]; v[0][e] = (a1 * cr - a2 * sr) * osc; v[1][e] = (a1 * sr + a2 * cr) * osc;
                const float b1 = v[2][e], b2 = v[3][e]; v[2][e] = (b1 * cc - b2 * sc) * osc; v[3][e] = (b1 * sc + b2 * cc) * osc;
            }
#pragma unroll
            for (int q = 0; q < 4; ++q) *(unsigned long long*)(p + 16 * q) = (unsigned long long)pk2(v[q][0], v[q][1]) | ((unsigned long long)pk2(v[q][2], v[q][3]) << 32);
        }
    }
#endif
    xcd_barrier(bar);

#ifndef NO_P2
    {
        const float qkb = __uint_as_float(((const unsigned*)ws)[CW_QMAX]) * __uint_as_float(((const unsigned*)ws)[CW_KMAX]) + __uint_as_float(((const unsigned*)ws)[CW_DNEG]) + SKIP_T;
        PHASE_IDS();
        volatile LAS int* qslot = (volatile LAS int*)(ldsl + 139280);
        const int x0 = (int)(bar.x & 7u);
        for (int dx = 0; dx < 8; ++dx) {
            const int x = (x0 + dx) & 7;
            for (;;) {
                if (tid == 0) *qslot = (int)__hip_atomic_fetch_add((unsigned*)ws + CW_QUEUE + 64 * x, 1u, __ATOMIC_RELAXED, __HIP_MEMORY_SCOPE_AGENT);
                __syncthreads();
                const int i = *qslot;
                __syncthreads();
                if (i >= 384) break;
                int kind, h = 0, c = 0, head = 0, qb;
                if (i < 32) { kind = 0; h = 3; qb = i; }
                else if (i < 64) { kind = 0; h = 2; qb = i - 32; }
                else if (i < 192) { kind = 1; head = (x & 1) * 4 + ((i - 64) >> 5); qb = (i - 64) & 31; }
                else if (i < 224) { kind = 0; h = 1; qb = i - 192; }
                else if (i < 256) { kind = 2; h = 3 - ((i - 224) >> 4); c = ((i - 224) & 15) >> 3; qb = (i - 224) & 7; }
                else if (i < 320) { kind = 3; head = (i - 256) >> 3; qb = (i - 256) & 7; }
                else if (i < 336) { kind = 2; h = 1; c = (i - 320) >> 3; qb = (i - 320) & 7; }
                else if (i < 368) { kind = 0; h = 0; qb = i - 336; }
                else { kind = 2; h = 0; c = (i - 368) >> 3; qb = (i - 368) & 7; }
                const bool prompt = kind < 2;
                const int b = prompt ? (x >> 1) : x; if (kind == 0) c = x & 1;
                const int S = prompt ? SEQ_P : SEQ_S; const long rowbase = prompt ? (long)b * SEQ_P : (long)MP + (long)b * SEQ_S;
                const int q0 = qb * 256, NT = S / 64;
                const bf16* Zb = Z + rowbase * ZP;
                if (!(kind & 1)) {
                    const float slope = (h == 0 ? 0.25f : h == 1 ? 0.0625f : h == 2 ? 0.015625f : 0.00390625f), sl2 = LOG2E * slope;
                    const float W = qkb / sl2;
                    int t_lo = (int)floorf(fmaxf((float)q0 - W, 0.f) * (1.0f / 64.0f));
                    int t_hi = (int)fminf(floorf(((float)(q0 + 255) + W) * (1.0f / 64.0f)) + 1.0f, (float)NT);
                    if ((t_hi - t_lo) & 1) { if (t_lo > 0) --t_lo; else ++t_hi; }
                    const int hd = h * 2 + c;
                    att::attn_unit_pp<128, true, bf16>(Zb + (long)q0 * ZP + h * 128 + c * 64, Zb + (long)t_lo * 64 * ZP + 512 + h * 128 + c * 64, Zb + (long)t_lo * 64 * ZP + 1024 + h * 128,
                                                     (bf16*)out + (rowbase + q0) * 1024 + hd * 128, t_hi - t_lo, q0 - t_lo * 64, sl2, ldsl);
                } else {
                    attn_body::attn_unit<8>((const attn_body::bf16*)(Zb + (long)q0 * ZP + 1536 + head * 64), (const attn_body::bf16*)(Zb + 2048 + (head >> 2) * 64), (const attn_body::bf16*)(Zb + 2176 + (head >> 2) * 64),
                                            (attn_body::bf16*)(MIX + (rowbase + q0) * 1024 + 512 + head * 64), NT, (char*)lds);
                }
            }
        }
    }
#endif
    xcd_barrier(bar);

#ifndef NO_P2B
#ifdef PROBE_EW2
    for (int rep = 0; rep < 2; ++rep)
#endif
    {
        PHASE_IDS();
        const float d1 = wave_sum(lq1[lane] * lk1[lane]), d2 = wave_sum(lq2[lane] * lk2[lane]);
        const float lam = expf(d1) - expf(d2) + 0.2f;
        const int h = lane >> 4, e0 = (lane & 15) * 8;
        const f32x4 g0 = *(const f32x4*)(g_subln + e0), g1 = *(const f32x4*)(g_subln + e0 + 4);
        for (int m0 = gw * 4; m0 < M; m0 += NGW * 4) {
            v4u wa[4], wb[4];
#pragma unroll
            for (int r = 0; r < 4; ++r) { const bf16* o0 = (const bf16*)out + (size_t)(m0 + r) * 1024 + (h * 2) * 128 + e0; wa[r] = *(const v4u*)o0; wb[r] = *(const v4u*)(o0 + 128); }
#pragma unroll
            for (int r = 0; r < 4; ++r) {
                f32x4 a0, a1, b0, b1;
                a0.x = __uint_as_float(wa[r].x << 16); a0.y = __uint_as_float(wa[r].x & 0xffff0000u); a0.z = __uint_as_float(wa[r].y << 16); a0.w = __uint_as_float(wa[r].y & 0xffff0000u);
                a1.x = __uint_as_float(wa[r].z << 16); a1.y = __uint_as_float(wa[r].z & 0xffff0000u); a1.z = __uint_as_float(wa[r].w << 16); a1.w = __uint_as_float(wa[r].w & 0xffff0000u);
                b0.x = __uint_as_float(wb[r].x << 16); b0.y = __uint_as_float(wb[r].x & 0xffff0000u); b0.z = __uint_as_float(wb[r].y << 16); b0.w = __uint_as_float(wb[r].y & 0xffff0000u);
                b1.x = __uint_as_float(wb[r].z << 16); b1.y = __uint_as_float(wb[r].z & 0xffff0000u); b1.z = __uint_as_float(wb[r].w << 16); b1.w = __uint_as_float(wb[r].w & 0xffff0000u);
                a0 = a0 - lam * b0; a1 = a1 - lam * b1;
                float s2 = ((a0.x * a0.x + a0.y * a0.y) + (a0.z * a0.z + a0.w * a0.w)) + ((a1.x * a1.x + a1.y * a1.y) + (a1.z * a1.z + a1.w * a1.w));
                s2 += __shfl_xor(s2, 1); s2 += __shfl_xor(s2, 2); s2 += __shfl_xor(s2, 4); s2 += __shfl_xor(s2, 8);
                const float rstd = 0.8f / sqrtf(s2 * (1.0f / 128.0f) + 1e-5f);
                a0 = a0 * rstd * g0; a1 = a1 * rstd * g1;
                v4u w; w.x = pk2(a0.x, a0.y); w.y = pk2(a0.z, a0.w); w.z = pk2(a1.x, a1.y); w.w = pk2(a1.z, a1.w);
                *(v4u*)(MIX + (size_t)(m0 + r) * 1024 + h * 128 + e0) = w; }
        }
    }
#endif
    xcd_barrier(bar);

#ifndef NO_P3
#ifdef PROBE_GEMM2
    for (int rep = 0; rep < 2; ++rep)
#endif
    {
        pg8::Gemm g{MIX, WoutT, M, D, D}; pg8::StaticOrder S; S.init(M, D, G, bx);
        pg8::EpiRes<false> E{x_p, x_s, MP, HB, RSP1, 0};
        pg8::gemm_phase<pg8::EpiRes<false>, pg8::StaticOrder, true, true>(ldsl, g, S, E);
    }
#endif
    xcd_barrier(bar);

#ifndef NO_P45
    for (int ch = 0; ch < 3; ++ch) {
        const int r0 = ch * 16384;
#ifndef NO_FF1
#ifdef PROBE_GEMM2
        for (int rep = 0; rep < 2; ++rep)
#endif
        {
            pg8::Gemm g{HB + (size_t)r0 * D, W1T, 16384, FF, D}; pg8::StaticOrder S; S.init(16384, FF, G, bx);
            pg8::EpiFF1 E{RSP1, HH, r0};
            pg8::gemm_phase<pg8::EpiFF1, pg8::StaticOrder, true, true>(ldsl, g, S, E);
        }
#endif
        xcd_barrier(bar);
#ifndef NO_FF2
        {
            pg8::Gemm g{HH, W2T, 16384, D, FF}; pg8::StaticOrder S; S.init(16384, D, G, bx);
            pg8::EpiRes<true> E{nullptr, nullptr, 0, HB, RSP2, r0};
            pg8::gemm_phase<pg8::EpiRes<true>, pg8::StaticOrder, true, true>(ldsl, g, S, E);
        }
#endif
        xcd_barrier(bar);
    }

#endif
#ifndef NO_P6
    {
        pg8::Gemm g{HB, WgT, M, D, D}; pg8::StaticOrder S; S.init(M, D, G, bx);
        pg8::EpiGateNorm E{RSP2, PROJ, HB, out, g_final, (float*)(ws + WS_XBUF), (unsigned*)ws + CW_PANEL};
        pg8::gemm_phase<pg8::EpiGateNorm, pg8::StaticOrder, true, true>(ldsl, g, S, E);
    }
#endif
#if 0
    {
        PHASE_IDS();
        f32x4 gv[4];
#pragma unroll
        for (int j = 0; j < 4; ++j) gv[j] = *((const f32x4*)g_final + lane + 64 * j);
        for (int m0 = gw * 4; m0 < M; m0 += NGW * 4) {
            unsigned long long w[4][4]; float rstd[4];
#pragma unroll
            for (int r = 0; r < 4; ++r) { const unsigned long long* hr = (const unsigned long long*)(XN + (size_t)(m0 + r) * D) + lane;
#pragma unroll
                for (int j = 0; j < 4; ++j) w[r][j] = hr[64 * j];
                rstd[r] = 1.0f / sqrtf(pg8::rs16(RSP3 + (size_t)(m0 + r) * 16) * (1.0f / D) + 1e-6f); }
#pragma unroll
            for (int r = 0; r < 4; ++r) { f32x4* xr = (f32x4*)(out + (size_t)(m0 + r) * D) + lane;
#pragma unroll
                for (int j = 0; j < 4; ++j) { const unsigned lo = (unsigned)w[r][j], hi2 = (unsigned)(w[r][j] >> 32);
                    f32x4 hv; hv.x = __uint_as_float(lo << 16); hv.y = __uint_as_float(lo & 0xffff0000u); hv.z = __uint_as_float(hi2 << 16); hv.w = __uint_as_float(hi2 & 0xffff0000u);
                    xr[64 * j] = hv * rstd[r] * gv[j]; } }
        }
    }
#endif
}

extern "C" void kernel_launch(void* const* d_in, const int* in_sizes, int n_in, void* d_out, int out_size, void* d_ws, size_t ws_size, hipStream_t stream) {
    static int grid = 0;
    if (grid == 0) {
        if (n_in != 21 || out_size != M * D || ws_size < WS_END) { fprintf(stderr, "kernel_launch: unexpected shapes (n_in %d out %d ws %zu)\n", n_in, out_size, ws_size); grid = -1; return; }
        int dev = 0, cus = 0, per_cu = 0;
        hipGetDevice(&dev); hipDeviceGetAttribute(&cus, hipDeviceAttributeMultiprocessorCount, dev);
        if (hipFuncSetAttribute((const void*)fwd_mega, hipFuncAttributeMaxDynamicSharedMemorySize, LDS_BYTES) != hipSuccess) { fprintf(stderr, "kernel_launch: hipFuncSetAttribute failed\n"); grid = -1; return; }
        if (hipOccupancyMaxActiveBlocksPerMultiprocessor(&per_cu, (const void*)fwd_mega, NWAVES * 64, LDS_BYTES) != hipSuccess || per_cu < 1) { fprintf(stderr, "kernel_launch: occupancy query gave %d\n", per_cu); per_cu = 1; }
        (void)hipGetLastError();
        grid = cus * per_cu;
    }
    if (grid < 0) return;
    if (hipMemsetAsync(d_ws, 0, CTL_BYTES, stream) != hipSuccess) { fprintf(stderr, "kernel_launch: memset failed\n"); return; }
    Args a{};
    for (int i = 0; i < 21; ++i) a.in[i] = (const float*)d_in[i];
    a.out = (float*)d_out; a.ws = (unsigned char*)d_ws;
    void* kargs[] = {&a};
    hipError_t e = hipLaunchCooperativeKernel((const void*)fwd_mega, dim3(grid), dim3(NWAVES * 64), kargs, LDS_BYTES, stream);
    if (e != hipSuccess) fprintf(stderr, "cooperative launch failed: %s (grid %d)\n", hipGetErrorString(e), grid);
}
```

```cpp
#include <hip/hip_runtime.h>
#include <hip/hip_bf16.h>
#include <hip/hip_cooperative_groups.h>
#include <cstdio>
#include <cstdint>
namespace cg = cooperative_groups;

namespace pg8 {
#define PG8_LAS __attribute__((address_space(3)))
typedef unsigned short bf16_t;
typedef short bf16x8 __attribute__((ext_vector_type(8)));
typedef float f32x4 __attribute__((ext_vector_type(4)));
typedef unsigned u32x4 __attribute__((ext_vector_type(4)));
constexpr int BM = 256, BK = 64, HALF = 128, HTB = HALF * BK * 2  , STAGE_BYTES = 8 * HTB, NXCD = 8, WGM = 8;

__host__ __device__ __forceinline__ int lds_byte(int r, int c) { const int st = (r >> 4) * 2 + (c >> 5), rr = r & 15, cc = c & 31, ob = rr * 64 + cc * 2; return st * 1024 + (ob ^ (((ob >> 9) & 1) << 5)); }
__host__ __device__ __forceinline__ void stage_rc(int b, int& R, int& C) { const int st = b / 1024, sb = b % 1024, swz = sb ^ (((sb >> 9) & 1) << 5); R = (st >> 1) * 16 + swz / 64; C = (st & 1) * 32 + (swz % 64) / 2; }
__host__ __device__ __forceinline__ int perm32(int rho) { const int n = rho >> 4, i = rho & 15; return 8 * (i >> 2) + 4 * n + (i & 3); }

struct Unit { int pm, pn; };
struct Gemm { const bf16_t* A; const bf16_t* Bt; int M, N, K; };

struct StaticOrder {
    int nM, nN, nwg, G, c;
    __host__ __device__ void init(int M, int N, int G_, int c_) { nM = M / BM; nN = N / BM; nwg = nM * nN; G = G_; c = c_; }
    __host__ __device__ bool next(int i, Unit& u) const {
        const long L = (long)i * G + c; if (L >= nwg) return false;
        int wgid = (int)L; { const int q = nwg / NXCD, r = nwg % NXCD, xcd = wgid % NXCD, off = wgid / NXCD; wgid = (xcd < r ? xcd * (q + 1) : r * (q + 1) + (xcd - r) * q) + off; }
        const int nig = WGM * nN, gid = wgid / nig, fm = gid * WGM, gsz = (nM - fm) < WGM ? (nM - fm) : WGM;
        u.pm = fm + ((wgid % nig) % gsz); u.pn = (wgid % nig) / gsz; return true;
    }
    __device__ __forceinline__ void a_ready(const Unit&) const {}
    __device__ __forceinline__ void done(const Unit&) const {}
};

__device__ __forceinline__ unsigned cvt_pk_bf16(float lo, float hi) { unsigned r; asm volatile("v_cvt_pk_bf16_f32 %0, %1, %2" : "=v"(r) : "v"(lo), "v"(hi)); return r; }
typedef float f32x2 __attribute__((ext_vector_type(2)));
typedef unsigned u32x2 __attribute__((ext_vector_type(2)));
__device__ __forceinline__ float rs16(const float* p) {
    const f32x4 a = *(const f32x4*)p, b = *(const f32x4*)(p + 4), c = *(const f32x4*)(p + 8), d = *(const f32x4*)(p + 12);
    return (((a[0] + a[1]) + (a[2] + a[3])) + ((b[0] + b[1]) + (b[2] + b[3]))) + (((c[0] + c[1]) + (c[2] + c[3])) + ((d[0] + d[1]) + (d[2] + d[3])));
}
struct EpiBf {
    static constexpr bool PERM = true, AFTER_DRAIN = false;
    bf16_t* O; int ldc; float scale_q; int nq_tiles;
    __device__ __forceinline__ void operator()(const f32x4 (&acc)[2][2][4][2], const Unit& u, int wr, int wc, int fr, int fq) const {
        const int row0 = u.pm * BM + wr * 64 + fr, col0 = u.pn * BM + wc * 32 + 8 * fq; const float sc = (u.pn < nq_tiles) ? scale_q : 1.f;
#pragma unroll
        for (int ai = 0; ai < 2; ++ai)
#pragma unroll
            for (int m = 0; m < 4; ++m) { bf16_t* rowp = O + (size_t)(row0 + ai * HALF + m * 16) * ldc + col0;
#pragma unroll
                for (int bj = 0; bj < 2; ++bj) { const f32x4 v0 = acc[ai][bj][m][0] * sc, v1 = acc[ai][bj][m][1] * sc;
                    u32x4 w; w.x = cvt_pk_bf16(v0[0], v0[1]); w.y = cvt_pk_bf16(v0[2], v0[3]); w.z = cvt_pk_bf16(v1[0], v1[1]); w.w = cvt_pk_bf16(v1[2], v1[3]);
                    *(u32x4*)(rowp + bj * HALF) = w; } }
    }
};
template <bool BASE_BF16> struct EpiRes {
    static constexpr bool PERM = false, AFTER_DRAIN = false;
    const float* base0; const float* base1; int split_row; bf16_t* hb; float* rsp; int row_off;
    __device__ __forceinline__ void operator()(const f32x4 (&acc)[2][2][4][2], const Unit& u, int wr, int wc, int fr, int fq) const {
        const int col0 = u.pn * BM + wc * 32 + 4 * fq;
#pragma unroll
        for (int ai = 0; ai < 2; ++ai)
#pragma unroll
            for (int m = 0; m < 4; ++m) { const int row = row_off + u.pm * BM + ai * HALF + wr * 64 + m * 16 + fr;
                const float* bp = row < split_row ? base0 + (size_t)row * 1024 : base1 + (size_t)(row - split_row) * 1024;
                bf16_t* hp = hb + (size_t)row * 1024; float s = 0.f;
#pragma unroll
                for (int bj = 0; bj < 2; ++bj)
#pragma unroll
                    for (int n = 0; n < 2; ++n) { const int c = col0 + bj * HALF + n * 16; f32x4 b;
                        if constexpr (BASE_BF16) { const u32x2 pw = *(const u32x2*)(hp + c);
                            b[0] = __uint_as_float(pw.x << 16); b[1] = __uint_as_float(pw.x & 0xffff0000u); b[2] = __uint_as_float(pw.y << 16); b[3] = __uint_as_float(pw.y & 0xffff0000u); }
                        else b = *(const f32x4*)(bp + c);
                        const f32x4 v = b + acc[ai][bj][m][n];
                        s += (v[0] * v[0] + v[1] * v[1]) + (v[2] * v[2] + v[3] * v[3]);
                        u32x2 w; w.x = cvt_pk_bf16(v[0], v[1]); w.y = cvt_pk_bf16(v[2], v[3]); *(u32x2*)(hp + c) = w; }
                s += __shfl_xor(s, 16); s += __shfl_xor(s, 32);
                if (fq == 0) rsp[(size_t)row * 16 + u.pn * 4 + wc] = s; }
    }
};
struct EpiFF1 {
    static constexpr bool PERM = true, AFTER_DRAIN = false;
    const float* rsp; bf16_t* H; int row_off;
    __device__ __forceinline__ void operator()(const f32x4 (&acc)[2][2][4][2], const Unit& u, int wr, int wc, int fr, int fq) const {
        const int col0 = u.pn * BM + wc * 32 + 8 * fq;
#pragma unroll
        for (int ai = 0; ai < 2; ++ai)
#pragma unroll
            for (int m = 0; m < 4; ++m) { const int lrow = u.pm * BM + ai * HALF + wr * 64 + m * 16 + fr;
                const float rstd = 1.0f / sqrtf(rs16(rsp + (size_t)(row_off + lrow) * 16) * (1.0f / 1024.0f) + 1e-6f);
                bf16_t* rowp = H + (size_t)lrow * 4096 + col0;
#pragma unroll
                for (int bj = 0; bj < 2; ++bj) { f32x4 v0 = acc[ai][bj][m][0] * rstd, v1 = acc[ai][bj][m][1] * rstd;
#pragma unroll
                    for (int e = 0; e < 4; ++e) { const float a = fmaxf(v0[e], 0.f), b = fmaxf(v1[e], 0.f); v0[e] = a * a; v1[e] = b * b; }
                    u32x4 w; w.x = cvt_pk_bf16(v0[0], v0[1]); w.y = cvt_pk_bf16(v0[2], v0[3]); w.z = cvt_pk_bf16(v1[0], v1[1]); w.w = cvt_pk_bf16(v1[2], v1[3]);
                    *(u32x4*)(rowp + bj * HALF) = w; }
                asm volatile("" ::: "memory"); }
    }
};
struct EpiGate {
    static constexpr bool PERM = false, AFTER_DRAIN = false;
    const float* rsp_in; const bf16_t* proj; const bf16_t* hb_in; bf16_t* hb_out; float* rsp_out;
    __device__ __forceinline__ void operator()(const f32x4 (&acc)[2][2][4][2], const Unit& u, int wr, int wc, int fr, int fq) const {
        const int col0 = u.pn * BM + wc * 32 + 4 * fq;
#pragma unroll
        for (int ai = 0; ai < 2; ++ai)
#pragma unroll
            for (int m = 0; m < 4; ++m) { const int row = u.pm * BM + ai * HALF + wr * 64 + m * 16 + fr;
                const float rstd = 1.0f / sqrtf(rs16(rsp_in + (size_t)row * 16) * (1.0f / 1024.0f) + 1e-6f);
                const bf16_t* ip = hb_in + (size_t)row * 1024; bf16_t* op = hb_out + (size_t)row * 1024; const bf16_t* pp = proj + (size_t)row * 1024; float s = 0.f;
#pragma unroll
                for (int bj = 0; bj < 2; ++bj)
#pragma unroll
                    for (int n = 0; n < 2; ++n) { const int c = col0 + bj * HALF + n * 16; const f32x4 a = acc[ai][bj][m][n] * rstd;
                        const u32x2 pw = *(const u32x2*)(pp + c), hw = *(const u32x2*)(ip + c);
                        f32x4 pr, h2; pr[0] = __uint_as_float(pw.x << 16); pr[1] = __uint_as_float(pw.x & 0xffff0000u); pr[2] = __uint_as_float(pw.y << 16); pr[3] = __uint_as_float(pw.y & 0xffff0000u);
                        h2[0] = __uint_as_float(hw.x << 16); h2[1] = __uint_as_float(hw.x & 0xffff0000u); h2[2] = __uint_as_float(hw.y << 16); h2[3] = __uint_as_float(hw.y & 0xffff0000u);
                        f32x4 g;
#pragma unroll
                        for (int e2 = 0; e2 < 4; ++e2) g[e2] = __builtin_amdgcn_rcpf(1.0f + __builtin_amdgcn_exp2f(-1.4426950408889634f * a[e2]));
                        const f32x4 v = h2 + g * pr;
                        s += (v[0] * v[0] + v[1] * v[1]) + (v[2] * v[2] + v[3] * v[3]);
                        u32x2 w; w.x = cvt_pk_bf16(v[0], v[1]); w.y = cvt_pk_bf16(v[2], v[3]); *(u32x2*)(op + c) = w; }
                s += __shfl_xor(s, 16); s += __shfl_xor(s, 32);
                if (fq == 0) rsp_out[(size_t)row * 16 + u.pn * 4 + wc] = s;
                asm volatile("" ::: "memory"); }
    }
};
template <class Epi, class Sched, bool ALIGN_EPI = false, bool SP2 = false>
__device__ __forceinline__ void gemm_phase(PG8_LAS unsigned char* lds, const Gemm g, const Sched& S, const Epi& E) {
    int tid_ = threadIdx.x; asm volatile("" : "+v"(tid_));
    const int tid = tid_, wid = __builtin_amdgcn_readfirstlane(tid >> 6), lane = tid & 63, wr = wid >> 2, wc = wid & 3, fr = lane & 15, fq = lane >> 4;
    const int K = g.K, nt = K / BK;
    unsigned voffA[2], voffB[2];
#pragma unroll
    for (int i = 0; i < 2; ++i) { int R, C; stage_rc(tid * 16 + i * 8192, R, C); const int Rb = Epi::PERM ? ((R & ~31) + perm32(R & 31)) : R;
        voffA[i] = (unsigned)(R * K + C) * 2u; voffB[i] = (unsigned)(Rb * K + C) * 2u; }
    const size_t kstep = (size_t)(BK * 2);
    const size_t hstep = (size_t)HALF * K * 2;
    const size_t tstep = 2 * hstep;
    const unsigned ldsw = (unsigned)wid * 1024u;
    const int aoff = lds_byte(wr * 64 + fr, fq * 8), boff = lds_byte(wc * 32 + fr, fq * 8);
#define PG8_SA(b, h) (((b) * 2 + (h)) * HTB)
#define PG8_SB(b, h) ((4 + (b) * 2 + (h)) * HTB)
#define PG8_STAGE(bufoff, gbase, voff) do { _Pragma("unroll") for (int _i = 0; _i < 2; ++_i) \
        __builtin_amdgcn_global_load_lds((const unsigned*)((const char*)(gbase) + (voff)[_i]), (PG8_LAS unsigned*)(lds + (bufoff) + ldsw + _i * 8192), 16, 0, 0); } while (0)
#define PG8_LDA(dst, b, h) do { _Pragma("unroll") for (int m = 0; m < 4; ++m) _Pragma("unroll") for (int k = 0; k < 2; ++k) dst[m][k] = *(const PG8_LAS bf16x8*)(lds + PG8_SA(b, h) + aoff + m * 2048 + k * 1024); } while (0)
#define PG8_LDB(dst, b, h) do { _Pragma("unroll") for (int n = 0; n < 2; ++n) _Pragma("unroll") for (int k = 0; k < 2; ++k) dst[n][k] = *(const PG8_LAS bf16x8*)(lds + PG8_SB(b, h) + boff + n * 2048 + k * 1024); } while (0)
#define PG8_MMA(ai, bj, At, Bt) do { __builtin_amdgcn_s_setprio(1); _Pragma("unroll") for (int m = 0; m < 4; ++m) _Pragma("unroll") for (int n = 0; n < 2; ++n) _Pragma("unroll") for (int k = 0; k < 2; ++k) \
        acc[ai][bj][m][n] = __builtin_amdgcn_mfma_f32_16x16x32_bf16(Bt[n][k], At[m][k], acc[ai][bj][m][n], 0, 0, 0); __builtin_amdgcn_s_setprio(0); } while (0)
#define PG8_WAIT_V(n) asm volatile("s_waitcnt vmcnt(" #n ")" ::: "memory")
#define PG8_WAIT_L(n) asm volatile("s_waitcnt lgkmcnt(" #n ")" ::: "memory")
#define PG8_BAR __builtin_amdgcn_s_barrier()
#define PG8_SCHED __builtin_amdgcn_sched_barrier(0)
    Unit cur, nxt; int ui = 0;
    if (!S.next(0, cur)) return;
    f32x4 acc[2][2][4][2];
#pragma unroll
    for (int a = 0; a < 2; ++a)
#pragma unroll
        for (int b = 0; b < 2; ++b)
#pragma unroll
            for (int m = 0; m < 4; ++m)
#pragma unroll
                for (int n = 0; n < 2; ++n) acc[a][b][m][n] = (f32x4){0.f, 0.f, 0.f, 0.f};
    bf16x8 At[4][2], B0[2][2], B1[2][2];
    const char* cA = (const char*)g.A + (size_t)cur.pm * tstep; const char* cB = (const char*)g.Bt + (size_t)cur.pn * tstep;
    S.a_ready(cur);
    if constexpr (SP2) {
        PG8_STAGE(PG8_SB(0, 0), cB, voffB); PG8_STAGE(PG8_SB(0, 1), cB + hstep, voffB); PG8_STAGE(PG8_SA(0, 0), cA, voffA); PG8_STAGE(PG8_SA(0, 1), cA + hstep, voffA);
        if (wr == 1) PG8_BAR;
        PG8_WAIT_V(2); PG8_BAR;
        PG8_STAGE(PG8_SB(1, 0), cB + kstep, voffB); PG8_STAGE(PG8_SA(1, 0), cA + kstep, voffA); PG8_STAGE(PG8_SB(1, 1), cB + hstep + kstep, voffB);
        PG8_WAIT_V(6); PG8_BAR;
    } else {
        PG8_STAGE(PG8_SB(0, 0), cB, voffB); PG8_STAGE(PG8_SA(0, 0), cA, voffA); PG8_STAGE(PG8_SB(0, 1), cB + hstep, voffB); PG8_STAGE(PG8_SA(0, 1), cA + hstep, voffA);
        if (wr == 1) PG8_BAR;
        PG8_WAIT_V(4); PG8_BAR;
        PG8_STAGE(PG8_SB(1, 0), cB + kstep, voffB); PG8_STAGE(PG8_SA(1, 0), cA + kstep, voffA); PG8_STAGE(PG8_SB(1, 1), cB + hstep + kstep, voffB);
        PG8_WAIT_V(6); PG8_BAR;
    }
    for (;;) {
        const bool has_next = S.next(ui + 1, nxt);
        const char* nA = has_next ? (const char*)g.A + (size_t)nxt.pm * tstep : cA; const char* nB = has_next ? (const char*)g.Bt + (size_t)nxt.pn * tstep : cB;
        for (int t = 0; t < nt; t += 2) {
            const bool last = (t == nt - 2);
            const char* a1 = cA + (size_t)(t + 1) * kstep;
            const char* a2 = last ? nA : cA + (size_t)(t + 2) * kstep; const char* b2 = last ? nB : cB + (size_t)(t + 2) * kstep;
            const char* a3 = a2 + kstep; const char* b3 = b2 + kstep;
            if (last && has_next) S.a_ready(nxt);
            if constexpr (SP2) {
            PG8_LDB(B0, 0, 0); PG8_LDB(B1, 0, 1); PG8_SCHED; PG8_LDA(At, 0, 0); PG8_STAGE(PG8_SA(1, 1), a1 + hstep, voffA);
            PG8_WAIT_V(8); PG8_WAIT_L(0); PG8_BAR; PG8_MMA(0, 0, At, B0); PG8_MMA(0, 1, At, B1); PG8_BAR; PG8_SCHED;
            PG8_LDA(At, 0, 1); PG8_STAGE(PG8_SB(0, 0), b2, voffB); PG8_STAGE(PG8_SB(0, 1), b2 + hstep, voffB); PG8_STAGE(PG8_SA(0, 0), a2, voffA);
            PG8_WAIT_V(8); PG8_WAIT_L(0); PG8_BAR; PG8_MMA(1, 0, At, B0); PG8_MMA(1, 1, At, B1); PG8_BAR; PG8_SCHED;
            PG8_LDB(B0, 1, 0); PG8_LDB(B1, 1, 1); PG8_SCHED; PG8_LDA(At, 1, 0); PG8_STAGE(PG8_SA(0, 1), a2 + hstep, voffA);
            PG8_WAIT_V(8); PG8_WAIT_L(0); PG8_BAR; PG8_MMA(0, 0, At, B0); PG8_MMA(0, 1, At, B1); PG8_BAR; PG8_SCHED;
            PG8_LDA(At, 1, 1); PG8_STAGE(PG8_SB(1, 0), b3, voffB); PG8_STAGE(PG8_SB(1, 1), b3 + hstep, voffB); PG8_STAGE(PG8_SA(1, 0), a3, voffA);
            PG8_WAIT_V(8); PG8_WAIT_L(0); PG8_BAR; PG8_MMA(1, 0, At, B0); PG8_MMA(1, 1, At, B1); PG8_BAR; PG8_SCHED;
            } else {
            PG8_LDB(B0, 0, 0); PG8_SCHED; PG8_LDA(At, 0, 0); PG8_STAGE(PG8_SA(1, 1), a1 + hstep, voffA);
            PG8_WAIT_L(8); PG8_BAR; PG8_WAIT_L(0); PG8_MMA(0, 0, At, B0); PG8_BAR; PG8_SCHED;
            PG8_LDB(B1, 0, 1); PG8_STAGE(PG8_SB(0, 0), b2, voffB);
            PG8_BAR; PG8_WAIT_L(0); PG8_MMA(0, 1, At, B1); PG8_BAR;
            PG8_LDA(At, 0, 1); PG8_STAGE(PG8_SA(0, 0), a2, voffA);
            PG8_BAR; PG8_WAIT_L(0); PG8_MMA(1, 0, At, B0); PG8_BAR; PG8_SCHED;
            PG8_STAGE(PG8_SB(0, 1), b2 + hstep, voffB);
            PG8_WAIT_V(6); PG8_BAR; PG8_MMA(1, 1, At, B1); PG8_BAR;
            PG8_LDB(B0, 1, 0); PG8_SCHED; PG8_LDA(At, 1, 0); PG8_STAGE(PG8_SA(0, 1), a2 + hstep, voffA);
            PG8_WAIT_L(8); PG8_BAR; PG8_WAIT_L(0); PG8_MMA(0, 0, At, B0); PG8_BAR; PG8_SCHED;
            PG8_LDB(B1, 1, 1); PG8_STAGE(PG8_SB(1, 0), b3, voffB);
            PG8_BAR; PG8_WAIT_L(0); PG8_MMA(0, 1, At, B1); PG8_BAR;
            PG8_LDA(At, 1, 1); PG8_STAGE(PG8_SA(1, 0), a3, voffA);
            PG8_BAR; PG8_WAIT_L(0); PG8_MMA(1, 0, At, B0); PG8_BAR; PG8_SCHED;
            PG8_STAGE(PG8_SB(1, 1), b3 + hstep, voffB);
            PG8_WAIT_V(6); PG8_BAR; PG8_MMA(1, 1, At, B1); PG8_BAR;
            }
        }
        if constexpr (ALIGN_EPI) { if (wr == 0) PG8_BAR; }
        if constexpr (!Epi::AFTER_DRAIN) { E(acc, cur, wr, wc, fr, fq); S.done(cur); }
        if (!has_next) break;
#pragma unroll
        for (int a = 0; a < 2; ++a)
#pragma unroll
            for (int b = 0; b < 2; ++b)
#pragma unroll
                for (int m = 0; m < 4; ++m)
#pragma unroll
                    for (int n = 0; n < 2; ++n) acc[a][b][m][n] = (f32x4){0.f, 0.f, 0.f, 0.f};
        cur = nxt; cA = nA; cB = nB; ++ui;
        if constexpr (ALIGN_EPI) { if (wr == 1) PG8_BAR; }
    }
    PG8_WAIT_V(0);
    if constexpr (!ALIGN_EPI) { if (wr == 0) PG8_BAR; }
    PG8_BAR;
    if constexpr (Epi::AFTER_DRAIN) { E.fused(acc, cur, wr, wc, fr, fq, lds, wid, lane); S.done(cur); }
#undef PG8_SA
#undef PG8_SB
#undef PG8_STAGE
#undef PG8_LDA
#undef PG8_LDB
#undef PG8_MMA
#undef PG8_WAIT_V
#undef PG8_WAIT_L
#undef PG8_BAR
#undef PG8_SCHED
}
}
namespace att {
typedef unsigned short bf16_t;
using bf16x8 = __attribute__((ext_vector_type(8))) short;
using s16x4  = __attribute__((ext_vector_type(4))) short;
using f32x16 = __attribute__((ext_vector_type(16))) float;
using u32x4  = __attribute__((ext_vector_type(4))) unsigned;
constexpr int LDZ = 2368;
constexpr int SHM_V = 16384, SHM_K = 8192;
constexpr int ATTN_LDS = 2 * SHM_V + 2 * SHM_K + 8 * 64 * 4;
constexpr float THR2 = 8.0f;
#define KSWZ64(row, colB) ((row) * 128 + ((colB) ^ ((((row) >> 1) & 7) << 4)))
#define SBAR() __builtin_amdgcn_sched_barrier(0)
__device__ __forceinline__ int crow(int r, int hi) { return (r & 3) + 8 * (r >> 2) + 4 * hi; }
__device__ __forceinline__ unsigned cvtpk(float lo, float hi) { unsigned r; asm volatile("v_cvt_pk_bf16_f32 %0, %1, %2" : "=v"(r) : "v"(lo), "v"(hi)); return r; }
__device__ __forceinline__ unsigned short f2bf(float f) { unsigned u = __builtin_bit_cast(unsigned, f); return (unsigned short)((u + 0x7fffu + ((u >> 16) & 1u)) >> 16); }

template <bool ALIBI>
__device__ __forceinline__ void partialSM(f32x16& p0, f32x16& p1, float& m_reg, float& alpha, float dq, float sl2) {
  if constexpr (ALIBI) {
#pragma unroll
    for (int r = 0; r < 16; ++r) { const float t0 = dq - (float)((r & 3) + 8 * (r >> 2)); const float t1 = t0 - 32.f;
      p0[r] = fmaf(-sl2, fabsf(t0), p0[r]); p1[r] = fmaf(-sl2, fabsf(t1), p1[r]); }
  }
  float pmax = p0[0];
#pragma unroll
  for (int r = 1; r < 16; ++r) pmax = fmaxf(pmax, p0[r]);
#pragma unroll
  for (int r = 0; r < 16; ++r) pmax = fmaxf(pmax, p1[r]);
  { auto rr = __builtin_amdgcn_permlane32_swap(__float_as_uint(pmax), __float_as_uint(pmax), false, false);
    pmax = fmaxf(__uint_as_float(rr[0]), __uint_as_float(rr[1])); }
  float mn;
  if (__builtin_expect(__all(pmax - m_reg <= THR2), 1)) { mn = m_reg; alpha = 1.f; }
  else { mn = fmaxf(m_reg, pmax); alpha = __builtin_amdgcn_exp2f(m_reg - mn); m_reg = mn; }
#pragma unroll
  for (int r = 0; r < 16; ++r) { p0[r] -= mn; p1[r] -= mn; }
#pragma unroll
  for (int r = 0; r < 16; ++r) p0[r] = __builtin_amdgcn_exp2f(p0[r]);
}
__device__ __forceinline__ void finishSM(f32x16& p0, f32x16& p1, float alpha, float& l_reg, bf16x8& pa0, bf16x8& pa1, bf16x8& pa2, bf16x8& pa3) {
#pragma unroll
  for (int r = 0; r < 16; ++r) p1[r] = __builtin_amdgcn_exp2f(p1[r]);
  float ps = 0;
#pragma unroll
  for (int r = 0; r < 16; ++r) ps += p0[r];
#pragma unroll
  for (int r = 0; r < 16; ++r) ps += p1[r];
  { auto rr = __builtin_amdgcn_permlane32_swap(__float_as_uint(ps), __float_as_uint(ps), false, false);
    ps = __uint_as_float(rr[0]) + __uint_as_float(rr[1]); }
  l_reg = l_reg * alpha + ps;
#define PK4(P, BASE, OUT) do { unsigned a0 = cvtpk(P[BASE + 0], P[BASE + 1]), a1 = cvtpk(P[BASE + 2], P[BASE + 3]);   \
    unsigned b0 = cvtpk(P[BASE + 4], P[BASE + 5]), b1 = cvtpk(P[BASE + 6], P[BASE + 7]);                              \
    auto r0 = __builtin_amdgcn_permlane32_swap(a0, b0, false, false); auto r1 = __builtin_amdgcn_permlane32_swap(a1, b1, false, false); \
    u32x4 w = {r0[0], r1[0], r0[1], r1[1]}; OUT = *reinterpret_cast<bf16x8*>(&w); } while (0)
  PK4(p0, 0, pa0); PK4(p0, 8, pa1); PK4(p1, 0, pa2); PK4(p1, 8, pa3);
#undef PK4
}
__device__ __forceinline__ void qkt(f32x16& p0, f32x16& p1, const char* Ks, const bf16x8* qr, int r32, int hi) {
  p0 = f32x16{}; p1 = f32x16{};
#pragma unroll
  for (int d0 = 0; d0 < 4; ++d0) { const int cb = (d0 * 16 + hi * 8) * 2;
    const bf16x8 b0 = *reinterpret_cast<const bf16x8*>(Ks + KSWZ64(r32, cb));
    const bf16x8 b1 = *reinterpret_cast<const bf16x8*>(Ks + 4096 + KSWZ64(r32, cb));
    p0 = __builtin_amdgcn_mfma_f32_32x32x16_bf16(b0, qr[d0], p0, 0, 0, 0);
    p1 = __builtin_amdgcn_mfma_f32_32x32x16_bf16(b1, qr[d0], p1, 0, 0, 0); }
}
template <int NCB> __device__ __forceinline__ int v_st(int k, int c) { const int kk = (k & ~0xC) | ((k & 4) << 1) | ((k & 8) >> 1); return ((kk >> 3) * NCB + (c >> 5)) * 512 + ((kk & 7) * 32 + (c & 31)) * 2; }
__device__ __forceinline__ int v_rd_base(int lane) { return ((lane & 3) << 3) | (((lane >> 2) & 3) << 6) | (((lane >> 4) & 1) << 5) | (((lane >> 5) & 1) << 8); }
template <int OFF> __device__ __forceinline__ s16x4 tr_read(int vb) {
  s16x4 r; asm volatile("ds_read_b64_tr_b16 %0, %1 offset:%2" : "=&v"(r) : "v"(vb), "i"(OFF) : "memory"); return r;
}
template <int NCB, int D0> __device__ __forceinline__ void pv_one(f32x16& od, int vb, bf16x8 pa0, bf16x8 pa1, bf16x8 pa2, bf16x8 pa3) {
  constexpr int KS = NCB * 1024, HF = NCB * 512, B0 = D0 * 512;
  const s16x4 l0 = tr_read<B0>(vb), h0 = tr_read<B0 + HF>(vb), l1 = tr_read<B0 + KS>(vb), h1 = tr_read<B0 + KS + HF>(vb);
  const s16x4 l2 = tr_read<B0 + 2 * KS>(vb), h2 = tr_read<B0 + 2 * KS + HF>(vb), l3 = tr_read<B0 + 3 * KS>(vb), h3 = tr_read<B0 + 3 * KS + HF>(vb);
  asm volatile("s_waitcnt lgkmcnt(0)" ::: "memory"); SBAR();
#define PK(L, H) (bf16x8){L[0], L[1], L[2], L[3], H[0], H[1], H[2], H[3]}
  od = __builtin_amdgcn_mfma_f32_32x32x16_bf16(pa0, PK(l0, h0), od, 0, 0, 0);
  od = __builtin_amdgcn_mfma_f32_32x32x16_bf16(pa1, PK(l1, h1), od, 0, 0, 0);
  od = __builtin_amdgcn_mfma_f32_32x32x16_bf16(pa2, PK(l2, h2), od, 0, 0, 0);
  od = __builtin_amdgcn_mfma_f32_32x32x16_bf16(pa3, PK(l3, h3), od, 0, 0, 0);
#undef PK
}
template <int NCB> __device__ __forceinline__ void pv_all(f32x16* o, int vb, bf16x8 pa0, bf16x8 pa1, bf16x8 pa2, bf16x8 pa3) {
  pv_one<NCB, 0>(o[0], vb, pa0, pa1, pa2, pa3); pv_one<NCB, 1>(o[1], vb, pa0, pa1, pa2, pa3);
  if constexpr (NCB == 4) { pv_one<NCB, 2>(o[2], vb, pa0, pa1, pa2, pa3); pv_one<NCB, 3>(o[3], vb, pa0, pa1, pa2, pa3); }
}
__device__ __forceinline__ void store_o(float* p, float v) { *p = v; }
__device__ __forceinline__ void store_o(bf16_t* p, float v) { *p = f2bf(v); }

template <int DV, bool ALIBI, typename TO>
__device__ __forceinline__ void attn_unit(const bf16_t* __restrict__ Qb, const bf16_t* __restrict__ Kh, const bf16_t* __restrict__ Vh, TO* __restrict__ Ob, int seq, int qpos0, float sl2, char* lds) {
  constexpr int NCB = DV / 32;
  const int tid = threadIdx.x, wid = tid >> 6, lane = tid & 63, r32 = lane & 31, hi = lane >> 5;
  char* V_lds = lds; char* K_lds = lds + 2 * SHM_V;
  float* ws = (float*)(lds + 2 * SHM_V + 2 * SHM_K) + wid * 64; float* li_l = ws; float* al_l = ws + 32;
  float m_reg = -1e30f, l_reg = 0; f32x16 o[NCB];
#pragma unroll
  for (int d = 0; d < NCB; ++d) o[d] = f32x16{};
  bf16x8 qr[4];
  const bf16_t* Qw = Qb + (long)(wid * 32 + r32) * LDZ + hi * 8;
#pragma unroll
  for (int d0 = 0; d0 < 4; ++d0) qr[d0] = *reinterpret_cast<const bf16x8*>(Qw + d0 * 16);
  const float dq0 = (float)(qpos0 + wid * 32 + r32 - 4 * hi);
  const int kr = tid >> 3, kc = (tid & 7) * 8, kst = KSWZ64(kr, kc * 2);
  const int sr = tid >> 4, sc = (tid & 15) * 8;
  const int vst0 = (DV == 128) ? v_st<NCB>(sr, sc) : v_st<NCB>(kr, kc), vst1 = v_st<NCB>(32 + sr, sc);
  const int vb0 = (int)(uintptr_t)V_lds + v_rd_base(lane);
  bf16x8 sv0[2], sv1[2], sk[2];
#define SLOAD(i, k0) do { if constexpr (DV == 128) { sv0[i] = *reinterpret_cast<const bf16x8*>(&Vh[(long)((k0) + sr) * LDZ + sc]); sv1[i] = *reinterpret_cast<const bf16x8*>(&Vh[(long)((k0) + 32 + sr) * LDZ + sc]); } \
    else { sv0[i] = *reinterpret_cast<const bf16x8*>(&Vh[(long)((k0) + kr) * LDZ + kc]); } \
    sk[i] = *reinterpret_cast<const bf16x8*>(&Kh[(long)((k0) + kr) * LDZ + kc]); } while (0)
#define SWRITE(b, i) do { *(bf16x8*)(V_lds + (b) * SHM_V + vst0) = sv0[i]; if constexpr (DV == 128) { *(bf16x8*)(V_lds + (b) * SHM_V + vst1) = sv1[i]; } \
    *(bf16x8*)(K_lds + (b) * SHM_K + kst) = sk[i]; } while (0)
#define SWAIT() do { if constexpr (DV == 128) asm volatile("s_waitcnt vmcnt(3)" ::: "memory"); else asm volatile("s_waitcnt vmcnt(2)" ::: "memory"); } while (0)
#define RESC(a) do { if (__any((a) < 1.f)) { if (hi == 0) al_l[r32] = (a); asm volatile("s_waitcnt lgkmcnt(0)" ::: "memory"); \
    _Pragma("unroll") for (int d = 0; d < NCB; ++d) _Pragma("unroll") for (int r = 0; r < 16; ++r) o[d][r] *= al_l[crow(r, hi)]; } } while (0)
  f32x16 pA0, pA1, pB0, pB1; float alA, alB; bf16x8 pa0, pa1, pa2, pa3; const int NT = seq / 64;
  SLOAD(0, 0); asm volatile("s_waitcnt vmcnt(0)" ::: "memory"); SWRITE(0, 0); __syncthreads();
  qkt(pA0, pA1, K_lds, qr, r32, hi); partialSM<ALIBI>(pA0, pA1, m_reg, alA, dq0, sl2);
  SLOAD(1, 64); if (2 < NT) SLOAD(0, 128);
  SWAIT(); SWRITE(1, 1); __syncthreads();
  for (int j = 1; j + 1 < NT; j += 2) {
    SBAR(); qkt(pB0, pB1, K_lds + SHM_K, qr, r32, hi);
    finishSM(pA0, pA1, alA, l_reg, pa0, pa1, pa2, pa3); SBAR();
    SLOAD(1, (j + 2) * 64); SBAR();
    pv_all<NCB>(o, vb0, pa0, pa1, pa2, pa3); partialSM<ALIBI>(pB0, pB1, m_reg, alB, dq0 - 64.f * (float)j, sl2);
    __syncthreads(); SWAIT(); SWRITE(0, 0);
    RESC(alB); __syncthreads();
    SBAR(); qkt(pA0, pA1, K_lds, qr, r32, hi);
    finishSM(pB0, pB1, alB, l_reg, pa0, pa1, pa2, pa3); SBAR();
    if (j + 3 < NT) SLOAD(0, (j + 3) * 64); SBAR();
    pv_all<NCB>(o, vb0 + SHM_V, pa0, pa1, pa2, pa3); partialSM<ALIBI>(pA0, pA1, m_reg, alA, dq0 - 64.f * (float)(j + 1), sl2);
    __syncthreads(); SWAIT(); SWRITE(1, 1);
    RESC(alA); __syncthreads();
  }
  SBAR(); qkt(pB0, pB1, K_lds + SHM_K, qr, r32, hi);
  finishSM(pA0, pA1, alA, l_reg, pa0, pa1, pa2, pa3); SBAR();
  pv_all<NCB>(o, vb0, pa0, pa1, pa2, pa3); partialSM<ALIBI>(pB0, pB1, m_reg, alB, dq0 - 64.f * (float)(NT - 1), sl2);
  __syncthreads(); RESC(alB);
  finishSM(pB0, pB1, alB, l_reg, pa0, pa1, pa2, pa3); SBAR();
  pv_all<NCB>(o, vb0 + SHM_V, pa0, pa1, pa2, pa3);
  if (hi == 0) li_l[r32] = l_reg; asm volatile("s_waitcnt lgkmcnt(0)" ::: "memory");
  float rli[16];
#pragma unroll
  for (int r = 0; r < 16; ++r) rli[r] = __builtin_amdgcn_rcpf(li_l[crow(r, hi)]);
  TO* Ow = Ob + (long)(wid * 32) * 1024;
#pragma unroll
  for (int r = 0; r < 16; ++r) { const int orow = crow(r, hi);
#pragma unroll
    for (int d0 = 0; d0 < NCB; ++d0) store_o(Ow + (long)orow * 1024 + d0 * 32 + r32, o[d0][r] * rli[r]); }
  __syncthreads();
#undef SLOAD
#undef SWRITE
#undef SWAIT
#undef RESC
}
#undef SBAR
}
namespace att {
#define ALAS __attribute__((address_space(3)))
__device__ __forceinline__ void qkt_l(f32x16& p0, f32x16& p1, const ALAS unsigned char* Ks, const bf16x8* qr, int r32, int hi) {
  p0 = f32x16{}; p1 = f32x16{};
#pragma unroll
  for (int d0 = 0; d0 < 4; ++d0) { const int cb = (d0 * 16 + hi * 8) * 2;
    const bf16x8 b0 = *reinterpret_cast<const ALAS bf16x8*>(Ks + KSWZ64(r32, cb));
    const bf16x8 b1 = *reinterpret_cast<const ALAS bf16x8*>(Ks + 4096 + KSWZ64(r32, cb));
    p0 = __builtin_amdgcn_mfma_f32_32x32x16_bf16(b0, qr[d0], p0, 0, 0, 0);
    p1 = __builtin_amdgcn_mfma_f32_32x32x16_bf16(b1, qr[d0], p1, 0, 0, 0); }
}
__device__ __forceinline__ void qkt_acc(f32x16& p0, f32x16& p1, const ALAS unsigned char* Ks, const bf16x8* qr, int r32, int hi) {
  bf16x8 kb0[4], kb1[4];
#pragma unroll
  for (int d0 = 0; d0 < 4; ++d0) { const int cb = (d0 * 16 + hi * 8) * 2;
    kb0[d0] = *reinterpret_cast<const ALAS bf16x8*>(Ks + KSWZ64(r32, cb)); kb1[d0] = *reinterpret_cast<const ALAS bf16x8*>(Ks + 4096 + KSWZ64(r32, cb)); }
  __builtin_amdgcn_sched_barrier(0);
#pragma unroll
  for (int d0 = 0; d0 < 4; ++d0) {
    p0 = __builtin_amdgcn_mfma_f32_32x32x16_bf16(kb0[d0], qr[d0], p0, 0, 0, 0);
    p1 = __builtin_amdgcn_mfma_f32_32x32x16_bf16(kb1[d0], qr[d0], p1, 0, 0, 0); }
}
__device__ __forceinline__ void qkt_c(f32x16& p0, f32x16& p1, const f32x16& negm, const ALAS unsigned char* Ks, const bf16x8* qr, int r32, int hi) {
  bf16x8 kb0[4], kb1[4];
#pragma unroll
  for (int d0 = 0; d0 < 4; ++d0) { const int cb = (d0 * 16 + hi * 8) * 2;
    kb0[d0] = *reinterpret_cast<const ALAS bf16x8*>(Ks + KSWZ64(r32, cb)); kb1[d0] = *reinterpret_cast<const ALAS bf16x8*>(Ks + 4096 + KSWZ64(r32, cb)); }
  __builtin_amdgcn_sched_barrier(0);
  p0 = __builtin_amdgcn_mfma_f32_32x32x16_bf16(kb0[0], qr[0], negm, 0, 0, 0); p1 = __builtin_amdgcn_mfma_f32_32x32x16_bf16(kb1[0], qr[0], negm, 0, 0, 0);
#pragma unroll
  for (int d0 = 1; d0 < 4; ++d0) {
    p0 = __builtin_amdgcn_mfma_f32_32x32x16_bf16(kb0[d0], qr[d0], p0, 0, 0, 0);
    p1 = __builtin_amdgcn_mfma_f32_32x32x16_bf16(kb1[d0], qr[d0], p1, 0, 0, 0); }
}
template <int NCB> __device__ __forceinline__ void pv_issue0(s16x4 (&vl)[4], s16x4 (&vh)[4], int vb) {
  constexpr int KS = NCB * 1024, HF = NCB * 512;
  vl[0] = tr_read<0>(vb); vh[0] = tr_read<HF>(vb); vl[1] = tr_read<KS>(vb); vh[1] = tr_read<KS + HF>(vb);
  vl[2] = tr_read<2 * KS>(vb); vh[2] = tr_read<2 * KS + HF>(vb); vl[3] = tr_read<3 * KS>(vb); vh[3] = tr_read<3 * KS + HF>(vb);
}
template <int NCB> __device__ __forceinline__ void pv_rest(f32x16* o, const s16x4 (&vl)[4], const s16x4 (&vh)[4], int vb, bf16x8 pa0, bf16x8 pa1, bf16x8 pa2, bf16x8 pa3) {
  asm volatile("s_waitcnt lgkmcnt(0)" ::: "memory"); __builtin_amdgcn_sched_barrier(0);
#define PK(L, H) (bf16x8){L[0], L[1], L[2], L[3], H[0], H[1], H[2], H[3]}
  o[0] = __builtin_amdgcn_mfma_f32_32x32x16_bf16(pa0, PK(vl[0], vh[0]), o[0], 0, 0, 0);
  o[0] = __builtin_amdgcn_mfma_f32_32x32x16_bf16(pa1, PK(vl[1], vh[1]), o[0], 0, 0, 0);
  o[0] = __builtin_amdgcn_mfma_f32_32x32x16_bf16(pa2, PK(vl[2], vh[2]), o[0], 0, 0, 0);
  o[0] = __builtin_amdgcn_mfma_f32_32x32x16_bf16(pa3, PK(vl[3], vh[3]), o[0], 0, 0, 0);
#undef PK
  pv_one<NCB, 1>(o[1], vb, pa0, pa1, pa2, pa3);
  if constexpr (NCB == 4) { pv_one<NCB, 2>(o[2], vb, pa0, pa1, pa2, pa3); pv_one<NCB, 3>(o[3], vb, pa0, pa1, pa2, pa3); }
}
constexpr int PP_NS = 5;
constexpr int PP_KSLOT = 8192, PP_VSLOT = 16384, PP_LK = 0, PP_LV = PP_NS * PP_KSLOT, PP_LW = PP_LV + PP_NS * PP_VSLOT, PP_LDS = PP_LW + 8 * 64 * 4;
static_assert(PP_LDS <= 131072, "attention rings");
#define PP_BAR() do { asm volatile("s_waitcnt lgkmcnt(0)" ::: "memory"); __builtin_amdgcn_s_barrier(); asm volatile("" ::: "memory"); } while (0)
template <int DV, bool ALIBI, typename TO>
__device__ __forceinline__ void attn_unit_pp(const bf16_t* __restrict__ Qb, const bf16_t* __restrict__ Kh, const bf16_t* __restrict__ Vh, TO* __restrict__ Ob, int NT, int qpos0, float sl2, ALAS unsigned char* ldsl) {
  constexpr int NCB = DV / 32, NVI = DV / 32;
  int tid_ = threadIdx.x; asm volatile("" : "+v"(tid_));
  const int tid = tid_, lane = tid & 63, r32 = lane & 31, hi = lane >> 5;
  const int wid = __builtin_amdgcn_readfirstlane(tid >> 6), g = wid >> 2, wq = wid & 3;
  ALAS float* li_l = (ALAS float*)(ldsl + PP_LW) + wid * 64; ALAS float* al_l = li_l + 32;
  bf16x8 qr[4];
  const bf16_t* Qw = Qb + (long)(wid * 32 + r32) * LDZ + hi * 8;
#pragma unroll
  for (int d0 = 0; d0 < 4; ++d0) qr[d0] = *reinterpret_cast<const bf16x8*>(Qw + d0 * 16);
  const float dq0 = (float)(qpos0 + wid * 32 + r32 - 4 * hi);
  unsigned doff[NVI];
#pragma unroll
  for (int i = 0; i < NVI; ++i) {
    const int Lk = (wq * 2 + (i & 1)) * 64 + lane, row = Lk >> 3, c = (Lk & 7) ^ ((row >> 1) & 7);
    const int Lv = (wq * NVI + i) * 64 + lane, st = Lv >> 5, wi = Lv & 31, kk = (st / NCB) * 8 + (wi >> 2), kv = (kk & ~0xC) | ((kk & 4) << 1) | ((kk & 8) >> 1);
    doff[i] = g ? (unsigned)(row * LDZ + c * 8) * 2u : (unsigned)(kv * LDZ + (st % NCB) * 32 + (wi & 3) * 8) * 2u; }
  const char* dbase = g ? (const char*)Kh : (const char*)Vh;
  const int dlds = g ? (PP_LK + wq * 2 * 1024) : (PP_LV + wq * NVI * 1024), dss = g ? PP_KSLOT : PP_VSLOT, ni = g ? 2 : NVI;
#define DMA_T(t, slot) do { const char* tb_ = dbase + (size_t)(t) * (64 * LDZ * 2); ALAS unsigned char* ld_ = ldsl + dlds + (slot) * dss; \
    _Pragma("unroll") for (int i_ = 0; i_ < NVI; ++i_) if (i_ < ni) __builtin_amdgcn_global_load_lds((const unsigned*)(tb_ + doff[i_]), (ALAS unsigned*)(ld_ + i_ * 1024), 16, 0, 0); } while (0)
  const int vbase = (int)(unsigned)(uintptr_t)(ldsl + PP_LV) + v_rd_base(lane);
  float m_reg = 0.f, l_reg = 0.f; f32x16 o[NCB];
  f32x16 negm = f32x16{}; const int qw = qpos0 + wid * 32;
#pragma unroll
  for (int d = 0; d < NCB; ++d) o[d] = f32x16{};
  f32x16 S0 = f32x16{}, S1 = f32x16{}; bf16x8 pa0 = bf16x8{}, pa1 = bf16x8{}, pa2 = bf16x8{}, pa3 = bf16x8{};
  if (g == 1) { _Pragma("unroll") for (int t = 0; t < PP_NS; ++t) DMA_T(t, t); asm volatile("s_waitcnt vmcnt(8)" ::: "memory"); static_assert(PP_NS == 5, "prologue wait = 2 * (NS - 1)"); }
  else { _Pragma("unroll") for (int t = 0; t < PP_NS - 2; ++t) DMA_T(t, t); }
  PP_BAR();
#define CRF(r) ((float)(((r) & 3) + 8 * ((r) >> 2)))
#define M_STEP(k) do { const int k_ = (k); s16x4 vl_[4], vh_[4]; const int vb_ = vbase + ((k_ >= 0 ? k_ : 0) % PP_NS) * PP_VSLOT; \
    if (k_ >= 0) pv_issue0<NCB>(vl_, vh_, vb_); \
    if (k_ + 1 < NT) { const int ks_ = (k_ + 1) % PP_NS; \
      if constexpr (ALIBI) { const int kt0_ = 64 * (k_ + 1); const float dq_ = dq0 - (float)kt0_; \
        if (kt0_ + 63 <= qw || kt0_ >= qw + 31) {     \
          const float ssl_ = (kt0_ + 63 <= qw) ? sl2 : -sl2; const float e0_ = -m_reg - ssl_ * dq_, e1_ = e0_ + 32.f * ssl_; \
          _Pragma("unroll") for (int r = 0; r < 16; ++r) { S0[r] = fmaf(ssl_, CRF(r), e0_); S1[r] = fmaf(ssl_, CRF(r), e1_); } \
        } else { \
          _Pragma("unroll") for (int r = 0; r < 16; ++r) { const float t0_ = dq_ - CRF(r); S0[r] = fmaf(-sl2, fabsf(t0_), -m_reg); S1[r] = fmaf(-sl2, fabsf(t0_ - 32.f), -m_reg); } \
        } \
        qkt_acc(S0, S1, ldsl + PP_LK + ks_ * PP_KSLOT, qr, r32, hi); \
      } else { qkt_c(S0, S1, negm, ldsl + PP_LK + ks_ * PP_KSLOT, qr, r32, hi); } } \
    if (k_ >= 0) pv_rest<NCB>(o, vl_, vh_, vb_, pa0, pa1, pa2, pa3); } while (0)
#define PK4(P, BASE, OUT) do { unsigned a0 = cvtpk(P[BASE + 0], P[BASE + 1]), a1 = cvtpk(P[BASE + 2], P[BASE + 3]);   \
    unsigned b0 = cvtpk(P[BASE + 4], P[BASE + 5]), b1 = cvtpk(P[BASE + 6], P[BASE + 7]);                              \
    auto r0 = __builtin_amdgcn_permlane32_swap(a0, b0, false, false); auto r1 = __builtin_amdgcn_permlane32_swap(a1, b1, false, false); \
    u32x4 w = {r0[0], r1[0], r0[1], r1[1]}; OUT = *reinterpret_cast<bf16x8*>(&w); } while (0)
#define V_STEP(k) do { const int k_ = (k); \
    { const int tt_ = k_ + (g ? PP_NS : PP_NS - 2); if (tt_ < NT) DMA_T(tt_, tt_ % PP_NS); } \
    float pmax = S0[0]; \
    _Pragma("unroll") for (int r = 1; r < 16; ++r) pmax = fmaxf(pmax, S0[r]); \
    _Pragma("unroll") for (int r = 0; r < 16; ++r) pmax = fmaxf(pmax, S1[r]); \
    { auto rr = __builtin_amdgcn_permlane32_swap(__float_as_uint(pmax), __float_as_uint(pmax), false, false); \
      pmax = fmaxf(__uint_as_float(rr[0]), __uint_as_float(rr[1])); } \
    if (k_ == 0 || !__builtin_expect(__all(pmax <= THR2), 1)) {       \
      const float dl = (k_ == 0) ? pmax : fmaxf(pmax, 0.f); m_reg += dl; \
      _Pragma("unroll") for (int r = 0; r < 16; ++r) { S0[r] -= dl; S1[r] -= dl; } \
      if constexpr (!ALIBI) { _Pragma("unroll") for (int r = 0; r < 16; ++r) negm[r] = -m_reg; } \
      if (k_ != 0) { const float alpha = __builtin_amdgcn_exp2f(-dl); l_reg *= alpha; \
        if (hi == 0) al_l[r32] = alpha; \
        asm volatile("s_waitcnt lgkmcnt(0)" ::: "memory"); \
        _Pragma("unroll") for (int d = 0; d < NCB; ++d) _Pragma("unroll") for (int r = 0; r < 16; ++r) o[d][r] *= al_l[crow(r, hi)]; } } \
    _Pragma("unroll") for (int r = 0; r < 16; ++r) { S0[r] = __builtin_amdgcn_exp2f(S0[r]); S1[r] = __builtin_amdgcn_exp2f(S1[r]); } \
    float ps = 0.f, ps1 = 0.f, ps2 = 0.f, ps3 = 0.f; \
    _Pragma("unroll") for (int r = 0; r < 16; r += 2) { ps += S0[r]; ps1 += S0[r + 1]; ps2 += S1[r]; ps3 += S1[r + 1]; } \
    ps = (ps + ps1) + (ps2 + ps3); \
    { auto rr = __builtin_amdgcn_permlane32_swap(__float_as_uint(ps), __float_as_uint(ps), false, false); \
      ps = __uint_as_float(rr[0]) + __uint_as_float(rr[1]); } \
    l_reg += ps; \
    PK4(S0, 0, pa0); PK4(S0, 8, pa1); PK4(S1, 0, pa2); PK4(S1, 8, pa3); } while (0)
#define WAIT_V(n) asm volatile("s_waitcnt vmcnt(" #n ")" ::: "memory")
  if (g == 0) {
    M_STEP(-1); PP_BAR();
    for (int k = 0; k < NT; ++k) {
      V_STEP(k);
      { const int no_ = NT - 1 - k;
        if (no_ >= 3) { if constexpr (NVI == 4) WAIT_V(12); else WAIT_V(6); } else if (no_ == 2) { if constexpr (NVI == 4) WAIT_V(8); else WAIT_V(4); }
        else if (no_ == 1) { if constexpr (NVI == 4) WAIT_V(4); else WAIT_V(2); } else WAIT_V(0); }
      PP_BAR();
      M_STEP(k); PP_BAR();
    }
    PP_BAR();
  } else {
    PP_BAR();
    for (int k = 0; k < NT; ++k) {
      M_STEP(k - 1);
      { const int no_ = NT - 2 - k;
        if (no_ >= 3) WAIT_V(6); else if (no_ == 2) WAIT_V(4); else if (no_ == 1) WAIT_V(2); else WAIT_V(0); }
      PP_BAR();
      V_STEP(k); PP_BAR();
    }
    M_STEP(NT - 1); PP_BAR();
  }
#undef M_STEP
#undef CRF
#undef V_STEP
#undef PK4
#undef WAIT_V
  if (hi == 0) li_l[r32] = l_reg; asm volatile("s_waitcnt lgkmcnt(0)" ::: "memory");
  float rli[16];
#pragma unroll
  for (int r = 0; r < 16; ++r) rli[r] = __builtin_amdgcn_rcpf(li_l[crow(r, hi)]);
  TO* Ow = Ob + (long)(wid * 32) * 1024;
#pragma unroll
  for (int r = 0; r < 16; ++r) { const int orow = crow(r, hi);
#pragma unroll
    for (int d0 = 0; d0 < NCB; ++d0) store_o(Ow + (long)orow * 1024 + d0 * 32 + r32, o[d0][r] * rli[r]); }
#undef DMA_T
}
#undef ALAS
}
namespace attn_body {
using bf16=__hip_bfloat16;
using bf16x8=__attribute__((ext_vector_type(8)))short;
using s16x4=__attribute__((ext_vector_type(4)))short;
using f32x16=__attribute__((ext_vector_type(16)))float;
using u32x4=__attribute__((ext_vector_type(4)))unsigned;
constexpr int D=64,DMQ=2368,DMK=2368,DMV=2368,DMO=1024;
constexpr int NW=8,QBLK=32,QB=QBLK*NW,KVBLK=64;
__device__ __forceinline__ int crow(int r,int hi){return (r&3)+8*(r>>2)+4*hi;}
#define SBAR() __builtin_amdgcn_sched_barrier(0)
__device__ __forceinline__ void cmask(f32x16&p0,f32x16&p1,int jb,int qrel,int hi){
  const float NEG=-INFINITY; int kb=64*jb+4*hi;
  #pragma unroll
  for(int r=0;r<16;++r){int kv=kb+(r&3)+8*(r>>2); if(kv>qrel)p0[r]=NEG; if(kv+32>qrel)p1[r]=NEG;}
}

constexpr int NSLOT=3, SLOTB=8192;
constexpr int LDS_K=0, LDS_V=NSLOT*SLOTB, LDS_WS=2*NSLOT*SLOTB, LDS_OST=LDS_WS+NW*64*4, LDS_BYTES=LDS_OST+NW*4096;
constexpr float C2=0.125f*1.4426950408889634f;
__device__ __forceinline__ void glds16(const void*gsrc,unsigned lds_dst){unsigned keep;
  asm volatile("s_mov_b32 %0, m0\n\ts_mov_b32 m0, %2\n\ts_nop 0\n\tglobal_load_lds_dwordx4 %1, off\n\ts_mov_b32 m0, %0":"=&s"(keep):"v"(gsrc),"s"(lds_dst):"memory");}
__device__ __forceinline__ float max3f(float a,float b,float c){float r;asm("v_max3_f32 %0, %1, %2, %3":"=v"(r):"v"(a),"v"(b),"v"(c));return r;}
__device__ __forceinline__ float max2f(float a,float b){float r;asm("v_max_f32_e32 %0, %1, %2":"=v"(r):"v"(a),"v"(b));return r;}
__device__ __forceinline__ float fadd_s(float a,float b){float r;asm("v_add_f32_e32 %0, %1, %2":"=v"(r):"v"(a),"v"(b));return r;}
__device__ __forceinline__ float fsub_s(float a,float b){float r;asm("v_sub_f32_e32 %0, %1, %2":"=v"(r):"v"(a),"v"(b));return r;}
typedef float f32x2_t __attribute__((ext_vector_type(2))); typedef __bf16 bf16x2_t __attribute__((ext_vector_type(2)));
__device__ __forceinline__ unsigned cvtpk_s(float lo,float hi){f32x2_t v={lo,hi};bf16x2_t b=__builtin_convertvector(v,bf16x2_t);return __builtin_bit_cast(unsigned,b);}
#define WAIT_BAR(N) asm volatile("s_waitcnt vmcnt(" #N ") lgkmcnt(0)\n\ts_barrier":::"memory")

__device__ __forceinline__ void qkt(f32x16&p0,f32x16&p1,const char*Kslot,const bf16x8*qr,const f32x16&negm,int r32,int hi){
  const char*kb=Kslot+hi*1024+r32*16;
  #pragma unroll
  for(int d0=0;d0<4;++d0){
    const bf16x8 b0=*reinterpret_cast<const bf16x8*>(kb+d0*2048);
    const bf16x8 b1=*reinterpret_cast<const bf16x8*>(kb+d0*2048+512);
    if(d0==0){p0=__builtin_amdgcn_mfma_f32_32x32x16_bf16(b0,qr[0],negm,0,0,0);p1=__builtin_amdgcn_mfma_f32_32x32x16_bf16(b1,qr[0],negm,0,0,0);}
    else{p0=__builtin_amdgcn_mfma_f32_32x32x16_bf16(b0,qr[d0],p0,0,0,0);p1=__builtin_amdgcn_mfma_f32_32x32x16_bf16(b1,qr[d0],p1,0,0,0);}}
}
typedef __attribute__((address_space(3))) const char* lds_cptr;
typedef short v4i16_t __attribute__((ext_vector_type(4)));
__device__ __forceinline__ void kload8(bf16x8*kf,lds_cptr kp){
  kf[0]=*(const __attribute__((address_space(3))) bf16x8*)(kp);      kf[1]=*(const __attribute__((address_space(3))) bf16x8*)(kp+512);
  kf[2]=*(const __attribute__((address_space(3))) bf16x8*)(kp+2048); kf[3]=*(const __attribute__((address_space(3))) bf16x8*)(kp+2560);
  kf[4]=*(const __attribute__((address_space(3))) bf16x8*)(kp+4096); kf[5]=*(const __attribute__((address_space(3))) bf16x8*)(kp+4608);
  kf[6]=*(const __attribute__((address_space(3))) bf16x8*)(kp+6144); kf[7]=*(const __attribute__((address_space(3))) bf16x8*)(kp+6656);
}
__device__ __forceinline__ void kload2(bf16x8*kf,lds_cptr kp,int j){ kf[2*j]=*(const __attribute__((address_space(3))) bf16x8*)(kp+j*2048); kf[2*j+1]=*(const __attribute__((address_space(3))) bf16x8*)(kp+j*2048+512); }
__device__ __forceinline__ s16x4 vtr(lds_cptr p){ return __builtin_bit_cast(s16x4,__builtin_amdgcn_ds_read_tr16_b64_v4i16((__attribute__((address_space(3))) v4i16_t*)p)); }
__device__ __forceinline__ float rowmax(const f32x16&p0,const f32x16&p1){
  float a=max3f(p0[0],p0[1],p1[0]),b=max3f(p0[2],p0[3],p1[1]);a=max3f(a,p1[2],p1[3]);
  #pragma unroll
  for(int r=4;r<16;r+=4){a=max3f(a,p0[r],p0[r+1]);b=max3f(b,p0[r+2],p0[r+3]);a=max3f(a,p1[r],p1[r+1]);b=max3f(b,p1[r+2],p1[r+3]);}
  const float m=max2f(a,b);
  auto rr=__builtin_amdgcn_permlane32_swap(__float_as_uint(m),__float_as_uint(m),false,false);
  return max2f(__uint_as_float(rr[0]),__uint_as_float(rr[1]));
}
__device__ __forceinline__ void pv(f32x16*o,int vb,bf16x8 pa0,bf16x8 pa1,bf16x8 pa2,bf16x8 pa3){
  #pragma unroll
  for(int d0=0;d0<2;++d0){s16x4 lo[4],hi[4];
    #pragma unroll
    for(int ks=0;ks<4;++ks){
      asm volatile("ds_read_b64_tr_b16 %0,%1 offset:%c2":"=&v"(lo[ks]):"v"(vb),"i"(d0*4096+ks*1024):"memory");
      asm volatile("ds_read_b64_tr_b16 %0,%1 offset:%c2":"=&v"(hi[ks]):"v"(vb),"i"(d0*4096+ks*1024+512):"memory");}
    asm volatile("s_waitcnt lgkmcnt(0)":::"memory");SBAR();
    #define PK(k) (bf16x8){lo[k][0],lo[k][1],lo[k][2],lo[k][3],hi[k][0],hi[k][1],hi[k][2],hi[k][3]}
    o[d0]=__builtin_amdgcn_mfma_f32_32x32x16_bf16(pa0,PK(0),o[d0],0,0,0);
    o[d0]=__builtin_amdgcn_mfma_f32_32x32x16_bf16(pa1,PK(1),o[d0],0,0,0);
    o[d0]=__builtin_amdgcn_mfma_f32_32x32x16_bf16(pa2,PK(2),o[d0],0,0,0);
    o[d0]=__builtin_amdgcn_mfma_f32_32x32x16_bf16(pa3,PK(3),o[d0],0,0,0);
    #undef PK
  }
}

#ifndef ATTN_STORE16
#define ATTN_STORE16(p,v) (*(u32x4*)(p)=(v))
#endif
template<int THRL> __device__ __forceinline__ void attn_unit(const bf16*Qb,const bf16*__restrict__ Kh,const bf16*__restrict__ Vh,bf16*Ob,const int NT,char*shm,const float sbound=0.f){
  const int tid=threadIdx.x,lane=tid&63,r32=lane&31,hi=lane>>5; const int wid=__builtin_amdgcn_readfirstlane(tid>>6);
  const bf16*Qw=Qb+(long)(wid*QBLK)*DMQ;
  const unsigned lds0=(unsigned)(uintptr_t)shm;
  float*wsf=(float*)(shm+LDS_WS)+wid*64;
  const bf16*ksrc=Kh+(long)lane*DMK+wid*8;
  const bf16*vsrc=Vh+(long)(16*(wid&3)+(lane>>2))*DMV+(wid>>2)*32+(lane&3)*8;
  const unsigned kdst=lds0+LDS_K+wid*1024, vdst=lds0+LDS_V+wid*1024;
  #define DMA_K(t,slot) glds16(ksrc+(long)(t)*KVBLK*DMK,(unsigned)__builtin_amdgcn_readfirstlane(kdst+(slot)))
  #define DMA_V(t,slot) glds16(vsrc+(long)(t)*KVBLK*DMV,(unsigned)__builtin_amdgcn_readfirstlane(vdst+(slot)))
  const int vb0=(int)(lds0+LDS_V)+((lane>>4)&1)*32+(lane&3)*8+(4*hi+((lane&15)>>2))*64;
  const char*Kbase=shm+LDS_K; bf16x8 kf[8];
  const lds_cptr shm3=(lds_cptr)shm; const lds_cptr kp0=shm3+LDS_K+hi*1024+r32*16; const lds_cptr vp0=shm3+LDS_V+((lane>>4)&1)*32+(lane&3)*8+(4*hi+((lane&15)>>2))*64;
  DMA_K(0,0);DMA_V(0,0);DMA_K(1,SLOTB);
  bf16x8 qr[4];
  #pragma unroll
  for(int d0=0;d0<4;++d0)qr[d0]=*reinterpret_cast<const bf16x8*>(&Qw[(long)r32*DMQ+d0*16+hi*8]);
  float sb_=sbound; asm volatile("":"+v"(sb_));
  float mhat=(THRL>=1000)?sb_:0.f,l_reg=0.f;f32x16 o[2];o[0]=f32x16{};o[1]=f32x16{};f32x16 negm;
  _Pragma("unroll") for(int r=0;r<16;++r)negm[r]=-mhat; asm volatile("":"+v"(negm));
  #define CMASK(P0,P1,t) do{}while(0)
  bool resc=false;
  #define START(P0,P1) do{ resc=false; if constexpr(THRL<1000) { const float rm=rowmax(P0,P1); \
      const float dl=rm; mhat=fadd_s(mhat,dl); \
      _Pragma("unroll") for(int r=0;r<16;++r){P0[r]=fsub_s(P0[r],dl);P1[r]=fsub_s(P1[r],dl);} \
      _Pragma("unroll") for(int r=0;r<16;++r)negm[r]=-mhat; asm volatile("":"+v"(negm)); } \
    _Pragma("unroll") for(int r=0;r<16;++r)P0[r]=__builtin_amdgcn_exp2f(P0[r]); }while(0)
  #define RESC() do{ if(resc){ asm volatile("s_waitcnt lgkmcnt(0)":::"memory"); \
      _Pragma("unroll") for(int d_=0;d_<2;++d_) _Pragma("unroll") for(int r=0;r<16;++r)o[d_][r]*=wsf[crow(r,hi)]; } }while(0)
  f32x16 pA0,pA1,pB0,pB1;
  int sl_prev=0,sl_cur=0,sl_next=SLOTB;
  #define ROT() do{sl_prev=sl_cur;sl_cur=sl_next;sl_next=(sl_next==(NSLOT-1)*SLOTB)?0:sl_next+SLOTB;}while(0)
  DMA_K(2,2*SLOTB);
  WAIT_BAR(3);
  qkt(pA0,pA1,Kbase,qr,negm,r32,hi);asm volatile("s_nop 15\n\ts_nop 7":"+v"(pA0),"+v"(pA1));CMASK(pA0,pA1,0);
  START(pA0,pA1);
  _Pragma("unroll") for(int r=0;r<16;++r)pA1[r]=__builtin_amdgcn_exp2f(pA1[r]);
  WAIT_BAR(0);
  DMA_K(3,0);DMA_V(1,SLOTB);
  ROT();
  kload8(kf,kp0+sl_cur);
  WAIT_BAR(2);
  s16x4 vlo[8],vhi[8]; u32x4 pw0,pw1,pw2,pw3;
  #define PKW(P,B) cvtpk_s(P[B],P[B+1])
  #define PAF(k) __builtin_bit_cast(bf16x8,pw##k)
  #define VFR(i) (bf16x8){vlo[i][0],vlo[i][1],vlo[i][2],vlo[i][3],vhi[i][0],vhi[i][1],vhi[i][2],vhi[i][3]}
  #define PIN(x) asm volatile("":"+v"(x))
  #define MX3(a,b,c) __builtin_fmaxf(__builtin_fmaxf((a),(b)),(c))
  #define GAPA(MF,A0,A1,A2,A3,W0,W1,PW) do{ MF; sacc+=A0; sacc+=A1; sacc+=A2; sacc+=A3; PIN(sacc); W0; W1; PIN(PW); SBAR(); }while(0)
  #define EX(v) __builtin_amdgcn_exp2f(v)
  #define GAPB(MF,X,B) do{ MF; X[B]=EX(X[B]); X[B+1]=EX(X[B+1]); X[B+2]=EX(X[B+2]); X[B+3]=EX(X[B+3]); PIN(X); SBAR(); }while(0)
  #define VRD(i) do{ vlo[i]=vtr(vp_+(((i)>>2)*4096+((i)&3)*1024)); vhi[i]=vtr(vp_+(((i)>>2)*4096+((i)&3)*1024+512)); }while(0)
  #define KRD(G,j) do{ if(G){ kload2(kf,kp0+sl_next,j); SBAR(); } }while(0)
  #define STEP(C0,C1,P0,P1,t,GK,GV,GL) do{ SBAR(); \
    const lds_cptr vp_=vp0+sl_prev; \
    VRD(0); SBAR(); float sacc=(P0[0]+P0[1]); \
    GAPA(C0=__builtin_amdgcn_mfma_f32_32x32x16_bf16(kf[0],qr[0],negm,0,0,0), P0[2],P0[3],P0[4],P0[5],     pw0[0]=PKW(P0,0), pw0[1]=PKW(P0,2), pw0); \
    VRD(4); SBAR(); GAPA(C1=__builtin_amdgcn_mfma_f32_32x32x16_bf16(kf[1],qr[0],negm,0,0,0), P0[6],P0[7],P0[8],P0[9],     pw0[2]=PKW(P0,4), pw0[3]=PKW(P0,6), pw0); \
    VRD(1); SBAR(); GAPA(C0=__builtin_amdgcn_mfma_f32_32x32x16_bf16(kf[2],qr[1],C0,0,0,0),   P0[10],P0[11],P0[12],P0[13], pw1[0]=PKW(P0,8), pw1[1]=PKW(P0,10), pw1); \
    VRD(5); SBAR(); GAPA(C1=__builtin_amdgcn_mfma_f32_32x32x16_bf16(kf[3],qr[1],C1,0,0,0),   P0[14],P0[15],P1[0],P1[1],   pw1[2]=PKW(P0,12),pw1[3]=PKW(P0,14), pw1); \
    VRD(2); SBAR(); GAPA(C0=__builtin_amdgcn_mfma_f32_32x32x16_bf16(kf[4],qr[2],C0,0,0,0),   P1[2],P1[3],P1[4],P1[5],     pw2[0]=PKW(P1,0), pw2[1]=PKW(P1,2), pw2); \
    VRD(6); SBAR(); GAPA(C1=__builtin_amdgcn_mfma_f32_32x32x16_bf16(kf[5],qr[2],C1,0,0,0),   P1[6],P1[7],P1[8],P1[9],     pw2[2]=PKW(P1,4), pw2[3]=PKW(P1,6), pw2); \
    VRD(3); SBAR(); GAPA(C0=__builtin_amdgcn_mfma_f32_32x32x16_bf16(kf[6],qr[3],C0,0,0,0),   P1[10],P1[11],P1[12],P1[13], pw3[0]=PKW(P1,8), pw3[1]=PKW(P1,10), pw3); \
    VRD(7); SBAR(); GAPA(C1=__builtin_amdgcn_mfma_f32_32x32x16_bf16(kf[7],qr[3],C1,0,0,0),   P1[14],P1[15],0.f,0.f,       pw3[2]=PKW(P1,12),pw3[3]=PKW(P1,14), pw3); \
    l_reg+=sacc; \
    if(GK){DMA_K((t)+3,sl_cur);} if(GV){DMA_V((t)+1,sl_next);} \
    CMASK(C0,C1,t); \
    resc=false; if constexpr(THRL<1000) { float a=MX3(C0[0],C0[1],C1[0]),b=MX3(C0[2],C0[3],C1[1]); a=MX3(a,C1[2],C1[3]); \
      _Pragma("unroll") for(int r=4;r<16;r+=4){a=MX3(a,C0[r],C0[r+1]);b=MX3(b,C0[r+2],C0[r+3]);a=MX3(a,C1[r],C1[r+1]);b=MX3(b,C1[r+2],C1[r+3]);} \
      float rm=__builtin_fmaxf(a,b); { auto rr=__builtin_amdgcn_permlane32_swap(__float_as_uint(rm),__float_as_uint(rm),false,false); rm=__builtin_fmaxf(__uint_as_float(rr[0]),__uint_as_float(rr[1])); } \
      resc=false; \
      if(__builtin_expect(__any(rm>(float)THRL),0)){ const float dl=__builtin_fmaxf(rm,0.f); mhat+=dl; \
        _Pragma("unroll") for(int r=0;r<16;++r){C0[r]-=dl;C1[r]-=dl;} \
        _Pragma("unroll") for(int r=0;r<16;++r)negm[r]=-mhat; asm volatile("":"+v"(negm)); \
        const float f=__builtin_amdgcn_exp2f(-dl); l_reg*=f; if(hi==0)wsf[r32]=f; resc=true; } } \
    SBAR(); \
    GAPB(o[0]=__builtin_amdgcn_mfma_f32_32x32x16_bf16(PAF(0),VFR(0),o[0],0,0,0), C0,0); \
    GAPB(o[1]=__builtin_amdgcn_mfma_f32_32x32x16_bf16(PAF(0),VFR(4),o[1],0,0,0), C0,4); \
    KRD(GL,0); GAPB(o[0]=__builtin_amdgcn_mfma_f32_32x32x16_bf16(PAF(1),VFR(1),o[0],0,0,0), C0,8); \
    KRD(GL,1); GAPB(o[1]=__builtin_amdgcn_mfma_f32_32x32x16_bf16(PAF(1),VFR(5),o[1],0,0,0), C0,12); \
    KRD(GL,2); GAPB(o[0]=__builtin_amdgcn_mfma_f32_32x32x16_bf16(PAF(2),VFR(2),o[0],0,0,0), C1,0); \
    KRD(GL,3); GAPB(o[1]=__builtin_amdgcn_mfma_f32_32x32x16_bf16(PAF(2),VFR(6),o[1],0,0,0), C1,4); \
    GAPB(o[0]=__builtin_amdgcn_mfma_f32_32x32x16_bf16(PAF(3),VFR(3),o[0],0,0,0), C1,8); \
    GAPB(o[1]=__builtin_amdgcn_mfma_f32_32x32x16_bf16(PAF(3),VFR(7),o[1],0,0,0), C1,12); \
    }while(0)
  int t=1;
  #undef CMASK
  #define CMASK(P0,P1,t) do{}while(0)
  for(;t+5<NT;t+=2){
    STEP(pB0,pB1,pA0,pA1,t,true,true,true);     WAIT_BAR(2); RESC(); ROT();
    STEP(pA0,pA1,pB0,pB1,t+1,true,true,true);   WAIT_BAR(2); RESC(); ROT();
  }
  #undef CMASK
  #define CMASK(P0,P1,t) do{}while(0)
  #define ENDW(tt) do{ if((tt)+3<NT){WAIT_BAR(2);} else if((tt)+2<NT){WAIT_BAR(1);} else {WAIT_BAR(0);} }while(0)
  for(;t+1<NT;t+=2){
    STEP(pB0,pB1,pA0,pA1,t,(t+3<NT),(t+1<NT),(t+1<NT));       ENDW(t);   RESC(); ROT();
    STEP(pA0,pA1,pB0,pB1,t+1,(t+4<NT),(t+2<NT),(t+2<NT));     ENDW(t+1); RESC(); ROT();
  }
  STEP(pB0,pB1,pA0,pA1,NT-1,false,false,false); RESC();
  { float sacc=pB0[0]+pB0[1]; _Pragma("unroll") for(int r=2;r<16;++r)sacc+=pB0[r]; _Pragma("unroll") for(int r=0;r<16;++r)sacc+=pB1[r]; l_reg+=sacc;
    pw0=(u32x4){PKW(pB0,0),PKW(pB0,2),PKW(pB0,4),PKW(pB0,6)};pw1=(u32x4){PKW(pB0,8),PKW(pB0,10),PKW(pB0,12),PKW(pB0,14)};pw2=(u32x4){PKW(pB1,0),PKW(pB1,2),PKW(pB1,4),PKW(pB1,6)};pw3=(u32x4){PKW(pB1,8),PKW(pB1,10),PKW(pB1,12),PKW(pB1,14)};
    SBAR(); pv(o,vb0+sl_cur,PAF(0),PAF(1),PAF(2),PAF(3)); }
  #undef PKW
  #undef PAF
  #undef VFR
  #undef PIN
  #undef MX3
  #undef GAPA
  #undef GAPB
  #undef EX
  #undef VRD
  #undef KRD
  #undef STEP
  #undef ENDW
  {auto rr=__builtin_amdgcn_permlane32_swap(__float_as_uint(l_reg),__float_as_uint(l_reg),false,false);l_reg=__uint_as_float(rr[0])+__uint_as_float(rr[1]);}
  if(hi==0)wsf[32+r32]=l_reg;asm volatile("s_waitcnt lgkmcnt(0)":::"memory");
  float rli[16];
  #pragma unroll
  for(int r=0;r<16;++r)rli[r]=__builtin_amdgcn_rcpf(wsf[32+crow(r,hi)]);
  bf16*Ow=Ob+(long)(wid*QBLK)*DMO;
  { bf16*stg=(bf16*)(shm+LDS_OST)+wid*2048;
    #pragma unroll
    for(int r=0;r<16;++r){const int orow=crow(r,hi);
      #pragma unroll
      for(int d0=0;d0<2;++d0)stg[orow*64+d0*32+r32]=__float2bfloat16(o[d0][r]*rli[r]);}
    asm volatile("s_waitcnt lgkmcnt(0)":::"memory");
    #pragma unroll
    for(int i=0;i<4;++i){const int row=i*8+(lane>>3),ch=lane&7; const u32x4 v=*(const u32x4*)(stg+row*64+ch*8); ATTN_STORE16(Ow+(long)row*DMO+ch*8,v);} }
  asm volatile("s_waitcnt lgkmcnt(0)\n\ts_barrier":::"memory");
  #undef DMA_K
  #undef DMA_V
  #undef CMASK
  #undef START
  #undef RESC
  #undef ROT
}
constexpr int ATTN_LDS_BYTES=LDS_BYTES;
#undef SBAR
#undef WAIT_BAR
}
typedef unsigned short bf16;
typedef unsigned v4u __attribute__((ext_vector_type(4)));
typedef float f32x4 __attribute__((ext_vector_type(4)));
#define LAS __attribute__((address_space(3)))
constexpr int NWAVES = 8;
constexpr int D = 1024, FF = 4096, NIN = 2304, PLE = 256;
constexpr int ZP = att::LDZ;
constexpr int MP = 4 * 8192, MS = 8 * 2048, M = MP + MS;
constexpr int SEQ_P = 8192, SEQ_S = 2048;
constexpr float C2 = 0.125f * 1.4426950408889634f;
constexpr float LOG2E = 1.4426950408889634f;
constexpr size_t MiB = 1u << 20;
constexpr size_t WS_RSP1 = 1 * MiB, WS_RSP2 = 4 * MiB, WS_RSP3 = 7 * MiB;
constexpr size_t WS_WIN = 10 * MiB, WS_WOUT = 15 * MiB, WS_W1 = 17 * MiB, WS_W2 = 25 * MiB, WS_WG = 33 * MiB, WS_WP = 35 * MiB;
constexpr size_t WS_PB = 36 * MiB;
constexpr size_t WS_PROJ = 60 * MiB;
constexpr size_t WS_Z = 156 * MiB;
constexpr size_t WS_HB = 156 * MiB;
constexpr size_t WS_XN = 380 * MiB;
constexpr size_t WS_H = 252 * MiB;
constexpr size_t WS_END = 512 * MiB;
static_assert(WS_XN + (size_t)M * D * 2 <= WS_END && WS_Z + (size_t)M * ZP * 2 <= WS_XN && WS_H + (size_t)16384 * FF * 2 <= WS_END && WS_HB + (size_t)M * D * 2 <= WS_H, "d_ws map");
constexpr int CW_QMAX = 3584, CW_KMAX = 3648, CW_DNEG = 3616, CW_QUEUE = 3712;
constexpr int CTL_BYTES = 32768;
constexpr float SKIP_T = 32.0f;
constexpr int LDS_BYTES = 147456;
static_assert(att::ATTN_LDS <= 131072 && attn_body::ATTN_LDS_BYTES <= 131072 && attn_body::DMQ == ZP, "attention LDS / pitches");

__device__ __forceinline__ unsigned f2bf(float f) { unsigned u = __builtin_bit_cast(unsigned, f); return (u + 0x7fffu + ((u >> 16) & 1u)) >> 16; }
__device__ __forceinline__ unsigned pk2(float lo, float hi) { return f2bf(lo) | (f2bf(hi) << 16); }
__device__ __forceinline__ float wave_sum(float v) {
#pragma unroll
    for (int o = 1; o < 64; o <<= 1) v += __shfl_xor(v, o);
    return v;
}
__device__ __forceinline__ void transpose_item(const float* W, int K, int N, const float* g, bf16* WT, LAS float* scr, int item, int lane) {
    const int nblk = N / 32, kb = item / nblk, nb = item % nblk, k0 = 64 * kb, n0 = 32 * nb;
#pragma unroll 8
    for (int i = 0; i < 32; ++i) { const int kk = 2 * i + (lane >> 5); const float gs = g ? g[k0 + kk] : 1.f; scr[kk * 33 + (lane & 31)] = W[(size_t)(k0 + kk) * N + n0 + (lane & 31)] * gs; }
    asm volatile("s_waitcnt lgkmcnt(0)" ::: "memory");
    const int c = lane & 7;
#pragma unroll
    for (int j = 0; j < 4; ++j) { const int n = (lane >> 3) + 8 * j; const LAS float* s = scr + (8 * c) * 33 + n;
        v4u o; o.x = pk2(s[0 * 33], s[1 * 33]); o.y = pk2(s[2 * 33], s[3 * 33]); o.z = pk2(s[4 * 33], s[5 * 33]); o.w = pk2(s[6 * 33], s[7 * 33]);
        *(v4u*)(WT + (size_t)(n0 + n) * K + k0 + 8 * c) = o; }
    asm volatile("s_waitcnt lgkmcnt(0)" ::: "memory");
}

#define XB_TMO      128
#define XB_XCNT(j)  (256  + 64 * (j))
#define XB_XSUB(j)  (1280 + 64 * (j))
#define XB_XGEN(j)  (2304 + 64 * (j))
#define XB_TOP      3328
#define XB_TOPGEN   3392
#define XCD_BAR_WORDS 3456
#define XB_SPIN_CAP (1u << 22)

__device__ __forceinline__ unsigned xb_ld(unsigned* p)              { return __hip_atomic_load(p, __ATOMIC_RELAXED, __HIP_MEMORY_SCOPE_AGENT); }
__device__ __forceinline__ unsigned xb_add(unsigned* p, unsigned v) { return __hip_atomic_fetch_add(p, v, __ATOMIC_RELAXED, __HIP_MEMORY_SCOPE_AGENT); }
__device__ __forceinline__ unsigned xb_xcc_id() { return (unsigned)__builtin_amdgcn_s_getreg((3 << 11) | 20) & 0xFu; }
#define XB_SPIN(cond, bar) do { unsigned _sp = 0; while (cond) { __builtin_amdgcn_s_sleep(1); \
    if ((++_sp & 255u) == 0u) { if (xb_ld(&(bar)[XB_TMO])) break; if (_sp > XB_SPIN_CAP) { atomicAdd(&(bar)[XB_TMO], 1u); break; } } } } while (0)

struct XcdBarrier {
    unsigned* bar; unsigned x;
    volatile LAS unsigned* st;
};

__device__ __forceinline__ XcdBarrier xcd_barrier_post(unsigned* bar, volatile LAS unsigned* st) {
    XcdBarrier b; b.bar = bar; b.x = xb_xcc_id(); b.st = st;
    if (threadIdx.x == 0) (void)xb_add(&bar[XB_XCNT(b.x)], 1u);
    return b;
}
__device__ __forceinline__ void xcd_barrier_complete(unsigned* bar, unsigned x, unsigned& nloc, unsigned& nx) {
    const unsigned G = gridDim.x * gridDim.y * gridDim.z;
    unsigned sum, cnt, mine, sp = 0u;
    for (;;) {
        sum = 0u; cnt = 0u; mine = 0u;
#pragma unroll
        for (unsigned j = 0; j < 16; ++j) { const unsigned c = xb_ld(&bar[XB_XCNT(j)]); sum += c; cnt += (c > 0u) ? 1u : 0u; mine = (j == x) ? c : mine; }
        if (sum == G) break;
        __builtin_amdgcn_s_sleep(1);
        if ((++sp & 255u) == 0u) { if (xb_ld(&bar[XB_TMO])) break; if (sp > XB_SPIN_CAP) { atomicAdd(&bar[XB_TMO], 1u); break; } }
    }
    nloc = mine > 0u ? mine : 1u; nx = cnt > 0u ? cnt : 1u;
}

__device__ __forceinline__ void xcd_barrier(const XcdBarrier& b) {
    asm volatile("s_waitcnt vmcnt(0)" ::: "memory");
    __syncthreads();
    if (threadIdx.x == 0) {
        unsigned* bar = b.bar;
        __builtin_amdgcn_s_waitcnt(0);
        unsigned nloc = b.st[0], nx = b.st[1];
        if (nloc == 0u) { xcd_barrier_complete(bar, b.x, nloc, nx); b.st[0] = nloc; b.st[1] = nx; }
        const unsigned old = xb_add(&bar[XB_XSUB(b.x)], 1u);
        const unsigned gen = old / nloc;
        if (old + 1u == (gen + 1u) * nloc) {
            __builtin_amdgcn_fence(__ATOMIC_RELEASE, "agent");
            asm volatile("s_waitcnt vmcnt(0)" ::: "memory");
            const unsigned og = xb_add(&bar[XB_TOP], 1u);
            const unsigned tg = og / nx;
            if (og + 1u == (tg + 1u) * nx) xb_add(&bar[XB_TOPGEN], 1u);
            else XB_SPIN(xb_ld(&bar[XB_TOPGEN]) == tg, bar);
            __builtin_amdgcn_fence(__ATOMIC_ACQUIRE, "agent");
            xb_add(&bar[XB_XGEN(b.x)], 1u);
            asm volatile("s_waitcnt vmcnt(0)" ::: "memory");
        } else {
            XB_SPIN(xb_ld(&bar[XB_XGEN(b.x)]) == gen, bar);
            __builtin_amdgcn_fence(__ATOMIC_ACQUIRE, "agent");
            asm volatile("s_waitcnt vmcnt(0)" ::: "memory");
        }
    }
    __syncthreads();
}

struct Args { const float* in[21]; float* out; unsigned char* ws; };

__global__ void __launch_bounds__(NWAVES * 64, 2) fwd_mega(Args args) {
    extern __shared__ __attribute__((aligned(16))) unsigned char lds[];
    cg::grid_group grid = cg::this_grid();
#define PHASE_IDS() int tid_p = threadIdx.x; asm volatile("" : "+v"(tid_p)); const int tid = tid_p, lane = tid & 63, wave = __builtin_amdgcn_readfirstlane(tid >> 6); const int gw = bx * NWAVES + wave; (void)lane; (void)gw; (void)tid
    const int G = gridDim.x, bx = blockIdx.x;
    const int NGW = G * NWAVES;
    unsigned char* ws = args.ws;
    const float* x_p = args.in[0]; const float* x_s = args.in[1]; const float* p_p = args.in[2]; const float* p_s = args.in[3];
    const float* w_in = args.in[4]; const float* g_mix = args.in[5];
    const float* lq1 = args.in[6]; const float* lk1 = args.in[7]; const float* lq2 = args.in[8]; const float* lk2 = args.in[9];
    const float* g_subln = args.in[10]; const float* g_qn = args.in[11]; const float* g_kn = args.in[12];
    const float* w_out = args.in[13]; const float* g_mlp = args.in[14]; const float* w_ff1 = args.in[15]; const float* w_ff2 = args.in[16];
    const float* g_ple = args.in[17]; const float* w_gate = args.in[18]; const float* w_proj = args.in[19]; const float* g_final = args.in[20];
    float* out = args.out;
    float* RSP1 = (float*)(ws + WS_RSP1); float* RSP2 = (float*)(ws + WS_RSP2); float* RSP3 = (float*)(ws + WS_RSP3);
    bf16* WinT = (bf16*)(ws + WS_WIN); bf16* WoutT = (bf16*)(ws + WS_WOUT); bf16* W1T = (bf16*)(ws + WS_W1); bf16* W2T = (bf16*)(ws + WS_W2); bf16* WgT = (bf16*)(ws + WS_WG); bf16* WpT = (bf16*)(ws + WS_WP);
    bf16* PB = (bf16*)(ws + WS_PB); bf16* PROJ = (bf16*)(ws + WS_PROJ); bf16* Z = (bf16*)(ws + WS_Z); bf16* HB = (bf16*)(ws + WS_HB);
    bf16* XN = (bf16*)(ws + WS_XN); bf16* MIX = XN; bf16* HH = (bf16*)(ws + WS_H);
    LAS unsigned char* ldsl = (LAS unsigned char*)lds;
    volatile LAS unsigned* bst = (volatile LAS unsigned*)(ldsl + 139264);
    if (threadIdx.x < 2) bst[threadIdx.x] = 0u;
    __syncthreads();
    const XcdBarrier bar = xcd_barrier_post((unsigned*)ws, bst);
    if (ws == nullptr) grid.sync();

#ifndef NO_P0
#ifdef PROBE_EW2
    for (int rep = 0; rep < 2; ++rep)
#endif
    {
        PHASE_IDS();
        LAS float* scr = (LAS float*)(ldsl + wave * 16384);
        constexpr int I_IN = (D / 64) * (NIN / 32), I_OUT = (D / 64) * (D / 32), I_1 = (D / 64) * (FF / 32), I_2 = (FF / 64) * (D / 32), I_G = I_OUT, I_P = (PLE / 64) * (D / 32);
        constexpr int NITEMS = I_IN + I_OUT + I_1 + I_2 + I_G + I_P;
        for (int it = gw; it < NITEMS; it += NGW) {
            int r = it;
            if (r < I_IN) { transpose_item(w_in, D, NIN, nullptr, WinT, scr, r, lane); continue; } r -= I_IN;
            if (r < I_OUT) { transpose_item(w_out, D, D, nullptr, WoutT, scr, r, lane); continue; } r -= I_OUT;
            if (r < I_1) { transpose_item(w_ff1, D, FF, g_mlp, W1T, scr, r, lane); continue; } r -= I_1;
            if (r < I_2) { transpose_item(w_ff2, FF, D, nullptr, W2T, scr, r, lane); continue; } r -= I_2;
            if (r < I_G) { transpose_item(w_gate, D, D, g_ple, WgT, scr, r, lane); continue; } r -= I_G;
            transpose_item(w_proj, PLE, D, nullptr, WpT, scr, r, lane);
        }
        f32x4 gv[4];
#pragma unroll
        for (int j = 0; j < 4; ++j) gv[j] = *((const f32x4*)g_mix + lane + 64 * j);
        for (int m0 = gw * 2; m0 < M; m0 += NGW * 2) {
            f32x4 v[2][4], pv[2];
#pragma unroll
            for (int r = 0; r < 2; ++r) { const int m = m0 + r;
                const float* xrow = m < MP ? x_p + (size_t)m * D : x_s + (size_t)(m - MP) * D;
                const float* prow = m < MP ? p_p + (size_t)m * PLE : p_s + (size_t)(m - MP) * PLE;
#pragma unroll
                for (int j = 0; j < 4; ++j) v[r][j] = *((const f32x4*)xrow + lane + 64 * j);
                pv[r] = *((const f32x4*)prow + lane); }
#pragma unroll
            for (int r = 0; r < 2; ++r) { const int m = m0 + r; float s = 0.f;
#pragma unroll
                for (int j = 0; j < 4; ++j) s += (v[r][j].x * v[r][j].x + v[r][j].y * v[r][j].y) + (v[r][j].z * v[r][j].z + v[r][j].w * v[r][j].w);
                const float rstd = 1.0f / sqrtf(wave_sum(s) * (1.0f / D) + 1e-6f);
                unsigned long long* o8 = (unsigned long long*)(XN + (size_t)m * D) + lane;
#pragma unroll
                for (int j = 0; j < 4; ++j) { const f32x4 y = v[r][j] * rstd * gv[j]; o8[64 * j] = (unsigned long long)pk2(y.x, y.y) | ((unsigned long long)pk2(y.z, y.w) << 32); }
                *((unsigned long long*)(PB + (size_t)m * PLE) + lane) = (unsigned long long)pk2(pv[r].x, pv[r].y) | ((unsigned long long)pk2(pv[r].z, pv[r].w) << 32); }
        }
    }
#endif
    xcd_barrier(bar);

#ifndef NO_P1
#ifdef PROBE_GEMM2
    for (int rep = 0; rep < 2; ++rep)
#endif
    {
        pg8::Gemm g{XN, WinT, M, NIN, D}; pg8::StaticOrder S; S.init(M, NIN, G, bx);
        pg8::EpiBf E{Z, ZP, C2, 2};
        pg8::gemm_phase<pg8::EpiBf, pg8::StaticOrder, true, true>(ldsl, g, S, E);
    }
    {
        pg8::Gemm g{PB, WpT, M, D, PLE}; pg8::StaticOrder S; S.init(M, D, G, bx);
        pg8::EpiBf E{PROJ, D, 1.f, 0};
        pg8::gemm_phase<pg8::EpiBf, pg8::StaticOrder, true, true>(ldsl, g, S, E);
    }
#endif
    xcd_barrier(bar);

#ifndef NO_P1B
    {
        int tl = threadIdx.x; asm volatile("" : "+v"(tl));
        const long nth = (long)G * 512;
        const int j4 = (tl & 3) * 4;
        {
            float mq = 0.f, mk = 0.f, md = 0.f;
            for (long it = (long)bx * 512 + tl; it < (long)M * 32; it += nth) {
                const long item = it >> 2; const int m = (int)(item >> 3), hc = (int)(item & 7);
                const bf16* p = Z + (size_t)m * ZP + hc * 64 + j4; float sq = 0.f, sk = 0.f, sd = 0.f;
#pragma unroll
                for (int q = 0; q < 4; ++q) { const unsigned long long w = *(const unsigned long long*)(p + 16 * q), wk = *(const unsigned long long*)(p + 512 + 16 * q);
                    const unsigned lo = (unsigned)w, hi = (unsigned)(w >> 32), klo = (unsigned)wk, khi = (unsigned)(wk >> 32);
                    const float a = __uint_as_float(lo << 16), b = __uint_as_float(lo & 0xffff0000u), c = __uint_as_float(hi << 16), d = __uint_as_float(hi & 0xffff0000u);
                    const float ka = __uint_as_float(klo << 16), kb = __uint_as_float(klo & 0xffff0000u), kc = __uint_as_float(khi << 16), kd = __uint_as_float(khi & 0xffff0000u);
                    sq += (a * a + b * b) + (c * c + d * d); sk += (ka * ka + kb * kb) + (kc * kc + kd * kd); sd += (a * ka + b * kb) + (c * kc + d * kd); }
                sq += __shfl_xor(sq, 1); sq += __shfl_xor(sq, 2); sk += __shfl_xor(sk, 1); sk += __shfl_xor(sk, 2); sd += __shfl_xor(sd, 1); sd += __shfl_xor(sd, 2);
                mq = fmaxf(mq, sq); mk = fmaxf(mk, sk); md = fmaxf(md, -sd);
            }
#pragma unroll
            for (int o = 1; o < 64; o <<= 1) { mq = fmaxf(mq, __shfl_xor(mq, o)); mk = fmaxf(mk, __shfl_xor(mk, o)); md = fmaxf(md, __shfl_xor(md, o)); }
            if ((tl & 63) == 0) { atomicMax((unsigned*)ws + CW_QMAX, __float_as_uint(sqrtf(mq) * 1.0001f)); atomicMax((unsigned*)ws + CW_KMAX, __float_as_uint(sqrtf(mk) * 1.0001f));
                                  atomicMax((unsigned*)ws + CW_DNEG, __float_as_uint(md * 1.0001f + 1e-3f)); }
        }
        for (long it = (long)bx * 512 + tl; it < (long)M * 40; it += nth) {
            const long item = it >> 2;
            const int m = (int)(item / 10), hh = (int)(item % 10);
            const int t = m < MP ? (m & (SEQ_P - 1)) : ((m - MP) & (SEQ_S - 1));
            bf16* p = Z + (size_t)m * ZP + 1536 + hh * 64 + j4;
            const float* gg = (hh < 8 ? g_qn : g_kn) + j4;
            float v[4][4]; float ss = 0.f;
#pragma unroll
            for (int q = 0; q < 4; ++q) { const unsigned long long w = *(const unsigned long long*)(p + 16 * q); const unsigned lo = (unsigned)w, hi = (unsigned)(w >> 32);
                v[q][0] = __uint_as_float(lo << 16); v[q][1] = __uint_as_float(lo & 0xffff0000u); v[q][2] = __uint_as_float(hi << 16); v[q][3] = __uint_as_float(hi & 0xffff0000u);
                ss += (v[q][0] * v[q][0] + v[q][1] * v[q][1]) + (v[q][2] * v[q][2] + v[q][3] * v[q][3]); }
            ss += __shfl_xor(ss, 1); ss += __shfl_xor(ss, 2);
            const float rstd = 1.0f / sqrtf(ss * (1.0f / 64.0f) + 1e-6f);
#pragma unroll
            for (int q = 0; q < 4; ++q) { const f32x4 g4 = *(const f32x4*)(gg + 16 * q);
#pragma unroll
                for (int e = 0; e < 4; ++e) v[q][e] = v[q][e] * rstd * g4[e]; }
            const float fr = (float)(t >> 6), fc = (float)(t & 63), osc = hh < 8 ? C2 : 1.f;
#pragma unroll
            for (int e = 0; e < 4; ++e) {
                const float invf = __builtin_amdgcn_exp2f(-(float)(j4 + e) * (13.287712379549449f / 16.0f));
                const float ar = fr * invf, ac = fc * invf;
                const float cr = __cosf(ar), sr = __sinf(ar), cc = __cosf(ac), sc = __sinf(ac);
                const float a1 = v[0][e], a2 = v[1][e]; v[0][e] = (a1 * cr - a2 * sr) * osc; v[1][e] = (a1 * sr + a2 * cr) * osc;
                const float b1 = v[2][e], b2 = v[3][e]; v[2][e] = (b1 * cc - b2 * sc) * osc; v[3][e] = (b1 * sc + b2 * cc) * osc;
            }
#pragma unroll
            for (int q = 0; q < 4; ++q) *(unsigned long long*)(p + 16 * q) = (unsigned long long)pk2(v[q][0], v[q][1]) | ((unsigned long long)pk2(v[q][2], v[q][3]) << 32);
        }
    }
#endif
    xcd_barrier(bar);

#ifndef NO_P2
    {
        const float qkb = __uint_as_float(((const unsigned*)ws)[CW_QMAX]) * __uint_as_float(((const unsigned*)ws)[CW_KMAX]) + __uint_as_float(((const unsigned*)ws)[CW_DNEG]) + SKIP_T;
        PHASE_IDS();
        volatile LAS int* qslot = (volatile LAS int*)(ldsl + 139280);
        float gq_ = fabsf(g_qn[lane]), gk_ = fabsf(g_kn[lane]);
#pragma unroll
        for (int o = 1; o < 64; o <<= 1) { gq_ = fmaxf(gq_, __shfl_xor(gq_, o)); gk_ = fmaxf(gk_, __shfl_xor(gk_, o)); }
        const float bbound = 64.0f * C2 * 1.03f * gq_ * gk_;
        const bool bmaxfree = __builtin_amdgcn_readfirstlane((int)(bbound < 40.0f)) != 0;
        const int x0 = (int)(bar.x & 7u);
        for (int dx = 0; dx < 8; ++dx) {
            const int x = (x0 + dx) & 7;
            for (;;) {
                if (tid == 0) *qslot = (int)__hip_atomic_fetch_add((unsigned*)ws + CW_QUEUE + 64 * x, 1u, __ATOMIC_RELAXED, __HIP_MEMORY_SCOPE_AGENT);
                __syncthreads();
                const int i = *qslot;
                __syncthreads();
                if (i >= 384) break;
                int kind, h = 0, c = 0, head = 0, qb;
                if (i < 32) { kind = 0; h = 3; qb = i; }
                else if (i < 64) { kind = 0; h = 2; qb = i - 32; }
                else if (i < 192) { kind = 1; head = (x & 1) * 4 + ((i - 64) >> 5); qb = (i - 64) & 31; }
                else if (i < 224) { kind = 0; h = 1; qb = i - 192; }
                else if (i < 256) { kind = 2; h = 3 - ((i - 224) >> 4); c = ((i - 224) & 15) >> 3; qb = (i - 224) & 7; }
                else if (i < 320) { kind = 3; head = (i - 256) >> 3; qb = (i - 256) & 7; }
                else if (i < 336) { kind = 2; h = 1; c = (i - 320) >> 3; qb = (i - 320) & 7; }
                else if (i < 368) { kind = 0; h = 0; qb = i - 336; }
                else { kind = 2; h = 0; c = (i - 368) >> 3; qb = (i - 368) & 7; }
                const bool prompt = kind < 2;
                const int b = prompt ? (x >> 1) : x; if (kind == 0) c = x & 1;
                const int S = prompt ? SEQ_P : SEQ_S; const long rowbase = prompt ? (long)b * SEQ_P : (long)MP + (long)b * SEQ_S;
                const int q0 = qb * 256, NT = S / 64;
                const bf16* Zb = Z + rowbase * ZP;
                if (!(kind & 1)) {
                    const float slope = (h == 0 ? 0.25f : h == 1 ? 0.0625f : h == 2 ? 0.015625f : 0.00390625f), sl2 = LOG2E * slope;
                    const float W = qkb / sl2;
                    int t_lo = (int)floorf(fmaxf((float)q0 - W, 0.f) * (1.0f / 64.0f));
                    int t_hi = (int)fminf(floorf(((float)(q0 + 255) + W) * (1.0f / 64.0f)) + 1.0f, (float)NT);
                    if ((t_hi - t_lo) & 1) { if (t_lo > 0) --t_lo; else ++t_hi; }
                    const int hd = h * 2 + c;
                    att::attn_unit_pp<128, true, bf16>(Zb + (long)q0 * ZP + h * 128 + c * 64, Zb + (long)t_lo * 64 * ZP + 512 + h * 128 + c * 64, Zb + (long)t_lo * 64 * ZP + 1024 + h * 128,
                                                     (bf16*)out + (rowbase + q0) * 1024 + hd * 128, t_hi - t_lo, q0 - t_lo * 64, sl2, ldsl);
                } else {
                    if (bmaxfree)
                        attn_body::attn_unit<1000>((const attn_body::bf16*)(Zb + (long)q0 * ZP + 1536 + head * 64), (const attn_body::bf16*)(Zb + 2048 + (head >> 2) * 64), (const attn_body::bf16*)(Zb + 2176 + (head >> 2) * 64),
                                                   (attn_body::bf16*)(MIX + (rowbase + q0) * 1024 + 512 + head * 64), NT, (char*)lds, bbound);
                    else
                        attn_body::attn_unit<8>((const attn_body::bf16*)(Zb + (long)q0 * ZP + 1536 + head * 64), (const attn_body::bf16*)(Zb + 2048 + (head >> 2) * 64), (const attn_body::bf16*)(Zb + 2176 + (head >> 2) * 64),
                                                (attn_body::bf16*)(MIX + (rowbase + q0) * 1024 + 512 + head * 64), NT, (char*)lds);
                }
            }
        }
    }
#endif
    xcd_barrier(bar);

#ifndef NO_P2B
#ifdef PROBE_EW2
    for (int rep = 0; rep < 2; ++rep)
#endif
    {
        PHASE_IDS();
        const float d1 = wave_sum(lq1[lane] * lk1[lane]), d2 = wave_sum(lq2[lane] * lk2[lane]);
        const float lam = expf(d1) - expf(d2) + 0.2f;
        const int h = lane >> 4, e0 = (lane & 15) * 8;
        const f32x4 g0 = *(const f32x4*)(g_subln + e0), g1 = *(const f32x4*)(g_subln + e0 + 4);
        for (int m0 = gw * 4; m0 < M; m0 += NGW * 4) {
            v4u wa[4], wb[4];
#pragma unroll
            for (int r = 0; r < 4; ++r) { const bf16* o0 = (const bf16*)out + (size_t)(m0 + r) * 1024 + (h * 2) * 128 + e0; wa[r] = *(const v4u*)o0; wb[r] = *(const v4u*)(o0 + 128); }
#pragma unroll
            for (int r = 0; r < 4; ++r) {
                f32x4 a0, a1, b0, b1;
                a0.x = __uint_as_float(wa[r].x << 16); a0.y = __uint_as_float(wa[r].x & 0xffff0000u); a0.z = __uint_as_float(wa[r].y << 16); a0.w = __uint_as_float(wa[r].y & 0xffff0000u);
                a1.x = __uint_as_float(wa[r].z << 16); a1.y = __uint_as_float(wa[r].z & 0xffff0000u); a1.z = __uint_as_float(wa[r].w << 16); a1.w = __uint_as_float(wa[r].w & 0xffff0000u);
                b0.x = __uint_as_float(wb[r].x << 16); b0.y = __uint_as_float(wb[r].x & 0xffff0000u); b0.z = __uint_as_float(wb[r].y << 16); b0.w = __uint_as_float(wb[r].y & 0xffff0000u);
                b1.x = __uint_as_float(wb[r].z << 16); b1.y = __uint_as_float(wb[r].z & 0xffff0000u); b1.z = __uint_as_float(wb[r].w << 16); b1.w = __uint_as_float(wb[r].w & 0xffff0000u);
                a0 = a0 - lam * b0; a1 = a1 - lam * b1;
                float s2 = ((a0.x * a0.x + a0.y * a0.y) + (a0.z * a0.z + a0.w * a0.w)) + ((a1.x * a1.x + a1.y * a1.y) + (a1.z * a1.z + a1.w * a1.w));
                s2 += __shfl_xor(s2, 1); s2 += __shfl_xor(s2, 2); s2 += __shfl_xor(s2, 4); s2 += __shfl_xor(s2, 8);
                const float rstd = 0.8f / sqrtf(s2 * (1.0f / 128.0f) + 1e-5f);
                a0 = a0 * rstd * g0; a1 = a1 * rstd * g1;
                v4u w; w.x = pk2(a0.x, a0.y); w.y = pk2(a0.z, a0.w); w.z = pk2(a1.x, a1.y); w.w = pk2(a1.z, a1.w);
                *(v4u*)(MIX + (size_t)(m0 + r) * 1024 + h * 128 + e0) = w; }
        }
    }
#endif
    xcd_barrier(bar);

#ifndef NO_P3
#ifdef PROBE_GEMM2
    for (int rep = 0; rep < 2; ++rep)
#endif
    {
        pg8::Gemm g{MIX, WoutT, M, D, D}; pg8::StaticOrder S; S.init(M, D, G, bx);
        pg8::EpiRes<false> E{x_p, x_s, MP, HB, RSP1, 0};
        pg8::gemm_phase<pg8::EpiRes<false>, pg8::StaticOrder, true, true>(ldsl, g, S, E);
    }
#endif
    xcd_barrier(bar);

#ifndef NO_P45
    for (int ch = 0; ch < 3; ++ch) {
        const int r0 = ch * 16384;
#ifndef NO_FF1
#ifdef PROBE_GEMM2
        for (int rep = 0; rep < 2; ++rep)
#endif
        {
            pg8::Gemm g{HB + (size_t)r0 * D, W1T, 16384, FF, D}; pg8::StaticOrder S; S.init(16384, FF, G, bx);
            pg8::EpiFF1 E{RSP1, HH, r0};
            pg8::gemm_phase<pg8::EpiFF1, pg8::StaticOrder, true, true>(ldsl, g, S, E);
        }
#endif
        xcd_barrier(bar);
#ifndef NO_FF2
        {
            pg8::Gemm g{HH, W2T, 16384, D, FF}; pg8::StaticOrder S; S.init(16384, D, G, bx);
            pg8::EpiRes<true> E{nullptr, nullptr, 0, HB, RSP2, r0};
            pg8::gemm_phase<pg8::EpiRes<true>, pg8::StaticOrder, true, true>(ldsl, g, S, E);
        }
#endif
        xcd_barrier(bar);
    }

#endif
#ifndef NO_P6
    {
        pg8::Gemm g{HB, WgT, M, D, D}; pg8::StaticOrder S; S.init(M, D, G, bx);
        pg8::EpiGate E{RSP2, PROJ, HB, XN, RSP3};
        pg8::gemm_phase<pg8::EpiGate, pg8::StaticOrder, true, true>(ldsl, g, S, E);
    }
#endif
    xcd_barrier(bar);

#ifndef NO_P7
    {
        PHASE_IDS();
        f32x4 gv[4];
#pragma unroll
        for (int j = 0; j < 4; ++j) gv[j] = *((const f32x4*)g_final + lane + 64 * j);
        for (int m0 = gw * 4; m0 < M; m0 += NGW * 4) {
            unsigned long long w[4][4]; float rstd[4];
#pragma unroll
            for (int r = 0; r < 4; ++r) { const unsigned long long* hr = (const unsigned long long*)(XN + (size_t)(m0 + r) * D) + lane;
#pragma unroll
                for (int j = 0; j < 4; ++j) w[r][j] = hr[64 * j];
                rstd[r] = 1.0f / sqrtf(pg8::rs16(RSP3 + (size_t)(m0 + r) * 16) * (1.0f / D) + 1e-6f); }
#pragma unroll
            for (int r = 0; r < 4; ++r) { f32x4* xr = (f32x4*)(out + (size_t)(m0 + r) * D) + lane;
#pragma unroll
                for (int j = 0; j < 4; ++j) { const unsigned lo = (unsigned)w[r][j], hi2 = (unsigned)(w[r][j] >> 32);
                    f32x4 hv; hv.x = __uint_as_float(lo << 16); hv.y = __uint_as_float(lo & 0xffff0000u); hv.z = __uint_as_float(hi2 << 16); hv.w = __uint_as_float(hi2 & 0xffff0000u);
                    xr[64 * j] = hv * rstd[r] * gv[j]; } }
        }
    }
#endif
}

extern "C" void kernel_launch(void* const* d_in, const int* in_sizes, int n_in, void* d_out, int out_size, void* d_ws, size_t ws_size, hipStream_t stream) {
    static int grid = 0;
    if (grid == 0) {
        if (n_in != 21 || out_size != M * D || ws_size < WS_END) { fprintf(stderr, "kernel_launch: unexpected shapes (n_in %d out %d ws %zu)\n", n_in, out_size, ws_size); grid = -1; return; }
        int dev = 0, cus = 0, per_cu = 0;
        hipGetDevice(&dev); hipDeviceGetAttribute(&cus, hipDeviceAttributeMultiprocessorCount, dev);
        if (hipFuncSetAttribute((const void*)fwd_mega, hipFuncAttributeMaxDynamicSharedMemorySize, LDS_BYTES) != hipSuccess) { fprintf(stderr, "kernel_launch: hipFuncSetAttribute failed\n"); grid = -1; return; }
        if (hipOccupancyMaxActiveBlocksPerMultiprocessor(&per_cu, (const void*)fwd_mega, NWAVES * 64, LDS_BYTES) != hipSuccess || per_cu < 1) { fprintf(stderr, "kernel_launch: occupancy query gave %d\n", per_cu); per_cu = 1; }
        (void)hipGetLastError();
        grid = cus * per_cu;
    }
    if (grid < 0) return;
    if (hipMemsetAsync(d_ws, 0, CTL_BYTES, stream) != hipSuccess) { fprintf(stderr, "kernel_launch: memset failed\n"); return; }
    Args a{};
    for (int i = 0; i < 21; ++i) a.in[i] = (const float*)d_in[i];
    a.out = (float*)d_out; a.ws = (unsigned char*)d_ws;
    void* kargs[] = {&a};
    hipError_t e = hipLaunchCooperativeKernel((const void*)fwd_mega, dim3(grid), dim3(NWAVES * 64), kargs, LDS_BYTES, stream);
    if (e != hipSuccess) fprintf(stderr, "cooperative launch failed: %s (grid %d)\n", hipGetErrorString(e), grid);
}
```

```cpp
#include <hip/hip_runtime.h>
#include <hip/hip_bf16.h>
#include <hip/hip_cooperative_groups.h>
#include <cstdio>
#include <cstdint>
namespace cg = cooperative_groups;

namespace pg8 {
#define PG8_LAS __attribute__((address_space(3)))
typedef unsigned short bf16_t;
typedef short bf16x8 __attribute__((ext_vector_type(8)));
typedef float f32x4 __attribute__((ext_vector_type(4)));
typedef unsigned u32x4 __attribute__((ext_vector_type(4)));
constexpr int BM = 256, BK = 64, HALF = 128, HTB = HALF * BK * 2  , STAGE_BYTES = 8 * HTB, NXCD = 8, WGM = 8;

__host__ __device__ __forceinline__ int lds_byte(int r, int c) { const int st = (r >> 4) * 2 + (c >> 5), rr = r & 15, cc = c & 31, ob = rr * 64 + cc * 2; return st * 1024 + (ob ^ (((ob >> 9) & 1) << 5)); }
__host__ __device__ __forceinline__ void stage_rc(int b, int& R, int& C) { const int st = b / 1024, sb = b % 1024, swz = sb ^ (((sb >> 9) & 1) << 5); R = (st >> 1) * 16 + swz / 64; C = (st & 1) * 32 + (swz % 64) / 2; }
__host__ __device__ __forceinline__ int perm32(int rho) { const int n = rho >> 4, i = rho & 15; return 8 * (i >> 2) + 4 * n + (i & 3); }

struct Unit { int pm, pn; };
struct Gemm { const bf16_t* A; const bf16_t* Bt; int M, N, K; };

struct StaticOrder {
    int nM, nN, nwg, G, c;
    __host__ __device__ void init(int M, int N, int G_, int c_) { nM = M / BM; nN = N / BM; nwg = nM * nN; G = G_; c = c_; }
    __host__ __device__ bool next(int i, Unit& u) const {
        const long L = (long)i * G + c; if (L >= nwg) return false;
        int wgid = (int)L; { const int q = nwg / NXCD, r = nwg % NXCD, xcd = wgid % NXCD, off = wgid / NXCD; wgid = (xcd < r ? xcd * (q + 1) : r * (q + 1) + (xcd - r) * q) + off; }
        const int nig = WGM * nN, gid = wgid / nig, fm = gid * WGM, gsz = (nM - fm) < WGM ? (nM - fm) : WGM;
        u.pm = fm + ((wgid % nig) % gsz); u.pn = (wgid % nig) / gsz; return true;
    }
    __device__ __forceinline__ void a_ready(const Unit&) const {}
    __device__ __forceinline__ void done(const Unit&) const {}
};

__device__ __forceinline__ unsigned cvt_pk_bf16(float lo, float hi) { unsigned r; asm volatile("v_cvt_pk_bf16_f32 %0, %1, %2" : "=v"(r) : "v"(lo), "v"(hi)); return r; }
typedef float f32x2 __attribute__((ext_vector_type(2)));
typedef unsigned u32x2 __attribute__((ext_vector_type(2)));
__device__ __forceinline__ float rs16(const float* p) {
    const f32x4 a = *(const f32x4*)p, b = *(const f32x4*)(p + 4), c = *(const f32x4*)(p + 8), d = *(const f32x4*)(p + 12);
    return (((a[0] + a[1]) + (a[2] + a[3])) + ((b[0] + b[1]) + (b[2] + b[3]))) + (((c[0] + c[1]) + (c[2] + c[3])) + ((d[0] + d[1]) + (d[2] + d[3])));
}
struct EpiBf {
    static constexpr bool PERM = true, AFTER_DRAIN = false;
    bf16_t* O; int ldc; float scale_q; int nq_tiles;
    __device__ __forceinline__ void operator()(const f32x4 (&acc)[2][2][4][2], const Unit& u, int wr, int wc, int fr, int fq) const {
        const int row0 = u.pm * BM + wr * 64 + fr, col0 = u.pn * BM + wc * 32 + 8 * fq; const float sc = (u.pn < nq_tiles) ? scale_q : 1.f;
#pragma unroll
        for (int ai = 0; ai < 2; ++ai)
#pragma unroll
            for (int m = 0; m < 4; ++m) { bf16_t* rowp = O + (size_t)(row0 + ai * HALF + m * 16) * ldc + col0;
#pragma unroll
                for (int bj = 0; bj < 2; ++bj) { const f32x4 v0 = acc[ai][bj][m][0] * sc, v1 = acc[ai][bj][m][1] * sc;
                    u32x4 w; w.x = cvt_pk_bf16(v0[0], v0[1]); w.y = cvt_pk_bf16(v0[2], v0[3]); w.z = cvt_pk_bf16(v1[0], v1[1]); w.w = cvt_pk_bf16(v1[2], v1[3]);
                    *(u32x4*)(rowp + bj * HALF) = w; } }
    }
};
template <bool BASE_BF16> struct EpiRes {
    static constexpr bool PERM = false, AFTER_DRAIN = false;
    const float* base0; const float* base1; int split_row; bf16_t* hb; float* rsp; int row_off;
    __device__ __forceinline__ void operator()(const f32x4 (&acc)[2][2][4][2], const Unit& u, int wr, int wc, int fr, int fq) const {
        const int col0 = u.pn * BM + wc * 32 + 4 * fq;
#pragma unroll
        for (int ai = 0; ai < 2; ++ai)
#pragma unroll
            for (int m = 0; m < 4; ++m) { const int row = row_off + u.pm * BM + ai * HALF + wr * 64 + m * 16 + fr;
                const float* bp = row < split_row ? base0 + (size_t)row * 1024 : base1 + (size_t)(row - split_row) * 1024;
                bf16_t* hp = hb + (size_t)row * 1024; float s = 0.f;
#pragma unroll
                for (int bj = 0; bj < 2; ++bj)
#pragma unroll
                    for (int n = 0; n < 2; ++n) { const int c = col0 + bj * HALF + n * 16; f32x4 b;
                        if constexpr (BASE_BF16) { const u32x2 pw = *(const u32x2*)(hp + c);
                            b[0] = __uint_as_float(pw.x << 16); b[1] = __uint_as_float(pw.x & 0xffff0000u); b[2] = __uint_as_float(pw.y << 16); b[3] = __uint_as_float(pw.y & 0xffff0000u); }
                        else b = *(const f32x4*)(bp + c);
                        const f32x4 v = b + acc[ai][bj][m][n];
                        s += (v[0] * v[0] + v[1] * v[1]) + (v[2] * v[2] + v[3] * v[3]);
                        u32x2 w; w.x = cvt_pk_bf16(v[0], v[1]); w.y = cvt_pk_bf16(v[2], v[3]); *(u32x2*)(hp + c) = w; }
                s += __shfl_xor(s, 16); s += __shfl_xor(s, 32);
                if (fq == 0) rsp[(size_t)row * 16 + u.pn * 4 + wc] = s; }
    }
};
struct EpiFF1 {
    static constexpr bool PERM = true, AFTER_DRAIN = false;
    const float* rsp; bf16_t* H; int row_off;
    __device__ __forceinline__ void operator()(const f32x4 (&acc)[2][2][4][2], const Unit& u, int wr, int wc, int fr, int fq) const {
        const int col0 = u.pn * BM + wc * 32 + 8 * fq;
#pragma unroll
        for (int ai = 0; ai < 2; ++ai)
#pragma unroll
            for (int m = 0; m < 4; ++m) { const int lrow = u.pm * BM + ai * HALF + wr * 64 + m * 16 + fr;
                const float rstd = 1.0f / sqrtf(rs16(rsp + (size_t)(row_off + lrow) * 16) * (1.0f / 1024.0f) + 1e-6f);
                bf16_t* rowp = H + (size_t)lrow * 4096 + col0;
#pragma unroll
                for (int bj = 0; bj < 2; ++bj) { f32x4 v0 = acc[ai][bj][m][0] * rstd, v1 = acc[ai][bj][m][1] * rstd;
#pragma unroll
                    for (int e = 0; e < 4; ++e) { const float a = fmaxf(v0[e], 0.f), b = fmaxf(v1[e], 0.f); v0[e] = a * a; v1[e] = b * b; }
                    u32x4 w; w.x = cvt_pk_bf16(v0[0], v0[1]); w.y = cvt_pk_bf16(v0[2], v0[3]); w.z = cvt_pk_bf16(v1[0], v1[1]); w.w = cvt_pk_bf16(v1[2], v1[3]);
                    *(u32x4*)(rowp + bj * HALF) = w; }
                asm volatile("" ::: "memory"); }
    }
};
struct EpiGate {
    static constexpr bool PERM = false, AFTER_DRAIN = false;
    const float* rsp_in; const bf16_t* proj; const bf16_t* hb_in; bf16_t* hb_out; float* rsp_out;
    __device__ __forceinline__ void operator()(const f32x4 (&acc)[2][2][4][2], const Unit& u, int wr, int wc, int fr, int fq) const {
        const int col0 = u.pn * BM + wc * 32 + 4 * fq;
#pragma unroll
        for (int ai = 0; ai < 2; ++ai)
#pragma unroll
            for (int m = 0; m < 4; ++m) { const int row = u.pm * BM + ai * HALF + wr * 64 + m * 16 + fr;
                const float rstd = 1.0f / sqrtf(rs16(rsp_in + (size_t)row * 16) * (1.0f / 1024.0f) + 1e-6f);
                const bf16_t* ip = hb_in + (size_t)row * 1024; bf16_t* op = hb_out + (size_t)row * 1024; const bf16_t* pp = proj + (size_t)row * 1024; float s = 0.f;
#pragma unroll
                for (int bj = 0; bj < 2; ++bj)
#pragma unroll
                    for (int n = 0; n < 2; ++n) { const int c = col0 + bj * HALF + n * 16; const f32x4 a = acc[ai][bj][m][n] * rstd;
                        const u32x2 pw = *(const u32x2*)(pp + c), hw = *(const u32x2*)(ip + c);
                        f32x4 pr, h2; pr[0] = __uint_as_float(pw.x << 16); pr[1] = __uint_as_float(pw.x & 0xffff0000u); pr[2] = __uint_as_float(pw.y << 16); pr[3] = __uint_as_float(pw.y & 0xffff0000u);
                        h2[0] = __uint_as_float(hw.x << 16); h2[1] = __uint_as_float(hw.x & 0xffff0000u); h2[2] = __uint_as_float(hw.y << 16); h2[3] = __uint_as_float(hw.y & 0xffff0000u);
                        f32x4 g;
#pragma unroll
                        for (int e2 = 0; e2 < 4; ++e2) g[e2] = __builtin_amdgcn_rcpf(1.0f + __builtin_amdgcn_exp2f(-1.4426950408889634f * a[e2]));
                        const f32x4 v = h2 + g * pr;
                        s += (v[0] * v[0] + v[1] * v[1]) + (v[2] * v[2] + v[3] * v[3]);
                        u32x2 w; w.x = cvt_pk_bf16(v[0], v[1]); w.y = cvt_pk_bf16(v[2], v[3]); *(u32x2*)(op + c) = w; }
                s += __shfl_xor(s, 16); s += __shfl_xor(s, 32);
                if (fq == 0) rsp_out[(size_t)row * 16 + u.pn * 4 + wc] = s;
                asm volatile("" ::: "memory"); }
    }
};
template <class Epi, class Sched, bool ALIGN_EPI = false, bool SP2 = false>
__device__ __forceinline__ void gemm_phase(PG8_LAS unsigned char* lds, const Gemm g, const Sched& S, const Epi& E) {
    int tid_ = threadIdx.x; asm volatile("" : "+v"(tid_));
    const int tid = tid_, wid = __builtin_amdgcn_readfirstlane(tid >> 6), lane = tid & 63, wr = wid >> 2, wc = wid & 3, fr = lane & 15, fq = lane >> 4;
    const int K = g.K, nt = K / BK;
    unsigned voffA[2], voffB[2];
#pragma unroll
    for (int i = 0; i < 2; ++i) { int R, C; stage_rc(tid * 16 + i * 8192, R, C); const int Rb = Epi::PERM ? ((R & ~31) + perm32(R & 31)) : R;
        voffA[i] = (unsigned)(R * K + C) * 2u; voffB[i] = (unsigned)(Rb * K + C) * 2u; }
    const size_t kstep = (size_t)(BK * 2);
    const size_t hstep = (size_t)HALF * K * 2;
    const size_t tstep = 2 * hstep;
    const unsigned ldsw = (unsigned)wid * 1024u;
    const int aoff = lds_byte(wr * 64 + fr, fq * 8), boff = lds_byte(wc * 32 + fr, fq * 8);
#define PG8_SA(b, h) (((b) * 2 + (h)) * HTB)
#define PG8_SB(b, h) ((4 + (b) * 2 + (h)) * HTB)
#define PG8_STAGE(bufoff, gbase, voff) do { _Pragma("unroll") for (int _i = 0; _i < 2; ++_i) \
        __builtin_amdgcn_global_load_lds((const unsigned*)((const char*)(gbase) + (voff)[_i]), (PG8_LAS unsigned*)(lds + (bufoff) + ldsw + _i * 8192), 16, 0, 0); } while (0)
#define PG8_LDA(dst, b, h) do { _Pragma("unroll") for (int m = 0; m < 4; ++m) _Pragma("unroll") for (int k = 0; k < 2; ++k) dst[m][k] = *(const PG8_LAS bf16x8*)(lds + PG8_SA(b, h) + aoff + m * 2048 + k * 1024); } while (0)
#define PG8_LDB(dst, b, h) do { _Pragma("unroll") for (int n = 0; n < 2; ++n) _Pragma("unroll") for (int k = 0; k < 2; ++k) dst[n][k] = *(const PG8_LAS bf16x8*)(lds + PG8_SB(b, h) + boff + n * 2048 + k * 1024); } while (0)
#define PG8_MMA(ai, bj, At, Bt) do { __builtin_amdgcn_s_setprio(1); _Pragma("unroll") for (int m = 0; m < 4; ++m) _Pragma("unroll") for (int n = 0; n < 2; ++n) _Pragma("unroll") for (int k = 0; k < 2; ++k) \
        acc[ai][bj][m][n] = __builtin_amdgcn_mfma_f32_16x16x32_bf16(Bt[n][k], At[m][k], acc[ai][bj][m][n], 0, 0, 0); __builtin_amdgcn_s_setprio(0); } while (0)
#define PG8_WAIT_V(n) asm volatile("s_waitcnt vmcnt(" #n ")" ::: "memory")
#define PG8_WAIT_L(n) asm volatile("s_waitcnt lgkmcnt(" #n ")" ::: "memory")
#define PG8_BAR __builtin_amdgcn_s_barrier()
#define PG8_SCHED __builtin_amdgcn_sched_barrier(0)
    Unit cur, nxt; int ui = 0;
    if (!S.next(0, cur)) return;
    f32x4 acc[2][2][4][2];
#pragma unroll
    for (int a = 0; a < 2; ++a)
#pragma unroll
        for (int b = 0; b < 2; ++b)
#pragma unroll
            for (int m = 0; m < 4; ++m)
#pragma unroll
                for (int n = 0; n < 2; ++n) acc[a][b][m][n] = (f32x4){0.f, 0.f, 0.f, 0.f};
    bf16x8 At[4][2], B0[2][2], B1[2][2];
    const char* cA = (const char*)g.A + (size_t)cur.pm * tstep; const char* cB = (const char*)g.Bt + (size_t)cur.pn * tstep;
    S.a_ready(cur);
    if constexpr (SP2) {
        PG8_STAGE(PG8_SB(0, 0), cB, voffB); PG8_STAGE(PG8_SB(0, 1), cB + hstep, voffB); PG8_STAGE(PG8_SA(0, 0), cA, voffA); PG8_STAGE(PG8_SA(0, 1), cA + hstep, voffA);
        if (wr == 1) PG8_BAR;
        PG8_WAIT_V(2); PG8_BAR;
        PG8_STAGE(PG8_SB(1, 0), cB + kstep, voffB); PG8_STAGE(PG8_SA(1, 0), cA + kstep, voffA); PG8_STAGE(PG8_SB(1, 1), cB + hstep + kstep, voffB);
        PG8_WAIT_V(6); PG8_BAR;
    } else {
        PG8_STAGE(PG8_SB(0, 0), cB, voffB); PG8_STAGE(PG8_SA(0, 0), cA, voffA); PG8_STAGE(PG8_SB(0, 1), cB + hstep, voffB); PG8_STAGE(PG8_SA(0, 1), cA + hstep, voffA);
        if (wr == 1) PG8_BAR;
        PG8_WAIT_V(4); PG8_BAR;
        PG8_STAGE(PG8_SB(1, 0), cB + kstep, voffB); PG8_STAGE(PG8_SA(1, 0), cA + kstep, voffA); PG8_STAGE(PG8_SB(1, 1), cB + hstep + kstep, voffB);
        PG8_WAIT_V(6); PG8_BAR;
    }
    for (;;) {
        const bool has_next = S.next(ui + 1, nxt);
        const char* nA = has_next ? (const char*)g.A + (size_t)nxt.pm * tstep : cA; const char* nB = has_next ? (const char*)g.Bt + (size_t)nxt.pn * tstep : cB;
        for (int t = 0; t < nt; t += 2) {
            const bool last = (t == nt - 2);
            const char* a1 = cA + (size_t)(t + 1) * kstep;
            const char* a2 = last ? nA : cA + (size_t)(t + 2) * kstep; const char* b2 = last ? nB : cB + (size_t)(t + 2) * kstep;
            const char* a3 = a2 + kstep; const char* b3 = b2 + kstep;
            if (last && has_next) S.a_ready(nxt);
            if constexpr (SP2) {
            PG8_LDB(B0, 0, 0); PG8_LDB(B1, 0, 1); PG8_SCHED; PG8_LDA(At, 0, 0); PG8_STAGE(PG8_SA(1, 1), a1 + hstep, voffA);
            PG8_WAIT_V(8); PG8_WAIT_L(0); PG8_BAR; PG8_MMA(0, 0, At, B0); PG8_MMA(0, 1, At, B1); PG8_BAR; PG8_SCHED;
            PG8_LDA(At, 0, 1); PG8_STAGE(PG8_SB(0, 0), b2, voffB); PG8_STAGE(PG8_SB(0, 1), b2 + hstep, voffB); PG8_STAGE(PG8_SA(0, 0), a2, voffA);
            PG8_WAIT_V(8); PG8_WAIT_L(0); PG8_BAR; PG8_MMA(1, 0, At, B0); PG8_MMA(1, 1, At, B1); PG8_BAR; PG8_SCHED;
            PG8_LDB(B0, 1, 0); PG8_LDB(B1, 1, 1); PG8_SCHED; PG8_LDA(At, 1, 0); PG8_STAGE(PG8_SA(0, 1), a2 + hstep, voffA);
            PG8_WAIT_V(8); PG8_WAIT_L(0); PG8_BAR; PG8_MMA(0, 0, At, B0); PG8_MMA(0, 1, At, B1); PG8_BAR; PG8_SCHED;
            PG8_LDA(At, 1, 1); PG8_STAGE(PG8_SB(1, 0), b3, voffB); PG8_STAGE(PG8_SB(1, 1), b3 + hstep, voffB); PG8_STAGE(PG8_SA(1, 0), a3, voffA);
            PG8_WAIT_V(8); PG8_WAIT_L(0); PG8_BAR; PG8_MMA(1, 0, At, B0); PG8_MMA(1, 1, At, B1); PG8_BAR; PG8_SCHED;
            } else {
            PG8_LDB(B0, 0, 0); PG8_SCHED; PG8_LDA(At, 0, 0); PG8_STAGE(PG8_SA(1, 1), a1 + hstep, voffA);
            PG8_WAIT_L(8); PG8_BAR; PG8_WAIT_L(0); PG8_MMA(0, 0, At, B0); PG8_BAR; PG8_SCHED;
            PG8_LDB(B1, 0, 1); PG8_STAGE(PG8_SB(0, 0), b2, voffB);
            PG8_BAR; PG8_WAIT_L(0); PG8_MMA(0, 1, At, B1); PG8_BAR;
            PG8_LDA(At, 0, 1); PG8_STAGE(PG8_SA(0, 0), a2, voffA);
            PG8_BAR; PG8_WAIT_L(0); PG8_MMA(1, 0, At, B0); PG8_BAR; PG8_SCHED;
            PG8_STAGE(PG8_SB(0, 1), b2 + hstep, voffB);
            PG8_WAIT_V(6); PG8_BAR; PG8_MMA(1, 1, At, B1); PG8_BAR;
            PG8_LDB(B0, 1, 0); PG8_SCHED; PG8_LDA(At, 1, 0); PG8_STAGE(PG8_SA(0, 1), a2 + hstep, voffA);
            PG8_WAIT_L(8); PG8_BAR; PG8_WAIT_L(0); PG8_MMA(0, 0, At, B0); PG8_BAR; PG8_SCHED;
            PG8_LDB(B1, 1, 1); PG8_STAGE(PG8_SB(1, 0), b3, voffB);
            PG8_BAR; PG8_WAIT_L(0); PG8_MMA(0, 1, At, B1); PG8_BAR;
            PG8_LDA(At, 1, 1); PG8_STAGE(PG8_SA(1, 0), a3, voffA);
            PG8_BAR; PG8_WAIT_L(0); PG8_MMA(1, 0, At, B0); PG8_BAR; PG8_SCHED;
            PG8_STAGE(PG8_SB(1, 1), b3 + hstep, voffB);
            PG8_WAIT_V(6); PG8_BAR; PG8_MMA(1, 1, At, B1); PG8_BAR;
            }
        }
        if constexpr (ALIGN_EPI) { if (wr == 0) PG8_BAR; }
        if constexpr (!Epi::AFTER_DRAIN) { E(acc, cur, wr, wc, fr, fq); S.done(cur); }
        if (!has_next) break;
#pragma unroll
        for (int a = 0; a < 2; ++a)
#pragma unroll
            for (int b = 0; b < 2; ++b)
#pragma unroll
                for (int m = 0; m < 4; ++m)
#pragma unroll
                    for (int n = 0; n < 2; ++n) acc[a][b][m][n] = (f32x4){0.f, 0.f, 0.f, 0.f};
        cur = nxt; cA = nA; cB = nB; ++ui;
        if constexpr (ALIGN_EPI) { if (wr == 1) PG8_BAR; }
    }
    PG8_WAIT_V(0);
    if constexpr (!ALIGN_EPI) { if (wr == 0) PG8_BAR; }
    PG8_BAR;
    if constexpr (Epi::AFTER_DRAIN) { E.fused(acc, cur, wr, wc, fr, fq, lds, wid, lane); S.done(cur); }
#undef PG8_SA
#undef PG8_SB
#undef PG8_STAGE
#undef PG8_LDA
#undef PG8_LDB
#undef PG8_MMA
#undef PG8_WAIT_V
#undef PG8_WAIT_L
#undef PG8_BAR
#undef PG8_SCHED
}
}
namespace att {
typedef unsigned short bf16_t;
using bf16x8 = __attribute__((ext_vector_type(8))) short;
using s16x4  = __attribute__((ext_vector_type(4))) short;
using f32x16 = __attribute__((ext_vector_type(16))) float;
using u32x4  = __attribute__((ext_vector_type(4))) unsigned;
constexpr int LDZ = 2368;
constexpr int SHM_V = 16384, SHM_K = 8192;
constexpr int ATTN_LDS = 2 * SHM_V + 2 * SHM_K + 8 * 64 * 4;
constexpr float THR2 = 8.0f;
#define KSWZ64(row, colB) ((row) * 128 + ((colB) ^ ((((row) >> 1) & 7) << 4)))
#define SBAR() __builtin_amdgcn_sched_barrier(0)
__device__ __forceinline__ int crow(int r, int hi) { return (r & 3) + 8 * (r >> 2) + 4 * hi; }
__device__ __forceinline__ unsigned cvtpk(float lo, float hi) { unsigned r; asm volatile("v_cvt_pk_bf16_f32 %0, %1, %2" : "=v"(r) : "v"(lo), "v"(hi)); return r; }
__device__ __forceinline__ unsigned short f2bf(float f) { unsigned u = __builtin_bit_cast(unsigned, f); return (unsigned short)((u + 0x7fffu + ((u >> 16) & 1u)) >> 16); }

template <bool ALIBI>
__device__ __forceinline__ void partialSM(f32x16& p0, f32x16& p1, float& m_reg, float& alpha, float dq, float sl2) {
  if constexpr (ALIBI) {
#pragma unroll
    for (int r = 0; r < 16; ++r) { const float t0 = dq - (float)((r & 3) + 8 * (r >> 2)); const float t1 = t0 - 32.f;
      p0[r] = fmaf(-sl2, fabsf(t0), p0[r]); p1[r] = fmaf(-sl2, fabsf(t1), p1[r]); }
  }
  float pmax = p0[0];
#pragma unroll
  for (int r = 1; r < 16; ++r) pmax = fmaxf(pmax, p0[r]);
#pragma unroll
  for (int r = 0; r < 16; ++r) pmax = fmaxf(pmax, p1[r]);
  { auto rr = __builtin_amdgcn_permlane32_swap(__float_as_uint(pmax), __float_as_uint(pmax), false, false);
    pmax = fmaxf(__uint_as_float(rr[0]), __uint_as_float(rr[1])); }
  float mn;
  if (__builtin_expect(__all(pmax - m_reg <= THR2), 1)) { mn = m_reg; alpha = 1.f; }
  else { mn = fmaxf(m_reg, pmax); alpha = __builtin_amdgcn_exp2f(m_reg - mn); m_reg = mn; }
#pragma unroll
  for (int r = 0; r < 16; ++r) { p0[r] -= mn; p1[r] -= mn; }
#pragma unroll
  for (int r = 0; r < 16; ++r) p0[r] = __builtin_amdgcn_exp2f(p0[r]);
}
__device__ __forceinline__ void finishSM(f32x16& p0, f32x16& p1, float alpha, float& l_reg, bf16x8& pa0, bf16x8& pa1, bf16x8& pa2, bf16x8& pa3) {
#pragma unroll
  for (int r = 0; r < 16; ++r) p1[r] = __builtin_amdgcn_exp2f(p1[r]);
  float ps = 0;
#pragma unroll
  for (int r = 0; r < 16; ++r) ps += p0[r];
#pragma unroll
  for (int r = 0; r < 16; ++r) ps += p1[r];
  { auto rr = __builtin_amdgcn_permlane32_swap(__float_as_uint(ps), __float_as_uint(ps), false, false);
    ps = __uint_as_float(rr[0]) + __uint_as_float(rr[1]); }
  l_reg = l_reg * alpha + ps;
#define PK4(P, BASE, OUT) do { unsigned a0 = cvtpk(P[BASE + 0], P[BASE + 1]), a1 = cvtpk(P[BASE + 2], P[BASE + 3]);   \
    unsigned b0 = cvtpk(P[BASE + 4], P[BASE + 5]), b1 = cvtpk(P[BASE + 6], P[BASE + 7]);                              \
    auto r0 = __builtin_amdgcn_permlane32_swap(a0, b0, false, false); auto r1 = __builtin_amdgcn_permlane32_swap(a1, b1, false, false); \
    u32x4 w = {r0[0], r1[0], r0[1], r1[1]}; OUT = *reinterpret_cast<bf16x8*>(&w); } while (0)
  PK4(p0, 0, pa0); PK4(p0, 8, pa1); PK4(p1, 0, pa2); PK4(p1, 8, pa3);
#undef PK4
}
__device__ __forceinline__ void qkt(f32x16& p0, f32x16& p1, const char* Ks, const bf16x8* qr, int r32, int hi) {
  p0 = f32x16{}; p1 = f32x16{};
#pragma unroll
  for (int d0 = 0; d0 < 4; ++d0) { const int cb = (d0 * 16 + hi * 8) * 2;
    const bf16x8 b0 = *reinterpret_cast<const bf16x8*>(Ks + KSWZ64(r32, cb));
    const bf16x8 b1 = *reinterpret_cast<const bf16x8*>(Ks + 4096 + KSWZ64(r32, cb));
    p0 = __builtin_amdgcn_mfma_f32_32x32x16_bf16(b0, qr[d0], p0, 0, 0, 0);
    p1 = __builtin_amdgcn_mfma_f32_32x32x16_bf16(b1, qr[d0], p1, 0, 0, 0); }
}
template <int NCB> __device__ __forceinline__ int v_st(int k, int c) { const int kk = (k & ~0xC) | ((k & 4) << 1) | ((k & 8) >> 1); return ((kk >> 3) * NCB + (c >> 5)) * 512 + ((kk & 7) * 32 + (c & 31)) * 2; }
__device__ __forceinline__ int v_rd_base(int lane) { return ((lane & 3) << 3) | (((lane >> 2) & 3) << 6) | (((lane >> 4) & 1) << 5) | (((lane >> 5) & 1) << 8); }
template <int OFF> __device__ __forceinline__ s16x4 tr_read(int vb) {
  s16x4 r; asm volatile("ds_read_b64_tr_b16 %0, %1 offset:%2" : "=&v"(r) : "v"(vb), "i"(OFF) : "memory"); return r;
}
template <int NCB, int D0> __device__ __forceinline__ void pv_one(f32x16& od, int vb, bf16x8 pa0, bf16x8 pa1, bf16x8 pa2, bf16x8 pa3) {
  constexpr int KS = NCB * 1024, HF = NCB * 512, B0 = D0 * 512;
  const s16x4 l0 = tr_read<B0>(vb), h0 = tr_read<B0 + HF>(vb), l1 = tr_read<B0 + KS>(vb), h1 = tr_read<B0 + KS + HF>(vb);
  const s16x4 l2 = tr_read<B0 + 2 * KS>(vb), h2 = tr_read<B0 + 2 * KS + HF>(vb), l3 = tr_read<B0 + 3 * KS>(vb), h3 = tr_read<B0 + 3 * KS + HF>(vb);
  asm volatile("s_waitcnt lgkmcnt(0)" ::: "memory"); SBAR();
#define PK(L, H) (bf16x8){L[0], L[1], L[2], L[3], H[0], H[1], H[2], H[3]}
  od = __builtin_amdgcn_mfma_f32_32x32x16_bf16(pa0, PK(l0, h0), od, 0, 0, 0);
  od = __builtin_amdgcn_mfma_f32_32x32x16_bf16(pa1, PK(l1, h1), od, 0, 0, 0);
  od = __builtin_amdgcn_mfma_f32_32x32x16_bf16(pa2, PK(l2, h2), od, 0, 0, 0);
  od = __builtin_amdgcn_mfma_f32_32x32x16_bf16(pa3, PK(l3, h3), od, 0, 0, 0);
#undef PK
}
template <int NCB> __device__ __forceinline__ void pv_all(f32x16* o, int vb, bf16x8 pa0, bf16x8 pa1, bf16x8 pa2, bf16x8 pa3) {
  pv_one<NCB, 0>(o[0], vb, pa0, pa1, pa2, pa3); pv_one<NCB, 1>(o[1], vb, pa0, pa1, pa2, pa3);
  if constexpr (NCB == 4) { pv_one<NCB, 2>(o[2], vb, pa0, pa1, pa2, pa3); pv_one<NCB, 3>(o[3], vb, pa0, pa1, pa2, pa3); }
}
__device__ __forceinline__ void store_o(float* p, float v) { *p = v; }
__device__ __forceinline__ void store_o(bf16_t* p, float v) { *p = f2bf(v); }

template <int DV, bool ALIBI, typename TO>
__device__ __forceinline__ void attn_unit(const bf16_t* __restrict__ Qb, const bf16_t* __restrict__ Kh, const bf16_t* __restrict__ Vh, TO* __restrict__ Ob, int seq, int qpos0, float sl2, char* lds) {
  constexpr int NCB = DV / 32;
  const int tid = threadIdx.x, wid = tid >> 6, lane = tid & 63, r32 = lane & 31, hi = lane >> 5;
  char* V_lds = lds; char* K_lds = lds + 2 * SHM_V;
  float* ws = (float*)(lds + 2 * SHM_V + 2 * SHM_K) + wid * 64; float* li_l = ws; float* al_l = ws + 32;
  float m_reg = -1e30f, l_reg = 0; f32x16 o[NCB];
#pragma unroll
  for (int d = 0; d < NCB; ++d) o[d] = f32x16{};
  bf16x8 qr[4];
  const bf16_t* Qw = Qb + (long)(wid * 32 + r32) * LDZ + hi * 8;
#pragma unroll
  for (int d0 = 0; d0 < 4; ++d0) qr[d0] = *reinterpret_cast<const bf16x8*>(Qw + d0 * 16);
  const float dq0 = (float)(qpos0 + wid * 32 + r32 - 4 * hi);
  const int kr = tid >> 3, kc = (tid & 7) * 8, kst = KSWZ64(kr, kc * 2);
  const int sr = tid >> 4, sc = (tid & 15) * 8;
  const int vst0 = (DV == 128) ? v_st<NCB>(sr, sc) : v_st<NCB>(kr, kc), vst1 = v_st<NCB>(32 + sr, sc);
  const int vb0 = (int)(uintptr_t)V_lds + v_rd_base(lane);
  bf16x8 sv0[2], sv1[2], sk[2];
#define SLOAD(i, k0) do { if constexpr (DV == 128) { sv0[i] = *reinterpret_cast<const bf16x8*>(&Vh[(long)((k0) + sr) * LDZ + sc]); sv1[i] = *reinterpret_cast<const bf16x8*>(&Vh[(long)((k0) + 32 + sr) * LDZ + sc]); } \
    else { sv0[i] = *reinterpret_cast<const bf16x8*>(&Vh[(long)((k0) + kr) * LDZ + kc]); } \
    sk[i] = *reinterpret_cast<const bf16x8*>(&Kh[(long)((k0) + kr) * LDZ + kc]); } while (0)
#define SWRITE(b, i) do { *(bf16x8*)(V_lds + (b) * SHM_V + vst0) = sv0[i]; if constexpr (DV == 128) { *(bf16x8*)(V_lds + (b) * SHM_V + vst1) = sv1[i]; } \
    *(bf16x8*)(K_lds + (b) * SHM_K + kst) = sk[i]; } while (0)
#define SWAIT() do { if constexpr (DV == 128) asm volatile("s_waitcnt vmcnt(3)" ::: "memory"); else asm volatile("s_waitcnt vmcnt(2)" ::: "memory"); } while (0)
#define RESC(a) do { if (__any((a) < 1.f)) { if (hi == 0) al_l[r32] = (a); asm volatile("s_waitcnt lgkmcnt(0)" ::: "memory"); \
    _Pragma("unroll") for (int d = 0; d < NCB; ++d) _Pragma("unroll") for (int r = 0; r < 16; ++r) o[d][r] *= al_l[crow(r, hi)]; } } while (0)
  f32x16 pA0, pA1, pB0, pB1; float alA, alB; bf16x8 pa0, pa1, pa2, pa3; const int NT = seq / 64;
  SLOAD(0, 0); asm volatile("s_waitcnt vmcnt(0)" ::: "memory"); SWRITE(0, 0); __syncthreads();
  qkt(pA0, pA1, K_lds, qr, r32, hi); partialSM<ALIBI>(pA0, pA1, m_reg, alA, dq0, sl2);
  SLOAD(1, 64); if (2 < NT) SLOAD(0, 128);
  SWAIT(); SWRITE(1, 1); __syncthreads();
  for (int j = 1; j + 1 < NT; j += 2) {
    SBAR(); qkt(pB0, pB1, K_lds + SHM_K, qr, r32, hi);
    finishSM(pA0, pA1, alA, l_reg, pa0, pa1, pa2, pa3); SBAR();
    SLOAD(1, (j + 2) * 64); SBAR();
    pv_all<NCB>(o, vb0, pa0, pa1, pa2, pa3); partialSM<ALIBI>(pB0, pB1, m_reg, alB, dq0 - 64.f * (float)j, sl2);
    __syncthreads(); SWAIT(); SWRITE(0, 0);
    RESC(alB); __syncthreads();
    SBAR(); qkt(pA0, pA1, K_lds, qr, r32, hi);
    finishSM(pB0, pB1, alB, l_reg, pa0, pa1, pa2, pa3); SBAR();
    if (j + 3 < NT) SLOAD(0, (j + 3) * 64); SBAR();
    pv_all<NCB>(o, vb0 + SHM_V, pa0, pa1, pa2, pa3); partialSM<ALIBI>(pA0, pA1, m_reg, alA, dq0 - 64.f * (float)(j + 1), sl2);
    __syncthreads(); SWAIT(); SWRITE(1, 1);
    RESC(alA); __syncthreads();
  }
  SBAR(); qkt(pB0, pB1, K_lds + SHM_K, qr, r32, hi);
  finishSM(pA0, pA1, alA, l_reg, pa0, pa1, pa2, pa3); SBAR();
  pv_all<NCB>(o, vb0, pa0, pa1, pa2, pa3); partialSM<ALIBI>(pB0, pB1, m_reg, alB, dq0 - 64.f * (float)(NT - 1), sl2);
  __syncthreads(); RESC(alB);
  finishSM(pB0, pB1, alB, l_reg, pa0, pa1, pa2, pa3); SBAR();
  pv_all<NCB>(o, vb0 + SHM_V, pa0, pa1, pa2, pa3);
  if (hi == 0) li_l[r32] = l_reg; asm volatile("s_waitcnt lgkmcnt(0)" ::: "memory");
  float rli[16];
#pragma unroll
  for (int r = 0; r < 16; ++r) rli[r] = __builtin_amdgcn_rcpf(li_l[crow(r, hi)]);
  TO* Ow = Ob + (long)(wid * 32) * 1024;
#pragma unroll
  for (int r = 0; r < 16; ++r) { const int orow = crow(r, hi);
#pragma unroll
    for (int d0 = 0; d0 < NCB; ++d0) store_o(Ow + (long)orow * 1024 + d0 * 32 + r32, o[d0][r] * rli[r]); }
  __syncthreads();
#undef SLOAD
#undef SWRITE
#undef SWAIT
#undef RESC
}
#undef SBAR
}
namespace att {
#define ALAS __attribute__((address_space(3)))
__device__ __forceinline__ void qkt_l(f32x16& p0, f32x16& p1, const ALAS unsigned char* Ks, const bf16x8* qr, int r32, int hi) {
  p0 = f32x16{}; p1 = f32x16{};
#pragma unroll
  for (int d0 = 0; d0 < 4; ++d0) { const int cb = (d0 * 16 + hi * 8) * 2;
    const bf16x8 b0 = *reinterpret_cast<const ALAS bf16x8*>(Ks + KSWZ64(r32, cb));
    const bf16x8 b1 = *reinterpret_cast<const ALAS bf16x8*>(Ks + 4096 + KSWZ64(r32, cb));
    p0 = __builtin_amdgcn_mfma_f32_32x32x16_bf16(b0, qr[d0], p0, 0, 0, 0);
    p1 = __builtin_amdgcn_mfma_f32_32x32x16_bf16(b1, qr[d0], p1, 0, 0, 0); }
}
__device__ __forceinline__ void qkt_acc(f32x16& p0, f32x16& p1, const ALAS unsigned char* Ks, const bf16x8* qr, int r32, int hi) {
  bf16x8 kb0[4], kb1[4];
#pragma unroll
  for (int d0 = 0; d0 < 4; ++d0) { const int cb = (d0 * 16 + hi * 8) * 2;
    kb0[d0] = *reinterpret_cast<const ALAS bf16x8*>(Ks + KSWZ64(r32, cb)); kb1[d0] = *reinterpret_cast<const ALAS bf16x8*>(Ks + 4096 + KSWZ64(r32, cb)); }
  __builtin_amdgcn_sched_barrier(0);
#pragma unroll
  for (int d0 = 0; d0 < 4; ++d0) {
    p0 = __builtin_amdgcn_mfma_f32_32x32x16_bf16(kb0[d0], qr[d0], p0, 0, 0, 0);
    p1 = __builtin_amdgcn_mfma_f32_32x32x16_bf16(kb1[d0], qr[d0], p1, 0, 0, 0); }
}
__device__ __forceinline__ void qkt_c(f32x16& p0, f32x16& p1, const f32x16& negm, const ALAS unsigned char* Ks, const bf16x8* qr, int r32, int hi) {
  bf16x8 kb0[4], kb1[4];
#pragma unroll
  for (int d0 = 0; d0 < 4; ++d0) { const int cb = (d0 * 16 + hi * 8) * 2;
    kb0[d0] = *reinterpret_cast<const ALAS bf16x8*>(Ks + KSWZ64(r32, cb)); kb1[d0] = *reinterpret_cast<const ALAS bf16x8*>(Ks + 4096 + KSWZ64(r32, cb)); }
  __builtin_amdgcn_sched_barrier(0);
  p0 = __builtin_amdgcn_mfma_f32_32x32x16_bf16(kb0[0], qr[0], negm, 0, 0, 0); p1 = __builtin_amdgcn_mfma_f32_32x32x16_bf16(kb1[0], qr[0], negm, 0, 0, 0);
#pragma unroll
  for (int d0 = 1; d0 < 4; ++d0) {
    p0 = __builtin_amdgcn_mfma_f32_32x32x16_bf16(kb0[d0], qr[d0], p0, 0, 0, 0);
    p1 = __builtin_amdgcn_mfma_f32_32x32x16_bf16(kb1[d0], qr[d0], p1, 0, 0, 0); }
}
template <int NCB> __device__ __forceinline__ void pv_issue0(s16x4 (&vl)[4], s16x4 (&vh)[4], int vb) {
  constexpr int KS = NCB * 1024, HF = NCB * 512;
  vl[0] = tr_read<0>(vb); vh[0] = tr_read<HF>(vb); vl[1] = tr_read<KS>(vb); vh[1] = tr_read<KS + HF>(vb);
  vl[2] = tr_read<2 * KS>(vb); vh[2] = tr_read<2 * KS + HF>(vb); vl[3] = tr_read<3 * KS>(vb); vh[3] = tr_read<3 * KS + HF>(vb);
}
template <int NCB> __device__ __forceinline__ void pv_rest(f32x16* o, const s16x4 (&vl)[4], const s16x4 (&vh)[4], int vb, bf16x8 pa0, bf16x8 pa1, bf16x8 pa2, bf16x8 pa3) {
  asm volatile("s_waitcnt lgkmcnt(0)" ::: "memory"); __builtin_amdgcn_sched_barrier(0);
#define PK(L, H) (bf16x8){L[0], L[1], L[2], L[3], H[0], H[1], H[2], H[3]}
  o[0] = __builtin_amdgcn_mfma_f32_32x32x16_bf16(pa0, PK(vl[0], vh[0]), o[0], 0, 0, 0);
  o[0] = __builtin_amdgcn_mfma_f32_32x32x16_bf16(pa1, PK(vl[1], vh[1]), o[0], 0, 0, 0);
  o[0] = __builtin_amdgcn_mfma_f32_32x32x16_bf16(pa2, PK(vl[2], vh[2]), o[0], 0, 0, 0);
  o[0] = __builtin_amdgcn_mfma_f32_32x32x16_bf16(pa3, PK(vl[3], vh[3]), o[0], 0, 0, 0);
#undef PK
  pv_one<NCB, 1>(o[1], vb, pa0, pa1, pa2, pa3);
  if constexpr (NCB == 4) { pv_one<NCB, 2>(o[2], vb, pa0, pa1, pa2, pa3); pv_one<NCB, 3>(o[3], vb, pa0, pa1, pa2, pa3); }
}
constexpr int PP_NS = 5;
constexpr int PP_KSLOT = 8192, PP_VSLOT = 16384, PP_LK = 0, PP_LV = PP_NS * PP_KSLOT, PP_LW = PP_LV + PP_NS * PP_VSLOT, PP_LDS = PP_LW + 8 * 64 * 4;
static_assert(PP_LDS <= 131072, "attention rings");
#define PP_BAR() do { asm volatile("s_waitcnt lgkmcnt(0)" ::: "memory"); __builtin_amdgcn_s_barrier(); asm volatile("" ::: "memory"); } while (0)
template <int DV, bool ALIBI, typename TO>
__device__ __forceinline__ void attn_unit_pp(const bf16_t* __restrict__ Qb, const bf16_t* __restrict__ Kh, const bf16_t* __restrict__ Vh, TO* __restrict__ Ob, int NT, int qpos0, float sl2, ALAS unsigned char* ldsl, float mref = -1.f) {
  constexpr int NCB = DV / 32, NVI = DV / 32;
  int tid_ = threadIdx.x; asm volatile("" : "+v"(tid_));
  const int tid = tid_, lane = tid & 63, r32 = lane & 31, hi = lane >> 5;
  const int wid = __builtin_amdgcn_readfirstlane(tid >> 6), g = wid >> 2, wq = wid & 3;
  ALAS float* li_l = (ALAS float*)(ldsl + PP_LW) + wid * 64; ALAS float* al_l = li_l + 32;
  bf16x8 qr[4];
  const bf16_t* Qw = Qb + (long)(wid * 32 + r32) * LDZ + hi * 8;
#pragma unroll
  for (int d0 = 0; d0 < 4; ++d0) qr[d0] = *reinterpret_cast<const bf16x8*>(Qw + d0 * 16);
  const float dq0 = (float)(qpos0 + wid * 32 + r32 - 4 * hi);
  unsigned doff[NVI];
#pragma unroll
  for (int i = 0; i < NVI; ++i) {
    const int Lk = (wq * 2 + (i & 1)) * 64 + lane, row = Lk >> 3, c = (Lk & 7) ^ ((row >> 1) & 7);
    const int Lv = (wq * NVI + i) * 64 + lane, st = Lv >> 5, wi = Lv & 31, kk = (st / NCB) * 8 + (wi >> 2), kv = (kk & ~0xC) | ((kk & 4) << 1) | ((kk & 8) >> 1);
    doff[i] = g ? (unsigned)(row * LDZ + c * 8) * 2u : (unsigned)(kv * LDZ + (st % NCB) * 32 + (wi & 3) * 8) * 2u; }
  const char* dbase = g ? (const char*)Kh : (const char*)Vh;
  const int dlds = g ? (PP_LK + wq * 2 * 1024) : (PP_LV + wq * NVI * 1024), dss = g ? PP_KSLOT : PP_VSLOT, ni = g ? 2 : NVI;
#define DMA_T(t, slot) do { const char* tb_ = dbase + (size_t)(t) * (64 * LDZ * 2); ALAS unsigned char* ld_ = ldsl + dlds + (slot) * dss; \
    _Pragma("unroll") for (int i_ = 0; i_ < NVI; ++i_) if (i_ < ni) __builtin_amdgcn_global_load_lds((const unsigned*)(tb_ + doff[i_]), (ALAS unsigned*)(ld_ + i_ * 1024), 16, 0, 0); } while (0)
  const int vbase = (int)(unsigned)(uintptr_t)(ldsl + PP_LV) + v_rd_base(lane);
  const bool mfree = __builtin_amdgcn_readfirstlane((int)(mref >= 0.f)) != 0;
  float m_reg = mfree ? mref : 0.f, l_reg = 0.f; f32x16 o[NCB];
  f32x16 negm = f32x16{}; const int qw = qpos0 + wid * 32;
#pragma unroll
  for (int d = 0; d < NCB; ++d) o[d] = f32x16{};
  f32x16 S0 = f32x16{}, S1 = f32x16{}; bf16x8 pa0 = bf16x8{}, pa1 = bf16x8{}, pa2 = bf16x8{}, pa3 = bf16x8{};
  if (g == 1) { _Pragma("unroll") for (int t = 0; t < PP_NS; ++t) DMA_T(t, t); asm volatile("s_waitcnt vmcnt(8)" ::: "memory"); static_assert(PP_NS == 5, "prologue wait = 2 * (NS - 1)"); }
  else { _Pragma("unroll") for (int t = 0; t < PP_NS - 2; ++t) DMA_T(t, t); }
  PP_BAR();
#define CRF(r) ((float)(((r) & 3) + 8 * ((r) >> 2)))
#define M_STEP(k) do { const int k_ = (k); s16x4 vl_[4], vh_[4]; const int vb_ = vbase + ((k_ >= 0 ? k_ : 0) % PP_NS) * PP_VSLOT; \
    if (k_ >= 0) pv_issue0<NCB>(vl_, vh_, vb_); \
    if (k_ + 1 < NT) { const int ks_ = (k_ + 1) % PP_NS; \
      if constexpr (ALIBI) { const int kt0_ = 64 * (k_ + 1); const float dq_ = dq0 - (float)kt0_; \
        if (kt0_ + 63 <= qw || kt0_ >= qw + 31) {     \
          const float ssl_ = (kt0_ + 63 <= qw) ? sl2 : -sl2; const float e0_ = -m_reg - ssl_ * dq_, e1_ = e0_ + 32.f * ssl_; \
          _Pragma("unroll") for (int r = 0; r < 16; ++r) { S0[r] = fmaf(ssl_, CRF(r), e0_); S1[r] = fmaf(ssl_, CRF(r), e1_); } \
        } else { \
          _Pragma("unroll") for (int r = 0; r < 16; ++r) { const float t0_ = dq_ - CRF(r); S0[r] = fmaf(-sl2, fabsf(t0_), -m_reg); S1[r] = fmaf(-sl2, fabsf(t0_ - 32.f), -m_reg); } \
        } \
        qkt_acc(S0, S1, ldsl + PP_LK + ks_ * PP_KSLOT, qr, r32, hi); \
      } else { qkt_c(S0, S1, negm, ldsl + PP_LK + ks_ * PP_KSLOT, qr, r32, hi); } } \
    if (k_ >= 0) pv_rest<NCB>(o, vl_, vh_, vb_, pa0, pa1, pa2, pa3); } while (0)
#define PK4(P, BASE, OUT) do { unsigned a0 = cvtpk(P[BASE + 0], P[BASE + 1]), a1 = cvtpk(P[BASE + 2], P[BASE + 3]);   \
    unsigned b0 = cvtpk(P[BASE + 4], P[BASE + 5]), b1 = cvtpk(P[BASE + 6], P[BASE + 7]);                              \
    auto r0 = __builtin_amdgcn_permlane32_swap(a0, b0, false, false); auto r1 = __builtin_amdgcn_permlane32_swap(a1, b1, false, false); \
    u32x4 w = {r0[0], r1[0], r0[1], r1[1]}; OUT = *reinterpret_cast<bf16x8*>(&w); } while (0)
#define V_STEP(k) do { const int k_ = (k); \
    { const int tt_ = k_ + (g ? PP_NS : PP_NS - 2); if (tt_ < NT) DMA_T(tt_, tt_ % PP_NS); } \
    if (!mfree) { float pmax = S0[0]; \
    _Pragma("unroll") for (int r = 1; r < 16; ++r) pmax = fmaxf(pmax, S0[r]); \
    _Pragma("unroll") for (int r = 0; r < 16; ++r) pmax = fmaxf(pmax, S1[r]); \
    { auto rr = __builtin_amdgcn_permlane32_swap(__float_as_uint(pmax), __float_as_uint(pmax), false, false); \
      pmax = fmaxf(__uint_as_float(rr[0]), __uint_as_float(rr[1])); } \
    if (k_ == 0 || !__builtin_expect(__all(pmax <= THR2), 1)) {       \
      const float dl = (k_ == 0) ? pmax : fmaxf(pmax, 0.f); m_reg += dl; \
      _Pragma("unroll") for (int r = 0; r < 16; ++r) { S0[r] -= dl; S1[r] -= dl; } \
      if constexpr (!ALIBI) { _Pragma("unroll") for (int r = 0; r < 16; ++r) negm[r] = -m_reg; } \
      if (k_ != 0) { const float alpha = __builtin_amdgcn_exp2f(-dl); l_reg *= alpha; \
        if (hi == 0) al_l[r32] = alpha; \
        asm volatile("s_waitcnt lgkmcnt(0)" ::: "memory"); \
        _Pragma("unroll") for (int d = 0; d < NCB; ++d) _Pragma("unroll") for (int r = 0; r < 16; ++r) o[d][r] *= al_l[crow(r, hi)]; } } } \
    _Pragma("unroll") for (int r = 0; r < 16; ++r) { S0[r] = __builtin_amdgcn_exp2f(S0[r]); S1[r] = __builtin_amdgcn_exp2f(S1[r]); } \
    float ps = 0.f, ps1 = 0.f, ps2 = 0.f, ps3 = 0.f; \
    _Pragma("unroll") for (int r = 0; r < 16; r += 2) { ps += S0[r]; ps1 += S0[r + 1]; ps2 += S1[r]; ps3 += S1[r + 1]; } \
    ps = (ps + ps1) + (ps2 + ps3); \
    { auto rr = __builtin_amdgcn_permlane32_swap(__float_as_uint(ps), __float_as_uint(ps), false, false); \
      ps = __uint_as_float(rr[0]) + __uint_as_float(rr[1]); } \
    l_reg += ps; \
    PK4(S0, 0, pa0); PK4(S0, 8, pa1); PK4(S1, 0, pa2); PK4(S1, 8, pa3); } while (0)
#define WAIT_V(n) asm volatile("s_waitcnt vmcnt(" #n ")" ::: "memory")
  if (g == 0) {
    M_STEP(-1); PP_BAR();
    for (int k = 0; k < NT; ++k) {
      V_STEP(k);
      { const int no_ = NT - 1 - k;
        if (no_ >= 3) { if constexpr (NVI == 4) WAIT_V(12); else WAIT_V(6); } else if (no_ == 2) { if constexpr (NVI == 4) WAIT_V(8); else WAIT_V(4); }
        else if (no_ == 1) { if constexpr (NVI == 4) WAIT_V(4); else WAIT_V(2); } else WAIT_V(0); }
      PP_BAR();
      M_STEP(k); PP_BAR();
    }
    PP_BAR();
  } else {
    PP_BAR();
    for (int k = 0; k < NT; ++k) {
      M_STEP(k - 1);
      { const int no_ = NT - 2 - k;
        if (no_ >= 3) WAIT_V(6); else if (no_ == 2) WAIT_V(4); else if (no_ == 1) WAIT_V(2); else WAIT_V(0); }
      PP_BAR();
      V_STEP(k); PP_BAR();
    }
    M_STEP(NT - 1); PP_BAR();
  }
#undef M_STEP
#undef CRF
#undef V_STEP
#undef PK4
#undef WAIT_V
  if (hi == 0) li_l[r32] = l_reg; asm volatile("s_waitcnt lgkmcnt(0)" ::: "memory");
  float rli[16];
#pragma unroll
  for (int r = 0; r < 16; ++r) rli[r] = __builtin_amdgcn_rcpf(li_l[crow(r, hi)]);
  TO* Ow = Ob + (long)(wid * 32) * 1024;
#pragma unroll
  for (int r = 0; r < 16; ++r) { const int orow = crow(r, hi);
#pragma unroll
    for (int d0 = 0; d0 < NCB; ++d0) store_o(Ow + (long)orow * 1024 + d0 * 32 + r32, o[d0][r] * rli[r]); }
#undef DMA_T
}
#undef ALAS
}
namespace attn_body {
using bf16=__hip_bfloat16;
using bf16x8=__attribute__((ext_vector_type(8)))short;
using s16x4=__attribute__((ext_vector_type(4)))short;
using f32x16=__attribute__((ext_vector_type(16)))float;
using u32x4=__attribute__((ext_vector_type(4)))unsigned;
constexpr int D=64,DMQ=2368,DMK=2368,DMV=2368,DMO=1024;
constexpr int NW=8,QBLK=32,QB=QBLK*NW,KVBLK=64;
__device__ __forceinline__ int crow(int r,int hi){return (r&3)+8*(r>>2)+4*hi;}
#define SBAR() __builtin_amdgcn_sched_barrier(0)
__device__ __forceinline__ void cmask(f32x16&p0,f32x16&p1,int jb,int qrel,int hi){
  const float NEG=-INFINITY; int kb=64*jb+4*hi;
  #pragma unroll
  for(int r=0;r<16;++r){int kv=kb+(r&3)+8*(r>>2); if(kv>qrel)p0[r]=NEG; if(kv+32>qrel)p1[r]=NEG;}
}

constexpr int NSLOT=3, SLOTB=8192;
constexpr int LDS_K=0, LDS_V=NSLOT*SLOTB, LDS_WS=2*NSLOT*SLOTB, LDS_OST=LDS_WS+NW*64*4, LDS_BYTES=LDS_OST+NW*4096;
constexpr float C2=0.125f*1.4426950408889634f;
__device__ __forceinline__ void glds16(const void*gsrc,unsigned lds_dst){unsigned keep;
  asm volatile("s_mov_b32 %0, m0\n\ts_mov_b32 m0, %2\n\ts_nop 0\n\tglobal_load_lds_dwordx4 %1, off\n\ts_mov_b32 m0, %0":"=&s"(keep):"v"(gsrc),"s"(lds_dst):"memory");}
__device__ __forceinline__ float max3f(float a,float b,float c){float r;asm("v_max3_f32 %0, %1, %2, %3":"=v"(r):"v"(a),"v"(b),"v"(c));return r;}
__device__ __forceinline__ float max2f(float a,float b){float r;asm("v_max_f32_e32 %0, %1, %2":"=v"(r):"v"(a),"v"(b));return r;}
__device__ __forceinline__ float fadd_s(float a,float b){float r;asm("v_add_f32_e32 %0, %1, %2":"=v"(r):"v"(a),"v"(b));return r;}
__device__ __forceinline__ float fsub_s(float a,float b){float r;asm("v_sub_f32_e32 %0, %1, %2":"=v"(r):"v"(a),"v"(b));return r;}
typedef float f32x2_t __attribute__((ext_vector_type(2))); typedef __bf16 bf16x2_t __attribute__((ext_vector_type(2)));
__device__ __forceinline__ unsigned cvtpk_s(float lo,float hi){f32x2_t v={lo,hi};bf16x2_t b=__builtin_convertvector(v,bf16x2_t);return __builtin_bit_cast(unsigned,b);}
#define WAIT_BAR(N) asm volatile("s_waitcnt vmcnt(" #N ") lgkmcnt(0)\n\ts_barrier":::"memory")

__device__ __forceinline__ void qkt(f32x16&p0,f32x16&p1,const char*Kslot,const bf16x8*qr,const f32x16&negm,int r32,int hi){
  const char*kb=Kslot+hi*1024+r32*16;
  #pragma unroll
  for(int d0=0;d0<4;++d0){
    const bf16x8 b0=*reinterpret_cast<const bf16x8*>(kb+d0*2048);
    const bf16x8 b1=*reinterpret_cast<const bf16x8*>(kb+d0*2048+512);
    if(d0==0){p0=__builtin_amdgcn_mfma_f32_32x32x16_bf16(b0,qr[0],negm,0,0,0);p1=__builtin_amdgcn_mfma_f32_32x32x16_bf16(b1,qr[0],negm,0,0,0);}
    else{p0=__builtin_amdgcn_mfma_f32_32x32x16_bf16(b0,qr[d0],p0,0,0,0);p1=__builtin_amdgcn_mfma_f32_32x32x16_bf16(b1,qr[d0],p1,0,0,0);}}
}
typedef __attribute__((address_space(3))) const char* lds_cptr;
typedef short v4i16_t __attribute__((ext_vector_type(4)));
__device__ __forceinline__ void kload8(bf16x8*kf,lds_cptr kp){
  kf[0]=*(const __attribute__((address_space(3))) bf16x8*)(kp);      kf[1]=*(const __attribute__((address_space(3))) bf16x8*)(kp+512);
  kf[2]=*(const __attribute__((address_space(3))) bf16x8*)(kp+2048); kf[3]=*(const __attribute__((address_space(3))) bf16x8*)(kp+2560);
  kf[4]=*(const __attribute__((address_space(3))) bf16x8*)(kp+4096); kf[5]=*(const __attribute__((address_space(3))) bf16x8*)(kp+4608);
  kf[6]=*(const __attribute__((address_space(3))) bf16x8*)(kp+6144); kf[7]=*(const __attribute__((address_space(3))) bf16x8*)(kp+6656);
}
__device__ __forceinline__ void kload2(bf16x8*kf,lds_cptr kp,int j){ kf[2*j]=*(const __attribute__((address_space(3))) bf16x8*)(kp+j*2048); kf[2*j+1]=*(const __attribute__((address_space(3))) bf16x8*)(kp+j*2048+512); }
__device__ __forceinline__ s16x4 vtr(lds_cptr p){ return __builtin_bit_cast(s16x4,__builtin_amdgcn_ds_read_tr16_b64_v4i16((__attribute__((address_space(3))) v4i16_t*)p)); }
__device__ __forceinline__ float rowmax(const f32x16&p0,const f32x16&p1){
  float a=max3f(p0[0],p0[1],p1[0]),b=max3f(p0[2],p0[3],p1[1]);a=max3f(a,p1[2],p1[3]);
  #pragma unroll
  for(int r=4;r<16;r+=4){a=max3f(a,p0[r],p0[r+1]);b=max3f(b,p0[r+2],p0[r+3]);a=max3f(a,p1[r],p1[r+1]);b=max3f(b,p1[r+2],p1[r+3]);}
  const float m=max2f(a,b);
  auto rr=__builtin_amdgcn_permlane32_swap(__float_as_uint(m),__float_as_uint(m),false,false);
  return max2f(__uint_as_float(rr[0]),__uint_as_float(rr[1]));
}
__device__ __forceinline__ void pv(f32x16*o,int vb,bf16x8 pa0,bf16x8 pa1,bf16x8 pa2,bf16x8 pa3){
  #pragma unroll
  for(int d0=0;d0<2;++d0){s16x4 lo[4],hi[4];
    #pragma unroll
    for(int ks=0;ks<4;++ks){
      asm volatile("ds_read_b64_tr_b16 %0,%1 offset:%c2":"=&v"(lo[ks]):"v"(vb),"i"(d0*4096+ks*1024):"memory");
      asm volatile("ds_read_b64_tr_b16 %0,%1 offset:%c2":"=&v"(hi[ks]):"v"(vb),"i"(d0*4096+ks*1024+512):"memory");}
    asm volatile("s_waitcnt lgkmcnt(0)":::"memory");SBAR();
    #define PK(k) (bf16x8){lo[k][0],lo[k][1],lo[k][2],lo[k][3],hi[k][0],hi[k][1],hi[k][2],hi[k][3]}
    o[d0]=__builtin_amdgcn_mfma_f32_32x32x16_bf16(pa0,PK(0),o[d0],0,0,0);
    o[d0]=__builtin_amdgcn_mfma_f32_32x32x16_bf16(pa1,PK(1),o[d0],0,0,0);
    o[d0]=__builtin_amdgcn_mfma_f32_32x32x16_bf16(pa2,PK(2),o[d0],0,0,0);
    o[d0]=__builtin_amdgcn_mfma_f32_32x32x16_bf16(pa3,PK(3),o[d0],0,0,0);
    #undef PK
  }
}

#ifndef ATTN_STORE16
#define ATTN_STORE16(p,v) (*(u32x4*)(p)=(v))
#endif
template<int THRL> __device__ __forceinline__ void attn_unit(const bf16*Qb,const bf16*__restrict__ Kh,const bf16*__restrict__ Vh,bf16*Ob,const int NT,char*shm,const float sbound=0.f){
  const int tid=threadIdx.x,lane=tid&63,r32=lane&31,hi=lane>>5; const int wid=__builtin_amdgcn_readfirstlane(tid>>6);
  const bf16*Qw=Qb+(long)(wid*QBLK)*DMQ;
  const unsigned lds0=(unsigned)(uintptr_t)shm;
  float*wsf=(float*)(shm+LDS_WS)+wid*64;
  const bf16*ksrc=Kh+(long)lane*DMK+wid*8;
  const bf16*vsrc=Vh+(long)(16*(wid&3)+(lane>>2))*DMV+(wid>>2)*32+(lane&3)*8;
  const unsigned kdst=lds0+LDS_K+wid*1024, vdst=lds0+LDS_V+wid*1024;
  #define DMA_K(t,slot) glds16(ksrc+(long)(t)*KVBLK*DMK,(unsigned)__builtin_amdgcn_readfirstlane(kdst+(slot)))
  #define DMA_V(t,slot) glds16(vsrc+(long)(t)*KVBLK*DMV,(unsigned)__builtin_amdgcn_readfirstlane(vdst+(slot)))
  const int vb0=(int)(lds0+LDS_V)+((lane>>4)&1)*32+(lane&3)*8+(4*hi+((lane&15)>>2))*64;
  const char*Kbase=shm+LDS_K; bf16x8 kf[8];
  const lds_cptr shm3=(lds_cptr)shm; const lds_cptr kp0=shm3+LDS_K+hi*1024+r32*16; const lds_cptr vp0=shm3+LDS_V+((lane>>4)&1)*32+(lane&3)*8+(4*hi+((lane&15)>>2))*64;
  DMA_K(0,0);DMA_V(0,0);DMA_K(1,SLOTB);
  bf16x8 qr[4];
  #pragma unroll
  for(int d0=0;d0<4;++d0)qr[d0]=*reinterpret_cast<const bf16x8*>(&Qw[(long)r32*DMQ+d0*16+hi*8]);
  float sb_=sbound; asm volatile("":"+v"(sb_));
  float mhat=(THRL>=1000)?sb_:0.f,l_reg=0.f;f32x16 o[2];o[0]=f32x16{};o[1]=f32x16{};f32x16 negm;
  _Pragma("unroll") for(int r=0;r<16;++r)negm[r]=-mhat; asm volatile("":"+v"(negm));
  #define CMASK(P0,P1,t) do{}while(0)
  bool resc=false;
  #define START(P0,P1) do{ resc=false; if constexpr(THRL<1000) { const float rm=rowmax(P0,P1); \
      const float dl=rm; mhat=fadd_s(mhat,dl); \
      _Pragma("unroll") for(int r=0;r<16;++r){P0[r]=fsub_s(P0[r],dl);P1[r]=fsub_s(P1[r],dl);} \
      _Pragma("unroll") for(int r=0;r<16;++r)negm[r]=-mhat; asm volatile("":"+v"(negm)); } \
    _Pragma("unroll") for(int r=0;r<16;++r)P0[r]=__builtin_amdgcn_exp2f(P0[r]); }while(0)
  #define RESC() do{ if(resc){ asm volatile("s_waitcnt lgkmcnt(0)":::"memory"); \
      _Pragma("unroll") for(int d_=0;d_<2;++d_) _Pragma("unroll") for(int r=0;r<16;++r)o[d_][r]*=wsf[crow(r,hi)]; } }while(0)
  f32x16 pA0,pA1,pB0,pB1;
  int sl_prev=0,sl_cur=0,sl_next=SLOTB;
  #define ROT() do{sl_prev=sl_cur;sl_cur=sl_next;sl_next=(sl_next==(NSLOT-1)*SLOTB)?0:sl_next+SLOTB;}while(0)
  DMA_K(2,2*SLOTB);
  WAIT_BAR(3);
  qkt(pA0,pA1,Kbase,qr,negm,r32,hi);asm volatile("s_nop 15\n\ts_nop 7":"+v"(pA0),"+v"(pA1));CMASK(pA0,pA1,0);
  START(pA0,pA1);
  _Pragma("unroll") for(int r=0;r<16;++r)pA1[r]=__builtin_amdgcn_exp2f(pA1[r]);
  WAIT_BAR(0);
  DMA_K(3,0);DMA_V(1,SLOTB);
  ROT();
  kload8(kf,kp0+sl_cur);
  WAIT_BAR(2);
  s16x4 vlo[8],vhi[8]; u32x4 pw0,pw1,pw2,pw3;
  #define PKW(P,B) cvtpk_s(P[B],P[B+1])
  #define PAF(k) __builtin_bit_cast(bf16x8,pw##k)
  #define VFR(i) (bf16x8){vlo[i][0],vlo[i][1],vlo[i][2],vlo[i][3],vhi[i][0],vhi[i][1],vhi[i][2],vhi[i][3]}
  #define PIN(x) asm volatile("":"+v"(x))
  #define MX3(a,b,c) __builtin_fmaxf(__builtin_fmaxf((a),(b)),(c))
  #define GAPA(MF,A0,A1,A2,A3,W0,W1,PW) do{ MF; sacc+=A0; sacc+=A1; sacc+=A2; sacc+=A3; PIN(sacc); W0; W1; PIN(PW); SBAR(); }while(0)
  #define EX(v) __builtin_amdgcn_exp2f(v)
  #define GAPB(MF,X,B) do{ MF; X[B]=EX(X[B]); X[B+1]=EX(X[B+1]); X[B+2]=EX(X[B+2]); X[B+3]=EX(X[B+3]); PIN(X); SBAR(); }while(0)
  #define VRD(i) do{ vlo[i]=vtr(vp_+(((i)>>2)*4096+((i)&3)*1024)); vhi[i]=vtr(vp_+(((i)>>2)*4096+((i)&3)*1024+512)); }while(0)
  #define KRD(G,j) do{ if(G){ kload2(kf,kp0+sl_next,j); SBAR(); } }while(0)
  #define STEP(C0,C1,P0,P1,t,GK,GV,GL) do{ SBAR(); \
    const lds_cptr vp_=vp0+sl_prev; \
    VRD(0); SBAR(); float sacc=(P0[0]+P0[1]); \
    GAPA(C0=__builtin_amdgcn_mfma_f32_32x32x16_bf16(kf[0],qr[0],negm,0,0,0), P0[2],P0[3],P0[4],P0[5],     pw0[0]=PKW(P0,0), pw0[1]=PKW(P0,2), pw0); \
    VRD(4); SBAR(); GAPA(C1=__builtin_amdgcn_mfma_f32_32x32x16_bf16(kf[1],qr[0],negm,0,0,0), P0[6],P0[7],P0[8],P0[9],     pw0[2]=PKW(P0,4), pw0[3]=PKW(P0,6), pw0); \
    VRD(1); SBAR(); GAPA(C0=__builtin_amdgcn_mfma_f32_32x32x16_bf16(kf[2],qr[1],C0,0,0,0),   P0[10],P0[11],P0[12],P0[13], pw1[0]=PKW(P0,8), pw1[1]=PKW(P0,10), pw1); \
    VRD(5); SBAR(); GAPA(C1=__builtin_amdgcn_mfma_f32_32x32x16_bf16(kf[3],qr[1],C1,0,0,0),   P0[14],P0[15],P1[0],P1[1],   pw1[2]=PKW(P0,12),pw1[3]=PKW(P0,14), pw1); \
    VRD(2); SBAR(); GAPA(C0=__builtin_amdgcn_mfma_f32_32x32x16_bf16(kf[4],qr[2],C0,0,0,0),   P1[2],P1[3],P1[4],P1[5],     pw2[0]=PKW(P1,0), pw2[1]=PKW(P1,2), pw2); \
    VRD(6); SBAR(); GAPA(C1=__builtin_amdgcn_mfma_f32_32x32x16_bf16(kf[5],qr[2],C1,0,0,0),   P1[6],P1[7],P1[8],P1[9],     pw2[2]=PKW(P1,4), pw2[3]=PKW(P1,6), pw2); \
    VRD(3); SBAR(); GAPA(C0=__builtin_amdgcn_mfma_f32_32x32x16_bf16(kf[6],qr[3],C0,0,0,0),   P1[10],P1[11],P1[12],P1[13], pw3[0]=PKW(P1,8), pw3[1]=PKW(P1,10), pw3); \
    VRD(7); SBAR(); GAPA(C1=__builtin_amdgcn_mfma_f32_32x32x16_bf16(kf[7],qr[3],C1,0,0,0),   P1[14],P1[15],0.f,0.f,       pw3[2]=PKW(P1,12),pw3[3]=PKW(P1,14), pw3); \
    l_reg+=sacc; \
    if(GK){DMA_K((t)+3,sl_cur);} if(GV){DMA_V((t)+1,sl_next);} \
    CMASK(C0,C1,t); \
    resc=false; if constexpr(THRL<1000) { float a=MX3(C0[0],C0[1],C1[0]),b=MX3(C0[2],C0[3],C1[1]); a=MX3(a,C1[2],C1[3]); \
      _Pragma("unroll") for(int r=4;r<16;r+=4){a=MX3(a,C0[r],C0[r+1]);b=MX3(b,C0[r+2],C0[r+3]);a=MX3(a,C1[r],C1[r+1]);b=MX3(b,C1[r+2],C1[r+3]);} \
      float rm=__builtin_fmaxf(a,b); { auto rr=__builtin_amdgcn_permlane32_swap(__float_as_uint(rm),__float_as_uint(rm),false,false); rm=__builtin_fmaxf(__uint_as_float(rr[0]),__uint_as_float(rr[1])); } \
      resc=false; \
      if(__builtin_expect(__any(rm>(float)THRL),0)){ const float dl=__builtin_fmaxf(rm,0.f); mhat+=dl; \
        _Pragma("unroll") for(int r=0;r<16;++r){C0[r]-=dl;C1[r]-=dl;} \
        _Pragma("unroll") for(int r=0;r<16;++r)negm[r]=-mhat; asm volatile("":"+v"(negm)); \
        const float f=__builtin_amdgcn_exp2f(-dl); l_reg*=f; if(hi==0)wsf[r32]=f; resc=true; } } \
    SBAR(); \
    GAPB(o[0]=__builtin_amdgcn_mfma_f32_32x32x16_bf16(PAF(0),VFR(0),o[0],0,0,0), C0,0); \
    GAPB(o[1]=__builtin_amdgcn_mfma_f32_32x32x16_bf16(PAF(0),VFR(4),o[1],0,0,0), C0,4); \
    KRD(GL,0); GAPB(o[0]=__builtin_amdgcn_mfma_f32_32x32x16_bf16(PAF(1),VFR(1),o[0],0,0,0), C0,8); \
    KRD(GL,1); GAPB(o[1]=__builtin_amdgcn_mfma_f32_32x32x16_bf16(PAF(1),VFR(5),o[1],0,0,0), C0,12); \
    KRD(GL,2); GAPB(o[0]=__builtin_amdgcn_mfma_f32_32x32x16_bf16(PAF(2),VFR(2),o[0],0,0,0), C1,0); \
    KRD(GL,3); GAPB(o[1]=__builtin_amdgcn_mfma_f32_32x32x16_bf16(PAF(2),VFR(6),o[1],0,0,0), C1,4); \
    GAPB(o[0]=__builtin_amdgcn_mfma_f32_32x32x16_bf16(PAF(3),VFR(3),o[0],0,0,0), C1,8); \
    GAPB(o[1]=__builtin_amdgcn_mfma_f32_32x32x16_bf16(PAF(3),VFR(7),o[1],0,0,0), C1,12); \
    }while(0)
  int t=1;
  #undef CMASK
  #define CMASK(P0,P1,t) do{}while(0)
  for(;t+5<NT;t+=2){
    STEP(pB0,pB1,pA0,pA1,t,true,true,true);     WAIT_BAR(2); RESC(); ROT();
    STEP(pA0,pA1,pB0,pB1,t+1,true,true,true);   WAIT_BAR(2); RESC(); ROT();
  }
  #undef CMASK
  #define CMASK(P0,P1,t) do{}while(0)
  #define ENDW(tt) do{ if((tt)+3<NT){WAIT_BAR(2);} else if((tt)+2<NT){WAIT_BAR(1);} else {WAIT_BAR(0);} }while(0)
  for(;t+1<NT;t+=2){
    STEP(pB0,pB1,pA0,pA1,t,(t+3<NT),(t+1<NT),(t+1<NT));       ENDW(t);   RESC(); ROT();
    STEP(pA0,pA1,pB0,pB1,t+1,(t+4<NT),(t+2<NT),(t+2<NT));     ENDW(t+1); RESC(); ROT();
  }
  STEP(pB0,pB1,pA0,pA1,NT-1,false,false,false); RESC();
  { float sacc=pB0[0]+pB0[1]; _Pragma("unroll") for(int r=2;r<16;++r)sacc+=pB0[r]; _Pragma("unroll") for(int r=0;r<16;++r)sacc+=pB1[r]; l_reg+=sacc;
    pw0=(u32x4){PKW(pB0,0),PKW(pB0,2),PKW(pB0,4),PKW(pB0,6)};pw1=(u32x4){PKW(pB0,8),PKW(pB0,10),PKW(pB0,12),PKW(pB0,14)};pw2=(u32x4){PKW(pB1,0),PKW(pB1,2),PKW(pB1,4),PKW(pB1,6)};pw3=(u32x4){PKW(pB1,8),PKW(pB1,10),PKW(pB1,12),PKW(pB1,14)};
    SBAR(); pv(o,vb0+sl_cur,PAF(0),PAF(1),PAF(2),PAF(3)); }
  #undef PKW
  #undef PAF
  #undef VFR
  #undef PIN
  #undef MX3
  #undef GAPA
  #undef GAPB
  #undef EX
  #undef VRD
  #undef KRD
  #undef STEP
  #undef ENDW
  {auto rr=__builtin_amdgcn_permlane32_swap(__float_as_uint(l_reg),__float_as_uint(l_reg),false,false);l_reg=__uint_as_float(rr[0])+__uint_as_float(rr[1]);}
  if(hi==0)wsf[32+r32]=l_reg;asm volatile("s_waitcnt lgkmcnt(0)":::"memory");
  float rli[16];
  #pragma unroll
  for(int r=0;r<16;++r)rli[r]=__builtin_amdgcn_rcpf(wsf[32+crow(r,hi)]);
  bf16*Ow=Ob+(long)(wid*QBLK)*DMO;
  { bf16*stg=(bf16*)(shm+LDS_OST)+wid*2048;
    #pragma unroll
    for(int r=0;r<16;++r){const int orow=crow(r,hi);
      #pragma unroll
      for(int d0=0;d0<2;++d0)stg[orow*64+d0*32+r32]=__float2bfloat16(o[d0][r]*rli[r]);}
    asm volatile("s_waitcnt lgkmcnt(0)":::"memory");
    #pragma unroll
    for(int i=0;i<4;++i){const int row=i*8+(lane>>3),ch=lane&7; const u32x4 v=*(const u32x4*)(stg+row*64+ch*8); ATTN_STORE16(Ow+(long)row*DMO+ch*8,v);} }
  asm volatile("s_waitcnt lgkmcnt(0)\n\ts_barrier":::"memory");
  #undef DMA_K
  #undef DMA_V
  #undef CMASK
  #undef START
  #undef RESC
  #undef ROT
}
constexpr int ATTN_LDS_BYTES=LDS_BYTES;
#undef SBAR
#undef WAIT_BAR
}
typedef unsigned short bf16;
typedef unsigned v4u __attribute__((ext_vector_type(4)));
typedef float f32x4 __attribute__((ext_vector_type(4)));
#define LAS __attribute__((address_space(3)))
constexpr int NWAVES = 8;
constexpr int D = 1024, FF = 4096, NIN = 2304, PLE = 256;
constexpr int ZP = att::LDZ;
constexpr int MP = 4 * 8192, MS = 8 * 2048, M = MP + MS;
constexpr int SEQ_P = 8192, SEQ_S = 2048;
constexpr float C2 = 0.125f * 1.4426950408889634f;
constexpr float LOG2E = 1.4426950408889634f;
constexpr size_t MiB = 1u << 20;
constexpr size_t WS_RSP1 = 1 * MiB, WS_RSP2 = 4 * MiB, WS_RSP3 = 7 * MiB;
constexpr size_t WS_WIN = 10 * MiB, WS_WOUT = 15 * MiB, WS_W1 = 17 * MiB, WS_W2 = 25 * MiB, WS_WG = 33 * MiB, WS_WP = 35 * MiB;
constexpr size_t WS_PB = 36 * MiB;
constexpr size_t WS_PROJ = 60 * MiB;
constexpr size_t WS_Z = 156 * MiB;
constexpr size_t WS_HB = 156 * MiB;
constexpr size_t WS_XN = 380 * MiB;
constexpr size_t WS_H = 252 * MiB;
constexpr size_t WS_END = 512 * MiB;
static_assert(WS_XN + (size_t)M * D * 2 <= WS_END && WS_Z + (size_t)M * ZP * 2 <= WS_XN && WS_H + (size_t)16384 * FF * 2 <= WS_END && WS_HB + (size_t)M * D * 2 <= WS_H, "d_ws map");
constexpr int CW_QMAX = 3584, CW_KMAX = 3648, CW_DNEG = 3616, CW_QUEUE = 3712;
constexpr int CTL_BYTES = 32768;
constexpr float SKIP_T = 32.0f;
constexpr int LDS_BYTES = 147456;
static_assert(att::ATTN_LDS <= 131072 && attn_body::ATTN_LDS_BYTES <= 131072 && attn_body::DMQ == ZP, "attention LDS / pitches");

__device__ __forceinline__ unsigned f2bf(float f) { unsigned u = __builtin_bit_cast(unsigned, f); return (u + 0x7fffu + ((u >> 16) & 1u)) >> 16; }
__device__ __forceinline__ unsigned pk2(float lo, float hi) { return f2bf(lo) | (f2bf(hi) << 16); }
__device__ __forceinline__ float wave_sum(float v) {
#pragma unroll
    for (int o = 1; o < 64; o <<= 1) v += __shfl_xor(v, o);
    return v;
}
__device__ __forceinline__ void transpose_item(const float* W, int K, int N, const float* g, bf16* WT, LAS float* scr, int item, int lane) {
    const int nblk = N / 32, kb = item / nblk, nb = item % nblk, k0 = 64 * kb, n0 = 32 * nb;
#pragma unroll 8
    for (int i = 0; i < 32; ++i) { const int kk = 2 * i + (lane >> 5); const float gs = g ? g[k0 + kk] : 1.f; scr[kk * 33 + (lane & 31)] = W[(size_t)(k0 + kk) * N + n0 + (lane & 31)] * gs; }
    asm volatile("s_waitcnt lgkmcnt(0)" ::: "memory");
    const int c = lane & 7;
#pragma unroll
    for (int j = 0; j < 4; ++j) { const int n = (lane >> 3) + 8 * j; const LAS float* s = scr + (8 * c) * 33 + n;
        v4u o; o.x = pk2(s[0 * 33], s[1 * 33]); o.y = pk2(s[2 * 33], s[3 * 33]); o.z = pk2(s[4 * 33], s[5 * 33]); o.w = pk2(s[6 * 33], s[7 * 33]);
        *(v4u*)(WT + (size_t)(n0 + n) * K + k0 + 8 * c) = o; }
    asm volatile("s_waitcnt lgkmcnt(0)" ::: "memory");
}

#define XB_TMO      128
#define XB_XCNT(j)  (256  + 64 * (j))
#define XB_XSUB(j)  (1280 + 64 * (j))
#define XB_XGEN(j)  (2304 + 64 * (j))
#define XB_TOP      3328
#define XB_TOPGEN   3392
#define XCD_BAR_WORDS 3456
#define XB_SPIN_CAP (1u << 22)

__device__ __forceinline__ unsigned xb_ld(unsigned* p)              { return __hip_atomic_load(p, __ATOMIC_RELAXED, __HIP_MEMORY_SCOPE_AGENT); }
__device__ __forceinline__ unsigned xb_add(unsigned* p, unsigned v) { return __hip_atomic_fetch_add(p, v, __ATOMIC_RELAXED, __HIP_MEMORY_SCOPE_AGENT); }
__device__ __forceinline__ unsigned xb_xcc_id() { return (unsigned)__builtin_amdgcn_s_getreg((3 << 11) | 20) & 0xFu; }
#define XB_SPIN(cond, bar) do { unsigned _sp = 0; while (cond) { __builtin_amdgcn_s_sleep(1); \
    if ((++_sp & 255u) == 0u) { if (xb_ld(&(bar)[XB_TMO])) break; if (_sp > XB_SPIN_CAP) { atomicAdd(&(bar)[XB_TMO], 1u); break; } } } } while (0)

struct XcdBarrier {
    unsigned* bar; unsigned x;
    volatile LAS unsigned* st;
};

__device__ __forceinline__ XcdBarrier xcd_barrier_post(unsigned* bar, volatile LAS unsigned* st) {
    XcdBarrier b; b.bar = bar; b.x = xb_xcc_id(); b.st = st;
    if (threadIdx.x == 0) (void)xb_add(&bar[XB_XCNT(b.x)], 1u);
    return b;
}
__device__ __forceinline__ void xcd_barrier_complete(unsigned* bar, unsigned x, unsigned& nloc, unsigned& nx) {
    const unsigned G = gridDim.x * gridDim.y * gridDim.z;
    unsigned sum, cnt, mine, sp = 0u;
    for (;;) {
        sum = 0u; cnt = 0u; mine = 0u;
#pragma unroll
        for (unsigned j = 0; j < 16; ++j) { const unsigned c = xb_ld(&bar[XB_XCNT(j)]); sum += c; cnt += (c > 0u) ? 1u : 0u; mine = (j == x) ? c : mine; }
        if (sum == G) break;
        __builtin_amdgcn_s_sleep(1);
        if ((++sp & 255u) == 0u) { if (xb_ld(&bar[XB_TMO])) break; if (sp > XB_SPIN_CAP) { atomicAdd(&bar[XB_TMO], 1u); break; } }
    }
    nloc = mine > 0u ? mine : 1u; nx = cnt > 0u ? cnt : 1u;
}

__device__ __forceinline__ void xcd_barrier(const XcdBarrier& b) {
    asm volatile("s_waitcnt vmcnt(0)" ::: "memory");
    __syncthreads();
    if (threadIdx.x == 0) {
        unsigned* bar = b.bar;
        __builtin_amdgcn_s_waitcnt(0);
        unsigned nloc = b.st[0], nx = b.st[1];
        if (nloc == 0u) { xcd_barrier_complete(bar, b.x, nloc, nx); b.st[0] = nloc; b.st[1] = nx; }
        const unsigned old = xb_add(&bar[XB_XSUB(b.x)], 1u);
        const unsigned gen = old / nloc;
        if (old + 1u == (gen + 1u) * nloc) {
            __builtin_amdgcn_fence(__ATOMIC_RELEASE, "agent");
            asm volatile("s_waitcnt vmcnt(0)" ::: "memory");
            const unsigned og = xb_add(&bar[XB_TOP], 1u);
            const unsigned tg = og / nx;
            if (og + 1u == (tg + 1u) * nx) xb_add(&bar[XB_TOPGEN], 1u);
            else XB_SPIN(xb_ld(&bar[XB_TOPGEN]) == tg, bar);
            __builtin_amdgcn_fence(__ATOMIC_ACQUIRE, "agent");
            xb_add(&bar[XB_XGEN(b.x)], 1u);
            asm volatile("s_waitcnt vmcnt(0)" ::: "memory");
        } else {
            XB_SPIN(xb_ld(&bar[XB_XGEN(b.x)]) == gen, bar);
            __builtin_amdgcn_fence(__ATOMIC_ACQUIRE, "agent");
            asm volatile("s_waitcnt vmcnt(0)" ::: "memory");
        }
    }
    __syncthreads();
}

struct Args { const float* in[21]; float* out; unsigned char* ws; };

__global__ void __launch_bounds__(NWAVES * 64, 2) fwd_mega(Args args) {
    extern __shared__ __attribute__((aligned(16))) unsigned char lds[];
    cg::grid_group grid = cg::this_grid();
#define PHASE_IDS() int tid_p = threadIdx.x; asm volatile("" : "+v"(tid_p)); const int tid = tid_p, lane = tid & 63, wave = __builtin_amdgcn_readfirstlane(tid >> 6); const int gw = bx * NWAVES + wave; (void)lane; (void)gw; (void)tid
    const int G = gridDim.x, bx = blockIdx.x;
    const int NGW = G * NWAVES;
    unsigned char* ws = args.ws;
    const float* x_p = args.in[0]; const float* x_s = args.in[1]; const float* p_p = args.in[2]; const float* p_s = args.in[3];
    const float* w_in = args.in[4]; const float* g_mix = args.in[5];
    const float* lq1 = args.in[6]; const float* lk1 = args.in[7]; const float* lq2 = args.in[8]; const float* lk2 = args.in[9];
    const float* g_subln = args.in[10]; const float* g_qn = args.in[11]; const float* g_kn = args.in[12];
    const float* w_out = args.in[13]; const float* g_mlp = args.in[14]; const float* w_ff1 = args.in[15]; const float* w_ff2 = args.in[16];
    const float* g_ple = args.in[17]; const float* w_gate = args.in[18]; const float* w_proj = args.in[19]; const float* g_final = args.in[20];
    float* out = args.out;
    float* RSP1 = (float*)(ws + WS_RSP1); float* RSP2 = (float*)(ws + WS_RSP2); float* RSP3 = (float*)(ws + WS_RSP3);
    bf16* WinT = (bf16*)(ws + WS_WIN); bf16* WoutT = (bf16*)(ws + WS_WOUT); bf16* W1T = (bf16*)(ws + WS_W1); bf16* W2T = (bf16*)(ws + WS_W2); bf16* WgT = (bf16*)(ws + WS_WG); bf16* WpT = (bf16*)(ws + WS_WP);
    bf16* PB = (bf16*)(ws + WS_PB); bf16* PROJ = (bf16*)(ws + WS_PROJ); bf16* Z = (bf16*)(ws + WS_Z); bf16* HB = (bf16*)(ws + WS_HB);
    bf16* XN = (bf16*)(ws + WS_XN); bf16* MIX = XN; bf16* HH = (bf16*)(ws + WS_H);
    LAS unsigned char* ldsl = (LAS unsigned char*)lds;
    volatile LAS unsigned* bst = (volatile LAS unsigned*)(ldsl + 139264);
    if (threadIdx.x < 2) bst[threadIdx.x] = 0u;
    __syncthreads();
    const XcdBarrier bar = xcd_barrier_post((unsigned*)ws, bst);
    if (ws == nullptr) grid.sync();

#ifndef NO_P0
#ifdef PROBE_EW2
    for (int rep = 0; rep < 2; ++rep)
#endif
    {
        PHASE_IDS();
        LAS float* scr = (LAS float*)(ldsl + wave * 16384);
        constexpr int I_IN = (D / 64) * (NIN / 32), I_OUT = (D / 64) * (D / 32), I_1 = (D / 64) * (FF / 32), I_2 = (FF / 64) * (D / 32), I_G = I_OUT, I_P = (PLE / 64) * (D / 32);
        constexpr int NITEMS = I_IN + I_OUT + I_1 + I_2 + I_G + I_P;
        for (int it = gw; it < NITEMS; it += NGW) {
            int r = it;
            if (r < I_IN) { transpose_item(w_in, D, NIN, nullptr, WinT, scr, r, lane); continue; } r -= I_IN;
            if (r < I_OUT) { transpose_item(w_out, D, D, nullptr, WoutT, scr, r, lane); continue; } r -= I_OUT;
            if (r < I_1) { transpose_item(w_ff1, D, FF, g_mlp, W1T, scr, r, lane); continue; } r -= I_1;
            if (r < I_2) { transpose_item(w_ff2, FF, D, nullptr, W2T, scr, r, lane); continue; } r -= I_2;
            if (r < I_G) { transpose_item(w_gate, D, D, g_ple, WgT, scr, r, lane); continue; } r -= I_G;
            transpose_item(w_proj, PLE, D, nullptr, WpT, scr, r, lane);
        }
        f32x4 gv[4];
#pragma unroll
        for (int j = 0; j < 4; ++j) gv[j] = *((const f32x4*)g_mix + lane + 64 * j);
        for (int m0 = gw * 2; m0 < M; m0 += NGW * 2) {
            f32x4 v[2][4], pv[2];
#pragma unroll
            for (int r = 0; r < 2; ++r) { const int m = m0 + r;
                const float* xrow = m < MP ? x_p + (size_t)m * D : x_s + (size_t)(m - MP) * D;
                const float* prow = m < MP ? p_p + (size_t)m * PLE : p_s + (size_t)(m - MP) * PLE;
#pragma unroll
                for (int j = 0; j < 4; ++j) v[r][j] = *((const f32x4*)xrow + lane + 64 * j);
                pv[r] = *((const f32x4*)prow + lane); }
#pragma unroll
            for (int r = 0; r < 2; ++r) { const int m = m0 + r; float s = 0.f;
#pragma unroll
                for (int j = 0; j < 4; ++j) s += (v[r][j].x * v[r][j].x + v[r][j].y * v[r][j].y) + (v[r][j].z * v[r][j].z + v[r][j].w * v[r][j].w);
                const float rstd = 1.0f / sqrtf(wave_sum(s) * (1.0f / D) + 1e-6f);
                unsigned long long* o8 = (unsigned long long*)(XN + (size_t)m * D) + lane;
#pragma unroll
                for (int j = 0; j < 4; ++j) { const f32x4 y = v[r][j] * rstd * gv[j]; o8[64 * j] = (unsigned long long)pk2(y.x, y.y) | ((unsigned long long)pk2(y.z, y.w) << 32); }
                *((unsigned long long*)(PB + (size_t)m * PLE) + lane) = (unsigned long long)pk2(pv[r].x, pv[r].y) | ((unsigned long long)pk2(pv[r].z, pv[r].w) << 32); }
        }
    }
#endif
    xcd_barrier(bar);

#ifndef NO_P1
#ifdef PROBE_GEMM2
    for (int rep = 0; rep < 2; ++rep)
#endif
    {
        pg8::Gemm g{XN, WinT, M, NIN, D}; pg8::StaticOrder S; S.init(M, NIN, G, bx);
        pg8::EpiBf E{Z, ZP, C2, 2};
        pg8::gemm_phase<pg8::EpiBf, pg8::StaticOrder, true, true>(ldsl, g, S, E);
    }
    {
        pg8::Gemm g{PB, WpT, M, D, PLE}; pg8::StaticOrder S; S.init(M, D, G, bx);
        pg8::EpiBf E{PROJ, D, 1.f, 0};
        pg8::gemm_phase<pg8::EpiBf, pg8::StaticOrder, true, true>(ldsl, g, S, E);
    }
#endif
    xcd_barrier(bar);

#ifndef NO_P1B
    {
        int tl = threadIdx.x; asm volatile("" : "+v"(tl));
        const long nth = (long)G * 512;
        const int j4 = (tl & 3) * 4;
        {
            float mq = 0.f, mk = 0.f, md = 0.f;
            for (long it = (long)bx * 512 + tl; it < (long)M * 32; it += nth) {
                const long item = it >> 2; const int m = (int)(item >> 3), hc = (int)(item & 7);
                const bf16* p = Z + (size_t)m * ZP + hc * 64 + j4; float sq = 0.f, sk = 0.f, sd = 0.f;
#pragma unroll
                for (int q = 0; q < 4; ++q) { const unsigned long long w = *(const unsigned long long*)(p + 16 * q), wk = *(const unsigned long long*)(p + 512 + 16 * q);
                    const unsigned lo = (unsigned)w, hi = (unsigned)(w >> 32), klo = (unsigned)wk, khi = (unsigned)(wk >> 32);
                    const float a = __uint_as_float(lo << 16), b = __uint_as_float(lo & 0xffff0000u), c = __uint_as_float(hi << 16), d = __uint_as_float(hi & 0xffff0000u);
                    const float ka = __uint_as_float(klo << 16), kb = __uint_as_float(klo & 0xffff0000u), kc = __uint_as_float(khi << 16), kd = __uint_as_float(khi & 0xffff0000u);
                    sq += (a * a + b * b) + (c * c + d * d); sk += (ka * ka + kb * kb) + (kc * kc + kd * kd); sd += (a * ka + b * kb) + (c * kc + d * kd); }
                sq += __shfl_xor(sq, 1); sq += __shfl_xor(sq, 2); sk += __shfl_xor(sk, 1); sk += __shfl_xor(sk, 2); sd += __shfl_xor(sd, 1); sd += __shfl_xor(sd, 2);
                mq = fmaxf(mq, sq); mk = fmaxf(mk, sk); md = fmaxf(md, -sd);
            }
#pragma unroll
            for (int o = 1; o < 64; o <<= 1) { mq = fmaxf(mq, __shfl_xor(mq, o)); mk = fmaxf(mk, __shfl_xor(mk, o)); md = fmaxf(md, __shfl_xor(md, o)); }
            if ((tl & 63) == 0) { atomicMax((unsigned*)ws + CW_QMAX, __float_as_uint(sqrtf(mq) * 1.0001f)); atomicMax((unsigned*)ws + CW_KMAX, __float_as_uint(sqrtf(mk) * 1.0001f));
                                  atomicMax((unsigned*)ws + CW_DNEG, __float_as_uint(md * 1.0001f + 1e-3f)); }
        }
        for (long it = (long)bx * 512 + tl; it < (long)M * 40; it += nth) {
            const long item = it >> 2;
            const int m = (int)(item / 10), hh = (int)(item % 10);
            const int t = m < MP ? (m & (SEQ_P - 1)) : ((m - MP) & (SEQ_S - 1));
            bf16* p = Z + (size_t)m * ZP + 1536 + hh * 64 + j4;
            const float* gg = (hh < 8 ? g_qn : g_kn) + j4;
            float v[4][4]; float ss = 0.f;
#pragma unroll
            for (int q = 0; q < 4; ++q) { const unsigned long long w = *(const unsigned long long*)(p + 16 * q); const unsigned lo = (unsigned)w, hi = (unsigned)(w >> 32);
                v[q][0] = __uint_as_float(lo << 16); v[q][1] = __uint_as_float(lo & 0xffff0000u); v[q][2] = __uint_as_float(hi << 16); v[q][3] = __uint_as_float(hi & 0xffff0000u);
                ss += (v[q][0] * v[q][0] + v[q][1] * v[q][1]) + (v[q][2] * v[q][2] + v[q][3] * v[q][3]); }
            ss += __shfl_xor(ss, 1); ss += __shfl_xor(ss, 2);
            const float rstd = 1.0f / sqrtf(ss * (1.0f / 64.0f) + 1e-6f);
#pragma unroll
            for (int q = 0; q < 4; ++q) { const f32x4 g4 = *(const f32x4*)(gg + 16 * q);
#pragma unroll
                for (int e = 0; e < 4; ++e) v[q][e] = v[q][e] * rstd * g4[e]; }
            const float fr = (float)(t >> 6), fc = (float)(t & 63), osc = hh < 8 ? C2 : 1.f;
#pragma unroll
            for (int e = 0; e < 4; ++e) {
                const float invf = __builtin_amdgcn_exp2f(-(float)(j4 + e) * (13.287712379549449f / 16.0f));
                const float ar = fr * invf, ac = fc * invf;
                const float cr = __cosf(ar), sr = __sinf(ar), cc = __cosf(ac), sc = __sinf(ac);
                const float a1 = v[0][e], a2 = v[1][e]; v[0][e] = (a1 * cr - a2 * sr) * osc; v[1][e] = (a1 * sr + a2 * cr) * osc;
                const float b1 = v[2][e], b2 = v[3][e]; v[2][e] = (b1 * cc - b2 * sc) * osc; v[3][e] = (b1 * sc + b2 * cc) * osc;
            }
#pragma unroll
            for (int q = 0; q < 4; ++q) *(unsigned long long*)(p + 16 * q) = (unsigned long long)pk2(v[q][0], v[q][1]) | ((unsigned long long)pk2(v[q][2], v[q][3]) << 32);
        }
    }
#endif
    xcd_barrier(bar);

#ifndef NO_P2
    {
        const float qkb = __uint_as_float(((const unsigned*)ws)[CW_QMAX]) * __uint_as_float(((const unsigned*)ws)[CW_KMAX]) + __uint_as_float(((const unsigned*)ws)[CW_DNEG]) + SKIP_T;
        PHASE_IDS();
        volatile LAS int* qslot = (volatile LAS int*)(ldsl + 139280);
        const float aqk_ = __uint_as_float(((const unsigned*)ws)[CW_QMAX]) * __uint_as_float(((const unsigned*)ws)[CW_KMAX]);
        const float amref = (aqk_ + __uint_as_float(((const unsigned*)ws)[CW_DNEG]) < 90.0f) ? aqk_ : -1.f;
        float gq_ = fabsf(g_qn[lane]), gk_ = fabsf(g_kn[lane]);
#pragma unroll
        for (int o = 1; o < 64; o <<= 1) { gq_ = fmaxf(gq_, __shfl_xor(gq_, o)); gk_ = fmaxf(gk_, __shfl_xor(gk_, o)); }
        const float bbound = 64.0f * C2 * 1.03f * gq_ * gk_;
        const bool bmaxfree = __builtin_amdgcn_readfirstlane((int)(bbound < 40.0f)) != 0;
        const int x0 = (int)(bar.x & 7u);
        for (int dx = 0; dx < 8; ++dx) {
            const int x = (x0 + dx) & 7;
            for (;;) {
                if (tid == 0) *qslot = (int)__hip_atomic_fetch_add((unsigned*)ws + CW_QUEUE + 64 * x, 1u, __ATOMIC_RELAXED, __HIP_MEMORY_SCOPE_AGENT);
                __syncthreads();
                const int i = *qslot;
                __syncthreads();
                if (i >= 384) break;
                int kind, h = 0, c = 0, head = 0, qb;
                if (i < 32) { kind = 0; h = 3; qb = i; }
                else if (i < 64) { kind = 0; h = 2; qb = i - 32; }
                else if (i < 192) { kind = 1; head = (x & 1) * 4 + ((i - 64) >> 5); qb = (i - 64) & 31; }
                else if (i < 224) { kind = 0; h = 1; qb = i - 192; }
                else if (i < 256) { kind = 2; h = 3 - ((i - 224) >> 4); c = ((i - 224) & 15) >> 3; qb = (i - 224) & 7; }
                else if (i < 320) { kind = 3; head = (i - 256) >> 3; qb = (i - 256) & 7; }
                else if (i < 336) { kind = 2; h = 1; c = (i - 320) >> 3; qb = (i - 320) & 7; }
                else if (i < 368) { kind = 0; h = 0; qb = i - 336; }
                else { kind = 2; h = 0; c = (i - 368) >> 3; qb = (i - 368) & 7; }
                const bool prompt = kind < 2;
                const int b = prompt ? (x >> 1) : x; if (kind == 0) c = x & 1;
                const int S = prompt ? SEQ_P : SEQ_S; const long rowbase = prompt ? (long)b * SEQ_P : (long)MP + (long)b * SEQ_S;
                const int q0 = qb * 256, NT = S / 64;
                const bf16* Zb = Z + rowbase * ZP;
                if (!(kind & 1)) {
                    const float slope = (h == 0 ? 0.25f : h == 1 ? 0.0625f : h == 2 ? 0.015625f : 0.00390625f), sl2 = LOG2E * slope;
                    const float W = qkb / sl2;
                    int t_lo = (int)floorf(fmaxf((float)q0 - W, 0.f) * (1.0f / 64.0f));
                    int t_hi = (int)fminf(floorf(((float)(q0 + 255) + W) * (1.0f / 64.0f)) + 1.0f, (float)NT);
                    if ((t_hi - t_lo) & 1) { if (t_lo > 0) --t_lo; else ++t_hi; }
                    const int hd = h * 2 + c;
                    att::attn_unit_pp<128, true, bf16>(Zb + (long)q0 * ZP + h * 128 + c * 64, Zb + (long)t_lo * 64 * ZP + 512 + h * 128 + c * 64, Zb + (long)t_lo * 64 * ZP + 1024 + h * 128,
                                                     (bf16*)out + (rowbase + q0) * 1024 + hd * 128, t_hi - t_lo, q0 - t_lo * 64, sl2, ldsl, amref);
                } else {
                    if (bmaxfree)
                        attn_body::attn_unit<1000>((const attn_body::bf16*)(Zb + (long)q0 * ZP + 1536 + head * 64), (const attn_body::bf16*)(Zb + 2048 + (head >> 2) * 64), (const attn_body::bf16*)(Zb + 2176 + (head >> 2) * 64),
                                                   (attn_body::bf16*)(MIX + (rowbase + q0) * 1024 + 512 + head * 64), NT, (char*)lds, bbound);
                    else
                        attn_body::attn_unit<8>((const attn_body::bf16*)(Zb + (long)q0 * ZP + 1536 + head * 64), (const attn_body::bf16*)(Zb + 2048 + (head >> 2) * 64), (const attn_body::bf16*)(Zb + 2176 + (head >> 2) * 64),
                                                (attn_body::bf16*)(MIX + (rowbase + q0) * 1024 + 512 + head * 64), NT, (char*)lds);
                }
            }
        }
    }
#endif
    xcd_barrier(bar);

#ifndef NO_P2B
#ifdef PROBE_EW2
    for (int rep = 0; rep < 2; ++rep)
#endif
    {
        PHASE_IDS();
        const float d1 = wave_sum(lq1[lane] * lk1[lane]), d2 = wave_sum(lq2[lane] * lk2[lane]);
        const float lam = expf(d1) - expf(d2) + 0.2f;
        const int h = lane >> 4, e0 = (lane & 15) * 8;
        const f32x4 g0 = *(const f32x4*)(g_subln + e0), g1 = *(const f32x4*)(g_subln + e0 + 4);
        for (int m0 = gw * 4; m0 < M; m0 += NGW * 4) {
            v4u wa[4], wb[4];
#pragma unroll
            for (int r = 0; r < 4; ++r) { const bf16* o0 = (const bf16*)out + (size_t)(m0 + r) * 1024 + (h * 2) * 128 + e0; wa[r] = *(const v4u*)o0; wb[r] = *(const v4u*)(o0 + 128); }
#pragma unroll
            for (int r = 0; r < 4; ++r) {
                f32x4 a0, a1, b0, b1;
                a0.x = __uint_as_float(wa[r].x << 16); a0.y = __uint_as_float(wa[r].x & 0xffff0000u); a0.z = __uint_as_float(wa[r].y << 16); a0.w = __uint_as_float(wa[r].y & 0xffff0000u);
                a1.x = __uint_as_float(wa[r].z << 16); a1.y = __uint_as_float(wa[r].z & 0xffff0000u); a1.z = __uint_as_float(wa[r].w << 16); a1.w = __uint_as_float(wa[r].w & 0xffff0000u);
                b0.x = __uint_as_float(wb[r].x << 16); b0.y = __uint_as_float(wb[r].x & 0xffff0000u); b0.z = __uint_as_float(wb[r].y << 16); b0.w = __uint_as_float(wb[r].y & 0xffff0000u);
                b1.x = __uint_as_float(wb[r].z << 16); b1.y = __uint_as_float(wb[r].z & 0xffff0000u); b1.z = __uint_as_float(wb[r].w << 16); b1.w = __uint_as_float(wb[r].w & 0xffff0000u);
                a0 = a0 - lam * b0; a1 = a1 - lam * b1;
                float s2 = ((a0.x * a0.x + a0.y * a0.y) + (a0.z * a0.z + a0.w * a0.w)) + ((a1.x * a1.x + a1.y * a1.y) + (a1.z * a1.z + a1.w * a1.w));
                s2 += __shfl_xor(s2, 1); s2 += __shfl_xor(s2, 2); s2 += __shfl_xor(s2, 4); s2 += __shfl_xor(s2, 8);
                const float rstd = 0.8f / sqrtf(s2 * (1.0f / 128.0f) + 1e-5f);
                a0 = a0 * rstd * g0; a1 = a1 * rstd * g1;
                v4u w; w.x = pk2(a0.x, a0.y); w.y = pk2(a0.z, a0.w); w.z = pk2(a1.x, a1.y); w.w = pk2(a1.z, a1.w);
                *(v4u*)(MIX + (size_t)(m0 + r) * 1024 + h * 128 + e0) = w; }
        }
    }
#endif
    xcd_barrier(bar);

#ifndef NO_P3
#ifdef PROBE_GEMM2
    for (int rep = 0; rep < 2; ++rep)
#endif
    {
        pg8::Gemm g{MIX, WoutT, M, D, D}; pg8::StaticOrder S; S.init(M, D, G, bx);
        pg8::EpiRes<false> E{x_p, x_s, MP, HB, RSP1, 0};
        pg8::gemm_phase<pg8::EpiRes<false>, pg8::StaticOrder, true, true>(ldsl, g, S, E);
    }
#endif
    xcd_barrier(bar);

#ifndef NO_P45
    for (int ch = 0; ch < 3; ++ch) {
        const int r0 = ch * 16384;
#ifndef NO_FF1
#ifdef PROBE_GEMM2
        for (int rep = 0; rep < 2; ++rep)
#endif
        {
            pg8::Gemm g{HB + (size_t)r0 * D, W1T, 16384, FF, D}; pg8::StaticOrder S; S.init(16384, FF, G, bx);
            pg8::EpiFF1 E{RSP1, HH, r0};
            pg8::gemm_phase<pg8::EpiFF1, pg8::StaticOrder, true, true>(ldsl, g, S, E);
        }
#endif
        xcd_barrier(bar);
#ifndef NO_FF2
        {
            pg8::Gemm g{HH, W2T, 16384, D, FF}; pg8::StaticOrder S; S.init(16384, D, G, bx);
            pg8::EpiRes<true> E{nullptr, nullptr, 0, HB, RSP2, r0};
            pg8::gemm_phase<pg8::EpiRes<true>, pg8::StaticOrder, true, true>(ldsl, g, S, E);
        }
#endif
        xcd_barrier(bar);
    }

#endif
#ifndef NO_P6
    {
        pg8::Gemm g{HB, WgT, M, D, D}; pg8::StaticOrder S; S.init(M, D, G, bx);
        pg8::EpiGate E{RSP2, PROJ, HB, XN, RSP3};
        pg8::gemm_phase<pg8::EpiGate, pg8::StaticOrder, true, true>(ldsl, g, S, E);
    }
#endif
    xcd_barrier(bar);

#ifndef NO_P7
    {
        PHASE_IDS();
        f32x4 gv[4];
#pragma unroll
        for (int j = 0; j < 4; ++j) gv[j] = *((const f32x4*)g_final + lane + 64 * j);
        for (int m0 = gw * 4; m0 < M; m0 += NGW * 4) {
            unsigned long long w[4][4]; float rstd[4];
#pragma unroll
            for (int r = 0; r < 4; ++r) { const unsigned long long* hr = (const unsigned long long*)(XN + (size_t)(m0 + r) * D) + lane;
#pragma unroll
                for (int j = 0; j < 4; ++j) w[r][j] = hr[64 * j];
                rstd[r] = 1.0f / sqrtf(pg8::rs16(RSP3 + (size_t)(m0 + r) * 16) * (1.0f / D) + 1e-6f); }
#pragma unroll
            for (int r = 0; r < 4; ++r) { f32x4* xr = (f32x4*)(out + (size_t)(m0 + r) * D) + lane;
#pragma unroll
                for (int j = 0; j < 4; ++j) { const unsigned lo = (unsigned)w[r][j], hi2 = (unsigned)(w[r][j] >> 32);
                    f32x4 hv; hv.x = __uint_as_float(lo << 16); hv.y = __uint_as_float(lo & 0xffff0000u); hv.z = __uint_as_float(hi2 << 16); hv.w = __uint_as_float(hi2 & 0xffff0000u);
                    xr[64 * j] = hv * rstd[r] * gv[j]; } }
        }
    }
#endif
}

extern "C" void kernel_launch(void* const* d_in, const int* in_sizes, int n_in, void* d_out, int out_size, void* d_ws, size_t ws_size, hipStream_t stream) {
    static int grid = 0;
    if (grid == 0) {
        if (n_in != 21 || out_size != M * D || ws_size < WS_END) { fprintf(stderr, "kernel_launch: unexpected shapes (n_in %d out %d ws %zu)\n", n_in, out_size, ws_size); grid = -1; return; }
        int dev = 0, cus = 0, per_cu = 0;
        hipGetDevice(&dev); hipDeviceGetAttribute(&cus, hipDeviceAttributeMultiprocessorCount, dev);
        if (hipFuncSetAttribute((const void*)fwd_mega, hipFuncAttributeMaxDynamicSharedMemorySize, LDS_BYTES) != hipSuccess) { fprintf(stderr, "kernel_launch: hipFuncSetAttribute failed\n"); grid = -1; return; }
        if (hipOccupancyMaxActiveBlocksPerMultiprocessor(&per_cu, (const void*)fwd_mega, NWAVES * 64, LDS_BYTES) != hipSuccess || per_cu < 1) { fprintf(stderr, "kernel_launch: occupancy query gave %d\n", per_cu); per_cu = 1; }
        (void)hipGetLastError();
        grid = cus * per_cu;
    }
    if (grid < 0) return;
    if (hipMemsetAsync(d_ws, 0, CTL_BYTES, stream) != hipSuccess) { fprintf(stderr, "kernel_launch: memset failed\n"); return; }
    Args a{};
    for (int i = 0; i < 21; ++i) a.in[i] = (const float*)d_in[i];
    a.out = (float*)d_out; a.ws = (unsigned char*)d_ws;
    void* kargs[] = {&a};
    hipError_t e = hipLaunchCooperativeKernel((const void*)fwd_mega, dim3(grid), dim3(NWAVES * 64), kargs, LDS_BYTES, stream);
    if (e != hipSuccess) fprintf(stderr, "cooperative launch failed: %s (grid %d)\n", hipGetErrorString(e), grid);
}
```

```cpp
#include <hip/hip_runtime.h>
#include <hip/hip_bf16.h>
#include <hip/hip_cooperative_groups.h>
#include <cstdio>
#include <cstdint>
namespace cg = cooperative_groups;

namespace pg8 {
#define PG8_LAS __attribute__((address_space(3)))
typedef unsigned short bf16_t;
typedef short bf16x8 __attribute__((ext_vector_type(8)));
typedef float f32x4 __attribute__((ext_vector_type(4)));
typedef unsigned u32x4 __attribute__((ext_vector_type(4)));
constexpr int BM = 256, BK = 64, HALF = 128, HTB = HALF * BK * 2  , STAGE_BYTES = 8 * HTB, NXCD = 8, WGM = 8;

__host__ __device__ __forceinline__ int lds_byte(int r, int c) { const int st = (r >> 4) * 2 + (c >> 5), rr = r & 15, cc = c & 31, ob = rr * 64 + cc * 2; return st * 1024 + (ob ^ (((ob >> 9) & 1) << 5)); }
__host__ __device__ __forceinline__ void stage_rc(int b, int& R, int& C) { const int st = b / 1024, sb = b % 1024, swz = sb ^ (((sb >> 9) & 1) << 5); R = (st >> 1) * 16 + swz / 64; C = (st & 1) * 32 + (swz % 64) / 2; }
__host__ __device__ __forceinline__ int perm32(int rho) { const int n = rho >> 4, i = rho & 15; return 8 * (i >> 2) + 4 * n + (i & 3); }

struct Unit { int pm, pn; };
struct Gemm { const bf16_t* A; const bf16_t* Bt; int M, N, K; };

struct StaticOrder {
    int nM, nN, nwg, G, c;
    __host__ __device__ void init(int M, int N, int G_, int c_) { nM = M / BM; nN = N / BM; nwg = nM * nN; G = G_; c = c_; }
    __host__ __device__ bool next(int i, Unit& u) const {
        const long L = (long)i * G + c; if (L >= nwg) return false;
        int wgid = (int)L; { const int q = nwg / NXCD, r = nwg % NXCD, xcd = wgid % NXCD, off = wgid / NXCD; wgid = (xcd < r ? xcd * (q + 1) : r * (q + 1) + (xcd - r) * q) + off; }
        const int nig = WGM * nN, gid = wgid / nig, fm = gid * WGM, gsz = (nM - fm) < WGM ? (nM - fm) : WGM;
        u.pm = fm + ((wgid % nig) % gsz); u.pn = (wgid % nig) / gsz; return true;
    }
    __device__ __forceinline__ void a_ready(const Unit&) const {}
    __device__ __forceinline__ void done(const Unit&) const {}
};

__device__ __forceinline__ unsigned cvt_pk_bf16(float lo, float hi) { unsigned r; asm volatile("v_cvt_pk_bf16_f32 %0, %1, %2" : "=v"(r) : "v"(lo), "v"(hi)); return r; }
typedef float f32x2 __attribute__((ext_vector_type(2)));
typedef unsigned u32x2 __attribute__((ext_vector_type(2)));
__device__ __forceinline__ float rs16(const float* p) {
    const f32x4 a = *(const f32x4*)p, b = *(const f32x4*)(p + 4), c = *(const f32x4*)(p + 8), d = *(const f32x4*)(p + 12);
    return (((a[0] + a[1]) + (a[2] + a[3])) + ((b[0] + b[1]) + (b[2] + b[3]))) + (((c[0] + c[1]) + (c[2] + c[3])) + ((d[0] + d[1]) + (d[2] + d[3])));
}
struct EpiBf {
    static constexpr bool PERM = true, AFTER_DRAIN = false;
    bf16_t* O; int ldc; float scale_q; int nq_tiles;
    __device__ __forceinline__ void operator()(const f32x4 (&acc)[2][2][4][2], const Unit& u, int wr, int wc, int fr, int fq) const {
        const int row0 = u.pm * BM + wr * 64 + fr, col0 = u.pn * BM + wc * 32 + 8 * fq; const float sc = (u.pn < nq_tiles) ? scale_q : 1.f;
#pragma unroll
        for (int ai = 0; ai < 2; ++ai)
#pragma unroll
            for (int m = 0; m < 4; ++m) { bf16_t* rowp = O + (size_t)(row0 + ai * HALF + m * 16) * ldc + col0;
#pragma unroll
                for (int bj = 0; bj < 2; ++bj) { const f32x4 v0 = acc[ai][bj][m][0] * sc, v1 = acc[ai][bj][m][1] * sc;
                    u32x4 w; w.x = cvt_pk_bf16(v0[0], v0[1]); w.y = cvt_pk_bf16(v0[2], v0[3]); w.z = cvt_pk_bf16(v1[0], v1[1]); w.w = cvt_pk_bf16(v1[2], v1[3]);
                    *(u32x4*)(rowp + bj * HALF) = w; } }
    }
};
template <bool BASE_BF16> struct EpiRes {
    static constexpr bool PERM = false, AFTER_DRAIN = false;
    const float* base0; const float* base1; int split_row; bf16_t* hb; float* rsp; int row_off;
    __device__ __forceinline__ void operator()(const f32x4 (&acc)[2][2][4][2], const Unit& u, int wr, int wc, int fr, int fq) const {
        const int col0 = u.pn * BM + wc * 32 + 4 * fq;
#pragma unroll
        for (int ai = 0; ai < 2; ++ai)
#pragma unroll
            for (int m = 0; m < 4; ++m) { const int row = row_off + u.pm * BM + ai * HALF + wr * 64 + m * 16 + fr;
                const float* bp = row < split_row ? base0 + (size_t)row * 1024 : base1 + (size_t)(row - split_row) * 1024;
                bf16_t* hp = hb + (size_t)row * 1024; float s = 0.f;
#pragma unroll
                for (int bj = 0; bj < 2; ++bj)
#pragma unroll
                    for (int n = 0; n < 2; ++n) { const int c = col0 + bj * HALF + n * 16; f32x4 b;
                        if constexpr (BASE_BF16) { const u32x2 pw = *(const u32x2*)(hp + c);
                            b[0] = __uint_as_float(pw.x << 16); b[1] = __uint_as_float(pw.x & 0xffff0000u); b[2] = __uint_as_float(pw.y << 16); b[3] = __uint_as_float(pw.y & 0xffff0000u); }
                        else b = *(const f32x4*)(bp + c);
                        const f32x4 v = b + acc[ai][bj][m][n];
                        s += (v[0] * v[0] + v[1] * v[1]) + (v[2] * v[2] + v[3] * v[3]);
                        u32x2 w; w.x = cvt_pk_bf16(v[0], v[1]); w.y = cvt_pk_bf16(v[2], v[3]); *(u32x2*)(hp + c) = w; }
                s += __shfl_xor(s, 16); s += __shfl_xor(s, 32);
                if (fq == 0) rsp[(size_t)row * 16 + u.pn * 4 + wc] = s; }
    }
};
struct EpiFF1 {
    static constexpr bool PERM = true, AFTER_DRAIN = false;
    const float* rsp; bf16_t* H; int row_off;
    __device__ __forceinline__ void operator()(const f32x4 (&acc)[2][2][4][2], const Unit& u, int wr, int wc, int fr, int fq) const {
        const int col0 = u.pn * BM + wc * 32 + 8 * fq;
#pragma unroll
        for (int ai = 0; ai < 2; ++ai)
#pragma unroll
            for (int m = 0; m < 4; ++m) { const int lrow = u.pm * BM + ai * HALF + wr * 64 + m * 16 + fr;
                const float rstd = 1.0f / sqrtf(rs16(rsp + (size_t)(row_off + lrow) * 16) * (1.0f / 1024.0f) + 1e-6f);
                bf16_t* rowp = H + (size_t)lrow * 4096 + col0;
#pragma unroll
                for (int bj = 0; bj < 2; ++bj) { f32x4 v0 = acc[ai][bj][m][0] * rstd, v1 = acc[ai][bj][m][1] * rstd;
#pragma unroll
                    for (int e = 0; e < 4; ++e) { const float a = fmaxf(v0[e], 0.f), b = fmaxf(v1[e], 0.f); v0[e] = a * a; v1[e] = b * b; }
                    u32x4 w; w.x = cvt_pk_bf16(v0[0], v0[1]); w.y = cvt_pk_bf16(v0[2], v0[3]); w.z = cvt_pk_bf16(v1[0], v1[1]); w.w = cvt_pk_bf16(v1[2], v1[3]);
                    *(u32x4*)(rowp + bj * HALF) = w; }
                asm volatile("" ::: "memory"); }
    }
};
struct EpiGate {
    static constexpr bool PERM = false, AFTER_DRAIN = false;
    const float* rsp_in; const bf16_t* proj; const bf16_t* hb_in; bf16_t* hb_out; float* rsp_out;
    __device__ __forceinline__ void operator()(const f32x4 (&acc)[2][2][4][2], const Unit& u, int wr, int wc, int fr, int fq) const {
        const int col0 = u.pn * BM + wc * 32 + 4 * fq;
#pragma unroll
        for (int ai = 0; ai < 2; ++ai)
#pragma unroll
            for (int m = 0; m < 4; ++m) { const int row = u.pm * BM + ai * HALF + wr * 64 + m * 16 + fr;
                const float rstd = 1.0f / sqrtf(rs16(rsp_in + (size_t)row * 16) * (1.0f / 1024.0f) + 1e-6f);
                const bf16_t* ip = hb_in + (size_t)row * 1024; bf16_t* op = hb_out + (size_t)row * 1024; const bf16_t* pp = proj + (size_t)row * 1024; float s = 0.f;
#pragma unroll
                for (int bj = 0; bj < 2; ++bj)
#pragma unroll
                    for (int n = 0; n < 2; ++n) { const int c = col0 + bj * HALF + n * 16; const f32x4 a = acc[ai][bj][m][n] * rstd;
                        const u32x2 pw = *(const u32x2*)(pp + c), hw = *(const u32x2*)(ip + c);
                        f32x4 pr, h2; pr[0] = __uint_as_float(pw.x << 16); pr[1] = __uint_as_float(pw.x & 0xffff0000u); pr[2] = __uint_as_float(pw.y << 16); pr[3] = __uint_as_float(pw.y & 0xffff0000u);
                        h2[0] = __uint_as_float(hw.x << 16); h2[1] = __uint_as_float(hw.x & 0xffff0000u); h2[2] = __uint_as_float(hw.y << 16); h2[3] = __uint_as_float(hw.y & 0xffff0000u);
                        f32x4 g;
#pragma unroll
                        for (int e2 = 0; e2 < 4; ++e2) g[e2] = __builtin_amdgcn_rcpf(1.0f + __builtin_amdgcn_exp2f(-1.4426950408889634f * a[e2]));
                        const f32x4 v = h2 + g * pr;
                        s += (v[0] * v[0] + v[1] * v[1]) + (v[2] * v[2] + v[3] * v[3]);
                        u32x2 w; w.x = cvt_pk_bf16(v[0], v[1]); w.y = cvt_pk_bf16(v[2], v[3]); *(u32x2*)(op + c) = w; }
                s += __shfl_xor(s, 16); s += __shfl_xor(s, 32);
                if (fq == 0) rsp_out[(size_t)row * 16 + u.pn * 4 + wc] = s;
                asm volatile("" ::: "memory"); }
    }
};
template <class Epi, class Sched, bool ALIGN_EPI = false, bool SP2 = false>
__device__ __forceinline__ void gemm_phase(PG8_LAS unsigned char* lds, const Gemm g, const Sched& S, const Epi& E) {
    int tid_ = threadIdx.x; asm volatile("" : "+v"(tid_));
    const int tid = tid_, wid = __builtin_amdgcn_readfirstlane(tid >> 6), lane = tid & 63, wr = wid >> 2, wc = wid & 3, fr = lane & 15, fq = lane >> 4;
    const int K = g.K, nt = K / BK;
    unsigned voffA[2], voffB[2];
#pragma unroll
    for (int i = 0; i < 2; ++i) { int R, C; stage_rc(tid * 16 + i * 8192, R, C); const int Rb = Epi::PERM ? ((R & ~31) + perm32(R & 31)) : R;
        voffA[i] = (unsigned)(R * K + C) * 2u; voffB[i] = (unsigned)(Rb * K + C) * 2u; }
    const size_t kstep = (size_t)(BK * 2);
    const size_t hstep = (size_t)HALF * K * 2;
    const size_t tstep = 2 * hstep;
    const unsigned ldsw = (unsigned)wid * 1024u;
    const int aoff = lds_byte(wr * 64 + fr, fq * 8), boff = lds_byte(wc * 32 + fr, fq * 8);
#define PG8_SA(b, h) (((b) * 2 + (h)) * HTB)
#define PG8_SB(b, h) ((4 + (b) * 2 + (h)) * HTB)
#define PG8_STAGE(bufoff, gbase, voff) do { _Pragma("unroll") for (int _i = 0; _i < 2; ++_i) \
        __builtin_amdgcn_global_load_lds((const unsigned*)((const char*)(gbase) + (voff)[_i]), (PG8_LAS unsigned*)(lds + (bufoff) + ldsw + _i * 8192), 16, 0, 0); } while (0)
#define PG8_LDA(dst, b, h) do { _Pragma("unroll") for (int m = 0; m < 4; ++m) _Pragma("unroll") for (int k = 0; k < 2; ++k) dst[m][k] = *(const PG8_LAS bf16x8*)(lds + PG8_SA(b, h) + aoff + m * 2048 + k * 1024); } while (0)
#define PG8_LDB(dst, b, h) do { _Pragma("unroll") for (int n = 0; n < 2; ++n) _Pragma("unroll") for (int k = 0; k < 2; ++k) dst[n][k] = *(const PG8_LAS bf16x8*)(lds + PG8_SB(b, h) + boff + n * 2048 + k * 1024); } while (0)
#define PG8_MMA(ai, bj, At, Bt) do { __builtin_amdgcn_s_setprio(1); _Pragma("unroll") for (int m = 0; m < 4; ++m) _Pragma("unroll") for (int n = 0; n < 2; ++n) _Pragma("unroll") for (int k = 0; k < 2; ++k) \
        acc[ai][bj][m][n] = __builtin_amdgcn_mfma_f32_16x16x32_bf16(Bt[n][k], At[m][k], acc[ai][bj][m][n], 0, 0, 0); __builtin_amdgcn_s_setprio(0); } while (0)
#define PG8_WAIT_V(n) asm volatile("s_waitcnt vmcnt(" #n ")" ::: "memory")
#define PG8_WAIT_L(n) asm volatile("s_waitcnt lgkmcnt(" #n ")" ::: "memory")
#define PG8_BAR __builtin_amdgcn_s_barrier()
#define PG8_SCHED __builtin_amdgcn_sched_barrier(0)
    Unit cur, nxt; int ui = 0;
    if (!S.next(0, cur)) return;
    f32x4 acc[2][2][4][2];
#pragma unroll
    for (int a = 0; a < 2; ++a)
#pragma unroll
        for (int b = 0; b < 2; ++b)
#pragma unroll
            for (int m = 0; m < 4; ++m)
#pragma unroll
                for (int n = 0; n < 2; ++n) acc[a][b][m][n] = (f32x4){0.f, 0.f, 0.f, 0.f};
    bf16x8 At[4][2], B0[2][2], B1[2][2];
    const char* cA = (const char*)g.A + (size_t)cur.pm * tstep; const char* cB = (const char*)g.Bt + (size_t)cur.pn * tstep;
    S.a_ready(cur);
    if constexpr (SP2) {
        PG8_STAGE(PG8_SB(0, 0), cB, voffB); PG8_STAGE(PG8_SB(0, 1), cB + hstep, voffB); PG8_STAGE(PG8_SA(0, 0), cA, voffA); PG8_STAGE(PG8_SA(0, 1), cA + hstep, voffA);
        if (wr == 1) PG8_BAR;
        PG8_WAIT_V(2); PG8_BAR;
        PG8_STAGE(PG8_SB(1, 0), cB + kstep, voffB); PG8_STAGE(PG8_SA(1, 0), cA + kstep, voffA); PG8_STAGE(PG8_SB(1, 1), cB + hstep + kstep, voffB);
        PG8_WAIT_V(6); PG8_BAR;
    } else {
        PG8_STAGE(PG8_SB(0, 0), cB, voffB); PG8_STAGE(PG8_SA(0, 0), cA, voffA); PG8_STAGE(PG8_SB(0, 1), cB + hstep, voffB); PG8_STAGE(PG8_SA(0, 1), cA + hstep, voffA);
        if (wr == 1) PG8_BAR;
        PG8_WAIT_V(4); PG8_BAR;
        PG8_STAGE(PG8_SB(1, 0), cB + kstep, voffB); PG8_STAGE(PG8_SA(1, 0), cA + kstep, voffA); PG8_STAGE(PG8_SB(1, 1), cB + hstep + kstep, voffB);
        PG8_WAIT_V(6); PG8_BAR;
    }
    for (;;) {
        const bool has_next = S.next(ui + 1, nxt);
        const char* nA = has_next ? (const char*)g.A + (size_t)nxt.pm * tstep : cA; const char* nB = has_next ? (const char*)g.Bt + (size_t)nxt.pn * tstep : cB;
        for (int t = 0; t < nt; t += 2) {
            const bool last = (t == nt - 2);
            const char* a1 = cA + (size_t)(t + 1) * kstep;
            const char* a2 = last ? nA : cA + (size_t)(t + 2) * kstep; const char* b2 = last ? nB : cB + (size_t)(t + 2) * kstep;
            const char* a3 = a2 + kstep; const char* b3 = b2 + kstep;
            if (last && has_next) S.a_ready(nxt);
            if constexpr (SP2) {
            PG8_LDB(B0, 0, 0); PG8_LDB(B1, 0, 1); PG8_SCHED; PG8_LDA(At, 0, 0); PG8_STAGE(PG8_SA(1, 1), a1 + hstep, voffA);
            PG8_WAIT_V(8); PG8_WAIT_L(0); PG8_BAR; PG8_MMA(0, 0, At, B0); PG8_MMA(0, 1, At, B1); PG8_BAR; PG8_SCHED;
            PG8_LDA(At, 0, 1); PG8_STAGE(PG8_SB(0, 0), b2, voffB); PG8_STAGE(PG8_SB(0, 1), b2 + hstep, voffB); PG8_STAGE(PG8_SA(0, 0), a2, voffA);
            PG8_WAIT_V(8); PG8_WAIT_L(0); PG8_BAR; PG8_MMA(1, 0, At, B0); PG8_MMA(1, 1, At, B1); PG8_BAR; PG8_SCHED;
            PG8_LDB(B0, 1, 0); PG8_LDB(B1, 1, 1); PG8_SCHED; PG8_LDA(At, 1, 0); PG8_STAGE(PG8_SA(0, 1), a2 + hstep, voffA);
            PG8_WAIT_V(8); PG8_WAIT_L(0); PG8_BAR; PG8_MMA(0, 0, At, B0); PG8_MMA(0, 1, At, B1); PG8_BAR; PG8_SCHED;
            PG8_LDA(At, 1, 1); PG8_STAGE(PG8_SB(1, 0), b3, voffB); PG8_STAGE(PG8_SB(1, 1), b3 + hstep, voffB); PG8_STAGE(PG8_SA(1, 0), a3, voffA);
            PG8_WAIT_V(8); PG8_WAIT_L(0); PG8_BAR; PG8_MMA(1, 0, At, B0); PG8_MMA(1, 1, At, B1); PG8_BAR; PG8_SCHED;
            } else {
            PG8_LDB(B0, 0, 0); PG8_SCHED; PG8_LDA(At, 0, 0); PG8_STAGE(PG8_SA(1, 1), a1 + hstep, voffA);
            PG8_WAIT_L(8); PG8_BAR; PG8_WAIT_L(0); PG8_MMA(0, 0, At, B0); PG8_BAR; PG8_SCHED;
            PG8_LDB(B1, 0, 1); PG8_STAGE(PG8_SB(0, 0), b2, voffB);
            PG8_BAR; PG8_WAIT_L(0); PG8_MMA(0, 1, At, B1); PG8_BAR;
            PG8_LDA(At, 0, 1); PG8_STAGE(PG8_SA(0, 0), a2, voffA);
            PG8_BAR; PG8_WAIT_L(0); PG8_MMA(1, 0, At, B0); PG8_BAR; PG8_SCHED;
            PG8_STAGE(PG8_SB(0, 1), b2 + hstep, voffB);
            PG8_WAIT_V(6); PG8_BAR; PG8_MMA(1, 1, At, B1); PG8_BAR;
            PG8_LDB(B0, 1, 0); PG8_SCHED; PG8_LDA(At, 1, 0); PG8_STAGE(PG8_SA(0, 1), a2 + hstep, voffA);
            PG8_WAIT_L(8); PG8_BAR; PG8_WAIT_L(0); PG8_MMA(0, 0, At, B0); PG8_BAR; PG8_SCHED;
            PG8_LDB(B1, 1, 1); PG8_STAGE(PG8_SB(1, 0), b3, voffB);
            PG8_BAR; PG8_WAIT_L(0); PG8_MMA(0, 1, At, B1); PG8_BAR;
            PG8_LDA(At, 1, 1); PG8_STAGE(PG8_SA(1, 0), a3, voffA);
            PG8_BAR; PG8_WAIT_L(0); PG8_MMA(1, 0, At, B0); PG8_BAR; PG8_SCHED;
            PG8_STAGE(PG8_SB(1, 1), b3 + hstep, voffB);
            PG8_WAIT_V(6); PG8_BAR; PG8_MMA(1, 1, At, B1); PG8_BAR;
            }
        }
        if constexpr (ALIGN_EPI) { if (wr == 0) PG8_BAR; }
        if constexpr (!Epi::AFTER_DRAIN) { E(acc, cur, wr, wc, fr, fq); S.done(cur); }
        if (!has_next) break;
#pragma unroll
        for (int a = 0; a < 2; ++a)
#pragma unroll
            for (int b = 0; b < 2; ++b)
#pragma unroll
                for (int m = 0; m < 4; ++m)
#pragma unroll
                    for (int n = 0; n < 2; ++n) acc[a][b][m][n] = (f32x4){0.f, 0.f, 0.f, 0.f};
        cur = nxt; cA = nA; cB = nB; ++ui;
        if constexpr (ALIGN_EPI) { if (wr == 1) PG8_BAR; }
    }
    PG8_WAIT_V(0);
    if constexpr (!ALIGN_EPI) { if (wr == 0) PG8_BAR; }
    PG8_BAR;
    if constexpr (Epi::AFTER_DRAIN) { E.fused(acc, cur, wr, wc, fr, fq, lds, wid, lane); S.done(cur); }
#undef PG8_SA
#undef PG8_SB
#undef PG8_STAGE
#undef PG8_LDA
#undef PG8_LDB
#undef PG8_MMA
#undef PG8_WAIT_V
#undef PG8_WAIT_L
#undef PG8_BAR
#undef PG8_SCHED
}
}
namespace att {
typedef unsigned short bf16_t;
using bf16x8 = __attribute__((ext_vector_type(8))) short;
using s16x4  = __attribute__((ext_vector_type(4))) short;
using f32x16 = __attribute__((ext_vector_type(16))) float;
using u32x4  = __attribute__((ext_vector_type(4))) unsigned;
constexpr int LDZ = 2368;
constexpr int SHM_V = 16384, SHM_K = 8192;
constexpr int ATTN_LDS = 2 * SHM_V + 2 * SHM_K + 8 * 64 * 4;
constexpr float THR2 = 8.0f;
#define KSWZ64(row, colB) ((row) * 128 + ((colB) ^ ((((row) >> 1) & 7) << 4)))
#define SBAR() __builtin_amdgcn_sched_barrier(0)
__device__ __forceinline__ int crow(int r, int hi) { return (r & 3) + 8 * (r >> 2) + 4 * hi; }
__device__ __forceinline__ unsigned cvtpk(float lo, float hi) { unsigned r; asm volatile("v_cvt_pk_bf16_f32 %0, %1, %2" : "=v"(r) : "v"(lo), "v"(hi)); return r; }
__device__ __forceinline__ unsigned short f2bf(float f) { unsigned u = __builtin_bit_cast(unsigned, f); return (unsigned short)((u + 0x7fffu + ((u >> 16) & 1u)) >> 16); }

template <bool ALIBI>
__device__ __forceinline__ void partialSM(f32x16& p0, f32x16& p1, float& m_reg, float& alpha, float dq, float sl2) {
  if constexpr (ALIBI) {
#pragma unroll
    for (int r = 0; r < 16; ++r) { const float t0 = dq - (float)((r & 3) + 8 * (r >> 2)); const float t1 = t0 - 32.f;
      p0[r] = fmaf(-sl2, fabsf(t0), p0[r]); p1[r] = fmaf(-sl2, fabsf(t1), p1[r]); }
  }
  float pmax = p0[0];
#pragma unroll
  for (int r = 1; r < 16; ++r) pmax = fmaxf(pmax, p0[r]);
#pragma unroll
  for (int r = 0; r < 16; ++r) pmax = fmaxf(pmax, p1[r]);
  { auto rr = __builtin_amdgcn_permlane32_swap(__float_as_uint(pmax), __float_as_uint(pmax), false, false);
    pmax = fmaxf(__uint_as_float(rr[0]), __uint_as_float(rr[1])); }
  float mn;
  if (__builtin_expect(__all(pmax - m_reg <= THR2), 1)) { mn = m_reg; alpha = 1.f; }
  else { mn = fmaxf(m_reg, pmax); alpha = __builtin_amdgcn_exp2f(m_reg - mn); m_reg = mn; }
#pragma unroll
  for (int r = 0; r < 16; ++r) { p0[r] -= mn; p1[r] -= mn; }
#pragma unroll
  for (int r = 0; r < 16; ++r) p0[r] = __builtin_amdgcn_exp2f(p0[r]);
}
__device__ __forceinline__ void finishSM(f32x16& p0, f32x16& p1, float alpha, float& l_reg, bf16x8& pa0, bf16x8& pa1, bf16x8& pa2, bf16x8& pa3) {
#pragma unroll
  for (int r = 0; r < 16; ++r) p1[r] = __builtin_amdgcn_exp2f(p1[r]);
  float ps = 0;
#pragma unroll
  for (int r = 0; r < 16; ++r) ps += p0[r];
#pragma unroll
  for (int r = 0; r < 16; ++r) ps += p1[r];
  { auto rr = __builtin_amdgcn_permlane32_swap(__float_as_uint(ps), __float_as_uint(ps), false, false);
    ps = __uint_as_float(rr[0]) + __uint_as_float(rr[1]); }
  l_reg = l_reg * alpha + ps;
#define PK4(P, BASE, OUT) do { unsigned a0 = cvtpk(P[BASE + 0], P[BASE + 1]), a1 = cvtpk(P[BASE + 2], P[BASE + 3]);   \
    unsigned b0 = cvtpk(P[BASE + 4], P[BASE + 5]), b1 = cvtpk(P[BASE + 6], P[BASE + 7]);                              \
    auto r0 = __builtin_amdgcn_permlane32_swap(a0, b0, false, false); auto r1 = __builtin_amdgcn_permlane32_swap(a1, b1, false, false); \
    u32x4 w = {r0[0], r1[0], r0[1], r1[1]}; OUT = *reinterpret_cast<bf16x8*>(&w); } while (0)
  PK4(p0, 0, pa0); PK4(p0, 8, pa1); PK4(p1, 0, pa2); PK4(p1, 8, pa3);
#undef PK4
}
__device__ __forceinline__ void qkt(f32x16& p0, f32x16& p1, const char* Ks, const bf16x8* qr, int r32, int hi) {
  p0 = f32x16{}; p1 = f32x16{};
#pragma unroll
  for (int d0 = 0; d0 < 4; ++d0) { const int cb = (d0 * 16 + hi * 8) * 2;
    const bf16x8 b0 = *reinterpret_cast<const bf16x8*>(Ks + KSWZ64(r32, cb));
    const bf16x8 b1 = *reinterpret_cast<const bf16x8*>(Ks + 4096 + KSWZ64(r32, cb));
    p0 = __builtin_amdgcn_mfma_f32_32x32x16_bf16(b0, qr[d0], p0, 0, 0, 0);
    p1 = __builtin_amdgcn_mfma_f32_32x32x16_bf16(b1, qr[d0], p1, 0, 0, 0); }
}
template <int NCB> __device__ __forceinline__ int v_st(int k, int c) { const int kk = (k & ~0xC) | ((k & 4) << 1) | ((k & 8) >> 1); return ((kk >> 3) * NCB + (c >> 5)) * 512 + ((kk & 7) * 32 + (c & 31)) * 2; }
__device__ __forceinline__ int v_rd_base(int lane) { return ((lane & 3) << 3) | (((lane >> 2) & 3) << 6) | (((lane >> 4) & 1) << 5) | (((lane >> 5) & 1) << 8); }
template <int OFF> __device__ __forceinline__ s16x4 tr_read(int vb) {
  s16x4 r; asm volatile("ds_read_b64_tr_b16 %0, %1 offset:%2" : "=&v"(r) : "v"(vb), "i"(OFF) : "memory"); return r;
}
template <int NCB, int D0> __device__ __forceinline__ void pv_one(f32x16& od, int vb, bf16x8 pa0, bf16x8 pa1, bf16x8 pa2, bf16x8 pa3) {
  constexpr int KS = NCB * 1024, HF = NCB * 512, B0 = D0 * 512;
  const s16x4 l0 = tr_read<B0>(vb), h0 = tr_read<B0 + HF>(vb), l1 = tr_read<B0 + KS>(vb), h1 = tr_read<B0 + KS + HF>(vb);
  const s16x4 l2 = tr_read<B0 + 2 * KS>(vb), h2 = tr_read<B0 + 2 * KS + HF>(vb), l3 = tr_read<B0 + 3 * KS>(vb), h3 = tr_read<B0 + 3 * KS + HF>(vb);
  asm volatile("s_waitcnt lgkmcnt(0)" ::: "memory"); SBAR();
#define PK(L, H) (bf16x8){L[0], L[1], L[2], L[3], H[0], H[1], H[2], H[3]}
  od = __builtin_amdgcn_mfma_f32_32x32x16_bf16(pa0, PK(l0, h0), od, 0, 0, 0);
  od = __builtin_amdgcn_mfma_f32_32x32x16_bf16(pa1, PK(l1, h1), od, 0, 0, 0);
  od = __builtin_amdgcn_mfma_f32_32x32x16_bf16(pa2, PK(l2, h2), od, 0, 0, 0);
  od = __builtin_amdgcn_mfma_f32_32x32x16_bf16(pa3, PK(l3, h3), od, 0, 0, 0);
#undef PK
}
template <int NCB> __device__ __forceinline__ void pv_all(f32x16* o, int vb, bf16x8 pa0, bf16x8 pa1, bf16x8 pa2, bf16x8 pa3) {
  pv_one<NCB, 0>(o[0], vb, pa0, pa1, pa2, pa3); pv_one<NCB, 1>(o[1], vb, pa0, pa1, pa2, pa3);
  if constexpr (NCB == 4) { pv_one<NCB, 2>(o[2], vb, pa0, pa1, pa2, pa3); pv_one<NCB, 3>(o[3], vb, pa0, pa1, pa2, pa3); }
}
__device__ __forceinline__ void store_o(float* p, float v) { *p = v; }
__device__ __forceinline__ void store_o(bf16_t* p, float v) { *p = f2bf(v); }

template <int DV, bool ALIBI, typename TO>
__device__ __forceinline__ void attn_unit(const bf16_t* __restrict__ Qb, const bf16_t* __restrict__ Kh, const bf16_t* __restrict__ Vh, TO* __restrict__ Ob, int seq, int qpos0, float sl2, char* lds) {
  constexpr int NCB = DV / 32;
  const int tid = threadIdx.x, wid = tid >> 6, lane = tid & 63, r32 = lane & 31, hi = lane >> 5;
  char* V_lds = lds; char* K_lds = lds + 2 * SHM_V;
  float* ws = (float*)(lds + 2 * SHM_V + 2 * SHM_K) + wid * 64; float* li_l = ws; float* al_l = ws + 32;
  float m_reg = -1e30f, l_reg = 0; f32x16 o[NCB];
#pragma unroll
  for (int d = 0; d < NCB; ++d) o[d] = f32x16{};
  bf16x8 qr[4];
  const bf16_t* Qw = Qb + (long)(wid * 32 + r32) * LDZ + hi * 8;
#pragma unroll
  for (int d0 = 0; d0 < 4; ++d0) qr[d0] = *reinterpret_cast<const bf16x8*>(Qw + d0 * 16);
  const float dq0 = (float)(qpos0 + wid * 32 + r32 - 4 * hi);
  const int kr = tid >> 3, kc = (tid & 7) * 8, kst = KSWZ64(kr, kc * 2);
  const int sr = tid >> 4, sc = (tid & 15) * 8;
  const int vst0 = (DV == 128) ? v_st<NCB>(sr, sc) : v_st<NCB>(kr, kc), vst1 = v_st<NCB>(32 + sr, sc);
  const int vb0 = (int)(uintptr_t)V_lds + v_rd_base(lane);
  bf16x8 sv0[2], sv1[2], sk[2];
#define SLOAD(i, k0) do { if constexpr (DV == 128) { sv0[i] = *reinterpret_cast<const bf16x8*>(&Vh[(long)((k0) + sr) * LDZ + sc]); sv1[i] = *reinterpret_cast<const bf16x8*>(&Vh[(long)((k0) + 32 + sr) * LDZ + sc]); } \
    else { sv0[i] = *reinterpret_cast<const bf16x8*>(&Vh[(long)((k0) + kr) * LDZ + kc]); } \
    sk[i] = *reinterpret_cast<const bf16x8*>(&Kh[(long)((k0) + kr) * LDZ + kc]); } while (0)
#define SWRITE(b, i) do { *(bf16x8*)(V_lds + (b) * SHM_V + vst0) = sv0[i]; if constexpr (DV == 128) { *(bf16x8*)(V_lds + (b) * SHM_V + vst1) = sv1[i]; } \
    *(bf16x8*)(K_lds + (b) * SHM_K + kst) = sk[i]; } while (0)
#define SWAIT() do { if constexpr (DV == 128) asm volatile("s_waitcnt vmcnt(3)" ::: "memory"); else asm volatile("s_waitcnt vmcnt(2)" ::: "memory"); } while (0)
#define RESC(a) do { if (__any((a) < 1.f)) { if (hi == 0) al_l[r32] = (a); asm volatile("s_waitcnt lgkmcnt(0)" ::: "memory"); \
    _Pragma("unroll") for (int d = 0; d < NCB; ++d) _Pragma("unroll") for (int r = 0; r < 16; ++r) o[d][r] *= al_l[crow(r, hi)]; } } while (0)
  f32x16 pA0, pA1, pB0, pB1; float alA, alB; bf16x8 pa0, pa1, pa2, pa3; const int NT = seq / 64;
  SLOAD(0, 0); asm volatile("s_waitcnt vmcnt(0)" ::: "memory"); SWRITE(0, 0); __syncthreads();
  qkt(pA0, pA1, K_lds, qr, r32, hi); partialSM<ALIBI>(pA0, pA1, m_reg, alA, dq0, sl2);
  SLOAD(1, 64); if (2 < NT) SLOAD(0, 128);
  SWAIT(); SWRITE(1, 1); __syncthreads();
  for (int j = 1; j + 1 < NT; j += 2) {
    SBAR(); qkt(pB0, pB1, K_lds + SHM_K, qr, r32, hi);
    finishSM(pA0, pA1, alA, l_reg, pa0, pa1, pa2, pa3); SBAR();
    SLOAD(1, (j + 2) * 64); SBAR();
    pv_all<NCB>(o, vb0, pa0, pa1, pa2, pa3); partialSM<ALIBI>(pB0, pB1, m_reg, alB, dq0 - 64.f * (float)j, sl2);
    __syncthreads(); SWAIT(); SWRITE(0, 0);
    RESC(alB); __syncthreads();
    SBAR(); qkt(pA0, pA1, K_lds, qr, r32, hi);
    finishSM(pB0, pB1, alB, l_reg, pa0, pa1, pa2, pa3); SBAR();
    if (j + 3 < NT) SLOAD(0, (j + 3) * 64); SBAR();
    pv_all<NCB>(o, vb0 + SHM_V, pa0, pa1, pa2, pa3); partialSM<ALIBI>(pA0, pA1, m_reg, alA, dq0 - 64.f * (float)(j + 1), sl2);
    __syncthreads(); SWAIT(); SWRITE(1, 1);
    RESC(alA); __syncthreads();
  }
  SBAR(); qkt(pB0, pB1, K_lds + SHM_K, qr, r32, hi);
  finishSM(pA0, pA1, alA, l_reg, pa0, pa1, pa2, pa3); SBAR();
  pv_all<NCB>(o, vb0, pa0, pa1, pa2, pa3); partialSM<ALIBI>(pB0, pB1, m_reg, alB, dq0 - 64.f * (float)(NT - 1), sl2);
  __syncthreads(); RESC(alB);
  finishSM(pB0, pB1, alB, l_reg, pa0, pa1, pa2, pa3); SBAR();
  pv_all<NCB>(o, vb0 + SHM_V, pa0, pa1, pa2, pa3);
  if (hi == 0) li_l[r32] = l_reg; asm volatile("s_waitcnt lgkmcnt(0)" ::: "memory");
  float rli[16];
#pragma unroll
  for (int r = 0; r < 16; ++r) rli[r] = __builtin_amdgcn_rcpf(li_l[crow(r, hi)]);
  TO* Ow = Ob + (long)(wid * 32) * 1024;
#pragma unroll
  for (int r = 0; r < 16; ++r) { const int orow = crow(r, hi);
#pragma unroll
    for (int d0 = 0; d0 < NCB; ++d0) store_o(Ow + (long)orow * 1024 + d0 * 32 + r32, o[d0][r] * rli[r]); }
  __syncthreads();
#undef SLOAD
#undef SWRITE
#undef SWAIT
#undef RESC
}
#undef SBAR
}
namespace att {
#define ALAS __attribute__((address_space(3)))
__device__ __forceinline__ void qkt_l(f32x16& p0, f32x16& p1, const ALAS unsigned char* Ks, const bf16x8* qr, int r32, int hi) {
  p0 = f32x16{}; p1 = f32x16{};
#pragma unroll
  for (int d0 = 0; d0 < 4; ++d0) { const int cb = (d0 * 16 + hi * 8) * 2;
    const bf16x8 b0 = *reinterpret_cast<const ALAS bf16x8*>(Ks + KSWZ64(r32, cb));
    const bf16x8 b1 = *reinterpret_cast<const ALAS bf16x8*>(Ks + 4096 + KSWZ64(r32, cb));
    p0 = __builtin_amdgcn_mfma_f32_32x32x16_bf16(b0, qr[d0], p0, 0, 0, 0);
    p1 = __builtin_amdgcn_mfma_f32_32x32x16_bf16(b1, qr[d0], p1, 0, 0, 0); }
}
__device__ __forceinline__ void qkt_acc(f32x16& p0, f32x16& p1, const ALAS unsigned char* Ks, const bf16x8* qr, int r32, int hi) {
  bf16x8 kb0[4], kb1[4];
#pragma unroll
  for (int d0 = 0; d0 < 4; ++d0) { const int cb = (d0 * 16 + hi * 8) * 2;
    kb0[d0] = *reinterpret_cast<const ALAS bf16x8*>(Ks + KSWZ64(r32, cb)); kb1[d0] = *reinterpret_cast<const ALAS bf16x8*>(Ks + 4096 + KSWZ64(r32, cb)); }
  __builtin_amdgcn_sched_barrier(0);
#pragma unroll
  for (int d0 = 0; d0 < 4; ++d0) {
    p0 = __builtin_amdgcn_mfma_f32_32x32x16_bf16(kb0[d0], qr[d0], p0, 0, 0, 0);
    p1 = __builtin_amdgcn_mfma_f32_32x32x16_bf16(kb1[d0], qr[d0], p1, 0, 0, 0); }
}
__device__ __forceinline__ void qkt_c(f32x16& p0, f32x16& p1, const f32x16& negm, const ALAS unsigned char* Ks, const bf16x8* qr, int r32, int hi) {
  bf16x8 kb0[4], kb1[4];
#pragma unroll
  for (int d0 = 0; d0 < 4; ++d0) { const int cb = (d0 * 16 + hi * 8) * 2;
    kb0[d0] = *reinterpret_cast<const ALAS bf16x8*>(Ks + KSWZ64(r32, cb)); kb1[d0] = *reinterpret_cast<const ALAS bf16x8*>(Ks + 4096 + KSWZ64(r32, cb)); }
  __builtin_amdgcn_sched_barrier(0);
  p0 = __builtin_amdgcn_mfma_f32_32x32x16_bf16(kb0[0], qr[0], negm, 0, 0, 0); p1 = __builtin_amdgcn_mfma_f32_32x32x16_bf16(kb1[0], qr[0], negm, 0, 0, 0);
#pragma unroll
  for (int d0 = 1; d0 < 4; ++d0) {
    p0 = __builtin_amdgcn_mfma_f32_32x32x16_bf16(kb0[d0], qr[d0], p0, 0, 0, 0);
    p1 = __builtin_amdgcn_mfma_f32_32x32x16_bf16(kb1[d0], qr[d0], p1, 0, 0, 0); }
}
template <int NCB> __device__ __forceinline__ void pv_issue0(s16x4 (&vl)[4], s16x4 (&vh)[4], int vb) {
  constexpr int KS = NCB * 1024, HF = NCB * 512;
  vl[0] = tr_read<0>(vb); vh[0] = tr_read<HF>(vb); vl[1] = tr_read<KS>(vb); vh[1] = tr_read<KS + HF>(vb);
  vl[2] = tr_read<2 * KS>(vb); vh[2] = tr_read<2 * KS + HF>(vb); vl[3] = tr_read<3 * KS>(vb); vh[3] = tr_read<3 * KS + HF>(vb);
}
template <int NCB> __device__ __forceinline__ void pv_rest(f32x16* o, const s16x4 (&vl)[4], const s16x4 (&vh)[4], int vb, bf16x8 pa0, bf16x8 pa1, bf16x8 pa2, bf16x8 pa3) {
  asm volatile("s_waitcnt lgkmcnt(0)" ::: "memory"); __builtin_amdgcn_sched_barrier(0);
#define PK(L, H) (bf16x8){L[0], L[1], L[2], L[3], H[0], H[1], H[2], H[3]}
  o[0] = __builtin_amdgcn_mfma_f32_32x32x16_bf16(pa0, PK(vl[0], vh[0]), o[0], 0, 0, 0);
  o[0] = __builtin_amdgcn_mfma_f32_32x32x16_bf16(pa1, PK(vl[1], vh[1]), o[0], 0, 0, 0);
  o[0] = __builtin_amdgcn_mfma_f32_32x32x16_bf16(pa2, PK(vl[2], vh[2]), o[0], 0, 0, 0);
  o[0] = __builtin_amdgcn_mfma_f32_32x32x16_bf16(pa3, PK(vl[3], vh[3]), o[0], 0, 0, 0);
#undef PK
  pv_one<NCB, 1>(o[1], vb, pa0, pa1, pa2, pa3);
  if constexpr (NCB == 4) { pv_one<NCB, 2>(o[2], vb, pa0, pa1, pa2, pa3); pv_one<NCB, 3>(o[3], vb, pa0, pa1, pa2, pa3); }
}
constexpr int PP_NK = 4, PP_NV = 6;
constexpr int PP_KSLOT = 8192, PP_VSLOT = 16384, PP_LK = 0, PP_LV = PP_NK * PP_KSLOT, PP_LW = PP_LV + PP_NV * PP_VSLOT, PP_LDS = PP_LW + 8 * 64 * 4;
static_assert(PP_LDS <= 139264, "attention rings (the frame keeps its control words at byte 139264 of the 144 KiB)");
#define PP_BAR() do { asm volatile("s_waitcnt lgkmcnt(0)" ::: "memory"); __builtin_amdgcn_s_barrier(); asm volatile("" ::: "memory"); } while (0)
template <int DV, bool ALIBI, typename TO>
__device__ __forceinline__ void attn_unit_pp(const bf16_t* __restrict__ Qb, const bf16_t* __restrict__ Kh, const bf16_t* __restrict__ Vh, TO* __restrict__ Ob, int NT, int qpos0, float sl2, ALAS unsigned char* ldsl, float mref = -1.f) {
  constexpr int NCB = DV / 32, NVI = DV / 32;
  int tid_ = threadIdx.x; asm volatile("" : "+v"(tid_));
  const int tid = tid_, lane = tid & 63, r32 = lane & 31, hi = lane >> 5;
  const int wid = __builtin_amdgcn_readfirstlane(tid >> 6), g = wid >> 2, wq = wid & 3;
  ALAS float* li_l = (ALAS float*)(ldsl + PP_LW) + wid * 64; ALAS float* al_l = li_l + 32;
  bf16x8 qr[4];
  const bf16_t* Qw = Qb + (long)(wid * 32 + r32) * LDZ + hi * 8;
#pragma unroll
  for (int d0 = 0; d0 < 4; ++d0) qr[d0] = *reinterpret_cast<const bf16x8*>(Qw + d0 * 16);
  const float dq0 = (float)(qpos0 + wid * 32 + r32 - 4 * hi);
  unsigned doff[NVI];
#pragma unroll
  for (int i = 0; i < NVI; ++i) {
    const int Lk = (wq * 2 + (i & 1)) * 64 + lane, row = Lk >> 3, c = (Lk & 7) ^ ((row >> 1) & 7);
    const int Lv = (wq * NVI + i) * 64 + lane, st = Lv >> 5, wi = Lv & 31, kk = (st / NCB) * 8 + (wi >> 2), kv = (kk & ~0xC) | ((kk & 4) << 1) | ((kk & 8) >> 1);
    doff[i] = g ? (unsigned)(row * LDZ + c * 8) * 2u : (unsigned)(kv * LDZ + (st % NCB) * 32 + (wi & 3) * 8) * 2u; }
  const char* dbase = g ? (const char*)Kh : (const char*)Vh;
  const int dlds = g ? (PP_LK + wq * 2 * 1024) : (PP_LV + wq * NVI * 1024), dss = g ? PP_KSLOT : PP_VSLOT, ni = g ? 2 : NVI;
#define DMA_T(t, slot) do { const char* tb_ = dbase + (size_t)(t) * (64 * LDZ * 2); ALAS unsigned char* ld_ = ldsl + dlds + (slot) * dss; \
    _Pragma("unroll") for (int i_ = 0; i_ < NVI; ++i_) if (i_ < ni) __builtin_amdgcn_global_load_lds((const unsigned*)(tb_ + doff[i_]), (ALAS unsigned*)(ld_ + i_ * 1024), 16, 0, 0); } while (0)
  const int vbase = (int)(unsigned)(uintptr_t)(ldsl + PP_LV) + v_rd_base(lane);
  const bool mfree = __builtin_amdgcn_readfirstlane((int)(mref >= 0.f)) != 0;
  float m_reg = mfree ? mref : 0.f, l_reg = 0.f; f32x16 o[NCB];
  f32x16 negm = f32x16{}; const int qw = qpos0 + wid * 32;
#pragma unroll
  for (int d = 0; d < NCB; ++d) o[d] = f32x16{};
  f32x16 S0 = f32x16{}, S1 = f32x16{}; bf16x8 pa0 = bf16x8{}, pa1 = bf16x8{}, pa2 = bf16x8{}, pa3 = bf16x8{};
  if (g == 1) { _Pragma("unroll") for (int t = 0; t < PP_NK; ++t) DMA_T(t, t); asm volatile("s_waitcnt vmcnt(6)" ::: "memory"); static_assert(PP_NK == 4, "prologue wait = 2 * (NK - 1)"); }
  else { _Pragma("unroll") for (int t = 0; t < PP_NV - 2; ++t) DMA_T(t, t); }
  PP_BAR();
#define CRF(r) ((float)(((r) & 3) + 8 * ((r) >> 2)))
#define M_STEP(k) do { const int k_ = (k); s16x4 vl_[4], vh_[4]; const int vb_ = vbase + ((k_ >= 0 ? k_ : 0) % PP_NV) * PP_VSLOT; \
    if (k_ >= 0) pv_issue0<NCB>(vl_, vh_, vb_); \
    if (k_ + 1 < NT) { const int ks_ = (k_ + 1) % PP_NK; \
      if constexpr (ALIBI) { const int kt0_ = 64 * (k_ + 1); const float dq_ = dq0 - (float)kt0_; \
        if (kt0_ + 63 <= qw || kt0_ >= qw + 31) {     \
          const float ssl_ = (kt0_ + 63 <= qw) ? sl2 : -sl2; const float e0_ = -m_reg - ssl_ * dq_, e1_ = e0_ + 32.f * ssl_; \
          _Pragma("unroll") for (int r = 0; r < 16; ++r) { S0[r] = fmaf(ssl_, CRF(r), e0_); S1[r] = fmaf(ssl_, CRF(r), e1_); } \
        } else { \
          _Pragma("unroll") for (int r = 0; r < 16; ++r) { const float t0_ = dq_ - CRF(r); S0[r] = fmaf(-sl2, fabsf(t0_), -m_reg); S1[r] = fmaf(-sl2, fabsf(t0_ - 32.f), -m_reg); } \
        } \
        qkt_acc(S0, S1, ldsl + PP_LK + ks_ * PP_KSLOT, qr, r32, hi); \
      } else { qkt_c(S0, S1, negm, ldsl + PP_LK + ks_ * PP_KSLOT, qr, r32, hi); } } \
    if (k_ >= 0) pv_rest<NCB>(o, vl_, vh_, vb_, pa0, pa1, pa2, pa3); } while (0)
#define PK4(P, BASE, OUT) do { unsigned a0 = cvtpk(P[BASE + 0], P[BASE + 1]), a1 = cvtpk(P[BASE + 2], P[BASE + 3]);   \
    unsigned b0 = cvtpk(P[BASE + 4], P[BASE + 5]), b1 = cvtpk(P[BASE + 6], P[BASE + 7]);                              \
    auto r0 = __builtin_amdgcn_permlane32_swap(a0, b0, false, false); auto r1 = __builtin_amdgcn_permlane32_swap(a1, b1, false, false); \
    u32x4 w = {r0[0], r1[0], r0[1], r1[1]}; OUT = *reinterpret_cast<bf16x8*>(&w); } while (0)
#define V_STEP(k) do { const int k_ = (k); \
    { const int tt_ = k_ + (g ? PP_NK : PP_NV - 2); if (tt_ < NT) DMA_T(tt_, g ? tt_ % PP_NK : tt_ % PP_NV); } \
    if (!mfree) { float pmax = S0[0]; \
    _Pragma("unroll") for (int r = 1; r < 16; ++r) pmax = fmaxf(pmax, S0[r]); \
    _Pragma("unroll") for (int r = 0; r < 16; ++r) pmax = fmaxf(pmax, S1[r]); \
    { auto rr = __builtin_amdgcn_permlane32_swap(__float_as_uint(pmax), __float_as_uint(pmax), false, false); \
      pmax = fmaxf(__uint_as_float(rr[0]), __uint_as_float(rr[1])); } \
    if (k_ == 0 || !__builtin_expect(__all(pmax <= THR2), 1)) {       \
      const float dl = (k_ == 0) ? pmax : fmaxf(pmax, 0.f); m_reg += dl; \
      _Pragma("unroll") for (int r = 0; r < 16; ++r) { S0[r] -= dl; S1[r] -= dl; } \
      if constexpr (!ALIBI) { _Pragma("unroll") for (int r = 0; r < 16; ++r) negm[r] = -m_reg; } \
      if (k_ != 0) { const float alpha = __builtin_amdgcn_exp2f(-dl); l_reg *= alpha; \
        if (hi == 0) al_l[r32] = alpha; \
        asm volatile("s_waitcnt lgkmcnt(0)" ::: "memory"); \
        _Pragma("unroll") for (int d = 0; d < NCB; ++d) _Pragma("unroll") for (int r = 0; r < 16; ++r) o[d][r] *= al_l[crow(r, hi)]; } } } \
    _Pragma("unroll") for (int r = 0; r < 16; ++r) { S0[r] = __builtin_amdgcn_exp2f(S0[r]); S1[r] = __builtin_amdgcn_exp2f(S1[r]); } \
    float ps = 0.f, ps1 = 0.f, ps2 = 0.f, ps3 = 0.f; \
    _Pragma("unroll") for (int r = 0; r < 16; r += 2) { ps += S0[r]; ps1 += S0[r + 1]; ps2 += S1[r]; ps3 += S1[r + 1]; } \
    ps = (ps + ps1) + (ps2 + ps3); \
    { auto rr = __builtin_amdgcn_permlane32_swap(__float_as_uint(ps), __float_as_uint(ps), false, false); \
      ps = __uint_as_float(rr[0]) + __uint_as_float(rr[1]); } \
    l_reg += ps; \
    PK4(S0, 0, pa0); PK4(S0, 8, pa1); PK4(S1, 0, pa2); PK4(S1, 8, pa3); } while (0)
#define WAIT_V(n) asm volatile("s_waitcnt vmcnt(" #n ")" ::: "memory")
  if (g == 0) {
    M_STEP(-1); PP_BAR();
    for (int k = 0; k < NT; ++k) {
      V_STEP(k);
      { const int no_ = NT - 1 - k;
        static_assert(PP_NV == 6, "up to NV - 2 = 4 later V tiles in flight");
        if (no_ >= 4) { if constexpr (NVI == 4) WAIT_V(16); else WAIT_V(8); } else if (no_ == 3) { if constexpr (NVI == 4) WAIT_V(12); else WAIT_V(6); }
        else if (no_ == 2) { if constexpr (NVI == 4) WAIT_V(8); else WAIT_V(4); } else if (no_ == 1) { if constexpr (NVI == 4) WAIT_V(4); else WAIT_V(2); } else WAIT_V(0); }
      PP_BAR();
      M_STEP(k); PP_BAR();
    }
    PP_BAR();
  } else {
    PP_BAR();
    for (int k = 0; k < NT; ++k) {
      M_STEP(k - 1);
      { const int no_ = NT - 2 - k;
        if (no_ >= 2) WAIT_V(4); else if (no_ == 1) WAIT_V(2); else WAIT_V(0); }
      PP_BAR();
      V_STEP(k); PP_BAR();
    }
    M_STEP(NT - 1); PP_BAR();
  }
#undef M_STEP
#undef CRF
#undef V_STEP
#undef PK4
#undef WAIT_V
  if (hi == 0) li_l[r32] = l_reg; asm volatile("s_waitcnt lgkmcnt(0)" ::: "memory");
  float rli[16];
#pragma unroll
  for (int r = 0; r < 16; ++r) rli[r] = __builtin_amdgcn_rcpf(li_l[crow(r, hi)]);
  TO* Ow = Ob + (long)(wid * 32) * 1024;
#pragma unroll
  for (int r = 0; r < 16; ++r) { const int orow = crow(r, hi);
#pragma unroll
    for (int d0 = 0; d0 < NCB; ++d0) store_o(Ow + (long)orow * 1024 + d0 * 32 + r32, o[d0][r] * rli[r]); }
#undef DMA_T
}
#undef ALAS
}
namespace attn_body {
using bf16=__hip_bfloat16;
using bf16x8=__attribute__((ext_vector_type(8)))short;
using s16x4=__attribute__((ext_vector_type(4)))short;
using f32x16=__attribute__((ext_vector_type(16)))float;
using u32x4=__attribute__((ext_vector_type(4)))unsigned;
constexpr int D=64,DMQ=2368,DMK=2368,DMV=2368,DMO=1024;
constexpr int NW=8,QBLK=32,QB=QBLK*NW,KVBLK=64;
__device__ __forceinline__ int crow(int r,int hi){return (r&3)+8*(r>>2)+4*hi;}
#define SBAR() __builtin_amdgcn_sched_barrier(0)
__device__ __forceinline__ void cmask(f32x16&p0,f32x16&p1,int jb,int qrel,int hi){
  const float NEG=-INFINITY; int kb=64*jb+4*hi;
  #pragma unroll
  for(int r=0;r<16;++r){int kv=kb+(r&3)+8*(r>>2); if(kv>qrel)p0[r]=NEG; if(kv+32>qrel)p1[r]=NEG;}
}

constexpr int NSLOT=3, SLOTB=8192;
constexpr int LDS_K=0, LDS_V=NSLOT*SLOTB, LDS_WS=2*NSLOT*SLOTB, LDS_OST=LDS_WS+NW*64*4, LDS_BYTES=LDS_OST+NW*4096;
constexpr float C2=0.125f*1.4426950408889634f;
__device__ __forceinline__ void glds16(const void*gsrc,unsigned lds_dst){unsigned keep;
  asm volatile("s_mov_b32 %0, m0\n\ts_mov_b32 m0, %2\n\ts_nop 0\n\tglobal_load_lds_dwordx4 %1, off\n\ts_mov_b32 m0, %0":"=&s"(keep):"v"(gsrc),"s"(lds_dst):"memory");}
__device__ __forceinline__ float max3f(float a,float b,float c){float r;asm("v_max3_f32 %0, %1, %2, %3":"=v"(r):"v"(a),"v"(b),"v"(c));return r;}
__device__ __forceinline__ float max2f(float a,float b){float r;asm("v_max_f32_e32 %0, %1, %2":"=v"(r):"v"(a),"v"(b));return r;}
__device__ __forceinline__ float fadd_s(float a,float b){float r;asm("v_add_f32_e32 %0, %1, %2":"=v"(r):"v"(a),"v"(b));return r;}
__device__ __forceinline__ float fsub_s(float a,float b){float r;asm("v_sub_f32_e32 %0, %1, %2":"=v"(r):"v"(a),"v"(b));return r;}
typedef float f32x2_t __attribute__((ext_vector_type(2))); typedef __bf16 bf16x2_t __attribute__((ext_vector_type(2)));
__device__ __forceinline__ unsigned cvtpk_s(float lo,float hi){f32x2_t v={lo,hi};bf16x2_t b=__builtin_convertvector(v,bf16x2_t);return __builtin_bit_cast(unsigned,b);}
#define WAIT_BAR(N) asm volatile("s_waitcnt vmcnt(" #N ") lgkmcnt(0)\n\ts_barrier":::"memory")

__device__ __forceinline__ void qkt(f32x16&p0,f32x16&p1,const char*Kslot,const bf16x8*qr,const f32x16&negm,int r32,int hi){
  const char*kb=Kslot+hi*1024+r32*16;
  #pragma unroll
  for(int d0=0;d0<4;++d0){
    const bf16x8 b0=*reinterpret_cast<const bf16x8*>(kb+d0*2048);
    const bf16x8 b1=*reinterpret_cast<const bf16x8*>(kb+d0*2048+512);
    if(d0==0){p0=__builtin_amdgcn_mfma_f32_32x32x16_bf16(b0,qr[0],negm,0,0,0);p1=__builtin_amdgcn_mfma_f32_32x32x16_bf16(b1,qr[0],negm,0,0,0);}
    else{p0=__builtin_amdgcn_mfma_f32_32x32x16_bf16(b0,qr[d0],p0,0,0,0);p1=__builtin_amdgcn_mfma_f32_32x32x16_bf16(b1,qr[d0],p1,0,0,0);}}
}
typedef __attribute__((address_space(3))) const char* lds_cptr;
typedef short v4i16_t __attribute__((ext_vector_type(4)));
__device__ __forceinline__ void kload8(bf16x8*kf,lds_cptr kp){
  kf[0]=*(const __attribute__((address_space(3))) bf16x8*)(kp);      kf[1]=*(const __attribute__((address_space(3))) bf16x8*)(kp+512);
  kf[2]=*(const __attribute__((address_space(3))) bf16x8*)(kp+2048); kf[3]=*(const __attribute__((address_space(3))) bf16x8*)(kp+2560);
  kf[4]=*(const __attribute__((address_space(3))) bf16x8*)(kp+4096); kf[5]=*(const __attribute__((address_space(3))) bf16x8*)(kp+4608);
  kf[6]=*(const __attribute__((address_space(3))) bf16x8*)(kp+6144); kf[7]=*(const __attribute__((address_space(3))) bf16x8*)(kp+6656);
}
__device__ __forceinline__ void kload2(bf16x8*kf,lds_cptr kp,int j){ kf[2*j]=*(const __attribute__((address_space(3))) bf16x8*)(kp+j*2048); kf[2*j+1]=*(const __attribute__((address_space(3))) bf16x8*)(kp+j*2048+512); }
__device__ __forceinline__ s16x4 vtr(lds_cptr p){ return __builtin_bit_cast(s16x4,__builtin_amdgcn_ds_read_tr16_b64_v4i16((__attribute__((address_space(3))) v4i16_t*)p)); }
__device__ __forceinline__ float rowmax(const f32x16&p0,const f32x16&p1){
  float a=max3f(p0[0],p0[1],p1[0]),b=max3f(p0[2],p0[3],p1[1]);a=max3f(a,p1[2],p1[3]);
  #pragma unroll
  for(int r=4;r<16;r+=4){a=max3f(a,p0[r],p0[r+1]);b=max3f(b,p0[r+2],p0[r+3]);a=max3f(a,p1[r],p1[r+1]);b=max3f(b,p1[r+2],p1[r+3]);}
  const float m=max2f(a,b);
  auto rr=__builtin_amdgcn_permlane32_swap(__float_as_uint(m),__float_as_uint(m),false,false);
  return max2f(__uint_as_float(rr[0]),__uint_as_float(rr[1]));
}
__device__ __forceinline__ void pv(f32x16*o,int vb,bf16x8 pa0,bf16x8 pa1,bf16x8 pa2,bf16x8 pa3){
  #pragma unroll
  for(int d0=0;d0<2;++d0){s16x4 lo[4],hi[4];
    #pragma unroll
    for(int ks=0;ks<4;++ks){
      asm volatile("ds_read_b64_tr_b16 %0,%1 offset:%c2":"=&v"(lo[ks]):"v"(vb),"i"(d0*4096+ks*1024):"memory");
      asm volatile("ds_read_b64_tr_b16 %0,%1 offset:%c2":"=&v"(hi[ks]):"v"(vb),"i"(d0*4096+ks*1024+512):"memory");}
    asm volatile("s_waitcnt lgkmcnt(0)":::"memory");SBAR();
    #define PK(k) (bf16x8){lo[k][0],lo[k][1],lo[k][2],lo[k][3],hi[k][0],hi[k][1],hi[k][2],hi[k][3]}
    o[d0]=__builtin_amdgcn_mfma_f32_32x32x16_bf16(pa0,PK(0),o[d0],0,0,0);
    o[d0]=__builtin_amdgcn_mfma_f32_32x32x16_bf16(pa1,PK(1),o[d0],0,0,0);
    o[d0]=__builtin_amdgcn_mfma_f32_32x32x16_bf16(pa2,PK(2),o[d0],0,0,0);
    o[d0]=__builtin_amdgcn_mfma_f32_32x32x16_bf16(pa3,PK(3),o[d0],0,0,0);
    #undef PK
  }
}

#ifndef ATTN_STORE16
#define ATTN_STORE16(p,v) (*(u32x4*)(p)=(v))
#endif
template<int THRL> __device__ __forceinline__ void attn_unit(const bf16*Qb,const bf16*__restrict__ Kh,const bf16*__restrict__ Vh,bf16*Ob,const int NT,char*shm,const float sbound=0.f){
  const int tid=threadIdx.x,lane=tid&63,r32=lane&31,hi=lane>>5; const int wid=__builtin_amdgcn_readfirstlane(tid>>6);
  const bf16*Qw=Qb+(long)(wid*QBLK)*DMQ;
  const unsigned lds0=(unsigned)(uintptr_t)shm;
  float*wsf=(float*)(shm+LDS_WS)+wid*64;
  const bf16*ksrc=Kh+(long)lane*DMK+wid*8;
  const bf16*vsrc=Vh+(long)(16*(wid&3)+(lane>>2))*DMV+(wid>>2)*32+(lane&3)*8;
  const unsigned kdst=lds0+LDS_K+wid*1024, vdst=lds0+LDS_V+wid*1024;
  #define DMA_K(t,slot) glds16(ksrc+(long)(t)*KVBLK*DMK,(unsigned)__builtin_amdgcn_readfirstlane(kdst+(slot)))
  #define DMA_V(t,slot) glds16(vsrc+(long)(t)*KVBLK*DMV,(unsigned)__builtin_amdgcn_readfirstlane(vdst+(slot)))
  const int vb0=(int)(lds0+LDS_V)+((lane>>4)&1)*32+(lane&3)*8+(4*hi+((lane&15)>>2))*64;
  const char*Kbase=shm+LDS_K; bf16x8 kf[8];
  const lds_cptr shm3=(lds_cptr)shm; const lds_cptr kp0=shm3+LDS_K+hi*1024+r32*16; const lds_cptr vp0=shm3+LDS_V+((lane>>4)&1)*32+(lane&3)*8+(4*hi+((lane&15)>>2))*64;
  DMA_K(0,0);DMA_V(0,0);DMA_K(1,SLOTB);
  bf16x8 qr[4];
  #pragma unroll
  for(int d0=0;d0<4;++d0)qr[d0]=*reinterpret_cast<const bf16x8*>(&Qw[(long)r32*DMQ+d0*16+hi*8]);
  float sb_=sbound; asm volatile("":"+v"(sb_));
  float mhat=(THRL>=1000)?sb_:0.f,l_reg=0.f;f32x16 o[2];o[0]=f32x16{};o[1]=f32x16{};f32x16 negm;
  _Pragma("unroll") for(int r=0;r<16;++r)negm[r]=-mhat; asm volatile("":"+v"(negm));
  #define CMASK(P0,P1,t) do{}while(0)
  bool resc=false;
  #define START(P0,P1) do{ resc=false; if constexpr(THRL<1000) { const float rm=rowmax(P0,P1); \
      const float dl=rm; mhat=fadd_s(mhat,dl); \
      _Pragma("unroll") for(int r=0;r<16;++r){P0[r]=fsub_s(P0[r],dl);P1[r]=fsub_s(P1[r],dl);} \
      _Pragma("unroll") for(int r=0;r<16;++r)negm[r]=-mhat; asm volatile("":"+v"(negm)); } \
    _Pragma("unroll") for(int r=0;r<16;++r)P0[r]=__builtin_amdgcn_exp2f(P0[r]); }while(0)
  #define RESC() do{ if(resc){ asm volatile("s_waitcnt lgkmcnt(0)":::"memory"); \
      _Pragma("unroll") for(int d_=0;d_<2;++d_) _Pragma("unroll") for(int r=0;r<16;++r)o[d_][r]*=wsf[crow(r,hi)]; } }while(0)
  f32x16 pA0,pA1,pB0,pB1;
  int sl_prev=0,sl_cur=0,sl_next=SLOTB;
  #define ROT() do{sl_prev=sl_cur;sl_cur=sl_next;sl_next=(sl_next==(NSLOT-1)*SLOTB)?0:sl_next+SLOTB;}while(0)
  DMA_K(2,2*SLOTB);
  WAIT_BAR(3);
  qkt(pA0,pA1,Kbase,qr,negm,r32,hi);asm volatile("s_nop 15\n\ts_nop 7":"+v"(pA0),"+v"(pA1));CMASK(pA0,pA1,0);
  START(pA0,pA1);
  _Pragma("unroll") for(int r=0;r<16;++r)pA1[r]=__builtin_amdgcn_exp2f(pA1[r]);
  WAIT_BAR(0);
  DMA_K(3,0);DMA_V(1,SLOTB);
  ROT();
  kload8(kf,kp0+sl_cur);
  WAIT_BAR(2);
  s16x4 vlo[8],vhi[8]; u32x4 pw0,pw1,pw2,pw3;
  #define PKW(P,B) cvtpk_s(P[B],P[B+1])
  #define PAF(k) __builtin_bit_cast(bf16x8,pw##k)
  #define VFR(i) (bf16x8){vlo[i][0],vlo[i][1],vlo[i][2],vlo[i][3],vhi[i][0],vhi[i][1],vhi[i][2],vhi[i][3]}
  #define PIN(x) asm volatile("":"+v"(x))
  #define MX3(a,b,c) __builtin_fmaxf(__builtin_fmaxf((a),(b)),(c))
  #define GAPA(MF,A0,A1,A2,A3,W0,W1,PW) do{ MF; sacc+=A0; sacc+=A1; sacc+=A2; sacc+=A3; PIN(sacc); W0; W1; PIN(PW); SBAR(); }while(0)
  #define EX(v) __builtin_amdgcn_exp2f(v)
  #define GAPB(MF,X,B) do{ MF; X[B]=EX(X[B]); X[B+1]=EX(X[B+1]); X[B+2]=EX(X[B+2]); X[B+3]=EX(X[B+3]); PIN(X); SBAR(); }while(0)
  #define VRD(i) do{ vlo[i]=vtr(vp_+(((i)>>2)*4096+((i)&3)*1024)); vhi[i]=vtr(vp_+(((i)>>2)*4096+((i)&3)*1024+512)); }while(0)
  #define KRD(G,j) do{ if(G){ kload2(kf,kp0+sl_next,j); SBAR(); } }while(0)
  #define STEP(C0,C1,P0,P1,t,GK,GV,GL) do{ SBAR(); \
    const lds_cptr vp_=vp0+sl_prev; \
    VRD(0); SBAR(); float sacc=(P0[0]+P0[1]); \
    GAPA(C0=__builtin_amdgcn_mfma_f32_32x32x16_bf16(kf[0],qr[0],negm,0,0,0), P0[2],P0[3],P0[4],P0[5],     pw0[0]=PKW(P0,0), pw0[1]=PKW(P0,2), pw0); \
    VRD(4); SBAR(); GAPA(C1=__builtin_amdgcn_mfma_f32_32x32x16_bf16(kf[1],qr[0],negm,0,0,0), P0[6],P0[7],P0[8],P0[9],     pw0[2]=PKW(P0,4), pw0[3]=PKW(P0,6), pw0); \
    VRD(1); SBAR(); GAPA(C0=__builtin_amdgcn_mfma_f32_32x32x16_bf16(kf[2],qr[1],C0,0,0,0),   P0[10],P0[11],P0[12],P0[13], pw1[0]=PKW(P0,8), pw1[1]=PKW(P0,10), pw1); \
    VRD(5); SBAR(); GAPA(C1=__builtin_amdgcn_mfma_f32_32x32x16_bf16(kf[3],qr[1],C1,0,0,0),   P0[14],P0[15],P1[0],P1[1],   pw1[2]=PKW(P0,12),pw1[3]=PKW(P0,14), pw1); \
    VRD(2); SBAR(); GAPA(C0=__builtin_amdgcn_mfma_f32_32x32x16_bf16(kf[4],qr[2],C0,0,0,0),   P1[2],P1[3],P1[4],P1[5],     pw2[0]=PKW(P1,0), pw2[1]=PKW(P1,2), pw2); \
    VRD(6); SBAR(); GAPA(C1=__builtin_amdgcn_mfma_f32_32x32x16_bf16(kf[5],qr[2],C1,0,0,0),   P1[6],P1[7],P1[8],P1[9],     pw2[2]=PKW(P1,4), pw2[3]=PKW(P1,6), pw2); \
    VRD(3); SBAR(); GAPA(C0=__builtin_amdgcn_mfma_f32_32x32x16_bf16(kf[6],qr[3],C0,0,0,0),   P1[10],P1[11],P1[12],P1[13], pw3[0]=PKW(P1,8), pw3[1]=PKW(P1,10), pw3); \
    VRD(7); SBAR(); GAPA(C1=__builtin_amdgcn_mfma_f32_32x32x16_bf16(kf[7],qr[3],C1,0,0,0),   P1[14],P1[15],0.f,0.f,       pw3[2]=PKW(P1,12),pw3[3]=PKW(P1,14), pw3); \
    l_reg+=sacc; \
    if(GK){DMA_K((t)+3,sl_cur);} if(GV){DMA_V((t)+1,sl_next);} \
    CMASK(C0,C1,t); \
    resc=false; if constexpr(THRL<1000) { float a=MX3(C0[0],C0[1],C1[0]),b=MX3(C0[2],C0[3],C1[1]); a=MX3(a,C1[2],C1[3]); \
      _Pragma("unroll") for(int r=4;r<16;r+=4){a=MX3(a,C0[r],C0[r+1]);b=MX3(b,C0[r+2],C0[r+3]);a=MX3(a,C1[r],C1[r+1]);b=MX3(b,C1[r+2],C1[r+3]);} \
      float rm=__builtin_fmaxf(a,b); { auto rr=__builtin_amdgcn_permlane32_swap(__float_as_uint(rm),__float_as_uint(rm),false,false); rm=__builtin_fmaxf(__uint_as_float(rr[0]),__uint_as_float(rr[1])); } \
      resc=false; \
      if(__builtin_expect(__any(rm>(float)THRL),0)){ const float dl=__builtin_fmaxf(rm,0.f); mhat+=dl; \
        _Pragma("unroll") for(int r=0;r<16;++r){C0[r]-=dl;C1[r]-=dl;} \
        _Pragma("unroll") for(int r=0;r<16;++r)negm[r]=-mhat; asm volatile("":"+v"(negm)); \
        const float f=__builtin_amdgcn_exp2f(-dl); l_reg*=f; if(hi==0)wsf[r32]=f; resc=true; } } \
    SBAR(); \
    GAPB(o[0]=__builtin_amdgcn_mfma_f32_32x32x16_bf16(PAF(0),VFR(0),o[0],0,0,0), C0,0); \
    GAPB(o[1]=__builtin_amdgcn_mfma_f32_32x32x16_bf16(PAF(0),VFR(4),o[1],0,0,0), C0,4); \
    KRD(GL,0); GAPB(o[0]=__builtin_amdgcn_mfma_f32_32x32x16_bf16(PAF(1),VFR(1),o[0],0,0,0), C0,8); \
    KRD(GL,1); GAPB(o[1]=__builtin_amdgcn_mfma_f32_32x32x16_bf16(PAF(1),VFR(5),o[1],0,0,0), C0,12); \
    KRD(GL,2); GAPB(o[0]=__builtin_amdgcn_mfma_f32_32x32x16_bf16(PAF(2),VFR(2),o[0],0,0,0), C1,0); \
    KRD(GL,3); GAPB(o[1]=__builtin_amdgcn_mfma_f32_32x32x16_bf16(PAF(2),VFR(6),o[1],0,0,0), C1,4); \
    GAPB(o[0]=__builtin_amdgcn_mfma_f32_32x32x16_bf16(PAF(3),VFR(3),o[0],0,0,0), C1,8); \
    GAPB(o[1]=__builtin_amdgcn_mfma_f32_32x32x16_bf16(PAF(3),VFR(7),o[1],0,0,0), C1,12); \
    }while(0)
  int t=1;
  #undef CMASK
  #define CMASK(P0,P1,t) do{}while(0)
  for(;t+5<NT;t+=2){
    STEP(pB0,pB1,pA0,pA1,t,true,true,true);     WAIT_BAR(2); RESC(); ROT();
    STEP(pA0,pA1,pB0,pB1,t+1,true,true,true);   WAIT_BAR(2); RESC(); ROT();
  }
  #undef CMASK
  #define CMASK(P0,P1,t) do{}while(0)
  #define ENDW(tt) do{ if((tt)+3<NT){WAIT_BAR(2);} else if((tt)+2<NT){WAIT_BAR(1);} else {WAIT_BAR(0);} }while(0)
  for(;t+1<NT;t+=2){
    STEP(pB0,pB1,pA0,pA1,t,(t+3<NT),(t+1<NT),(t+1<NT));       ENDW(t);   RESC(); ROT();
    STEP(pA0,pA1,pB0,pB1,t+1,(t+4<NT),(t+2<NT),(t+2<NT));     ENDW(t+1); RESC(); ROT();
  }
  STEP(pB0,pB1,pA0,pA1,NT-1,false,false,false); RESC();
  { float sacc=pB0[0]+pB0[1]; _Pragma("unroll") for(int r=2;r<16;++r)sacc+=pB0[r]; _Pragma("unroll") for(int r=0;r<16;++r)sacc+=pB1[r]; l_reg+=sacc;
    pw0=(u32x4){PKW(pB0,0),PKW(pB0,2),PKW(pB0,4),PKW(pB0,6)};pw1=(u32x4){PKW(pB0,8),PKW(pB0,10),PKW(pB0,12),PKW(pB0,14)};pw2=(u32x4){PKW(pB1,0),PKW(pB1,2),PKW(pB1,4),PKW(pB1,6)};pw3=(u32x4){PKW(pB1,8),PKW(pB1,10),PKW(pB1,12),PKW(pB1,14)};
    SBAR(); pv(o,vb0+sl_cur,PAF(0),PAF(1),PAF(2),PAF(3)); }
  #undef PKW
  #undef PAF
  #undef VFR
  #undef PIN
  #undef MX3
  #undef GAPA
  #undef GAPB
  #undef EX
  #undef VRD
  #undef KRD
  #undef STEP
  #undef ENDW
  {auto rr=__builtin_amdgcn_permlane32_swap(__float_as_uint(l_reg),__float_as_uint(l_reg),false,false);l_reg=__uint_as_float(rr[0])+__uint_as_float(rr[1]);}
  if(hi==0)wsf[32+r32]=l_reg;asm volatile("s_waitcnt lgkmcnt(0)":::"memory");
  float rli[16];
  #pragma unroll
  for(int r=0;r<16;++r)rli[r]=__builtin_amdgcn_rcpf(wsf[32+crow(r,hi)]);
  bf16*Ow=Ob+(long)(wid*QBLK)*DMO;
  { bf16*stg=(bf16*)(shm+LDS_OST)+wid*2048;
    #pragma unroll
    for(int r=0;r<16;++r){const int orow=crow(r,hi);
      #pragma unroll
      for(int d0=0;d0<2;++d0)stg[orow*64+d0*32+r32]=__float2bfloat16(o[d0][r]*rli[r]);}
    asm volatile("s_waitcnt lgkmcnt(0)":::"memory");
    #pragma unroll
    for(int i=0;i<4;++i){const int row=i*8+(lane>>3),ch=lane&7; const u32x4 v=*(const u32x4*)(stg+row*64+ch*8); ATTN_STORE16(Ow+(long)row*DMO+ch*8,v);} }
  asm volatile("s_waitcnt lgkmcnt(0)\n\ts_barrier":::"memory");
  #undef DMA_K
  #undef DMA_V
  #undef CMASK
  #undef START
  #undef RESC
  #undef ROT
}
constexpr int ATTN_LDS_BYTES=LDS_BYTES;
#undef SBAR
#undef WAIT_BAR
}
typedef unsigned short bf16;
typedef unsigned v4u __attribute__((ext_vector_type(4)));
typedef float f32x4 __attribute__((ext_vector_type(4)));
#define LAS __attribute__((address_space(3)))
constexpr int NWAVES = 8;
constexpr int D = 1024, FF = 4096, NIN = 2304, PLE = 256;
constexpr int ZP = att::LDZ;
constexpr int MP = 4 * 8192, MS = 8 * 2048, M = MP + MS;
constexpr int SEQ_P = 8192, SEQ_S = 2048;
constexpr float C2 = 0.125f * 1.4426950408889634f;
constexpr float LOG2E = 1.4426950408889634f;
constexpr size_t MiB = 1u << 20;
constexpr size_t WS_RSP1 = 1 * MiB, WS_RSP2 = 4 * MiB, WS_RSP3 = 7 * MiB;
constexpr size_t WS_WIN = 10 * MiB, WS_WOUT = 15 * MiB, WS_W1 = 17 * MiB, WS_W2 = 25 * MiB, WS_WG = 33 * MiB, WS_WP = 35 * MiB;
constexpr size_t WS_PB = 36 * MiB;
constexpr size_t WS_PROJ = 60 * MiB;
constexpr size_t WS_Z = 156 * MiB;
constexpr size_t WS_HB = 156 * MiB;
constexpr size_t WS_XN = 380 * MiB;
constexpr size_t WS_H = 252 * MiB;
constexpr size_t WS_END = 512 * MiB;
static_assert(WS_XN + (size_t)M * D * 2 <= WS_END && WS_Z + (size_t)M * ZP * 2 <= WS_XN && WS_H + (size_t)16384 * FF * 2 <= WS_END && WS_HB + (size_t)M * D * 2 <= WS_H, "d_ws map");
constexpr int CW_QMAX = 3584, CW_KMAX = 3648, CW_DNEG = 3616, CW_QUEUE = 3712;
constexpr int CTL_BYTES = 32768;
constexpr float SKIP_T = 32.0f;
constexpr int LDS_BYTES = 147456;
static_assert(att::ATTN_LDS <= 131072 && attn_body::ATTN_LDS_BYTES <= 131072 && attn_body::DMQ == ZP, "attention LDS / pitches");

__device__ __forceinline__ unsigned f2bf(float f) { unsigned u = __builtin_bit_cast(unsigned, f); return (u + 0x7fffu + ((u >> 16) & 1u)) >> 16; }
__device__ __forceinline__ unsigned pk2(float lo, float hi) { return f2bf(lo) | (f2bf(hi) << 16); }
__device__ __forceinline__ float wave_sum(float v) {
#pragma unroll
    for (int o = 1; o < 64; o <<= 1) v += __shfl_xor(v, o);
    return v;
}
__device__ __forceinline__ void transpose_item(const float* W, int K, int N, const float* g, bf16* WT, LAS float* scr, int item, int lane) {
    const int nblk = N / 32, kb = item / nblk, nb = item % nblk, k0 = 64 * kb, n0 = 32 * nb;
#pragma unroll 8
    for (int i = 0; i < 32; ++i) { const int kk = 2 * i + (lane >> 5); const float gs = g ? g[k0 + kk] : 1.f; scr[kk * 33 + (lane & 31)] = W[(size_t)(k0 + kk) * N + n0 + (lane & 31)] * gs; }
    asm volatile("s_waitcnt lgkmcnt(0)" ::: "memory");
    const int c = lane & 7;
#pragma unroll
    for (int j = 0; j < 4; ++j) { const int n = (lane >> 3) + 8 * j; const LAS float* s = scr + (8 * c) * 33 + n;
        v4u o; o.x = pk2(s[0 * 33], s[1 * 33]); o.y = pk2(s[2 * 33], s[3 * 33]); o.z = pk2(s[4 * 33], s[5 * 33]); o.w = pk2(s[6 * 33], s[7 * 33]);
        *(v4u*)(WT + (size_t)(n0 + n) * K + k0 + 8 * c) = o; }
    asm volatile("s_waitcnt lgkmcnt(0)" ::: "memory");
}

#define XB_TMO      128
#define XB_XCNT(j)  (256  + 64 * (j))
#define XB_XSUB(j)  (1280 + 64 * (j))
#define XB_XGEN(j)  (2304 + 64 * (j))
#define XB_TOP      3328
#define XB_TOPGEN   3392
#define XCD_BAR_WORDS 3456
#define XB_SPIN_CAP (1u << 22)

__device__ __forceinline__ unsigned xb_ld(unsigned* p)              { return __hip_atomic_load(p, __ATOMIC_RELAXED, __HIP_MEMORY_SCOPE_AGENT); }
__device__ __forceinline__ unsigned xb_add(unsigned* p, unsigned v) { return __hip_atomic_fetch_add(p, v, __ATOMIC_RELAXED, __HIP_MEMORY_SCOPE_AGENT); }
__device__ __forceinline__ unsigned xb_xcc_id() { return (unsigned)__builtin_amdgcn_s_getreg((3 << 11) | 20) & 0xFu; }
#define XB_SPIN(cond, bar) do { unsigned _sp = 0; while (cond) { __builtin_amdgcn_s_sleep(1); \
    if ((++_sp & 255u) == 0u) { if (xb_ld(&(bar)[XB_TMO])) break; if (_sp > XB_SPIN_CAP) { atomicAdd(&(bar)[XB_TMO], 1u); break; } } } } while (0)

struct XcdBarrier {
    unsigned* bar; unsigned x;
    volatile LAS unsigned* st;
};

__device__ __forceinline__ XcdBarrier xcd_barrier_post(unsigned* bar, volatile LAS unsigned* st) {
    XcdBarrier b; b.bar = bar; b.x = xb_xcc_id(); b.st = st;
    if (threadIdx.x == 0) (void)xb_add(&bar[XB_XCNT(b.x)], 1u);
    return b;
}
__device__ __forceinline__ void xcd_barrier_complete(unsigned* bar, unsigned x, unsigned& nloc, unsigned& nx) {
    const unsigned G = gridDim.x * gridDim.y * gridDim.z;
    unsigned sum, cnt, mine, sp = 0u;
    for (;;) {
        sum = 0u; cnt = 0u; mine = 0u;
#pragma unroll
        for (unsigned j = 0; j < 16; ++j) { const unsigned c = xb_ld(&bar[XB_XCNT(j)]); sum += c; cnt += (c > 0u) ? 1u : 0u; mine = (j == x) ? c : mine; }
        if (sum == G) break;
        __builtin_amdgcn_s_sleep(1);
        if ((++sp & 255u) == 0u) { if (xb_ld(&bar[XB_TMO])) break; if (sp > XB_SPIN_CAP) { atomicAdd(&bar[XB_TMO], 1u); break; } }
    }
    nloc = mine > 0u ? mine : 1u; nx = cnt > 0u ? cnt : 1u;
}

__device__ __forceinline__ void xcd_barrier(const XcdBarrier& b) {
    asm volatile("s_waitcnt vmcnt(0)" ::: "memory");
    __syncthreads();
    if (threadIdx.x == 0) {
        unsigned* bar = b.bar;
        __builtin_amdgcn_s_waitcnt(0);
        unsigned nloc = b.st[0], nx = b.st[1];
        if (nloc == 0u) { xcd_barrier_complete(bar, b.x, nloc, nx); b.st[0] = nloc; b.st[1] = nx; }
        const unsigned old = xb_add(&bar[XB_XSUB(b.x)], 1u);
        const unsigned gen = old / nloc;
        if (old + 1u == (gen + 1u) * nloc) {
            __builtin_amdgcn_fence(__ATOMIC_RELEASE, "agent");
            asm volatile("s_waitcnt vmcnt(0)" ::: "memory");
            const unsigned og = xb_add(&bar[XB_TOP], 1u);
            const unsigned tg = og / nx;
            if (og + 1u == (tg + 1u) * nx) xb_add(&bar[XB_TOPGEN], 1u);
            else XB_SPIN(xb_ld(&bar[XB_TOPGEN]) == tg, bar);
            __builtin_amdgcn_fence(__ATOMIC_ACQUIRE, "agent");
            xb_add(&bar[XB_XGEN(b.x)], 1u);
            asm volatile("s_waitcnt vmcnt(0)" ::: "memory");
        } else {
            XB_SPIN(xb_ld(&bar[XB_XGEN(b.x)]) == gen, bar);
            __builtin_amdgcn_fence(__ATOMIC_ACQUIRE, "agent");
            asm volatile("s_waitcnt vmcnt(0)" ::: "memory");
        }
    }
    __syncthreads();
}

struct Args { const float* in[21]; float* out; unsigned char* ws; };

__global__ void __launch_bounds__(NWAVES * 64, 2) fwd_mega(Args args) {
    extern __shared__ __attribute__((aligned(16))) unsigned char lds[];
    cg::grid_group grid = cg::this_grid();
#define PHASE_IDS() int tid_p = threadIdx.x; asm volatile("" : "+v"(tid_p)); const int tid = tid_p, lane = tid & 63, wave = __builtin_amdgcn_readfirstlane(tid >> 6); const int gw = bx * NWAVES + wave; (void)lane; (void)gw; (void)tid
    const int G = gridDim.x, bx = blockIdx.x;
    const int NGW = G * NWAVES;
    unsigned char* ws = args.ws;
    const float* x_p = args.in[0]; const float* x_s = args.in[1]; const float* p_p = args.in[2]; const float* p_s = args.in[3];
    const float* w_in = args.in[4]; const float* g_mix = args.in[5];
    const float* lq1 = args.in[6]; const float* lk1 = args.in[7]; const float* lq2 = args.in[8]; const float* lk2 = args.in[9];
    const float* g_subln = args.in[10]; const float* g_qn = args.in[11]; const float* g_kn = args.in[12];
    const float* w_out = args.in[13]; const float* g_mlp = args.in[14]; const float* w_ff1 = args.in[15]; const float* w_ff2 = args.in[16];
    const float* g_ple = args.in[17]; const float* w_gate = args.in[18]; const float* w_proj = args.in[19]; const float* g_final = args.in[20];
    float* out = args.out;
    float* RSP1 = (float*)(ws + WS_RSP1); float* RSP2 = (float*)(ws + WS_RSP2); float* RSP3 = (float*)(ws + WS_RSP3);
    bf16* WinT = (bf16*)(ws + WS_WIN); bf16* WoutT = (bf16*)(ws + WS_WOUT); bf16* W1T = (bf16*)(ws + WS_W1); bf16* W2T = (bf16*)(ws + WS_W2); bf16* WgT = (bf16*)(ws + WS_WG); bf16* WpT = (bf16*)(ws + WS_WP);
    bf16* PB = (bf16*)(ws + WS_PB); bf16* PROJ = (bf16*)(ws + WS_PROJ); bf16* Z = (bf16*)(ws + WS_Z); bf16* HB = (bf16*)(ws + WS_HB);
    bf16* XN = (bf16*)(ws + WS_XN); bf16* MIX = XN; bf16* HH = (bf16*)(ws + WS_H);
    LAS unsigned char* ldsl = (LAS unsigned char*)lds;
    volatile LAS unsigned* bst = (volatile LAS unsigned*)(ldsl + 139264);
    if (threadIdx.x < 2) bst[threadIdx.x] = 0u;
    __syncthreads();
    const XcdBarrier bar = xcd_barrier_post((unsigned*)ws, bst);
    if (ws == nullptr) grid.sync();

#ifndef NO_P0
#ifdef PROBE_EW2
    for (int rep = 0; rep < 2; ++rep)
#endif
    {
        PHASE_IDS();
        LAS float* scr = (LAS float*)(ldsl + wave * 16384);
        constexpr int I_IN = (D / 64) * (NIN / 32), I_OUT = (D / 64) * (D / 32), I_1 = (D / 64) * (FF / 32), I_2 = (FF / 64) * (D / 32), I_G = I_OUT, I_P = (PLE / 64) * (D / 32);
        constexpr int NITEMS = I_IN + I_OUT + I_1 + I_2 + I_G + I_P;
        for (int it = gw; it < NITEMS; it += NGW) {
            int r = it;
            if (r < I_IN) { transpose_item(w_in, D, NIN, nullptr, WinT, scr, r, lane); continue; } r -= I_IN;
            if (r < I_OUT) { transpose_item(w_out, D, D, nullptr, WoutT, scr, r, lane); continue; } r -= I_OUT;
            if (r < I_1) { transpose_item(w_ff1, D, FF, g_mlp, W1T, scr, r, lane); continue; } r -= I_1;
            if (r < I_2) { transpose_item(w_ff2, FF, D, nullptr, W2T, scr, r, lane); continue; } r -= I_2;
            if (r < I_G) { transpose_item(w_gate, D, D, g_ple, WgT, scr, r, lane); continue; } r -= I_G;
            transpose_item(w_proj, PLE, D, nullptr, WpT, scr, r, lane);
        }
        f32x4 gv[4];
#pragma unroll
        for (int j = 0; j < 4; ++j) gv[j] = *((const f32x4*)g_mix + lane + 64 * j);
        for (int m0 = gw * 2; m0 < M; m0 += NGW * 2) {
            f32x4 v[2][4], pv[2];
#pragma unroll
            for (int r = 0; r < 2; ++r) { const int m = m0 + r;
                const float* xrow = m < MP ? x_p + (size_t)m * D : x_s + (size_t)(m - MP) * D;
                const float* prow = m < MP ? p_p + (size_t)m * PLE : p_s + (size_t)(m - MP) * PLE;
#pragma unroll
                for (int j = 0; j < 4; ++j) v[r][j] = *((const f32x4*)xrow + lane + 64 * j);
                pv[r] = *((const f32x4*)prow + lane); }
#pragma unroll
            for (int r = 0; r < 2; ++r) { const int m = m0 + r; float s = 0.f;
#pragma unroll
                for (int j = 0; j < 4; ++j) s += (v[r][j].x * v[r][j].x + v[r][j].y * v[r][j].y) + (v[r][j].z * v[r][j].z + v[r][j].w * v[r][j].w);
                const float rstd = 1.0f / sqrtf(wave_sum(s) * (1.0f / D) + 1e-6f);
                unsigned long long* o8 = (unsigned long long*)(XN + (size_t)m * D) + lane;
#pragma unroll
                for (int j = 0; j < 4; ++j) { const f32x4 y = v[r][j] * rstd * gv[j]; o8[64 * j] = (unsigned long long)pk2(y.x, y.y) | ((unsigned long long)pk2(y.z, y.w) << 32); }
                *((unsigned long long*)(PB + (size_t)m * PLE) + lane) = (unsigned long long)pk2(pv[r].x, pv[r].y) | ((unsigned long long)pk2(pv[r].z, pv[r].w) << 32); }
        }
    }
#endif
    xcd_barrier(bar);

#ifndef NO_P1
#ifdef PROBE_GEMM2
    for (int rep = 0; rep < 2; ++rep)
#endif
    {
        pg8::Gemm g{XN, WinT, M, NIN, D}; pg8::StaticOrder S; S.init(M, NIN, G, bx);
        pg8::EpiBf E{Z, ZP, C2, 2};
        pg8::gemm_phase<pg8::EpiBf, pg8::StaticOrder, true, true>(ldsl, g, S, E);
    }
    {
        pg8::Gemm g{PB, WpT, M, D, PLE}; pg8::StaticOrder S; S.init(M, D, G, bx);
        pg8::EpiBf E{PROJ, D, 1.f, 0};
        pg8::gemm_phase<pg8::EpiBf, pg8::StaticOrder, true, true>(ldsl, g, S, E);
    }
#endif
    xcd_barrier(bar);

#ifndef NO_P1B
    {
        int tl = threadIdx.x; asm volatile("" : "+v"(tl));
        const long nth = (long)G * 512;
        const int j4 = (tl & 3) * 4;
        {
            float mq = 0.f, mk = 0.f, md = 0.f;
            for (long it = (long)bx * 512 + tl; it < (long)M * 32; it += nth) {
                const long item = it >> 2; const int m = (int)(item >> 3), hc = (int)(item & 7);
                const bf16* p = Z + (size_t)m * ZP + hc * 64 + j4; float sq = 0.f, sk = 0.f, sd = 0.f;
#pragma unroll
                for (int q = 0; q < 4; ++q) { const unsigned long long w = *(const unsigned long long*)(p + 16 * q), wk = *(const unsigned long long*)(p + 512 + 16 * q);
                    const unsigned lo = (unsigned)w, hi = (unsigned)(w >> 32), klo = (unsigned)wk, khi = (unsigned)(wk >> 32);
                    const float a = __uint_as_float(lo << 16), b = __uint_as_float(lo & 0xffff0000u), c = __uint_as_float(hi << 16), d = __uint_as_float(hi & 0xffff0000u);
                    const float ka = __uint_as_float(klo << 16), kb = __uint_as_float(klo & 0xffff0000u), kc = __uint_as_float(khi << 16), kd = __uint_as_float(khi & 0xffff0000u);
                    sq += (a * a + b * b) + (c * c + d * d); sk += (ka * ka + kb * kb) + (kc * kc + kd * kd); sd += (a * ka + b * kb) + (c * kc + d * kd); }
                sq += __shfl_xor(sq, 1); sq += __shfl_xor(sq, 2); sk += __shfl_xor(sk, 1); sk += __shfl_xor(sk, 2); sd += __shfl_xor(sd, 1); sd += __shfl_xor(sd, 2);
                mq = fmaxf(mq, sq); mk = fmaxf(mk, sk); md = fmaxf(md, -sd);
            }
#pragma unroll
            for (int o = 1; o < 64; o <<= 1) { mq = fmaxf(mq, __shfl_xor(mq, o)); mk = fmaxf(mk, __shfl_xor(mk, o)); md = fmaxf(md, __shfl_xor(md, o)); }
            if ((tl & 63) == 0) { atomicMax((unsigned*)ws + CW_QMAX, __float_as_uint(sqrtf(mq) * 1.0001f)); atomicMax((unsigned*)ws + CW_KMAX, __float_as_uint(sqrtf(mk) * 1.0001f));
                                  atomicMax((unsigned*)ws + CW_DNEG, __float_as_uint(md * 1.0001f + 1e-3f)); }
        }
        for (long it = (long)bx * 512 + tl; it < (long)M * 40; it += nth) {
            const long item = it >> 2;
            const int m = (int)(item / 10), hh = (int)(item % 10);
            const int t = m < MP ? (m & (SEQ_P - 1)) : ((m - MP) & (SEQ_S - 1));
            bf16* p = Z + (size_t)m * ZP + 1536 + hh * 64 + j4;
            const float* gg = (hh < 8 ? g_qn : g_kn) + j4;
            float v[4][4]; float ss = 0.f;
#pragma unroll
            for (int q = 0; q < 4; ++q) { const unsigned long long w = *(const unsigned long long*)(p + 16 * q); const unsigned lo = (unsigned)w, hi = (unsigned)(w >> 32);
                v[q][0] = __uint_as_float(lo << 16); v[q][1] = __uint_as_float(lo & 0xffff0000u); v[q][2] = __uint_as_float(hi << 16); v[q][3] = __uint_as_float(hi & 0xffff0000u);
                ss += (v[q][0] * v[q][0] + v[q][1] * v[q][1]) + (v[q][2] * v[q][2] + v[q][3] * v[q][3]); }
            ss += __shfl_xor(ss, 1); ss += __shfl_xor(ss, 2);
            const float rstd = 1.0f / sqrtf(ss * (1.0f / 64.0f) + 1e-6f);
#pragma unroll
            for (int q = 0; q < 4; ++q) { const f32x4 g4 = *(const f32x4*)(gg + 16 * q);
#pragma unroll
                for (int e = 0; e < 4; ++e) v[q][e] = v[q][e] * rstd * g4[e]; }
            const float fr = (float)(t >> 6), fc = (float)(t & 63), osc = hh < 8 ? C2 : 1.f;
#pragma unroll
            for (int e = 0; e < 4; ++e) {
                const float invf = __builtin_amdgcn_exp2f(-(float)(j4 + e) * (13.287712379549449f / 16.0f));
                const float ar = fr * invf, ac = fc * invf;
                const float cr = __cosf(ar), sr = __sinf(ar), cc = __cosf(ac), sc = __sinf(ac);
                const float a1 = v[0][e], a2 = v[1][e]; v[0][e] = (a1 * cr - a2 * sr) * osc; v[1][e] = (a1 * sr + a2 * cr) * osc;
                const float b1 = v[2][e], b2 = v[3][e]; v[2][e] = (b1 * cc - b2 * sc) * osc; v[3][e] = (b1 * sc + b2 * cc) * osc;
            }
#pragma unroll
            for (int q = 0; q < 4; ++q) *(unsigned long long*)(p + 16 * q) = (unsigned long long)pk2(v[q][0], v[q][1]) | ((unsigned long long)pk2(v[q][2], v[q][3]) << 32);
        }
    }
#endif
    xcd_barrier(bar);

#ifndef NO_P2
    {
        const float qkb = __uint_as_float(((const unsigned*)ws)[CW_QMAX]) * __uint_as_float(((const unsigned*)ws)[CW_KMAX]) + __uint_as_float(((const unsigned*)ws)[CW_DNEG]) + SKIP_T;
        PHASE_IDS();
        volatile LAS int* qslot = (volatile LAS int*)(ldsl + 139280);
        const float aqk_ = __uint_as_float(((const unsigned*)ws)[CW_QMAX]) * __uint_as_float(((const unsigned*)ws)[CW_KMAX]);
        const float amref = (aqk_ + __uint_as_float(((const unsigned*)ws)[CW_DNEG]) < 90.0f) ? aqk_ : -1.f;
        float gq_ = fabsf(g_qn[lane]), gk_ = fabsf(g_kn[lane]);
#pragma unroll
        for (int o = 1; o < 64; o <<= 1) { gq_ = fmaxf(gq_, __shfl_xor(gq_, o)); gk_ = fmaxf(gk_, __shfl_xor(gk_, o)); }
        const float bbound = 64.0f * C2 * 1.03f * gq_ * gk_;
        const bool bmaxfree = __builtin_amdgcn_readfirstlane((int)(bbound < 40.0f)) != 0;
        const int x0 = (int)(bar.x & 7u);
        for (int dx = 0; dx < 8; ++dx) {
            const int x = (x0 + dx) & 7;
            for (;;) {
                if (tid == 0) *qslot = (int)__hip_atomic_fetch_add((unsigned*)ws + CW_QUEUE + 64 * x, 1u, __ATOMIC_RELAXED, __HIP_MEMORY_SCOPE_AGENT);
                __syncthreads();
                const int i = *qslot;
                __syncthreads();
                if (i >= 384) break;
                int kind, h = 0, c = 0, head = 0, qb;
                if (i < 32) { kind = 0; h = 3; qb = i; }
                else if (i < 64) { kind = 0; h = 2; qb = i - 32; }
                else if (i < 192) { kind = 1; head = (x & 1) * 4 + ((i - 64) >> 5); qb = (i - 64) & 31; }
                else if (i < 224) { kind = 0; h = 1; qb = i - 192; }
                else if (i < 256) { kind = 2; h = 3 - ((i - 224) >> 4); c = ((i - 224) & 15) >> 3; qb = (i - 224) & 7; }
                else if (i < 320) { kind = 3; head = (i - 256) >> 3; qb = (i - 256) & 7; }
                else if (i < 336) { kind = 2; h = 1; c = (i - 320) >> 3; qb = (i - 320) & 7; }
                else if (i < 368) { kind = 0; h = 0; qb = i - 336; }
                else { kind = 2; h = 0; c = (i - 368) >> 3; qb = (i - 368) & 7; }
                const bool prompt = kind < 2;
                const int b = prompt ? (x >> 1) : x; if (kind == 0) c = x & 1;
                const int S = prompt ? SEQ_P : SEQ_S; const long rowbase = prompt ? (long)b * SEQ_P : (long)MP + (long)b * SEQ_S;
                const int q0 = qb * 256, NT = S / 64;
                const bf16* Zb = Z + rowbase * ZP;
                if (!(kind & 1)) {
                    const float slope = (h == 0 ? 0.25f : h == 1 ? 0.0625f : h == 2 ? 0.015625f : 0.00390625f), sl2 = LOG2E * slope;
                    const float W = qkb / sl2;
                    int t_lo = (int)floorf(fmaxf((float)q0 - W, 0.f) * (1.0f / 64.0f));
                    int t_hi = (int)fminf(floorf(((float)(q0 + 255) + W) * (1.0f / 64.0f)) + 1.0f, (float)NT);
                    if ((t_hi - t_lo) & 1) { if (t_lo > 0) --t_lo; else ++t_hi; }
                    const int hd = h * 2 + c;
                    att::attn_unit_pp<128, true, bf16>(Zb + (long)q0 * ZP + h * 128 + c * 64, Zb + (long)t_lo * 64 * ZP + 512 + h * 128 + c * 64, Zb + (long)t_lo * 64 * ZP + 1024 + h * 128,
                                                     (bf16*)out + (rowbase + q0) * 1024 + hd * 128, t_hi - t_lo, q0 - t_lo * 64, sl2, ldsl, amref);
                } else {
                    if (bmaxfree)
                        attn_body::attn_unit<1000>((const attn_body::bf16*)(Zb + (long)q0 * ZP + 1536 + head * 64), (const attn_body::bf16*)(Zb + 2048 + (head >> 2) * 64), (const attn_body::bf16*)(Zb + 2176 + (head >> 2) * 64),
                                                   (attn_body::bf16*)(MIX + (rowbase + q0) * 1024 + 512 + head * 64), NT, (char*)lds, bbound);
                    else
                        attn_body::attn_unit<8>((const attn_body::bf16*)(Zb + (long)q0 * ZP + 1536 + head * 64), (const attn_body::bf16*)(Zb + 2048 + (head >> 2) * 64), (const attn_body::bf16*)(Zb + 2176 + (head >> 2) * 64),
                                                (attn_body::bf16*)(MIX + (rowbase + q0) * 1024 + 512 + head * 64), NT, (char*)lds);
                }
            }
        }
    }
#endif
    xcd_barrier(bar);

#ifndef NO_P2B
#ifdef PROBE_EW2
    for (int rep = 0; rep < 2; ++rep)
#endif
    {
        PHASE_IDS();
        const float d1 = wave_sum(lq1[lane] * lk1[lane]), d2 = wave_sum(lq2[lane] * lk2[lane]);
        const float lam = expf(d1) - expf(d2) + 0.2f;
        const int h = lane >> 4, e0 = (lane & 15) * 8;
        const f32x4 g0 = *(const f32x4*)(g_subln + e0), g1 = *(const f32x4*)(g_subln + e0 + 4);
        for (int m0 = gw * 4; m0 < M; m0 += NGW * 4) {
            v4u wa[4], wb[4];
#pragma unroll
            for (int r = 0; r < 4; ++r) { const bf16* o0 = (const bf16*)out + (size_t)(m0 + r) * 1024 + (h * 2) * 128 + e0; wa[r] = *(const v4u*)o0; wb[r] = *(const v4u*)(o0 + 128); }
#pragma unroll
            for (int r = 0; r < 4; ++r) {
                f32x4 a0, a1, b0, b1;
                a0.x = __uint_as_float(wa[r].x << 16); a0.y = __uint_as_float(wa[r].x & 0xffff0000u); a0.z = __uint_as_float(wa[r].y << 16); a0.w = __uint_as_float(wa[r].y & 0xffff0000u);
                a1.x = __uint_as_float(wa[r].z << 16); a1.y = __uint_as_float(wa[r].z & 0xffff0000u); a1.z = __uint_as_float(wa[r].w << 16); a1.w = __uint_as_float(wa[r].w & 0xffff0000u);
                b0.x = __uint_as_float(wb[r].x << 16); b0.y = __uint_as_float(wb[r].x & 0xffff0000u); b0.z = __uint_as_float(wb[r].y << 16); b0.w = __uint_as_float(wb[r].y & 0xffff0000u);
                b1.x = __uint_as_float(wb[r].z << 16); b1.y = __uint_as_float(wb[r].z & 0xffff0000u); b1.z = __uint_as_float(wb[r].w << 16); b1.w = __uint_as_float(wb[r].w & 0xffff0000u);
                a0 = a0 - lam * b0; a1 = a1 - lam * b1;
                float s2 = ((a0.x * a0.x + a0.y * a0.y) + (a0.z * a0.z + a0.w * a0.w)) + ((a1.x * a1.x + a1.y * a1.y) + (a1.z * a1.z + a1.w * a1.w));
                s2 += __shfl_xor(s2, 1); s2 += __shfl_xor(s2, 2); s2 += __shfl_xor(s2, 4); s2 += __shfl_xor(s2, 8);
                const float rstd = 0.8f / sqrtf(s2 * (1.0f / 128.0f) + 1e-5f);
                a0 = a0 * rstd * g0; a1 = a1 * rstd * g1;
                v4u w; w.x = pk2(a0.x, a0.y); w.y = pk2(a0.z, a0.w); w.z = pk2(a1.x, a1.y); w.w = pk2(a1.z, a1.w);
                *(v4u*)(MIX + (size_t)(m0 + r) * 1024 + h * 128 + e0) = w; }
        }
    }
#endif
    xcd_barrier(bar);

#ifndef NO_P3
#ifdef PROBE_GEMM2
    for (int rep = 0; rep < 2; ++rep)
#endif
    {
        pg8::Gemm g{MIX, WoutT, M, D, D}; pg8::StaticOrder S; S.init(M, D, G, bx);
        pg8::EpiRes<false> E{x_p, x_s, MP, HB, RSP1, 0};
        pg8::gemm_phase<pg8::EpiRes<false>, pg8::StaticOrder, true, true>(ldsl, g, S, E);
    }
#endif
    xcd_barrier(bar);

#ifndef NO_P45
    for (int ch = 0; ch < 3; ++ch) {
        const int r0 = ch * 16384;
#ifndef NO_FF1
#ifdef PROBE_GEMM2
        for (int rep = 0; rep < 2; ++rep)
#endif
        {
            pg8::Gemm g{HB + (size_t)r0 * D, W1T, 16384, FF, D}; pg8::StaticOrder S; S.init(16384, FF, G, bx);
            pg8::EpiFF1 E{RSP1, HH, r0};
            pg8::gemm_phase<pg8::EpiFF1, pg8::StaticOrder, true, true>(ldsl, g, S, E);
        }
#endif
        xcd_barrier(bar);
#ifndef NO_FF2
        {
            pg8::Gemm g{HH, W2T, 16384, D, FF}; pg8::StaticOrder S; S.init(16384, D, G, bx);
            pg8::EpiRes<true> E{nullptr, nullptr, 0, HB, RSP2, r0};
            pg8::gemm_phase<pg8::EpiRes<true>, pg8::StaticOrder, true, true>(ldsl, g, S, E);
        }
#endif
        xcd_barrier(bar);
    }

#endif
#ifndef NO_P6
    {
        pg8::Gemm g{HB, WgT, M, D, D}; pg8::StaticOrder S; S.init(M, D, G, bx);
        pg8::EpiGate E{RSP2, PROJ, HB, XN, RSP3};
        pg8::gemm_phase<pg8::EpiGate, pg8::StaticOrder, true, true>(ldsl, g, S, E);
    }
#endif
    xcd_barrier(bar);

#ifndef NO_P7
    {
        PHASE_IDS();
        f32x4 gv[4];
#pragma unroll
        for (int j = 0; j < 4; ++j) gv[j] = *((const f32x4*)g_final + lane + 64 * j);
        for (int m0 = gw * 4; m0 < M; m0 += NGW * 4) {
            unsigned long long w[4][4]; float rstd[4];
#pragma unroll
            for (int r = 0; r < 4; ++r) { const unsigned long long* hr = (const unsigned long long*)(XN + (size_t)(m0 + r) * D) + lane;
#pragma unroll
                for (int j = 0; j < 4; ++j) w[r][j] = hr[64 * j];
                rstd[r] = 1.0f / sqrtf(pg8::rs16(RSP3 + (size_t)(m0 + r) * 16) * (1.0f / D) + 1e-6f); }
#pragma unroll
            for (int r = 0; r < 4; ++r) { f32x4* xr = (f32x4*)(out + (size_t)(m0 + r) * D) + lane;
#pragma unroll
                for (int j = 0; j < 4; ++j) { const unsigned lo = (unsigned)w[r][j], hi2 = (unsigned)(w[r][j] >> 32);
                    f32x4 hv; hv.x = __uint_as_float(lo << 16); hv.y = __uint_as_float(lo & 0xffff0000u); hv.z = __uint_as_float(hi2 << 16); hv.w = __uint_as_float(hi2 & 0xffff0000u);
                    xr[64 * j] = hv * rstd[r] * gv[j]; } }
        }
    }
#endif
}

extern "C" void kernel_launch(void* const* d_in, const int* in_sizes, int n_in, void* d_out, int out_size, void* d_ws, size_t ws_size, hipStream_t stream) {
    static int grid = 0;
    if (grid == 0) {
        if (n_in != 21 || out_size != M * D || ws_size < WS_END) { fprintf(stderr, "kernel_launch: unexpected shapes (n_in %d out %d ws %zu)\n", n_in, out_size, ws_size); grid = -1; return; }
        int dev = 0, cus = 0, per_cu = 0;
        hipGetDevice(&dev); hipDeviceGetAttribute(&cus, hipDeviceAttributeMultiprocessorCount, dev);
        if (hipFuncSetAttribute((const void*)fwd_mega, hipFuncAttributeMaxDynamicSharedMemorySize, LDS_BYTES) != hipSuccess) { fprintf(stderr, "kernel_launch: hipFuncSetAttribute failed\n"); grid = -1; return; }
        if (hipOccupancyMaxActiveBlocksPerMultiprocessor(&per_cu, (const void*)fwd_mega, NWAVES * 64, LDS_BYTES) != hipSuccess || per_cu < 1) { fprintf(stderr, "kernel_launch: occupancy query gave %d\n", per_cu); per_cu = 1; }
        (void)hipGetLastError();
        grid = cus * per_cu;
    }
    if (grid < 0) return;
    if (hipMemsetAsync(d_ws, 0, CTL_BYTES, stream) != hipSuccess) { fprintf(stderr, "kernel_launch: memset failed\n"); return; }
    Args a{};
    for (int i = 0; i < 21; ++i) a.in[i] = (const float*)d_in[i];
    a.out = (float*)d_out; a.ws = (unsigned char*)d_ws;
    void* kargs[] = {&a};
    hipError_t e = hipLaunchCooperativeKernel((const void*)fwd_mega, dim3(grid), dim3(NWAVES * 64), kargs, LDS_BYTES, stream);
    if (e != hipSuccess) fprintf(stderr, "cooperative launch failed: %s (grid %d)\n", hipGetErrorString(e), grid);
}
```

```cpp
#include <hip/hip_runtime.h>
#include <hip/hip_bf16.h>
#include <hip/hip_cooperative_groups.h>
#include <cstdio>
#include <cstdint>
namespace cg = cooperative_groups;

namespace pg8 {
#define PG8_LAS __attribute__((address_space(3)))
typedef unsigned short bf16_t;
typedef short bf16x8 __attribute__((ext_vector_type(8)));
typedef float f32x4 __attribute__((ext_vector_type(4)));
typedef unsigned u32x4 __attribute__((ext_vector_type(4)));
constexpr int BM = 256, BK = 64, HALF = 128, HTB = HALF * BK * 2  , STAGE_BYTES = 8 * HTB, NXCD = 8, WGM = 8;

__host__ __device__ __forceinline__ int lds_byte(int r, int c) { const int st = (r >> 4) * 2 + (c >> 5), rr = r & 15, cc = c & 31, ob = rr * 64 + cc * 2; return st * 1024 + (ob ^ (((ob >> 9) & 1) << 5)); }
__host__ __device__ __forceinline__ void stage_rc(int b, int& R, int& C) { const int st = b / 1024, sb = b % 1024, swz = sb ^ (((sb >> 9) & 1) << 5); R = (st >> 1) * 16 + swz / 64; C = (st & 1) * 32 + (swz % 64) / 2; }
__host__ __device__ __forceinline__ int perm32(int rho) { const int n = rho >> 4, i = rho & 15; return 8 * (i >> 2) + 4 * n + (i & 3); }

struct Unit { int pm, pn; };
struct Gemm { const bf16_t* A; const bf16_t* Bt; int M, N, K; };

struct StaticOrder {
    int nM, nN, nwg, G, c;
    __host__ __device__ void init(int M, int N, int G_, int c_) { nM = M / BM; nN = N / BM; nwg = nM * nN; G = G_; c = c_; }
    __host__ __device__ bool next(int i, Unit& u) const {
        const long L = (long)i * G + c; if (L >= nwg) return false;
        int wgid = (int)L; { const int q = nwg / NXCD, r = nwg % NXCD, xcd = wgid % NXCD, off = wgid / NXCD; wgid = (xcd < r ? xcd * (q + 1) : r * (q + 1) + (xcd - r) * q) + off; }
        const int nig = WGM * nN, gid = wgid / nig, fm = gid * WGM, gsz = (nM - fm) < WGM ? (nM - fm) : WGM;
        u.pm = fm + ((wgid % nig) % gsz); u.pn = (wgid % nig) / gsz; return true;
    }
    __device__ __forceinline__ void a_ready(const Unit&) const {}
    __device__ __forceinline__ void done(const Unit&) const {}
};

__device__ __forceinline__ unsigned cvt_pk_bf16(float lo, float hi) { unsigned r; asm volatile("v_cvt_pk_bf16_f32 %0, %1, %2" : "=v"(r) : "v"(lo), "v"(hi)); return r; }
typedef float f32x2 __attribute__((ext_vector_type(2)));
typedef unsigned u32x2 __attribute__((ext_vector_type(2)));
__device__ __forceinline__ float rs16(const float* p) {
    const f32x4 a = *(const f32x4*)p, b = *(const f32x4*)(p + 4), c = *(const f32x4*)(p + 8), d = *(const f32x4*)(p + 12);
    return (((a[0] + a[1]) + (a[2] + a[3])) + ((b[0] + b[1]) + (b[2] + b[3]))) + (((c[0] + c[1]) + (c[2] + c[3])) + ((d[0] + d[1]) + (d[2] + d[3])));
}
struct EpiBf {
    static constexpr bool PERM = true, AFTER_DRAIN = false;
    bf16_t* O; int ldc; float scale_q; int nq_tiles;
    __device__ __forceinline__ void operator()(const f32x4 (&acc)[2][2][4][2], const Unit& u, int wr, int wc, int fr, int fq) const {
        const int row0 = u.pm * BM + wr * 64 + fr, col0 = u.pn * BM + wc * 32 + 8 * fq; const float sc = (u.pn < nq_tiles) ? scale_q : 1.f;
#pragma unroll
        for (int ai = 0; ai < 2; ++ai)
#pragma unroll
            for (int m = 0; m < 4; ++m) { bf16_t* rowp = O + (size_t)(row0 + ai * HALF + m * 16) * ldc + col0;
#pragma unroll
                for (int bj = 0; bj < 2; ++bj) { const f32x4 v0 = acc[ai][bj][m][0] * sc, v1 = acc[ai][bj][m][1] * sc;
                    u32x4 w; w.x = cvt_pk_bf16(v0[0], v0[1]); w.y = cvt_pk_bf16(v0[2], v0[3]); w.z = cvt_pk_bf16(v1[0], v1[1]); w.w = cvt_pk_bf16(v1[2], v1[3]);
                    *(u32x4*)(rowp + bj * HALF) = w; } }
    }
};
template <bool BASE_BF16> struct EpiRes {
    static constexpr bool PERM = false, AFTER_DRAIN = false;
    const float* base0; const float* base1; int split_row; bf16_t* hb; float* rsp; int row_off;
    __device__ __forceinline__ void operator()(const f32x4 (&acc)[2][2][4][2], const Unit& u, int wr, int wc, int fr, int fq) const {
        const int col0 = u.pn * BM + wc * 32 + 4 * fq;
#pragma unroll
        for (int ai = 0; ai < 2; ++ai)
#pragma unroll
            for (int m = 0; m < 4; ++m) { const int row = row_off + u.pm * BM + ai * HALF + wr * 64 + m * 16 + fr;
                const float* bp = row < split_row ? base0 + (size_t)row * 1024 : base1 + (size_t)(row - split_row) * 1024;
                bf16_t* hp = hb + (size_t)row * 1024; float s = 0.f;
#pragma unroll
                for (int bj = 0; bj < 2; ++bj)
#pragma unroll
                    for (int n = 0; n < 2; ++n) { const int c = col0 + bj * HALF + n * 16; f32x4 b;
                        if constexpr (BASE_BF16) { const u32x2 pw = *(const u32x2*)(hp + c);
                            b[0] = __uint_as_float(pw.x << 16); b[1] = __uint_as_float(pw.x & 0xffff0000u); b[2] = __uint_as_float(pw.y << 16); b[3] = __uint_as_float(pw.y & 0xffff0000u); }
                        else b = *(const f32x4*)(bp + c);
                        const f32x4 v = b + acc[ai][bj][m][n];
                        s += (v[0] * v[0] + v[1] * v[1]) + (v[2] * v[2] + v[3] * v[3]);
                        u32x2 w; w.x = cvt_pk_bf16(v[0], v[1]); w.y = cvt_pk_bf16(v[2], v[3]); *(u32x2*)(hp + c) = w; }
                s += __shfl_xor(s, 16); s += __shfl_xor(s, 32);
                if (fq == 0) rsp[(size_t)row * 16 + u.pn * 4 + wc] = s; }
    }
};
struct EpiFF1 {
    static constexpr bool PERM = true, AFTER_DRAIN = false;
    const float* rsp; bf16_t* H; int row_off;
    __device__ __forceinline__ void operator()(const f32x4 (&acc)[2][2][4][2], const Unit& u, int wr, int wc, int fr, int fq) const {
        const int col0 = u.pn * BM + wc * 32 + 8 * fq;
#pragma unroll
        for (int ai = 0; ai < 2; ++ai)
#pragma unroll
            for (int m = 0; m < 4; ++m) { const int lrow = u.pm * BM + ai * HALF + wr * 64 + m * 16 + fr;
                const float rstd = 1.0f / sqrtf(rs16(rsp + (size_t)(row_off + lrow) * 16) * (1.0f / 1024.0f) + 1e-6f);
                bf16_t* rowp = H + (size_t)lrow * 4096 + col0;
#pragma unroll
                for (int bj = 0; bj < 2; ++bj) { f32x4 v0 = acc[ai][bj][m][0] * rstd, v1 = acc[ai][bj][m][1] * rstd;
#pragma unroll
                    for (int e = 0; e < 4; ++e) { const float a = fmaxf(v0[e], 0.f), b = fmaxf(v1[e], 0.f); v0[e] = a * a; v1[e] = b * b; }
                    u32x4 w; w.x = cvt_pk_bf16(v0[0], v0[1]); w.y = cvt_pk_bf16(v0[2], v0[3]); w.z = cvt_pk_bf16(v1[0], v1[1]); w.w = cvt_pk_bf16(v1[2], v1[3]);
                    *(u32x4*)(rowp + bj * HALF) = w; }
                asm volatile("" ::: "memory"); }
    }
};
struct EpiGate {
    static constexpr bool PERM = false, AFTER_DRAIN = false;
    const float* rsp_in; const bf16_t* proj; const bf16_t* hb_in; bf16_t* hb_out; float* rsp_out;
    __device__ __forceinline__ void operator()(const f32x4 (&acc)[2][2][4][2], const Unit& u, int wr, int wc, int fr, int fq) const {
        const int col0 = u.pn * BM + wc * 32 + 4 * fq;
#pragma unroll
        for (int ai = 0; ai < 2; ++ai)
#pragma unroll
            for (int m = 0; m < 4; ++m) { const int row = u.pm * BM + ai * HALF + wr * 64 + m * 16 + fr;
                const float rstd = 1.0f / sqrtf(rs16(rsp_in + (size_t)row * 16) * (1.0f / 1024.0f) + 1e-6f);
                const bf16_t* ip = hb_in + (size_t)row * 1024; bf16_t* op = hb_out + (size_t)row * 1024; const bf16_t* pp = proj + (size_t)row * 1024; float s = 0.f;
#pragma unroll
                for (int bj = 0; bj < 2; ++bj)
#pragma unroll
                    for (int n = 0; n < 2; ++n) { const int c = col0 + bj * HALF + n * 16; const f32x4 a = acc[ai][bj][m][n] * rstd;
                        const u32x2 pw = *(const u32x2*)(pp + c), hw = *(const u32x2*)(ip + c);
                        f32x4 pr, h2; pr[0] = __uint_as_float(pw.x << 16); pr[1] = __uint_as_float(pw.x & 0xffff0000u); pr[2] = __uint_as_float(pw.y << 16); pr[3] = __uint_as_float(pw.y & 0xffff0000u);
                        h2[0] = __uint_as_float(hw.x << 16); h2[1] = __uint_as_float(hw.x & 0xffff0000u); h2[2] = __uint_as_float(hw.y << 16); h2[3] = __uint_as_float(hw.y & 0xffff0000u);
                        f32x4 g;
#pragma unroll
                        for (int e2 = 0; e2 < 4; ++e2) g[e2] = __builtin_amdgcn_rcpf(1.0f + __builtin_amdgcn_exp2f(-1.4426950408889634f * a[e2]));
                        const f32x4 v = h2 + g * pr;
                        s += (v[0] * v[0] + v[1] * v[1]) + (v[2] * v[2] + v[3] * v[3]);
                        u32x2 w; w.x = cvt_pk_bf16(v[0], v[1]); w.y = cvt_pk_bf16(v[2], v[3]); *(u32x2*)(op + c) = w; }
                s += __shfl_xor(s, 16); s += __shfl_xor(s, 32);
                if (fq == 0) rsp_out[(size_t)row * 16 + u.pn * 4 + wc] = s;
                asm volatile("" ::: "memory"); }
    }
};
template <class Epi, class Sched, bool ALIGN_EPI = false, bool SP2 = false>
__device__ __forceinline__ void gemm_phase(PG8_LAS unsigned char* lds, const Gemm g, const Sched& S, const Epi& E) {
    int tid_ = threadIdx.x; asm volatile("" : "+v"(tid_));
    const int tid = tid_, wid = __builtin_amdgcn_readfirstlane(tid >> 6), lane = tid & 63, wr = wid >> 2, wc = wid & 3, fr = lane & 15, fq = lane >> 4;
    const int K = g.K, nt = K / BK;
    unsigned voffA[2], voffB[2];
#pragma unroll
    for (int i = 0; i < 2; ++i) { int R, C; stage_rc(tid * 16 + i * 8192, R, C); const int Rb = Epi::PERM ? ((R & ~31) + perm32(R & 31)) : R;
        voffA[i] = (unsigned)(R * K + C) * 2u; voffB[i] = (unsigned)(Rb * K + C) * 2u; }
    const size_t kstep = (size_t)(BK * 2);
    const size_t hstep = (size_t)HALF * K * 2;
    const size_t tstep = 2 * hstep;
    const unsigned ldsw = (unsigned)wid * 1024u;
    const int aoff = lds_byte(wr * 64 + fr, fq * 8), boff = lds_byte(wc * 32 + fr, fq * 8);
#define PG8_SA(b, h) (((b) * 2 + (h)) * HTB)
#define PG8_SB(b, h) ((4 + (b) * 2 + (h)) * HTB)
#define PG8_STAGE(bufoff, gbase, voff) do { _Pragma("unroll") for (int _i = 0; _i < 2; ++_i) \
        __builtin_amdgcn_global_load_lds((const unsigned*)((const char*)(gbase) + (voff)[_i]), (PG8_LAS unsigned*)(lds + (bufoff) + ldsw + _i * 8192), 16, 0, 0); } while (0)
#define PG8_LDA(dst, b, h) do { _Pragma("unroll") for (int m = 0; m < 4; ++m) _Pragma("unroll") for (int k = 0; k < 2; ++k) dst[m][k] = *(const PG8_LAS bf16x8*)(lds + PG8_SA(b, h) + aoff + m * 2048 + k * 1024); } while (0)
#define PG8_LDB(dst, b, h) do { _Pragma("unroll") for (int n = 0; n < 2; ++n) _Pragma("unroll") for (int k = 0; k < 2; ++k) dst[n][k] = *(const PG8_LAS bf16x8*)(lds + PG8_SB(b, h) + boff + n * 2048 + k * 1024); } while (0)
#define PG8_MMA(ai, bj, At, Bt) do { __builtin_amdgcn_s_setprio(1); _Pragma("unroll") for (int m = 0; m < 4; ++m) _Pragma("unroll") for (int n = 0; n < 2; ++n) _Pragma("unroll") for (int k = 0; k < 2; ++k) \
        acc[ai][bj][m][n] = __builtin_amdgcn_mfma_f32_16x16x32_bf16(Bt[n][k], At[m][k], acc[ai][bj][m][n], 0, 0, 0); __builtin_amdgcn_s_setprio(0); } while (0)
#define PG8_WAIT_V(n) asm volatile("s_waitcnt vmcnt(" #n ")" ::: "memory")
#define PG8_WAIT_L(n) asm volatile("s_waitcnt lgkmcnt(" #n ")" ::: "memory")
#define PG8_BAR __builtin_amdgcn_s_barrier()
#define PG8_SCHED __builtin_amdgcn_sched_barrier(0)
    Unit cur, nxt; int ui = 0;
    if (!S.next(0, cur)) return;
    f32x4 acc[2][2][4][2];
#pragma unroll
    for (int a = 0; a < 2; ++a)
#pragma unroll
        for (int b = 0; b < 2; ++b)
#pragma unroll
            for (int m = 0; m < 4; ++m)
#pragma unroll
                for (int n = 0; n < 2; ++n) acc[a][b][m][n] = (f32x4){0.f, 0.f, 0.f, 0.f};
    bf16x8 At[4][2], B0[2][2], B1[2][2];
    const char* cA = (const char*)g.A + (size_t)cur.pm * tstep; const char* cB = (const char*)g.Bt + (size_t)cur.pn * tstep;
    S.a_ready(cur);
    if constexpr (SP2) {
        PG8_STAGE(PG8_SB(0, 0), cB, voffB); PG8_STAGE(PG8_SB(0, 1), cB + hstep, voffB); PG8_STAGE(PG8_SA(0, 0), cA, voffA); PG8_STAGE(PG8_SA(0, 1), cA + hstep, voffA);
        if (wr == 1) PG8_BAR;
        PG8_WAIT_V(2); PG8_BAR;
        PG8_STAGE(PG8_SB(1, 0), cB + kstep, voffB); PG8_STAGE(PG8_SA(1, 0), cA + kstep, voffA); PG8_STAGE(PG8_SB(1, 1), cB + hstep + kstep, voffB);
        PG8_WAIT_V(6); PG8_BAR;
    } else {
        PG8_STAGE(PG8_SB(0, 0), cB, voffB); PG8_STAGE(PG8_SA(0, 0), cA, voffA); PG8_STAGE(PG8_SB(0, 1), cB + hstep, voffB); PG8_STAGE(PG8_SA(0, 1), cA + hstep, voffA);
        if (wr == 1) PG8_BAR;
        PG8_WAIT_V(4); PG8_BAR;
        PG8_STAGE(PG8_SB(1, 0), cB + kstep, voffB); PG8_STAGE(PG8_SA(1, 0), cA + kstep, voffA); PG8_STAGE(PG8_SB(1, 1), cB + hstep + kstep, voffB);
        PG8_WAIT_V(6); PG8_BAR;
    }
    for (;;) {
        const bool has_next = S.next(ui + 1, nxt);
        const char* nA = has_next ? (const char*)g.A + (size_t)nxt.pm * tstep : cA; const char* nB = has_next ? (const char*)g.Bt + (size_t)nxt.pn * tstep : cB;
        for (int t = 0; t < nt; t += 2) {
            const bool last = (t == nt - 2);
            const char* a1 = cA + (size_t)(t + 1) * kstep;
            const char* a2 = last ? nA : cA + (size_t)(t + 2) * kstep; const char* b2 = last ? nB : cB + (size_t)(t + 2) * kstep;
            const char* a3 = a2 + kstep; const char* b3 = b2 + kstep;
            if (last && has_next) S.a_ready(nxt);
            if constexpr (SP2) {
            PG8_LDB(B0, 0, 0); PG8_LDB(B1, 0, 1); PG8_SCHED; PG8_LDA(At, 0, 0); PG8_STAGE(PG8_SA(1, 1), a1 + hstep, voffA);
            PG8_WAIT_V(8); PG8_WAIT_L(0); PG8_BAR; PG8_MMA(0, 0, At, B0); PG8_MMA(0, 1, At, B1); PG8_BAR; PG8_SCHED;
            PG8_LDA(At, 0, 1); PG8_STAGE(PG8_SB(0, 0), b2, voffB); PG8_STAGE(PG8_SB(0, 1), b2 + hstep, voffB); PG8_STAGE(PG8_SA(0, 0), a2, voffA);
            PG8_WAIT_V(8); PG8_WAIT_L(0); PG8_BAR; PG8_MMA(1, 0, At, B0); PG8_MMA(1, 1, At, B1); PG8_BAR; PG8_SCHED;
            PG8_LDB(B0, 1, 0); PG8_LDB(B1, 1, 1); PG8_SCHED; PG8_LDA(At, 1, 0); PG8_STAGE(PG8_SA(0, 1), a2 + hstep, voffA);
            PG8_WAIT_V(8); PG8_WAIT_L(0); PG8_BAR; PG8_MMA(0, 0, At, B0); PG8_MMA(0, 1, At, B1); PG8_BAR; PG8_SCHED;
            PG8_LDA(At, 1, 1); PG8_STAGE(PG8_SB(1, 0), b3, voffB); PG8_STAGE(PG8_SB(1, 1), b3 + hstep, voffB); PG8_STAGE(PG8_SA(1, 0), a3, voffA);
            PG8_WAIT_V(8); PG8_WAIT_L(0); PG8_BAR; PG8_MMA(1, 0, At, B0); PG8_MMA(1, 1, At, B1); PG8_BAR; PG8_SCHED;
            } else {
            PG8_LDB(B0, 0, 0); PG8_SCHED; PG8_LDA(At, 0, 0); PG8_STAGE(PG8_SA(1, 1), a1 + hstep, voffA);
            PG8_WAIT_L(8); PG8_BAR; PG8_WAIT_L(0); PG8_MMA(0, 0, At, B0); PG8_BAR; PG8_SCHED;
            PG8_LDB(B1, 0, 1); PG8_STAGE(PG8_SB(0, 0), b2, voffB);
            PG8_BAR; PG8_WAIT_L(0); PG8_MMA(0, 1, At, B1); PG8_BAR;
            PG8_LDA(At, 0, 1); PG8_STAGE(PG8_SA(0, 0), a2, voffA);
            PG8_BAR; PG8_WAIT_L(0); PG8_MMA(1, 0, At, B0); PG8_BAR; PG8_SCHED;
            PG8_STAGE(PG8_SB(0, 1), b2 + hstep, voffB);
            PG8_WAIT_V(6); PG8_BAR; PG8_MMA(1, 1, At, B1); PG8_BAR;
            PG8_LDB(B0, 1, 0); PG8_SCHED; PG8_LDA(At, 1, 0); PG8_STAGE(PG8_SA(0, 1), a2 + hstep, voffA);
            PG8_WAIT_L(8); PG8_BAR; PG8_WAIT_L(0); PG8_MMA(0, 0, At, B0); PG8_BAR; PG8_SCHED;
            PG8_LDB(B1, 1, 1); PG8_STAGE(PG8_SB(1, 0), b3, voffB);
            PG8_BAR; PG8_WAIT_L(0); PG8_MMA(0, 1, At, B1); PG8_BAR;
            PG8_LDA(At, 1, 1); PG8_STAGE(PG8_SA(1, 0), a3, voffA);
            PG8_BAR; PG8_WAIT_L(0); PG8_MMA(1, 0, At, B0); PG8_BAR; PG8_SCHED;
            PG8_STAGE(PG8_SB(1, 1), b3 + hstep, voffB);
            PG8_WAIT_V(6); PG8_BAR; PG8_MMA(1, 1, At, B1); PG8_BAR;
            }
        }
        if constexpr (ALIGN_EPI) { if (wr == 0) PG8_BAR; }
        if constexpr (!Epi::AFTER_DRAIN) { E(acc, cur, wr, wc, fr, fq); S.done(cur); }
        if (!has_next) break;
#pragma unroll
        for (int a = 0; a < 2; ++a)
#pragma unroll
            for (int b = 0; b < 2; ++b)
#pragma unroll
                for (int m = 0; m < 4; ++m)
#pragma unroll
                    for (int n = 0; n < 2; ++n) acc[a][b][m][n] = (f32x4){0.f, 0.f, 0.f, 0.f};
        cur = nxt; cA = nA; cB = nB; ++ui;
        if constexpr (ALIGN_EPI) { if (wr == 1) PG8_BAR; }
    }
    PG8_WAIT_V(0);
    if constexpr (!ALIGN_EPI) { if (wr == 0) PG8_BAR; }
    PG8_BAR;
    if constexpr (Epi::AFTER_DRAIN) { E.fused(acc, cur, wr, wc, fr, fq, lds, wid, lane); S.done(cur); }
#undef PG8_SA
#undef PG8_SB
#undef PG8_STAGE
#undef PG8_LDA
#undef PG8_LDB
#undef PG8_MMA
#undef PG8_WAIT_V
#undef PG8_WAIT_L
#undef PG8_BAR
#undef PG8_SCHED
}
}
namespace att {
typedef unsigned short bf16_t;
using bf16x8 = __attribute__((ext_vector_type(8))) short;
using s16x4  = __attribute__((ext_vector_type(4))) short;
using f32x16 = __attribute__((ext_vector_type(16))) float;
using u32x4  = __attribute__((ext_vector_type(4))) unsigned;
constexpr int LDZ = 2368;
constexpr int SHM_V = 16384, SHM_K = 8192;
constexpr int ATTN_LDS = 2 * SHM_V + 2 * SHM_K + 8 * 64 * 4;
constexpr float THR2 = 8.0f;
#define KSWZ64(row, colB) ((row) * 128 + ((colB) ^ ((((row) >> 1) & 7) << 4)))
#define SBAR() __builtin_amdgcn_sched_barrier(0)
__device__ __forceinline__ int crow(int r, int hi) { return (r & 3) + 8 * (r >> 2) + 4 * hi; }
__device__ __forceinline__ unsigned cvtpk(float lo, float hi) { unsigned r; asm volatile("v_cvt_pk_bf16_f32 %0, %1, %2" : "=v"(r) : "v"(lo), "v"(hi)); return r; }
__device__ __forceinline__ unsigned short f2bf(float f) { unsigned u = __builtin_bit_cast(unsigned, f); return (unsigned short)((u + 0x7fffu + ((u >> 16) & 1u)) >> 16); }

template <bool ALIBI>
__device__ __forceinline__ void partialSM(f32x16& p0, f32x16& p1, float& m_reg, float& alpha, float dq, float sl2) {
  if constexpr (ALIBI) {
#pragma unroll
    for (int r = 0; r < 16; ++r) { const float t0 = dq - (float)((r & 3) + 8 * (r >> 2)); const float t1 = t0 - 32.f;
      p0[r] = fmaf(-sl2, fabsf(t0), p0[r]); p1[r] = fmaf(-sl2, fabsf(t1), p1[r]); }
  }
  float pmax = p0[0];
#pragma unroll
  for (int r = 1; r < 16; ++r) pmax = fmaxf(pmax, p0[r]);
#pragma unroll
  for (int r = 0; r < 16; ++r) pmax = fmaxf(pmax, p1[r]);
  { auto rr = __builtin_amdgcn_permlane32_swap(__float_as_uint(pmax), __float_as_uint(pmax), false, false);
    pmax = fmaxf(__uint_as_float(rr[0]), __uint_as_float(rr[1])); }
  float mn;
  if (__builtin_expect(__all(pmax - m_reg <= THR2), 1)) { mn = m_reg; alpha = 1.f; }
  else { mn = fmaxf(m_reg, pmax); alpha = __builtin_amdgcn_exp2f(m_reg - mn); m_reg = mn; }
#pragma unroll
  for (int r = 0; r < 16; ++r) { p0[r] -= mn; p1[r] -= mn; }
#pragma unroll
  for (int r = 0; r < 16; ++r) p0[r] = __builtin_amdgcn_exp2f(p0[r]);
}
__device__ __forceinline__ void finishSM(f32x16& p0, f32x16& p1, float alpha, float& l_reg, bf16x8& pa0, bf16x8& pa1, bf16x8& pa2, bf16x8& pa3) {
#pragma unroll
  for (int r = 0; r < 16; ++r) p1[r] = __builtin_amdgcn_exp2f(p1[r]);
  float ps = 0;
#pragma unroll
  for (int r = 0; r < 16; ++r) ps += p0[r];
#pragma unroll
  for (int r = 0; r < 16; ++r) ps += p1[r];
  { auto rr = __builtin_amdgcn_permlane32_swap(__float_as_uint(ps), __float_as_uint(ps), false, false);
    ps = __uint_as_float(rr[0]) + __uint_as_float(rr[1]); }
  l_reg = l_reg * alpha + ps;
#define PK4(P, BASE, OUT) do { unsigned a0 = cvtpk(P[BASE + 0], P[BASE + 1]), a1 = cvtpk(P[BASE + 2], P[BASE + 3]);   \
    unsigned b0 = cvtpk(P[BASE + 4], P[BASE + 5]), b1 = cvtpk(P[BASE + 6], P[BASE + 7]);                              \
    auto r0 = __builtin_amdgcn_permlane32_swap(a0, b0, false, false); auto r1 = __builtin_amdgcn_permlane32_swap(a1, b1, false, false); \
    u32x4 w = {r0[0], r1[0], r0[1], r1[1]}; OUT = *reinterpret_cast<bf16x8*>(&w); } while (0)
  PK4(p0, 0, pa0); PK4(p0, 8, pa1); PK4(p1, 0, pa2); PK4(p1, 8, pa3);
#undef PK4
}
__device__ __forceinline__ void qkt(f32x16& p0, f32x16& p1, const char* Ks, const bf16x8* qr, int r32, int hi) {
  p0 = f32x16{}; p1 = f32x16{};
#pragma unroll
  for (int d0 = 0; d0 < 4; ++d0) { const int cb = (d0 * 16 + hi * 8) * 2;
    const bf16x8 b0 = *reinterpret_cast<const bf16x8*>(Ks + KSWZ64(r32, cb));
    const bf16x8 b1 = *reinterpret_cast<const bf16x8*>(Ks + 4096 + KSWZ64(r32, cb));
    p0 = __builtin_amdgcn_mfma_f32_32x32x16_bf16(b0, qr[d0], p0, 0, 0, 0);
    p1 = __builtin_amdgcn_mfma_f32_32x32x16_bf16(b1, qr[d0], p1, 0, 0, 0); }
}
template <int NCB> __device__ __forceinline__ int v_st(int k, int c) { const int kk = (k & ~0xC) | ((k & 4) << 1) | ((k & 8) >> 1); return ((kk >> 3) * NCB + (c >> 5)) * 512 + ((kk & 7) * 32 + (c & 31)) * 2; }
__device__ __forceinline__ int v_rd_base(int lane) { return ((lane & 3) << 3) | (((lane >> 2) & 3) << 6) | (((lane >> 4) & 1) << 5) | (((lane >> 5) & 1) << 8); }
template <int OFF> __device__ __forceinline__ s16x4 tr_read(int vb) {
  s16x4 r; asm volatile("ds_read_b64_tr_b16 %0, %1 offset:%2" : "=&v"(r) : "v"(vb), "i"(OFF) : "memory"); return r;
}
template <int NCB, int D0> __device__ __forceinline__ void pv_one(f32x16& od, int vb, bf16x8 pa0, bf16x8 pa1, bf16x8 pa2, bf16x8 pa3) {
  constexpr int KS = NCB * 1024, HF = NCB * 512, B0 = D0 * 512;
  const s16x4 l0 = tr_read<B0>(vb), h0 = tr_read<B0 + HF>(vb), l1 = tr_read<B0 + KS>(vb), h1 = tr_read<B0 + KS + HF>(vb);
  const s16x4 l2 = tr_read<B0 + 2 * KS>(vb), h2 = tr_read<B0 + 2 * KS + HF>(vb), l3 = tr_read<B0 + 3 * KS>(vb), h3 = tr_read<B0 + 3 * KS + HF>(vb);
  asm volatile("s_waitcnt lgkmcnt(0)" ::: "memory"); SBAR();
#define PK(L, H) (bf16x8){L[0], L[1], L[2], L[3], H[0], H[1], H[2], H[3]}
  od = __builtin_amdgcn_mfma_f32_32x32x16_bf16(pa0, PK(l0, h0), od, 0, 0, 0);
  od = __builtin_amdgcn_mfma_f32_32x32x16_bf16(pa1, PK(l1, h1), od, 0, 0, 0);
  od = __builtin_amdgcn_mfma_f32_32x32x16_bf16(pa2, PK(l2, h2), od, 0, 0, 0);
  od = __builtin_amdgcn_mfma_f32_32x32x16_bf16(pa3, PK(l3, h3), od, 0, 0, 0);
#undef PK
}
template <int NCB> __device__ __forceinline__ void pv_all(f32x16* o, int vb, bf16x8 pa0, bf16x8 pa1, bf16x8 pa2, bf16x8 pa3) {
  pv_one<NCB, 0>(o[0], vb, pa0, pa1, pa2, pa3); pv_one<NCB, 1>(o[1], vb, pa0, pa1, pa2, pa3);
  if constexpr (NCB == 4) { pv_one<NCB, 2>(o[2], vb, pa0, pa1, pa2, pa3); pv_one<NCB, 3>(o[3], vb, pa0, pa1, pa2, pa3); }
}
__device__ __forceinline__ void store_o(float* p, float v) { *p = v; }
__device__ __forceinline__ void store_o(bf16_t* p, float v) { *p = f2bf(v); }

template <int DV, bool ALIBI, typename TO>
__device__ __forceinline__ void attn_unit(const bf16_t* __restrict__ Qb, const bf16_t* __restrict__ Kh, const bf16_t* __restrict__ Vh, TO* __restrict__ Ob, int seq, int qpos0, float sl2, char* lds) {
  constexpr int NCB = DV / 32;
  const int tid = threadIdx.x, wid = tid >> 6, lane = tid & 63, r32 = lane & 31, hi = lane >> 5;
  char* V_lds = lds; char* K_lds = lds + 2 * SHM_V;
  float* ws = (float*)(lds + 2 * SHM_V + 2 * SHM_K) + wid * 64; float* li_l = ws; float* al_l = ws + 32;
  float m_reg = -1e30f, l_reg = 0; f32x16 o[NCB];
#pragma unroll
  for (int d = 0; d < NCB; ++d) o[d] = f32x16{};
  bf16x8 qr[4];
  const bf16_t* Qw = Qb + (long)(wid * 32 + r32) * LDZ + hi * 8;
#pragma unroll
  for (int d0 = 0; d0 < 4; ++d0) qr[d0] = *reinterpret_cast<const bf16x8*>(Qw + d0 * 16);
  const float dq0 = (float)(qpos0 + wid * 32 + r32 - 4 * hi);
  const int kr = tid >> 3, kc = (tid & 7) * 8, kst = KSWZ64(kr, kc * 2);
  const int sr = tid >> 4, sc = (tid & 15) * 8;
  const int vst0 = (DV == 128) ? v_st<NCB>(sr, sc) : v_st<NCB>(kr, kc), vst1 = v_st<NCB>(32 + sr, sc);
  const int vb0 = (int)(uintptr_t)V_lds + v_rd_base(lane);
  bf16x8 sv0[2], sv1[2], sk[2];
#define SLOAD(i, k0) do { if constexpr (DV == 128) { sv0[i] = *reinterpret_cast<const bf16x8*>(&Vh[(long)((k0) + sr) * LDZ + sc]); sv1[i] = *reinterpret_cast<const bf16x8*>(&Vh[(long)((k0) + 32 + sr) * LDZ + sc]); } \
    else { sv0[i] = *reinterpret_cast<const bf16x8*>(&Vh[(long)((k0) + kr) * LDZ + kc]); } \
    sk[i] = *reinterpret_cast<const bf16x8*>(&Kh[(long)((k0) + kr) * LDZ + kc]); } while (0)
#define SWRITE(b, i) do { *(bf16x8*)(V_lds + (b) * SHM_V + vst0) = sv0[i]; if constexpr (DV == 128) { *(bf16x8*)(V_lds + (b) * SHM_V + vst1) = sv1[i]; } \
    *(bf16x8*)(K_lds + (b) * SHM_K + kst) = sk[i]; } while (0)
#define SWAIT() do { if constexpr (DV == 128) asm volatile("s_waitcnt vmcnt(3)" ::: "memory"); else asm volatile("s_waitcnt vmcnt(2)" ::: "memory"); } while (0)
#define RESC(a) do { if (__any((a) < 1.f)) { if (hi == 0) al_l[r32] = (a); asm volatile("s_waitcnt lgkmcnt(0)" ::: "memory"); \
    _Pragma("unroll") for (int d = 0; d < NCB; ++d) _Pragma("unroll") for (int r = 0; r < 16; ++r) o[d][r] *= al_l[crow(r, hi)]; } } while (0)
  f32x16 pA0, pA1, pB0, pB1; float alA, alB; bf16x8 pa0, pa1, pa2, pa3; const int NT = seq / 64;
  SLOAD(0, 0); asm volatile("s_waitcnt vmcnt(0)" ::: "memory"); SWRITE(0, 0); __syncthreads();
  qkt(pA0, pA1, K_lds, qr, r32, hi); partialSM<ALIBI>(pA0, pA1, m_reg, alA, dq0, sl2);
  SLOAD(1, 64); if (2 < NT) SLOAD(0, 128);
  SWAIT(); SWRITE(1, 1); __syncthreads();
  for (int j = 1; j + 1 < NT; j += 2) {
    SBAR(); qkt(pB0, pB1, K_lds + SHM_K, qr, r32, hi);
    finishSM(pA0, pA1, alA, l_reg, pa0, pa1, pa2, pa3); SBAR();
    SLOAD(1, (j + 2) * 64); SBAR();
    pv_all<NCB>(o, vb0, pa0, pa1, pa2, pa3); partialSM<ALIBI>(pB0, pB1, m_reg, alB, dq0 - 64.f * (float)j, sl2);
    __syncthreads(); SWAIT(); SWRITE(0, 0);
    RESC(alB); __syncthreads();
    SBAR(); qkt(pA0, pA1, K_lds, qr, r32, hi);
    finishSM(pB0, pB1, alB, l_reg, pa0, pa1, pa2, pa3); SBAR();
    if (j + 3 < NT) SLOAD(0, (j + 3) * 64); SBAR();
    pv_all<NCB>(o, vb0 + SHM_V, pa0, pa1, pa2, pa3); partialSM<ALIBI>(pA0, pA1, m_reg, alA, dq0 - 64.f * (float)(j + 1), sl2);
    __syncthreads(); SWAIT(); SWRITE(1, 1);
    RESC(alA); __syncthreads();
  }
  SBAR(); qkt(pB0, pB1, K_lds + SHM_K, qr, r32, hi);
  finishSM(pA0, pA1, alA, l_reg, pa0, pa1, pa2, pa3); SBAR();
  pv_all<NCB>(o, vb0, pa0, pa1, pa2, pa3); partialSM<ALIBI>(pB0, pB1, m_reg, alB, dq0 - 64.f * (float)(NT - 1), sl2);
  __syncthreads(); RESC(alB);
  finishSM(pB0, pB1, alB, l_reg, pa0, pa1, pa2, pa3); SBAR();
  pv_all<NCB>(o, vb0 + SHM_V, pa0, pa1, pa2, pa3);
  if (hi == 0) li_l[r32] = l_reg; asm volatile("s_waitcnt lgkmcnt(0)" ::: "memory");
  float rli[16];
#pragma unroll
  for (int r = 0; r < 16; ++r) rli[r] = __builtin_amdgcn_rcpf(li_l[crow(r, hi)]);
  TO* Ow = Ob + (long)(wid * 32) * 1024;
#pragma unroll
  for (int r = 0; r < 16; ++r) { const int orow = crow(r, hi);
#pragma unroll
    for (int d0 = 0; d0 < NCB; ++d0) store_o(Ow + (long)orow * 1024 + d0 * 32 + r32, o[d0][r] * rli[r]); }
  __syncthreads();
#undef SLOAD
#undef SWRITE
#undef SWAIT
#undef RESC
}
#undef SBAR
}
namespace att {
#define ALAS __attribute__((address_space(3)))
__device__ __forceinline__ void qkt_l(f32x16& p0, f32x16& p1, const ALAS unsigned char* Ks, const bf16x8* qr, int r32, int hi) {
  p0 = f32x16{}; p1 = f32x16{};
#pragma unroll
  for (int d0 = 0; d0 < 4; ++d0) { const int cb = (d0 * 16 + hi * 8) * 2;
    const bf16x8 b0 = *reinterpret_cast<const ALAS bf16x8*>(Ks + KSWZ64(r32, cb));
    const bf16x8 b1 = *reinterpret_cast<const ALAS bf16x8*>(Ks + 4096 + KSWZ64(r32, cb));
    p0 = __builtin_amdgcn_mfma_f32_32x32x16_bf16(b0, qr[d0], p0, 0, 0, 0);
    p1 = __builtin_amdgcn_mfma_f32_32x32x16_bf16(b1, qr[d0], p1, 0, 0, 0); }
}
__device__ __forceinline__ void qkt_acc(f32x16& p0, f32x16& p1, const ALAS unsigned char* Ks, const bf16x8* qr, int r32, int hi) {
  bf16x8 kb0[4], kb1[4];
#pragma unroll
  for (int d0 = 0; d0 < 4; ++d0) { const int cb = (d0 * 16 + hi * 8) * 2;
    kb0[d0] = *reinterpret_cast<const ALAS bf16x8*>(Ks + KSWZ64(r32, cb)); kb1[d0] = *reinterpret_cast<const ALAS bf16x8*>(Ks + 4096 + KSWZ64(r32, cb)); }
  __builtin_amdgcn_sched_barrier(0);
#pragma unroll
  for (int d0 = 0; d0 < 4; ++d0) {
    p0 = __builtin_amdgcn_mfma_f32_32x32x16_bf16(kb0[d0], qr[d0], p0, 0, 0, 0);
    p1 = __builtin_amdgcn_mfma_f32_32x32x16_bf16(kb1[d0], qr[d0], p1, 0, 0, 0); }
}
__device__ __forceinline__ void qkt_c(f32x16& p0, f32x16& p1, const f32x16& negm, const ALAS unsigned char* Ks, const bf16x8* qr, int r32, int hi) {
  bf16x8 kb0[4], kb1[4];
#pragma unroll
  for (int d0 = 0; d0 < 4; ++d0) { const int cb = (d0 * 16 + hi * 8) * 2;
    kb0[d0] = *reinterpret_cast<const ALAS bf16x8*>(Ks + KSWZ64(r32, cb)); kb1[d0] = *reinterpret_cast<const ALAS bf16x8*>(Ks + 4096 + KSWZ64(r32, cb)); }
  __builtin_amdgcn_sched_barrier(0);
  p0 = __builtin_amdgcn_mfma_f32_32x32x16_bf16(kb0[0], qr[0], negm, 0, 0, 0); p1 = __builtin_amdgcn_mfma_f32_32x32x16_bf16(kb1[0], qr[0], negm, 0, 0, 0);
#pragma unroll
  for (int d0 = 1; d0 < 4; ++d0) {
    p0 = __builtin_amdgcn_mfma_f32_32x32x16_bf16(kb0[d0], qr[d0], p0, 0, 0, 0);
    p1 = __builtin_amdgcn_mfma_f32_32x32x16_bf16(kb1[d0], qr[d0], p1, 0, 0, 0); }
}
template <int NCB> __device__ __forceinline__ void pv_issue0(s16x4 (&vl)[4], s16x4 (&vh)[4], int vb) {
  constexpr int KS = NCB * 1024, HF = NCB * 512;
  vl[0] = tr_read<0>(vb); vh[0] = tr_read<HF>(vb); vl[1] = tr_read<KS>(vb); vh[1] = tr_read<KS + HF>(vb);
  vl[2] = tr_read<2 * KS>(vb); vh[2] = tr_read<2 * KS + HF>(vb); vl[3] = tr_read<3 * KS>(vb); vh[3] = tr_read<3 * KS + HF>(vb);
}
template <int NCB> __device__ __forceinline__ void pv_rest(f32x16* o, const s16x4 (&vl)[4], const s16x4 (&vh)[4], int vb, bf16x8 pa0, bf16x8 pa1, bf16x8 pa2, bf16x8 pa3) {
  asm volatile("s_waitcnt lgkmcnt(0)" ::: "memory"); __builtin_amdgcn_sched_barrier(0);
#define PK(L, H) (bf16x8){L[0], L[1], L[2], L[3], H[0], H[1], H[2], H[3]}
  o[0] = __builtin_amdgcn_mfma_f32_32x32x16_bf16(pa0, PK(vl[0], vh[0]), o[0], 0, 0, 0);
  o[0] = __builtin_amdgcn_mfma_f32_32x32x16_bf16(pa1, PK(vl[1], vh[1]), o[0], 0, 0, 0);
  o[0] = __builtin_amdgcn_mfma_f32_32x32x16_bf16(pa2, PK(vl[2], vh[2]), o[0], 0, 0, 0);
  o[0] = __builtin_amdgcn_mfma_f32_32x32x16_bf16(pa3, PK(vl[3], vh[3]), o[0], 0, 0, 0);
#undef PK
  pv_one<NCB, 1>(o[1], vb, pa0, pa1, pa2, pa3);
  if constexpr (NCB == 4) { pv_one<NCB, 2>(o[2], vb, pa0, pa1, pa2, pa3); pv_one<NCB, 3>(o[3], vb, pa0, pa1, pa2, pa3); }
}
constexpr int PP_NK = 4, PP_NV = 6;
constexpr int PP_KSLOT = 8192, PP_VSLOT = 16384, PP_LK = 0, PP_LV = PP_NK * PP_KSLOT, PP_LW = PP_LV + PP_NV * PP_VSLOT, PP_LDS = PP_LW + 8 * 64 * 4;
static_assert(PP_LDS <= 139264, "attention rings (the frame keeps its control words at byte 139264 of the 144 KiB)");
#define PP_BAR() do { asm volatile("s_waitcnt lgkmcnt(0)" ::: "memory"); __builtin_amdgcn_s_barrier(); asm volatile("" ::: "memory"); } while (0)
template <int DV, bool ALIBI, typename TO>
__device__ __forceinline__ void attn_unit_pp(const bf16_t* __restrict__ Qb, const bf16_t* __restrict__ Kh, const bf16_t* __restrict__ Vh, TO* __restrict__ Ob, int NT, int qpos0, float sl2, ALAS unsigned char* ldsl, float mref = -1.f) {
  constexpr int NCB = DV / 32, NVI = DV / 32;
  int tid_ = threadIdx.x; asm volatile("" : "+v"(tid_));
  const int tid = tid_, lane = tid & 63, r32 = lane & 31, hi = lane >> 5;
  const int wid = __builtin_amdgcn_readfirstlane(tid >> 6), g = wid >> 2, wq = wid & 3;
  ALAS float* li_l = (ALAS float*)(ldsl + PP_LW) + wid * 64; ALAS float* al_l = li_l + 32;
  bf16x8 qr[4];
  const bf16_t* Qw = Qb + (long)(wid * 32 + r32) * LDZ + hi * 8;
#pragma unroll
  for (int d0 = 0; d0 < 4; ++d0) qr[d0] = *reinterpret_cast<const bf16x8*>(Qw + d0 * 16);
  const float dq0 = (float)(qpos0 + wid * 32 + r32 - 8 * hi);
  unsigned doff[NVI];
#pragma unroll
  for (int i = 0; i < NVI; ++i) {
    const int Lk = (wq * 2 + (i & 1)) * 64 + lane, row = Lk >> 3, c = (Lk & 7) ^ ((row >> 1) & 7);
    const int Lv = (wq * NVI + i) * 64 + lane, st = Lv >> 5, wi = Lv & 31, kk = (st / NCB) * 8 + (wi >> 2), kv = (kk & ~0xC) | ((kk & 4) << 1) | ((kk & 8) >> 1);
    const int krow = (row & ~0xC) | ((row & 4) << 1) | ((row & 8) >> 1);
    doff[i] = g ? (unsigned)(krow * LDZ + c * 8) * 2u : (unsigned)(kv * LDZ + (st % NCB) * 32 + (wi & 3) * 8) * 2u; }
  const char* dbase = g ? (const char*)Kh : (const char*)Vh;
  const int dlds = g ? (PP_LK + wq * 2 * 1024) : (PP_LV + wq * NVI * 1024), dss = g ? PP_KSLOT : PP_VSLOT, ni = g ? 2 : NVI;
#define DMA_T(t, slot) do { const char* tb_ = dbase + (size_t)(t) * (64 * LDZ * 2); ALAS unsigned char* ld_ = ldsl + dlds + (slot) * dss; \
    _Pragma("unroll") for (int i_ = 0; i_ < NVI; ++i_) if (i_ < ni) __builtin_amdgcn_global_load_lds((const unsigned*)(tb_ + doff[i_]), (ALAS unsigned*)(ld_ + i_ * 1024), 16, 0, 0); } while (0)
  const int vbase = (int)(unsigned)(uintptr_t)(ldsl + PP_LV) + v_rd_base(lane);
  const bool mfree = __builtin_amdgcn_readfirstlane((int)(mref >= 0.f)) != 0;
  float m_reg = mfree ? mref : 0.f, l_reg = 0.f; f32x16 o[NCB];
  f32x16 negm = f32x16{}; const int qw = qpos0 + wid * 32;
#pragma unroll
  for (int d = 0; d < NCB; ++d) o[d] = f32x16{};
  f32x16 S0 = f32x16{}, S1 = f32x16{}; bf16x8 pa0 = bf16x8{}, pa1 = bf16x8{}, pa2 = bf16x8{}, pa3 = bf16x8{};
  if (g == 1) { _Pragma("unroll") for (int t = 0; t < PP_NK; ++t) DMA_T(t, t); asm volatile("s_waitcnt vmcnt(6)" ::: "memory"); static_assert(PP_NK == 4, "prologue wait = 2 * (NK - 1)"); }
  else { _Pragma("unroll") for (int t = 0; t < PP_NV - 2; ++t) DMA_T(t, t); }
  PP_BAR();
#define CRF(r) ((float)(((r) & 7) + 16 * ((r) >> 3)))
#define M_STEP(k) do { const int k_ = (k); s16x4 vl_[4], vh_[4]; const int vb_ = vbase + ((k_ >= 0 ? k_ : 0) % PP_NV) * PP_VSLOT; \
    if (k_ >= 0) pv_issue0<NCB>(vl_, vh_, vb_); \
    if (k_ + 1 < NT) { const int ks_ = (k_ + 1) % PP_NK; \
      if constexpr (ALIBI) { const int kt0_ = 64 * (k_ + 1); const float dq_ = dq0 - (float)kt0_; \
        if (kt0_ + 63 <= qw || kt0_ >= qw + 31) {     \
          const float ssl_ = (kt0_ + 63 <= qw) ? sl2 : -sl2; const float e0_ = -m_reg - ssl_ * dq_, e1_ = e0_ + 32.f * ssl_; \
          _Pragma("unroll") for (int r = 0; r < 16; ++r) { S0[r] = fmaf(ssl_, CRF(r), e0_); S1[r] = fmaf(ssl_, CRF(r), e1_); } \
        } else { \
          _Pragma("unroll") for (int r = 0; r < 16; ++r) { const float t0_ = dq_ - CRF(r); S0[r] = fmaf(-sl2, fabsf(t0_), -m_reg); S1[r] = fmaf(-sl2, fabsf(t0_ - 32.f), -m_reg); } \
        } \
        qkt_acc(S0, S1, ldsl + PP_LK + ks_ * PP_KSLOT, qr, r32, hi); \
      } else { qkt_c(S0, S1, negm, ldsl + PP_LK + ks_ * PP_KSLOT, qr, r32, hi); } } \
    if (k_ >= 0) pv_rest<NCB>(o, vl_, vh_, vb_, pa0, pa1, pa2, pa3); } while (0)
#define PKD(P, BASE, OUT) do { u32x4 w_ = {cvtpk(P[BASE + 0], P[BASE + 1]), cvtpk(P[BASE + 2], P[BASE + 3]), cvtpk(P[BASE + 4], P[BASE + 5]), cvtpk(P[BASE + 6], P[BASE + 7])}; OUT = *reinterpret_cast<bf16x8*>(&w_); } while (0)
#define PK4(P, BASE, OUT) do { unsigned a0 = cvtpk(P[BASE + 0], P[BASE + 1]), a1 = cvtpk(P[BASE + 2], P[BASE + 3]);   \
    unsigned b0 = cvtpk(P[BASE + 4], P[BASE + 5]), b1 = cvtpk(P[BASE + 6], P[BASE + 7]);                              \
    auto r0 = __builtin_amdgcn_permlane32_swap(a0, b0, false, false); auto r1 = __builtin_amdgcn_permlane32_swap(a1, b1, false, false); \
    u32x4 w = {r0[0], r1[0], r0[1], r1[1]}; OUT = *reinterpret_cast<bf16x8*>(&w); } while (0)
#define V_STEP(k) do { const int k_ = (k); \
    { const int tt_ = k_ + (g ? PP_NK : PP_NV - 2); if (tt_ < NT) DMA_T(tt_, g ? tt_ % PP_NK : tt_ % PP_NV); } \
    if (!mfree) { float pmax = S0[0]; \
    _Pragma("unroll") for (int r = 1; r < 16; ++r) pmax = fmaxf(pmax, S0[r]); \
    _Pragma("unroll") for (int r = 0; r < 16; ++r) pmax = fmaxf(pmax, S1[r]); \
    { auto rr = __builtin_amdgcn_permlane32_swap(__float_as_uint(pmax), __float_as_uint(pmax), false, false); \
      pmax = fmaxf(__uint_as_float(rr[0]), __uint_as_float(rr[1])); } \
    if (k_ == 0 || !__builtin_expect(__all(pmax <= THR2), 1)) {       \
      const float dl = (k_ == 0) ? pmax : fmaxf(pmax, 0.f); m_reg += dl; \
      _Pragma("unroll") for (int r = 0; r < 16; ++r) { S0[r] -= dl; S1[r] -= dl; } \
      if constexpr (!ALIBI) { _Pragma("unroll") for (int r = 0; r < 16; ++r) negm[r] = -m_reg; } \
      if (k_ != 0) { const float alpha = __builtin_amdgcn_exp2f(-dl); l_reg *= alpha; \
        if (hi == 0) al_l[r32] = alpha; \
        asm volatile("s_waitcnt lgkmcnt(0)" ::: "memory"); \
        _Pragma("unroll") for (int d = 0; d < NCB; ++d) _Pragma("unroll") for (int r = 0; r < 16; ++r) o[d][r] *= al_l[crow(r, hi)]; } } } \
    _Pragma("unroll") for (int r = 0; r < 16; ++r) { S0[r] = __builtin_amdgcn_exp2f(S0[r]); S1[r] = __builtin_amdgcn_exp2f(S1[r]); } \
    float ps = 0.f, ps1 = 0.f, ps2 = 0.f, ps3 = 0.f; \
    _Pragma("unroll") for (int r = 0; r < 16; r += 2) { ps += S0[r]; ps1 += S0[r + 1]; ps2 += S1[r]; ps3 += S1[r + 1]; } \
    ps = (ps + ps1) + (ps2 + ps3); \
    { auto rr = __builtin_amdgcn_permlane32_swap(__float_as_uint(ps), __float_as_uint(ps), false, false); \
      ps = __uint_as_float(rr[0]) + __uint_as_float(rr[1]); } \
    l_reg += ps; \
    PKD(S0, 0, pa0); PKD(S0, 8, pa1); PKD(S1, 0, pa2); PKD(S1, 8, pa3); } while (0)
#define WAIT_V(n) asm volatile("s_waitcnt vmcnt(" #n ")" ::: "memory")
  if (g == 0) {
    M_STEP(-1); PP_BAR();
    for (int k = 0; k < NT; ++k) {
      V_STEP(k);
      { const int no_ = NT - 1 - k;
        static_assert(PP_NV == 6, "up to NV - 2 = 4 later V tiles in flight");
        if (no_ >= 4) { if constexpr (NVI == 4) WAIT_V(16); else WAIT_V(8); } else if (no_ == 3) { if constexpr (NVI == 4) WAIT_V(12); else WAIT_V(6); }
        else if (no_ == 2) { if constexpr (NVI == 4) WAIT_V(8); else WAIT_V(4); } else if (no_ == 1) { if constexpr (NVI == 4) WAIT_V(4); else WAIT_V(2); } else WAIT_V(0); }
      PP_BAR();
      M_STEP(k); PP_BAR();
    }
    PP_BAR();
  } else {
    PP_BAR();
    for (int k = 0; k < NT; ++k) {
      M_STEP(k - 1);
      { const int no_ = NT - 2 - k;
        if (no_ >= 2) WAIT_V(4); else if (no_ == 1) WAIT_V(2); else WAIT_V(0); }
      PP_BAR();
      V_STEP(k); PP_BAR();
    }
    M_STEP(NT - 1); PP_BAR();
  }
#undef M_STEP
#undef CRF
#undef V_STEP
#undef PK4
#undef PKD
#undef WAIT_V
  if (hi == 0) li_l[r32] = l_reg; asm volatile("s_waitcnt lgkmcnt(0)" ::: "memory");
  float rli[16];
#pragma unroll
  for (int r = 0; r < 16; ++r) rli[r] = __builtin_amdgcn_rcpf(li_l[crow(r, hi)]);
  TO* Ow = Ob + (long)(wid * 32) * 1024;
#pragma unroll
  for (int r = 0; r < 16; ++r) { const int orow = crow(r, hi);
#pragma unroll
    for (int d0 = 0; d0 < NCB; ++d0) store_o(Ow + (long)orow * 1024 + d0 * 32 + r32, o[d0][r] * rli[r]); }
#undef DMA_T
}
#undef ALAS
}
namespace attn_body {
using bf16=__hip_bfloat16;
using bf16x8=__attribute__((ext_vector_type(8)))short;
using s16x4=__attribute__((ext_vector_type(4)))short;
using f32x16=__attribute__((ext_vector_type(16)))float;
using u32x4=__attribute__((ext_vector_type(4)))unsigned;
constexpr int D=64,DMQ=2368,DMK=2368,DMV=2368,DMO=1024;
constexpr int NW=8,QBLK=32,QB=QBLK*NW,KVBLK=64;
__device__ __forceinline__ int crow(int r,int hi){return (r&3)+8*(r>>2)+4*hi;}
#define SBAR() __builtin_amdgcn_sched_barrier(0)
__device__ __forceinline__ void cmask(f32x16&p0,f32x16&p1,int jb,int qrel,int hi){
  const float NEG=-INFINITY; int kb=64*jb+4*hi;
  #pragma unroll
  for(int r=0;r<16;++r){int kv=kb+(r&3)+8*(r>>2); if(kv>qrel)p0[r]=NEG; if(kv+32>qrel)p1[r]=NEG;}
}

constexpr int NSLOT=3, SLOTB=8192;
constexpr int LDS_K=0, LDS_V=NSLOT*SLOTB, LDS_WS=2*NSLOT*SLOTB, LDS_OST=LDS_WS+NW*64*4, LDS_BYTES=LDS_OST+NW*4096;
constexpr float C2=0.125f*1.4426950408889634f;
__device__ __forceinline__ void glds16(const void*gsrc,unsigned lds_dst){unsigned keep;
  asm volatile("s_mov_b32 %0, m0\n\ts_mov_b32 m0, %2\n\ts_nop 0\n\tglobal_load_lds_dwordx4 %1, off\n\ts_mov_b32 m0, %0":"=&s"(keep):"v"(gsrc),"s"(lds_dst):"memory");}
__device__ __forceinline__ float max3f(float a,float b,float c){float r;asm("v_max3_f32 %0, %1, %2, %3":"=v"(r):"v"(a),"v"(b),"v"(c));return r;}
__device__ __forceinline__ float max2f(float a,float b){float r;asm("v_max_f32_e32 %0, %1, %2":"=v"(r):"v"(a),"v"(b));return r;}
__device__ __forceinline__ float fadd_s(float a,float b){float r;asm("v_add_f32_e32 %0, %1, %2":"=v"(r):"v"(a),"v"(b));return r;}
__device__ __forceinline__ float fsub_s(float a,float b){float r;asm("v_sub_f32_e32 %0, %1, %2":"=v"(r):"v"(a),"v"(b));return r;}
typedef float f32x2_t __attribute__((ext_vector_type(2))); typedef __bf16 bf16x2_t __attribute__((ext_vector_type(2)));
__device__ __forceinline__ unsigned cvtpk_s(float lo,float hi){f32x2_t v={lo,hi};bf16x2_t b=__builtin_convertvector(v,bf16x2_t);return __builtin_bit_cast(unsigned,b);}
#define WAIT_BAR(N) asm volatile("s_waitcnt vmcnt(" #N ") lgkmcnt(0)\n\ts_barrier":::"memory")

__device__ __forceinline__ void qkt(f32x16&p0,f32x16&p1,const char*Kslot,const bf16x8*qr,const f32x16&negm,int r32,int hi){
  const char*kb=Kslot+hi*1024+r32*16;
  #pragma unroll
  for(int d0=0;d0<4;++d0){
    const bf16x8 b0=*reinterpret_cast<const bf16x8*>(kb+d0*2048);
    const bf16x8 b1=*reinterpret_cast<const bf16x8*>(kb+d0*2048+512);
    if(d0==0){p0=__builtin_amdgcn_mfma_f32_32x32x16_bf16(b0,qr[0],negm,0,0,0);p1=__builtin_amdgcn_mfma_f32_32x32x16_bf16(b1,qr[0],negm,0,0,0);}
    else{p0=__builtin_amdgcn_mfma_f32_32x32x16_bf16(b0,qr[d0],p0,0,0,0);p1=__builtin_amdgcn_mfma_f32_32x32x16_bf16(b1,qr[d0],p1,0,0,0);}}
}
typedef __attribute__((address_space(3))) const char* lds_cptr;
typedef short v4i16_t __attribute__((ext_vector_type(4)));
__device__ __forceinline__ void kload8(bf16x8*kf,lds_cptr kp){
  kf[0]=*(const __attribute__((address_space(3))) bf16x8*)(kp);      kf[1]=*(const __attribute__((address_space(3))) bf16x8*)(kp+512);
  kf[2]=*(const __attribute__((address_space(3))) bf16x8*)(kp+2048); kf[3]=*(const __attribute__((address_space(3))) bf16x8*)(kp+2560);
  kf[4]=*(const __attribute__((address_space(3))) bf16x8*)(kp+4096); kf[5]=*(const __attribute__((address_space(3))) bf16x8*)(kp+4608);
  kf[6]=*(const __attribute__((address_space(3))) bf16x8*)(kp+6144); kf[7]=*(const __attribute__((address_space(3))) bf16x8*)(kp+6656);
}
__device__ __forceinline__ void kload2(bf16x8*kf,lds_cptr kp,int j){ kf[2*j]=*(const __attribute__((address_space(3))) bf16x8*)(kp+j*2048); kf[2*j+1]=*(const __attribute__((address_space(3))) bf16x8*)(kp+j*2048+512); }
__device__ __forceinline__ s16x4 vtr(lds_cptr p){ return __builtin_bit_cast(s16x4,__builtin_amdgcn_ds_read_tr16_b64_v4i16((__attribute__((address_space(3))) v4i16_t*)p)); }
__device__ __forceinline__ float rowmax(const f32x16&p0,const f32x16&p1){
  float a=max3f(p0[0],p0[1],p1[0]),b=max3f(p0[2],p0[3],p1[1]);a=max3f(a,p1[2],p1[3]);
  #pragma unroll
  for(int r=4;r<16;r+=4){a=max3f(a,p0[r],p0[r+1]);b=max3f(b,p0[r+2],p0[r+3]);a=max3f(a,p1[r],p1[r+1]);b=max3f(b,p1[r+2],p1[r+3]);}
  const float m=max2f(a,b);
  auto rr=__builtin_amdgcn_permlane32_swap(__float_as_uint(m),__float_as_uint(m),false,false);
  return max2f(__uint_as_float(rr[0]),__uint_as_float(rr[1]));
}
__device__ __forceinline__ void pv(f32x16*o,int vb,bf16x8 pa0,bf16x8 pa1,bf16x8 pa2,bf16x8 pa3){
  #pragma unroll
  for(int d0=0;d0<2;++d0){s16x4 lo[4],hi[4];
    #pragma unroll
    for(int ks=0;ks<4;++ks){
      asm volatile("ds_read_b64_tr_b16 %0,%1 offset:%c2":"=&v"(lo[ks]):"v"(vb),"i"(d0*4096+ks*1024):"memory");
      asm volatile("ds_read_b64_tr_b16 %0,%1 offset:%c2":"=&v"(hi[ks]):"v"(vb),"i"(d0*4096+ks*1024+512):"memory");}
    asm volatile("s_waitcnt lgkmcnt(0)":::"memory");SBAR();
    #define PK(k) (bf16x8){lo[k][0],lo[k][1],lo[k][2],lo[k][3],hi[k][0],hi[k][1],hi[k][2],hi[k][3]}
    o[d0]=__builtin_amdgcn_mfma_f32_32x32x16_bf16(pa0,PK(0),o[d0],0,0,0);
    o[d0]=__builtin_amdgcn_mfma_f32_32x32x16_bf16(pa1,PK(1),o[d0],0,0,0);
    o[d0]=__builtin_amdgcn_mfma_f32_32x32x16_bf16(pa2,PK(2),o[d0],0,0,0);
    o[d0]=__builtin_amdgcn_mfma_f32_32x32x16_bf16(pa3,PK(3),o[d0],0,0,0);
    #undef PK
  }
}

#ifndef ATTN_STORE16
#define ATTN_STORE16(p,v) (*(u32x4*)(p)=(v))
#endif
template<int THRL> __device__ __forceinline__ void attn_unit(const bf16*Qb,const bf16*__restrict__ Kh,const bf16*__restrict__ Vh,bf16*Ob,const int NT,char*shm,const float sbound=0.f){
  const int tid=threadIdx.x,lane=tid&63,r32=lane&31,hi=lane>>5; const int wid=__builtin_amdgcn_readfirstlane(tid>>6);
  const bf16*Qw=Qb+(long)(wid*QBLK)*DMQ;
  const unsigned lds0=(unsigned)(uintptr_t)shm;
  float*wsf=(float*)(shm+LDS_WS)+wid*64;
  const bf16*ksrc=Kh+(long)lane*DMK+wid*8;
  const bf16*vsrc=Vh+(long)(16*(wid&3)+(lane>>2))*DMV+(wid>>2)*32+(lane&3)*8;
  const unsigned kdst=lds0+LDS_K+wid*1024, vdst=lds0+LDS_V+wid*1024;
  #define DMA_K(t,slot) glds16(ksrc+(long)(t)*KVBLK*DMK,(unsigned)__builtin_amdgcn_readfirstlane(kdst+(slot)))
  #define DMA_V(t,slot) glds16(vsrc+(long)(t)*KVBLK*DMV,(unsigned)__builtin_amdgcn_readfirstlane(vdst+(slot)))
  const int vb0=(int)(lds0+LDS_V)+((lane>>4)&1)*32+(lane&3)*8+(4*hi+((lane&15)>>2))*64;
  const char*Kbase=shm+LDS_K; bf16x8 kf[8];
  const lds_cptr shm3=(lds_cptr)shm; const lds_cptr kp0=shm3+LDS_K+hi*1024+r32*16; const lds_cptr vp0=shm3+LDS_V+((lane>>4)&1)*32+(lane&3)*8+(4*hi+((lane&15)>>2))*64;
  DMA_K(0,0);DMA_V(0,0);DMA_K(1,SLOTB);
  bf16x8 qr[4];
  #pragma unroll
  for(int d0=0;d0<4;++d0)qr[d0]=*reinterpret_cast<const bf16x8*>(&Qw[(long)r32*DMQ+d0*16+hi*8]);
  float sb_=sbound; asm volatile("":"+v"(sb_));
  float mhat=(THRL>=1000)?sb_:0.f,l_reg=0.f;f32x16 o[2];o[0]=f32x16{};o[1]=f32x16{};f32x16 negm;
  _Pragma("unroll") for(int r=0;r<16;++r)negm[r]=-mhat; asm volatile("":"+v"(negm));
  #define CMASK(P0,P1,t) do{}while(0)
  bool resc=false;
  #define START(P0,P1) do{ resc=false; if constexpr(THRL<1000) { const float rm=rowmax(P0,P1); \
      const float dl=rm; mhat=fadd_s(mhat,dl); \
      _Pragma("unroll") for(int r=0;r<16;++r){P0[r]=fsub_s(P0[r],dl);P1[r]=fsub_s(P1[r],dl);} \
      _Pragma("unroll") for(int r=0;r<16;++r)negm[r]=-mhat; asm volatile("":"+v"(negm)); } \
    _Pragma("unroll") for(int r=0;r<16;++r)P0[r]=__builtin_amdgcn_exp2f(P0[r]); }while(0)
  #define RESC() do{ if(resc){ asm volatile("s_waitcnt lgkmcnt(0)":::"memory"); \
      _Pragma("unroll") for(int d_=0;d_<2;++d_) _Pragma("unroll") for(int r=0;r<16;++r)o[d_][r]*=wsf[crow(r,hi)]; } }while(0)
  f32x16 pA0,pA1,pB0,pB1;
  int sl_prev=0,sl_cur=0,sl_next=SLOTB;
  #define ROT() do{sl_prev=sl_cur;sl_cur=sl_next;sl_next=(sl_next==(NSLOT-1)*SLOTB)?0:sl_next+SLOTB;}while(0)
  DMA_K(2,2*SLOTB);
  WAIT_BAR(3);
  qkt(pA0,pA1,Kbase,qr,negm,r32,hi);asm volatile("s_nop 15\n\ts_nop 7":"+v"(pA0),"+v"(pA1));CMASK(pA0,pA1,0);
  START(pA0,pA1);
  _Pragma("unroll") for(int r=0;r<16;++r)pA1[r]=__builtin_amdgcn_exp2f(pA1[r]);
  WAIT_BAR(0);
  DMA_K(3,0);DMA_V(1,SLOTB);
  ROT();
  kload8(kf,kp0+sl_cur);
  WAIT_BAR(2);
  s16x4 vlo[8],vhi[8]; u32x4 pw0,pw1,pw2,pw3;
  #define PKW(P,B) cvtpk_s(P[B],P[B+1])
  #define PAF(k) __builtin_bit_cast(bf16x8,pw##k)
  #define VFR(i) (bf16x8){vlo[i][0],vlo[i][1],vlo[i][2],vlo[i][3],vhi[i][0],vhi[i][1],vhi[i][2],vhi[i][3]}
  #define PIN(x) asm volatile("":"+v"(x))
  #define MX3(a,b,c) __builtin_fmaxf(__builtin_fmaxf((a),(b)),(c))
  #define GAPA(MF,A0,A1,A2,A3,W0,W1,PW) do{ MF; sacc+=A0; sacc+=A1; sacc+=A2; sacc+=A3; PIN(sacc); W0; W1; PIN(PW); SBAR(); }while(0)
  #define EX(v) __builtin_amdgcn_exp2f(v)
  #define GAPB(MF,X,B) do{ MF; X[B]=EX(X[B]); X[B+1]=EX(X[B+1]); X[B+2]=EX(X[B+2]); X[B+3]=EX(X[B+3]); PIN(X); SBAR(); }while(0)
  #define VRD(i) do{ vlo[i]=vtr(vp_+(((i)>>2)*4096+((i)&3)*1024)); vhi[i]=vtr(vp_+(((i)>>2)*4096+((i)&3)*1024+512)); }while(0)
  #define KRD(G,j) do{ if(G){ kload2(kf,kp0+sl_next,j); SBAR(); } }while(0)
  #define STEP(C0,C1,P0,P1,t,GK,GV,GL) do{ SBAR(); \
    const lds_cptr vp_=vp0+sl_prev; \
    VRD(0); SBAR(); float sacc=(P0[0]+P0[1]); \
    GAPA(C0=__builtin_amdgcn_mfma_f32_32x32x16_bf16(kf[0],qr[0],negm,0,0,0), P0[2],P0[3],P0[4],P0[5],     pw0[0]=PKW(P0,0), pw0[1]=PKW(P0,2), pw0); \
    VRD(4); SBAR(); GAPA(C1=__builtin_amdgcn_mfma_f32_32x32x16_bf16(kf[1],qr[0],negm,0,0,0), P0[6],P0[7],P0[8],P0[9],     pw0[2]=PKW(P0,4), pw0[3]=PKW(P0,6), pw0); \
    VRD(1); SBAR(); GAPA(C0=__builtin_amdgcn_mfma_f32_32x32x16_bf16(kf[2],qr[1],C0,0,0,0),   P0[10],P0[11],P0[12],P0[13], pw1[0]=PKW(P0,8), pw1[1]=PKW(P0,10), pw1); \
    VRD(5); SBAR(); GAPA(C1=__builtin_amdgcn_mfma_f32_32x32x16_bf16(kf[3],qr[1],C1,0,0,0),   P0[14],P0[15],P1[0],P1[1],   pw1[2]=PKW(P0,12),pw1[3]=PKW(P0,14), pw1); \
    VRD(2); SBAR(); GAPA(C0=__builtin_amdgcn_mfma_f32_32x32x16_bf16(kf[4],qr[2],C0,0,0,0),   P1[2],P1[3],P1[4],P1[5],     pw2[0]=PKW(P1,0), pw2[1]=PKW(P1,2), pw2); \
    VRD(6); SBAR(); GAPA(C1=__builtin_amdgcn_mfma_f32_32x32x16_bf16(kf[5],qr[2],C1,0,0,0),   P1[6],P1[7],P1[8],P1[9],     pw2[2]=PKW(P1,4), pw2[3]=PKW(P1,6), pw2); \
    VRD(3); SBAR(); GAPA(C0=__builtin_amdgcn_mfma_f32_32x32x16_bf16(kf[6],qr[3],C0,0,0,0),   P1[10],P1[11],P1[12],P1[13], pw3[0]=PKW(P1,8), pw3[1]=PKW(P1,10), pw3); \
    VRD(7); SBAR(); GAPA(C1=__builtin_amdgcn_mfma_f32_32x32x16_bf16(kf[7],qr[3],C1,0,0,0),   P1[14],P1[15],0.f,0.f,       pw3[2]=PKW(P1,12),pw3[3]=PKW(P1,14), pw3); \
    l_reg+=sacc; \
    if(GK){DMA_K((t)+3,sl_cur);} if(GV){DMA_V((t)+1,sl_next);} \
    CMASK(C0,C1,t); \
    resc=false; if constexpr(THRL<1000) { float a=MX3(C0[0],C0[1],C1[0]),b=MX3(C0[2],C0[3],C1[1]); a=MX3(a,C1[2],C1[3]); \
      _Pragma("unroll") for(int r=4;r<16;r+=4){a=MX3(a,C0[r],C0[r+1]);b=MX3(b,C0[r+2],C0[r+3]);a=MX3(a,C1[r],C1[r+1]);b=MX3(b,C1[r+2],C1[r+3]);} \
      float rm=__builtin_fmaxf(a,b); { auto rr=__builtin_amdgcn_permlane32_swap(__float_as_uint(rm),__float_as_uint(rm),false,false); rm=__builtin_fmaxf(__uint_as_float(rr[0]),__uint_as_float(rr[1])); } \
      resc=false; \
      if(__builtin_expect(__any(rm>(float)THRL),0)){ const float dl=__builtin_fmaxf(rm,0.f); mhat+=dl; \
        _Pragma("unroll") for(int r=0;r<16;++r){C0[r]-=dl;C1[r]-=dl;} \
        _Pragma("unroll") for(int r=0;r<16;++r)negm[r]=-mhat; asm volatile("":"+v"(negm)); \
        const float f=__builtin_amdgcn_exp2f(-dl); l_reg*=f; if(hi==0)wsf[r32]=f; resc=true; } } \
    SBAR(); \
    GAPB(o[0]=__builtin_amdgcn_mfma_f32_32x32x16_bf16(PAF(0),VFR(0),o[0],0,0,0), C0,0); \
    GAPB(o[1]=__builtin_amdgcn_mfma_f32_32x32x16_bf16(PAF(0),VFR(4),o[1],0,0,0), C0,4); \
    KRD(GL,0); GAPB(o[0]=__builtin_amdgcn_mfma_f32_32x32x16_bf16(PAF(1),VFR(1),o[0],0,0,0), C0,8); \
    KRD(GL,1); GAPB(o[1]=__builtin_amdgcn_mfma_f32_32x32x16_bf16(PAF(1),VFR(5),o[1],0,0,0), C0,12); \
    KRD(GL,2); GAPB(o[0]=__builtin_amdgcn_mfma_f32_32x32x16_bf16(PAF(2),VFR(2),o[0],0,0,0), C1,0); \
    KRD(GL,3); GAPB(o[1]=__builtin_amdgcn_mfma_f32_32x32x16_bf16(PAF(2),VFR(6),o[1],0,0,0), C1,4); \
    GAPB(o[0]=__builtin_amdgcn_mfma_f32_32x32x16_bf16(PAF(3),VFR(3),o[0],0,0,0), C1,8); \
    GAPB(o[1]=__builtin_amdgcn_mfma_f32_32x32x16_bf16(PAF(3),VFR(7),o[1],0,0,0), C1,12); \
    }while(0)
  int t=1;
  #undef CMASK
  #define CMASK(P0,P1,t) do{}while(0)
  for(;t+5<NT;t+=2){
    STEP(pB0,pB1,pA0,pA1,t,true,true,true);     WAIT_BAR(2); RESC(); ROT();
    STEP(pA0,pA1,pB0,pB1,t+1,true,true,true);   WAIT_BAR(2); RESC(); ROT();
  }
  #undef CMASK
  #define CMASK(P0,P1,t) do{}while(0)
  #define ENDW(tt) do{ if((tt)+3<NT){WAIT_BAR(2);} else if((tt)+2<NT){WAIT_BAR(1);} else {WAIT_BAR(0);} }while(0)
  for(;t+1<NT;t+=2){
    STEP(pB0,pB1,pA0,pA1,t,(t+3<NT),(t+1<NT),(t+1<NT));       ENDW(t);   RESC(); ROT();
    STEP(pA0,pA1,pB0,pB1,t+1,(t+4<NT),(t+2<NT),(t+2<NT));     ENDW(t+1); RESC(); ROT();
  }
  STEP(pB0,pB1,pA0,pA1,NT-1,false,false,false); RESC();
  { float sacc=pB0[0]+pB0[1]; _Pragma("unroll") for(int r=2;r<16;++r)sacc+=pB0[r]; _Pragma("unroll") for(int r=0;r<16;++r)sacc+=pB1[r]; l_reg+=sacc;
    pw0=(u32x4){PKW(pB0,0),PKW(pB0,2),PKW(pB0,4),PKW(pB0,6)};pw1=(u32x4){PKW(pB0,8),PKW(pB0,10),PKW(pB0,12),PKW(pB0,14)};pw2=(u32x4){PKW(pB1,0),PKW(pB1,2),PKW(pB1,4),PKW(pB1,6)};pw3=(u32x4){PKW(pB1,8),PKW(pB1,10),PKW(pB1,12),PKW(pB1,14)};
    SBAR(); pv(o,vb0+sl_cur,PAF(0),PAF(1),PAF(2),PAF(3)); }
  #undef PKW
  #undef PAF
  #undef VFR
  #undef PIN
  #undef MX3
  #undef GAPA
  #undef GAPB
  #undef EX
  #undef VRD
  #undef KRD
  #undef STEP
  #undef ENDW
  {auto rr=__builtin_amdgcn_permlane32_swap(__float_as_uint(l_reg),__float_as_uint(l_reg),false,false);l_reg=__uint_as_float(rr[0])+__uint_as_float(rr[1]);}
  if(hi==0)wsf[32+r32]=l_reg;asm volatile("s_waitcnt lgkmcnt(0)":::"memory");
  float rli[16];
  #pragma unroll
  for(int r=0;r<16;++r)rli[r]=__builtin_amdgcn_rcpf(wsf[32+crow(r,hi)]);
  bf16*Ow=Ob+(long)(wid*QBLK)*DMO;
  { bf16*stg=(bf16*)(shm+LDS_OST)+wid*2048;
    #pragma unroll
    for(int r=0;r<16;++r){const int orow=crow(r,hi);
      #pragma unroll
      for(int d0=0;d0<2;++d0)stg[orow*64+d0*32+r32]=__float2bfloat16(o[d0][r]*rli[r]);}
    asm volatile("s_waitcnt lgkmcnt(0)":::"memory");
    #pragma unroll
    for(int i=0;i<4;++i){const int row=i*8+(lane>>3),ch=lane&7; const u32x4 v=*(const u32x4*)(stg+row*64+ch*8); ATTN_STORE16(Ow+(long)row*DMO+ch*8,v);} }
  asm volatile("s_waitcnt lgkmcnt(0)\n\ts_barrier":::"memory");
  #undef DMA_K
  #undef DMA_V
  #undef CMASK
  #undef START
  #undef RESC
  #undef ROT
}
constexpr int ATTN_LDS_BYTES=LDS_BYTES;
#undef SBAR
#undef WAIT_BAR
}
typedef unsigned short bf16;
typedef unsigned v4u __attribute__((ext_vector_type(4)));
typedef float f32x4 __attribute__((ext_vector_type(4)));
#define LAS __attribute__((address_space(3)))
constexpr int NWAVES = 8;
constexpr int D = 1024, FF = 4096, NIN = 2304, PLE = 256;
constexpr int ZP = att::LDZ;
constexpr int MP = 4 * 8192, MS = 8 * 2048, M = MP + MS;
constexpr int SEQ_P = 8192, SEQ_S = 2048;
constexpr float C2 = 0.125f * 1.4426950408889634f;
constexpr float LOG2E = 1.4426950408889634f;
constexpr size_t MiB = 1u << 20;
constexpr size_t WS_RSP1 = 1 * MiB, WS_RSP2 = 4 * MiB, WS_RSP3 = 7 * MiB;
constexpr size_t WS_WIN = 10 * MiB, WS_WOUT = 15 * MiB, WS_W1 = 17 * MiB, WS_W2 = 25 * MiB, WS_WG = 33 * MiB, WS_WP = 35 * MiB;
constexpr size_t WS_PB = 36 * MiB;
constexpr size_t WS_PROJ = 60 * MiB;
constexpr size_t WS_Z = 156 * MiB;
constexpr size_t WS_HB = 156 * MiB;
constexpr size_t WS_XN = 380 * MiB;
constexpr size_t WS_H = 252 * MiB;
constexpr size_t WS_END = 512 * MiB;
static_assert(WS_XN + (size_t)M * D * 2 <= WS_END && WS_Z + (size_t)M * ZP * 2 <= WS_XN && WS_H + (size_t)16384 * FF * 2 <= WS_END && WS_HB + (size_t)M * D * 2 <= WS_H, "d_ws map");
constexpr int CW_QMAX = 3584, CW_KMAX = 3648, CW_DNEG = 3616, CW_QUEUE = 3712;
constexpr int CTL_BYTES = 32768;
constexpr float SKIP_T = 32.0f;
constexpr int LDS_BYTES = 147456;
static_assert(att::ATTN_LDS <= 131072 && attn_body::ATTN_LDS_BYTES <= 131072 && attn_body::DMQ == ZP, "attention LDS / pitches");

__device__ __forceinline__ unsigned f2bf(float f) { unsigned u = __builtin_bit_cast(unsigned, f); return (u + 0x7fffu + ((u >> 16) & 1u)) >> 16; }
__device__ __forceinline__ unsigned pk2(float lo, float hi) { return f2bf(lo) | (f2bf(hi) << 16); }
__device__ __forceinline__ float wave_sum(float v) {
#pragma unroll
    for (int o = 1; o < 64; o <<= 1) v += __shfl_xor(v, o);
    return v;
}
__device__ __forceinline__ void transpose_item(const float* W, int K, int N, const float* g, bf16* WT, LAS float* scr, int item, int lane) {
    const int nblk = N / 32, kb = item / nblk, nb = item % nblk, k0 = 64 * kb, n0 = 32 * nb;
#pragma unroll 8
    for (int i = 0; i < 32; ++i) { const int kk = 2 * i + (lane >> 5); const float gs = g ? g[k0 + kk] : 1.f; scr[kk * 33 + (lane & 31)] = W[(size_t)(k0 + kk) * N + n0 + (lane & 31)] * gs; }
    asm volatile("s_waitcnt lgkmcnt(0)" ::: "memory");
    const int c = lane & 7;
#pragma unroll
    for (int j = 0; j < 4; ++j) { const int n = (lane >> 3) + 8 * j; const LAS float* s = scr + (8 * c) * 33 + n;
        v4u o; o.x = pk2(s[0 * 33], s[1 * 33]); o.y = pk2(s[2 * 33], s[3 * 33]); o.z = pk2(s[4 * 33], s[5 * 33]); o.w = pk2(s[6 * 33], s[7 * 33]);
        *(v4u*)(WT + (size_t)(n0 + n) * K + k0 + 8 * c) = o; }
    asm volatile("s_waitcnt lgkmcnt(0)" ::: "memory");
}

#define XB_TMO      128
#define XB_XCNT(j)  (256  + 64 * (j))
#define XB_XSUB(j)  (1280 + 64 * (j))
#define XB_XGEN(j)  (2304 + 64 * (j))
#define XB_TOP      3328
#define XB_TOPGEN   3392
#define XCD_BAR_WORDS 3456
#define XB_SPIN_CAP (1u << 22)

__device__ __forceinline__ unsigned xb_ld(unsigned* p)              { return __hip_atomic_load(p, __ATOMIC_RELAXED, __HIP_MEMORY_SCOPE_AGENT); }
__device__ __forceinline__ unsigned xb_add(unsigned* p, unsigned v) { return __hip_atomic_fetch_add(p, v, __ATOMIC_RELAXED, __HIP_MEMORY_SCOPE_AGENT); }
__device__ __forceinline__ unsigned xb_xcc_id() { return (unsigned)__builtin_amdgcn_s_getreg((3 << 11) | 20) & 0xFu; }
#define XB_SPIN(cond, bar) do { unsigned _sp = 0; while (cond) { __builtin_amdgcn_s_sleep(1); \
    if ((++_sp & 255u) == 0u) { if (xb_ld(&(bar)[XB_TMO])) break; if (_sp > XB_SPIN_CAP) { atomicAdd(&(bar)[XB_TMO], 1u); break; } } } } while (0)

struct XcdBarrier {
    unsigned* bar; unsigned x;
    volatile LAS unsigned* st;
};

__device__ __forceinline__ XcdBarrier xcd_barrier_post(unsigned* bar, volatile LAS unsigned* st) {
    XcdBarrier b; b.bar = bar; b.x = xb_xcc_id(); b.st = st;
    if (threadIdx.x == 0) (void)xb_add(&bar[XB_XCNT(b.x)], 1u);
    return b;
}
__device__ __forceinline__ void xcd_barrier_complete(unsigned* bar, unsigned x, unsigned& nloc, unsigned& nx) {
    const unsigned G = gridDim.x * gridDim.y * gridDim.z;
    unsigned sum, cnt, mine, sp = 0u;
    for (;;) {
        sum = 0u; cnt = 0u; mine = 0u;
#pragma unroll
        for (unsigned j = 0; j < 16; ++j) { const unsigned c = xb_ld(&bar[XB_XCNT(j)]); sum += c; cnt += (c > 0u) ? 1u : 0u; mine = (j == x) ? c : mine; }
        if (sum == G) break;
        __builtin_amdgcn_s_sleep(1);
        if ((++sp & 255u) == 0u) { if (xb_ld(&bar[XB_TMO])) break; if (sp > XB_SPIN_CAP) { atomicAdd(&bar[XB_TMO], 1u); break; } }
    }
    nloc = mine > 0u ? mine : 1u; nx = cnt > 0u ? cnt : 1u;
}

__device__ __forceinline__ void xcd_barrier(const XcdBarrier& b) {
    asm volatile("s_waitcnt vmcnt(0)" ::: "memory");
    __syncthreads();
    if (threadIdx.x == 0) {
        unsigned* bar = b.bar;
        __builtin_amdgcn_s_waitcnt(0);
        unsigned nloc = b.st[0], nx = b.st[1];
        if (nloc == 0u) { xcd_barrier_complete(bar, b.x, nloc, nx); b.st[0] = nloc; b.st[1] = nx; }
        const unsigned old = xb_add(&bar[XB_XSUB(b.x)], 1u);
        const unsigned gen = old / nloc;
        if (old + 1u == (gen + 1u) * nloc) {
            __builtin_amdgcn_fence(__ATOMIC_RELEASE, "agent");
            asm volatile("s_waitcnt vmcnt(0)" ::: "memory");
            const unsigned og = xb_add(&bar[XB_TOP], 1u);
            const unsigned tg = og / nx;
            if (og + 1u == (tg + 1u) * nx) xb_add(&bar[XB_TOPGEN], 1u);
            else XB_SPIN(xb_ld(&bar[XB_TOPGEN]) == tg, bar);
            __builtin_amdgcn_fence(__ATOMIC_ACQUIRE, "agent");
            xb_add(&bar[XB_XGEN(b.x)], 1u);
            asm volatile("s_waitcnt vmcnt(0)" ::: "memory");
        } else {
            XB_SPIN(xb_ld(&bar[XB_XGEN(b.x)]) == gen, bar);
            __builtin_amdgcn_fence(__ATOMIC_ACQUIRE, "agent");
            asm volatile("s_waitcnt vmcnt(0)" ::: "memory");
        }
    }
    __syncthreads();
}

struct Args { const float* in[21]; float* out; unsigned char* ws; };

__global__ void __launch_bounds__(NWAVES * 64, 2) fwd_mega(Args args) {
    extern __shared__ __attribute__((aligned(16))) unsigned char lds[];
    cg::grid_group grid = cg::this_grid();
#define PHASE_IDS() int tid_p = threadIdx.x; asm volatile("" : "+v"(tid_p)); const int tid = tid_p, lane = tid & 63, wave = __builtin_amdgcn_readfirstlane(tid >> 6); const int gw = bx * NWAVES + wave; (void)lane; (void)gw; (void)tid
    const int G = gridDim.x, bx = blockIdx.x;
    const int NGW = G * NWAVES;
    unsigned char* ws = args.ws;
    const float* x_p = args.in[0]; const float* x_s = args.in[1]; const float* p_p = args.in[2]; const float* p_s = args.in[3];
    const float* w_in = args.in[4]; const float* g_mix = args.in[5];
    const float* lq1 = args.in[6]; const float* lk1 = args.in[7]; const float* lq2 = args.in[8]; const float* lk2 = args.in[9];
    const float* g_subln = args.in[10]; const float* g_qn = args.in[11]; const float* g_kn = args.in[12];
    const float* w_out = args.in[13]; const float* g_mlp = args.in[14]; const float* w_ff1 = args.in[15]; const float* w_ff2 = args.in[16];
    const float* g_ple = args.in[17]; const float* w_gate = args.in[18]; const float* w_proj = args.in[19]; const float* g_final = args.in[20];
    float* out = args.out;
    float* RSP1 = (float*)(ws + WS_RSP1); float* RSP2 = (float*)(ws + WS_RSP2); float* RSP3 = (float*)(ws + WS_RSP3);
    bf16* WinT = (bf16*)(ws + WS_WIN); bf16* WoutT = (bf16*)(ws + WS_WOUT); bf16* W1T = (bf16*)(ws + WS_W1); bf16* W2T = (bf16*)(ws + WS_W2); bf16* WgT = (bf16*)(ws + WS_WG); bf16* WpT = (bf16*)(ws + WS_WP);
    bf16* PB = (bf16*)(ws + WS_PB); bf16* PROJ = (bf16*)(ws + WS_PROJ); bf16* Z = (bf16*)(ws + WS_Z); bf16* HB = (bf16*)(ws + WS_HB);
    bf16* XN = (bf16*)(ws + WS_XN); bf16* MIX = XN; bf16* HH = (bf16*)(ws + WS_H);
    LAS unsigned char* ldsl = (LAS unsigned char*)lds;
    volatile LAS unsigned* bst = (volatile LAS unsigned*)(ldsl + 139264);
    if (threadIdx.x < 2) bst[threadIdx.x] = 0u;
    __syncthreads();
    const XcdBarrier bar = xcd_barrier_post((unsigned*)ws, bst);
    if (ws == nullptr) grid.sync();

#ifndef NO_P0
#ifdef PROBE_EW2
    for (int rep = 0; rep < 2; ++rep)
#endif
    {
        PHASE_IDS();
        LAS float* scr = (LAS float*)(ldsl + wave * 16384);
        constexpr int I_IN = (D / 64) * (NIN / 32), I_OUT = (D / 64) * (D / 32), I_1 = (D / 64) * (FF / 32), I_2 = (FF / 64) * (D / 32), I_G = I_OUT, I_P = (PLE / 64) * (D / 32);
        constexpr int NITEMS = I_IN + I_OUT + I_1 + I_2 + I_G + I_P;
        for (int it = gw; it < NITEMS; it += NGW) {
            int r = it;
            if (r < I_IN) { transpose_item(w_in, D, NIN, nullptr, WinT, scr, r, lane); continue; } r -= I_IN;
            if (r < I_OUT) { transpose_item(w_out, D, D, nullptr, WoutT, scr, r, lane); continue; } r -= I_OUT;
            if (r < I_1) { transpose_item(w_ff1, D, FF, g_mlp, W1T, scr, r, lane); continue; } r -= I_1;
            if (r < I_2) { transpose_item(w_ff2, FF, D, nullptr, W2T, scr, r, lane); continue; } r -= I_2;
            if (r < I_G) { transpose_item(w_gate, D, D, g_ple, WgT, scr, r, lane); continue; } r -= I_G;
            transpose_item(w_proj, PLE, D, nullptr, WpT, scr, r, lane);
        }
        f32x4 gv[4];
#pragma unroll
        for (int j = 0; j < 4; ++j) gv[j] = *((const f32x4*)g_mix + lane + 64 * j);
        for (int m0 = gw * 2; m0 < M; m0 += NGW * 2) {
            f32x4 v[2][4], pv[2];
#pragma unroll
            for (int r = 0; r < 2; ++r) { const int m = m0 + r;
                const float* xrow = m < MP ? x_p + (size_t)m * D : x_s + (size_t)(m - MP) * D;
                const float* prow = m < MP ? p_p + (size_t)m * PLE : p_s + (size_t)(m - MP) * PLE;
#pragma unroll
                for (int j = 0; j < 4; ++j) v[r][j] = *((const f32x4*)xrow + lane + 64 * j);
                pv[r] = *((const f32x4*)prow + lane); }
#pragma unroll
            for (int r = 0; r < 2; ++r) { const int m = m0 + r; float s = 0.f;
#pragma unroll
                for (int j = 0; j < 4; ++j) s += (v[r][j].x * v[r][j].x + v[r][j].y * v[r][j].y) + (v[r][j].z * v[r][j].z + v[r][j].w * v[r][j].w);
                const float rstd = 1.0f / sqrtf(wave_sum(s) * (1.0f / D) + 1e-6f);
                unsigned long long* o8 = (unsigned long long*)(XN + (size_t)m * D) + lane;
#pragma unroll
                for (int j = 0; j < 4; ++j) { const f32x4 y = v[r][j] * rstd * gv[j]; o8[64 * j] = (unsigned long long)pk2(y.x, y.y) | ((unsigned long long)pk2(y.z, y.w) << 32); }
                *((unsigned long long*)(PB + (size_t)m * PLE) + lane) = (unsigned long long)pk2(pv[r].x, pv[r].y) | ((unsigned long long)pk2(pv[r].z, pv[r].w) << 32); }
        }
    }
#endif
    xcd_barrier(bar);

#ifndef NO_P1
#ifdef PROBE_GEMM2
    for (int rep = 0; rep < 2; ++rep)
#endif
    {
        pg8::Gemm g{XN, WinT, M, NIN, D}; pg8::StaticOrder S; S.init(M, NIN, G, bx);
        pg8::EpiBf E{Z, ZP, C2, 2};
        pg8::gemm_phase<pg8::EpiBf, pg8::StaticOrder, true, true>(ldsl, g, S, E);
    }
    {
        pg8::Gemm g{PB, WpT, M, D, PLE}; pg8::StaticOrder S; S.init(M, D, G, bx);
        pg8::EpiBf E{PROJ, D, 1.f, 0};
        pg8::gemm_phase<pg8::EpiBf, pg8::StaticOrder, true, true>(ldsl, g, S, E);
    }
#endif
    xcd_barrier(bar);

#ifndef NO_P1B
    {
        int tl = threadIdx.x; asm volatile("" : "+v"(tl));
        const long nth = (long)G * 512;
        const int j4 = (tl & 3) * 4;
        {
            float mq = 0.f, mk = 0.f, md = 0.f;
            for (long it = (long)bx * 512 + tl; it < (long)M * 32; it += nth) {
                const long item = it >> 2; const int m = (int)(item >> 3), hc = (int)(item & 7);
                const bf16* p = Z + (size_t)m * ZP + hc * 64 + j4; float sq = 0.f, sk = 0.f, sd = 0.f;
#pragma unroll
                for (int q = 0; q < 4; ++q) { const unsigned long long w = *(const unsigned long long*)(p + 16 * q), wk = *(const unsigned long long*)(p + 512 + 16 * q);
                    const unsigned lo = (unsigned)w, hi = (unsigned)(w >> 32), klo = (unsigned)wk, khi = (unsigned)(wk >> 32);
                    const float a = __uint_as_float(lo << 16), b = __uint_as_float(lo & 0xffff0000u), c = __uint_as_float(hi << 16), d = __uint_as_float(hi & 0xffff0000u);
                    const float ka = __uint_as_float(klo << 16), kb = __uint_as_float(klo & 0xffff0000u), kc = __uint_as_float(khi << 16), kd = __uint_as_float(khi & 0xffff0000u);
                    sq += (a * a + b * b) + (c * c + d * d); sk += (ka * ka + kb * kb) + (kc * kc + kd * kd); sd += (a * ka + b * kb) + (c * kc + d * kd); }
                sq += __shfl_xor(sq, 1); sq += __shfl_xor(sq, 2); sk += __shfl_xor(sk, 1); sk += __shfl_xor(sk, 2); sd += __shfl_xor(sd, 1); sd += __shfl_xor(sd, 2);
                mq = fmaxf(mq, sq); mk = fmaxf(mk, sk); md = fmaxf(md, -sd);
            }
#pragma unroll
            for (int o = 1; o < 64; o <<= 1) { mq = fmaxf(mq, __shfl_xor(mq, o)); mk = fmaxf(mk, __shfl_xor(mk, o)); md = fmaxf(md, __shfl_xor(md, o)); }
            if ((tl & 63) == 0) { atomicMax((unsigned*)ws + CW_QMAX, __float_as_uint(sqrtf(mq) * 1.0001f)); atomicMax((unsigned*)ws + CW_KMAX, __float_as_uint(sqrtf(mk) * 1.0001f));
                                  atomicMax((unsigned*)ws + CW_DNEG, __float_as_uint(md * 1.0001f + 1e-3f)); }
        }
        for (long it = (long)bx * 512 + tl; it < (long)M * 40; it += nth) {
            const long item = it >> 2;
            const int m = (int)(item / 10), hh = (int)(item % 10);
            const int t = m < MP ? (m & (SEQ_P - 1)) : ((m - MP) & (SEQ_S - 1));
            bf16* p = Z + (size_t)m * ZP + 1536 + hh * 64 + j4;
            const float* gg = (hh < 8 ? g_qn : g_kn) + j4;
            float v[4][4]; float ss = 0.f;
#pragma unroll
            for (int q = 0; q < 4; ++q) { const unsigned long long w = *(const unsigned long long*)(p + 16 * q); const unsigned lo = (unsigned)w, hi = (unsigned)(w >> 32);
                v[q][0] = __uint_as_float(lo << 16); v[q][1] = __uint_as_float(lo & 0xffff0000u); v[q][2] = __uint_as_float(hi << 16); v[q][3] = __uint_as_float(hi & 0xffff0000u);
                ss += (v[q][0] * v[q][0] + v[q][1] * v[q][1]) + (v[q][2] * v[q][2] + v[q][3] * v[q][3]); }
            ss += __shfl_xor(ss, 1); ss += __shfl_xor(ss, 2);
            const float rstd = 1.0f / sqrtf(ss * (1.0f / 64.0f) + 1e-6f);
#pragma unroll
            for (int q = 0; q < 4; ++q) { const f32x4 g4 = *(const f32x4*)(gg + 16 * q);
#pragma unroll
                for (int e = 0; e < 4; ++e) v[q][e] = v[q][e] * rstd * g4[e]; }
            const float fr = (float)(t >> 6), fc = (float)(t & 63), osc = hh < 8 ? C2 : 1.f;
#pragma unroll
            for (int e = 0; e < 4; ++e) {
                const float invf = __builtin_amdgcn_exp2f(-(float)(j4 + e) * (13.287712379549449f / 16.0f));
                const float ar = fr * invf, ac = fc * invf;
                const float cr = __cosf(ar), sr = __sinf(ar), cc = __cosf(ac), sc = __sinf(ac);
                const float a1 = v[0][e], a2 = v[1][e]; v[0][e] = (a1 * cr - a2 * sr) * osc; v[1][e] = (a1 * sr + a2 * cr) * osc;
                const float b1 = v[2][e], b2 = v[3][e]; v[2][e] = (b1 * cc - b2 * sc) * osc; v[3][e] = (b1 * sc + b2 * cc) * osc;
            }
#pragma unroll
            for (int q = 0; q < 4; ++q) *(unsigned long long*)(p + 16 * q) = (unsigned long long)pk2(v[q][0], v[q][1]) | ((unsigned long long)pk2(v[q][2], v[q][3]) << 32);
        }
    }
#endif
    xcd_barrier(bar);

#ifndef NO_P2
    {
        const float qkb = __uint_as_float(((const unsigned*)ws)[CW_QMAX]) * __uint_as_float(((const unsigned*)ws)[CW_KMAX]) + __uint_as_float(((const unsigned*)ws)[CW_DNEG]) + SKIP_T;
        PHASE_IDS();
        volatile LAS int* qslot = (volatile LAS int*)(ldsl + 139280);
        const float aqk_ = __uint_as_float(((const unsigned*)ws)[CW_QMAX]) * __uint_as_float(((const unsigned*)ws)[CW_KMAX]);
        const float amref = (aqk_ + __uint_as_float(((const unsigned*)ws)[CW_DNEG]) < 90.0f) ? aqk_ : -1.f;
        float gq_ = fabsf(g_qn[lane]), gk_ = fabsf(g_kn[lane]);
#pragma unroll
        for (int o = 1; o < 64; o <<= 1) { gq_ = fmaxf(gq_, __shfl_xor(gq_, o)); gk_ = fmaxf(gk_, __shfl_xor(gk_, o)); }
        const float bbound = 64.0f * C2 * 1.03f * gq_ * gk_;
        const bool bmaxfree = __builtin_amdgcn_readfirstlane((int)(bbound < 40.0f)) != 0;
        const int x0 = (int)(bar.x & 7u);
        for (int dx = 0; dx < 8; ++dx) {
            const int x = (x0 + dx) & 7;
            for (;;) {
                if (tid == 0) *qslot = (int)__hip_atomic_fetch_add((unsigned*)ws + CW_QUEUE + 64 * x, 1u, __ATOMIC_RELAXED, __HIP_MEMORY_SCOPE_AGENT);
                __syncthreads();
                const int i = *qslot;
                __syncthreads();
                if (i >= 384) break;
                int kind, h = 0, c = 0, head = 0, qb;
                if (i < 32) { kind = 0; h = 3; qb = i; }
                else if (i < 64) { kind = 0; h = 2; qb = i - 32; }
                else if (i < 192) { kind = 1; head = (x & 1) * 4 + ((i - 64) >> 5); qb = (i - 64) & 31; }
                else if (i < 224) { kind = 0; h = 1; qb = i - 192; }
                else if (i < 256) { kind = 2; h = 3 - ((i - 224) >> 4); c = ((i - 224) & 15) >> 3; qb = (i - 224) & 7; }
                else if (i < 320) { kind = 3; head = (i - 256) >> 3; qb = (i - 256) & 7; }
                else if (i < 336) { kind = 2; h = 1; c = (i - 320) >> 3; qb = (i - 320) & 7; }
                else if (i < 368) { kind = 0; h = 0; qb = i - 336; }
                else { kind = 2; h = 0; c = (i - 368) >> 3; qb = (i - 368) & 7; }
                const bool prompt = kind < 2;
                const int b = prompt ? (x >> 1) : x; if (kind == 0) c = x & 1;
                const int S = prompt ? SEQ_P : SEQ_S; const long rowbase = prompt ? (long)b * SEQ_P : (long)MP + (long)b * SEQ_S;
                const int q0 = qb * 256, NT = S / 64;
                const bf16* Zb = Z + rowbase * ZP;
                if (!(kind & 1)) {
                    const float slope = (h == 0 ? 0.25f : h == 1 ? 0.0625f : h == 2 ? 0.015625f : 0.00390625f), sl2 = LOG2E * slope;
                    const float W = qkb / sl2;
                    int t_lo = (int)floorf(fmaxf((float)q0 - W, 0.f) * (1.0f / 64.0f));
                    int t_hi = (int)fminf(floorf(((float)(q0 + 255) + W) * (1.0f / 64.0f)) + 1.0f, (float)NT);
                    if ((t_hi - t_lo) & 1) { if (t_lo > 0) --t_lo; else ++t_hi; }
                    const int hd = h * 2 + c;
                    att::attn_unit_pp<128, true, bf16>(Zb + (long)q0 * ZP + h * 128 + c * 64, Zb + (long)t_lo * 64 * ZP + 512 + h * 128 + c * 64, Zb + (long)t_lo * 64 * ZP + 1024 + h * 128,
                                                     (bf16*)out + (rowbase + q0) * 1024 + hd * 128, t_hi - t_lo, q0 - t_lo * 64, sl2, ldsl, amref);
                } else {
                    if (bmaxfree)
                        attn_body::attn_unit<1000>((const attn_body::bf16*)(Zb + (long)q0 * ZP + 1536 + head * 64), (const attn_body::bf16*)(Zb + 2048 + (head >> 2) * 64), (const attn_body::bf16*)(Zb + 2176 + (head >> 2) * 64),
                                                   (attn_body::bf16*)(MIX + (rowbase + q0) * 1024 + 512 + head * 64), NT, (char*)lds, bbound);
                    else
                        attn_body::attn_unit<8>((const attn_body::bf16*)(Zb + (long)q0 * ZP + 1536 + head * 64), (const attn_body::bf16*)(Zb + 2048 + (head >> 2) * 64), (const attn_body::bf16*)(Zb + 2176 + (head >> 2) * 64),
                                                (attn_body::bf16*)(MIX + (rowbase + q0) * 1024 + 512 + head * 64), NT, (char*)lds);
                }
            }
        }
    }
#endif
    xcd_barrier(bar);

#ifndef NO_P2B
#ifdef PROBE_EW2
    for (int rep = 0; rep < 2; ++rep)
#endif
    {
        PHASE_IDS();
        const float d1 = wave_sum(lq1[lane] * lk1[lane]), d2 = wave_sum(lq2[lane] * lk2[lane]);
        const float lam = expf(d1) - expf(d2) + 0.2f;
        const int h = lane >> 4, e0 = (lane & 15) * 8;
        const f32x4 g0 = *(const f32x4*)(g_subln + e0), g1 = *(const f32x4*)(g_subln + e0 + 4);
        for (int m0 = gw * 4; m0 < M; m0 += NGW * 4) {
            v4u wa[4], wb[4];
#pragma unroll
            for (int r = 0; r < 4; ++r) { const bf16* o0 = (const bf16*)out + (size_t)(m0 + r) * 1024 + (h * 2) * 128 + e0; wa[r] = *(const v4u*)o0; wb[r] = *(const v4u*)(o0 + 128); }
#pragma unroll
            for (int r = 0; r < 4; ++r) {
                f32x4 a0, a1, b0, b1;
                a0.x = __uint_as_float(wa[r].x << 16); a0.y = __uint_as_float(wa[r].x & 0xffff0000u); a0.z = __uint_as_float(wa[r].y << 16); a0.w = __uint_as_float(wa[r].y & 0xffff0000u);
                a1.x = __uint_as_float(wa[r].z << 16); a1.y = __uint_as_float(wa[r].z & 0xffff0000u); a1.z = __uint_as_float(wa[r].w << 16); a1.w = __uint_as_float(wa[r].w & 0xffff0000u);
                b0.x = __uint_as_float(wb[r].x << 16); b0.y = __uint_as_float(wb[r].x & 0xffff0000u); b0.z = __uint_as_float(wb[r].y << 16); b0.w = __uint_as_float(wb[r].y & 0xffff0000u);
                b1.x = __uint_as_float(wb[r].z << 16); b1.y = __uint_as_float(wb[r].z & 0xffff0000u); b1.z = __uint_as_float(wb[r].w << 16); b1.w = __uint_as_float(wb[r].w & 0xffff0000u);
                a0 = a0 - lam * b0; a1 = a1 - lam * b1;
                float s2 = ((a0.x * a0.x + a0.y * a0.y) + (a0.z * a0.z + a0.w * a0.w)) + ((a1.x * a1.x + a1.y * a1.y) + (a1.z * a1.z + a1.w * a1.w));
                s2 += __shfl_xor(s2, 1); s2 += __shfl_xor(s2, 2); s2 += __shfl_xor(s2, 4); s2 += __shfl_xor(s2, 8);
                const float rstd = 0.8f / sqrtf(s2 * (1.0f / 128.0f) + 1e-5f);
                a0 = a0 * rstd * g0; a1 = a1 * rstd * g1;
                v4u w; w.x = pk2(a0.x, a0.y); w.y = pk2(a0.z, a0.w); w.z = pk2(a1.x, a1.y); w.w = pk2(a1.z, a1.w);
                *(v4u*)(MIX + (size_t)(m0 + r) * 1024 + h * 128 + e0) = w; }
        }
    }
#endif
    xcd_barrier(bar);

#ifndef NO_P3
#ifdef PROBE_GEMM2
    for (int rep = 0; rep < 2; ++rep)
#endif
    {
        pg8::Gemm g{MIX, WoutT, M, D, D}; pg8::StaticOrder S; S.init(M, D, G, bx);
        pg8::EpiRes<false> E{x_p, x_s, MP, HB, RSP1, 0};
        pg8::gemm_phase<pg8::EpiRes<false>, pg8::StaticOrder, true, true>(ldsl, g, S, E);
    }
#endif
    xcd_barrier(bar);

#ifndef NO_P45
    for (int ch = 0; ch < 3; ++ch) {
        const int r0 = ch * 16384;
#ifndef NO_FF1
#ifdef PROBE_GEMM2
        for (int rep = 0; rep < 2; ++rep)
#endif
        {
            pg8::Gemm g{HB + (size_t)r0 * D, W1T, 16384, FF, D}; pg8::StaticOrder S; S.init(16384, FF, G, bx);
            pg8::EpiFF1 E{RSP1, HH, r0};
            pg8::gemm_phase<pg8::EpiFF1, pg8::StaticOrder, true, true>(ldsl, g, S, E);
        }
#endif
        xcd_barrier(bar);
#ifndef NO_FF2
        {
            pg8::Gemm g{HH, W2T, 16384, D, FF}; pg8::StaticOrder S; S.init(16384, D, G, bx);
            pg8::EpiRes<true> E{nullptr, nullptr, 0, HB, RSP2, r0};
            pg8::gemm_phase<pg8::EpiRes<true>, pg8::StaticOrder, true, true>(ldsl, g, S, E);
        }
#endif
        xcd_barrier(bar);
    }

#endif
#ifndef NO_P6
    {
        pg8::Gemm g{HB, WgT, M, D, D}; pg8::StaticOrder S; S.init(M, D, G, bx);
        pg8::EpiGate E{RSP2, PROJ, HB, XN, RSP3};
        pg8::gemm_phase<pg8::EpiGate, pg8::StaticOrder, true, true>(ldsl, g, S, E);
    }
#endif
    xcd_barrier(bar);

#ifndef NO_P7
    {
        PHASE_IDS();
        f32x4 gv[4];
#pragma unroll
        for (int j = 0; j < 4; ++j) gv[j] = *((const f32x4*)g_final + lane + 64 * j);
        for (int m0 = gw * 4; m0 < M; m0 += NGW * 4) {
            unsigned long long w[4][4]; float rstd[4];
#pragma unroll
            for (int r = 0; r < 4; ++r) { const unsigned long long* hr = (const unsigned long long*)(XN + (size_t)(m0 + r) * D) + lane;
#pragma unroll
                for (int j = 0; j < 4; ++j) w[r][j] = hr[64 * j];
                rstd[r] = 1.0f / sqrtf(pg8::rs16(RSP3 + (size_t)(m0 + r) * 16) * (1.0f / D) + 1e-6f); }
#pragma unroll
            for (int r = 0; r < 4; ++r) { f32x4* xr = (f32x4*)(out + (size_t)(m0 + r) * D) + lane;
#pragma unroll
                for (int j = 0; j < 4; ++j) { const unsigned lo = (unsigned)w[r][j], hi2 = (unsigned)(w[r][j] >> 32);
                    f32x4 hv; hv.x = __uint_as_float(lo << 16); hv.y = __uint_as_float(lo & 0xffff0000u); hv.z = __uint_as_float(hi2 << 16); hv.w = __uint_as_float(hi2 & 0xffff0000u);
                    xr[64 * j] = hv * rstd[r] * gv[j]; } }
        }
    }
#endif
}

extern "C" void kernel_launch(void* const* d_in, const int* in_sizes, int n_in, void* d_out, int out_size, void* d_ws, size_t ws_size, hipStream_t stream) {
    static int grid = 0;
    if (grid == 0) {
        if (n_in != 21 || out_size != M * D || ws_size < WS_END) { fprintf(stderr, "kernel_launch: unexpected shapes (n_in %d out %d ws %zu)\n", n_in, out_size, ws_size); grid = -1; return; }
        int dev = 0, cus = 0, per_cu = 0;
        hipGetDevice(&dev); hipDeviceGetAttribute(&cus, hipDeviceAttributeMultiprocessorCount, dev);
        if (hipFuncSetAttribute((const void*)fwd_mega, hipFuncAttributeMaxDynamicSharedMemorySize, LDS_BYTES) != hipSuccess) { fprintf(stderr, "kernel_launch: hipFuncSetAttribute failed\n"); grid = -1; return; }
        if (hipOccupancyMaxActiveBlocksPerMultiprocessor(&per_cu, (const void*)fwd_mega, NWAVES * 64, LDS_BYTES) != hipSuccess || per_cu < 1) { fprintf(stderr, "kernel_launch: occupancy query gave %d\n", per_cu); per_cu = 1; }
        (void)hipGetLastError();
        grid = cus * per_cu;
    }
    if (grid < 0) return;
    if (hipMemsetAsync(d_ws, 0, CTL_BYTES, stream) != hipSuccess) { fprintf(stderr, "kernel_launch: memset failed\n"); return; }
    Args a{};
    for (int i = 0; i < 21; ++i) a.in[i] = (const float*)d_in[i];
    a.out = (float*)d_out; a.ws = (unsigned char*)d_ws;
    void* kargs[] = {&a};
    hipError_t e = hipLaunchCooperativeKernel((const void*)fwd_mega, dim3(grid), dim3(NWAVES * 64), kargs, LDS_BYTES, stream);
    if (e != hipSuccess) fprintf(stderr, "cooperative launch failed: %s (grid %d)\n", hipGetErrorString(e), grid);
}
```

```cpp
#include <hip/hip_runtime.h>
#include <hip/hip_bf16.h>
#include <hip/hip_cooperative_groups.h>
#include <cstdio>
#include <cstdint>
namespace cg = cooperative_groups;

namespace pg8 {
#define PG8_LAS __attribute__((address_space(3)))
typedef unsigned short bf16_t;
typedef short bf16x8 __attribute__((ext_vector_type(8)));
typedef float f32x4 __attribute__((ext_vector_type(4)));
typedef unsigned u32x4 __attribute__((ext_vector_type(4)));
constexpr int BM = 256, BK = 64, HALF = 128, HTB = HALF * BK * 2  , STAGE_BYTES = 8 * HTB, NXCD = 8, WGM = 8;

__host__ __device__ __forceinline__ int lds_byte(int r, int c) { const int st = (r >> 4) * 2 + (c >> 5), rr = r & 15, cc = c & 31, ob = rr * 64 + cc * 2; return st * 1024 + (ob ^ (((ob >> 9) & 1) << 5)); }
__host__ __device__ __forceinline__ void stage_rc(int b, int& R, int& C) { const int st = b / 1024, sb = b % 1024, swz = sb ^ (((sb >> 9) & 1) << 5); R = (st >> 1) * 16 + swz / 64; C = (st & 1) * 32 + (swz % 64) / 2; }
__host__ __device__ __forceinline__ int perm32(int rho) { const int n = rho >> 4, i = rho & 15; return 8 * (i >> 2) + 4 * n + (i & 3); }

struct Unit { int pm, pn; };
struct Gemm { const bf16_t* A; const bf16_t* Bt; int M, N, K; };

struct StaticOrder {
    int nM, nN, nwg, G, c;
    __host__ __device__ void init(int M, int N, int G_, int c_) { nM = M / BM; nN = N / BM; nwg = nM * nN; G = G_; c = c_; }
    __host__ __device__ bool next(int i, Unit& u) const {
        const long L = (long)i * G + c; if (L >= nwg) return false;
        int wgid = (int)L; { const int q = nwg / NXCD, r = nwg % NXCD, xcd = wgid % NXCD, off = wgid / NXCD; wgid = (xcd < r ? xcd * (q + 1) : r * (q + 1) + (xcd - r) * q) + off; }
        const int nig = WGM * nN, gid = wgid / nig, fm = gid * WGM, gsz = (nM - fm) < WGM ? (nM - fm) : WGM;
        u.pm = fm + ((wgid % nig) % gsz); u.pn = (wgid % nig) / gsz; return true;
    }
    __device__ __forceinline__ void a_ready(const Unit&) const {}
    __device__ __forceinline__ void done(const Unit&) const {}
};

__device__ __forceinline__ unsigned cvt_pk_bf16(float lo, float hi) { unsigned r; asm volatile("v_cvt_pk_bf16_f32 %0, %1, %2" : "=v"(r) : "v"(lo), "v"(hi)); return r; }
typedef float f32x2 __attribute__((ext_vector_type(2)));
typedef unsigned u32x2 __attribute__((ext_vector_type(2)));
__device__ __forceinline__ float rs16(const float* p) {
    const f32x4 a = *(const f32x4*)p, b = *(const f32x4*)(p + 4), c = *(const f32x4*)(p + 8), d = *(const f32x4*)(p + 12);
    return (((a[0] + a[1]) + (a[2] + a[3])) + ((b[0] + b[1]) + (b[2] + b[3]))) + (((c[0] + c[1]) + (c[2] + c[3])) + ((d[0] + d[1]) + (d[2] + d[3])));
}
struct EpiBf {
    static constexpr bool PERM = true, AFTER_DRAIN = false;
    bf16_t* O; int ldc; float scale_q; int nq_tiles;
    __device__ __forceinline__ void operator()(const f32x4 (&acc)[2][2][4][2], const Unit& u, int wr, int wc, int fr, int fq) const {
        const int row0 = u.pm * BM + wr * 64 + fr, col0 = u.pn * BM + wc * 32 + 8 * fq; const float sc = (u.pn < nq_tiles) ? scale_q : 1.f;
#pragma unroll
        for (int ai = 0; ai < 2; ++ai)
#pragma unroll
            for (int m = 0; m < 4; ++m) { bf16_t* rowp = O + (size_t)(row0 + ai * HALF + m * 16) * ldc + col0;
#pragma unroll
                for (int bj = 0; bj < 2; ++bj) { const f32x4 v0 = acc[ai][bj][m][0] * sc, v1 = acc[ai][bj][m][1] * sc;
                    u32x4 w; w.x = cvt_pk_bf16(v0[0], v0[1]); w.y = cvt_pk_bf16(v0[2], v0[3]); w.z = cvt_pk_bf16(v1[0], v1[1]); w.w = cvt_pk_bf16(v1[2], v1[3]);
                    *(u32x4*)(rowp + bj * HALF) = w; } }
    }
};
template <bool BASE_BF16> struct EpiRes {
    static constexpr bool PERM = false, AFTER_DRAIN = false;
    const float* base0; const float* base1; int split_row; bf16_t* hb; float* rsp; int row_off;
    __device__ __forceinline__ void operator()(const f32x4 (&acc)[2][2][4][2], const Unit& u, int wr, int wc, int fr, int fq) const {
        const int col0 = u.pn * BM + wc * 32 + 4 * fq;
#pragma unroll
        for (int ai = 0; ai < 2; ++ai)
#pragma unroll
            for (int m = 0; m < 4; ++m) { const int row = row_off + u.pm * BM + ai * HALF + wr * 64 + m * 16 + fr;
                const float* bp = row < split_row ? base0 + (size_t)row * 1024 : base1 + (size_t)(row - split_row) * 1024;
                bf16_t* hp = hb + (size_t)row * 1024; float s = 0.f;
#pragma unroll
                for (int bj = 0; bj < 2; ++bj)
#pragma unroll
                    for (int n = 0; n < 2; ++n) { const int c = col0 + bj * HALF + n * 16; f32x4 b;
                        if constexpr (BASE_BF16) { const u32x2 pw = *(const u32x2*)(hp + c);
                            b[0] = __uint_as_float(pw.x << 16); b[1] = __uint_as_float(pw.x & 0xffff0000u); b[2] = __uint_as_float(pw.y << 16); b[3] = __uint_as_float(pw.y & 0xffff0000u); }
                        else b = *(const f32x4*)(bp + c);
                        const f32x4 v = b + acc[ai][bj][m][n];
                        s += (v[0] * v[0] + v[1] * v[1]) + (v[2] * v[2] + v[3] * v[3]);
                        u32x2 w; w.x = cvt_pk_bf16(v[0], v[1]); w.y = cvt_pk_bf16(v[2], v[3]); *(u32x2*)(hp + c) = w; }
                s += __shfl_xor(s, 16); s += __shfl_xor(s, 32);
                if (fq == 0) rsp[(size_t)row * 16 + u.pn * 4 + wc] = s; }
    }
};
struct EpiFF1 {
    static constexpr bool PERM = true, AFTER_DRAIN = false;
    const float* rsp; bf16_t* H; int row_off;
    __device__ __forceinline__ void operator()(const f32x4 (&acc)[2][2][4][2], const Unit& u, int wr, int wc, int fr, int fq) const {
        const int col0 = u.pn * BM + wc * 32 + 8 * fq;
#pragma unroll
        for (int ai = 0; ai < 2; ++ai)
#pragma unroll
            for (int m = 0; m < 4; ++m) { const int lrow = u.pm * BM + ai * HALF + wr * 64 + m * 16 + fr;
                const float rstd = 1.0f / sqrtf(rs16(rsp + (size_t)(row_off + lrow) * 16) * (1.0f / 1024.0f) + 1e-6f);
                bf16_t* rowp = H + (size_t)lrow * 4096 + col0;
#pragma unroll
                for (int bj = 0; bj < 2; ++bj) { f32x4 v0 = acc[ai][bj][m][0] * rstd, v1 = acc[ai][bj][m][1] * rstd;
#pragma unroll
                    for (int e = 0; e < 4; ++e) { const float a = fmaxf(v0[e], 0.f), b = fmaxf(v1[e], 0.f); v0[e] = a * a; v1[e] = b * b; }
                    u32x4 w; w.x = cvt_pk_bf16(v0[0], v0[1]); w.y = cvt_pk_bf16(v0[2], v0[3]); w.z = cvt_pk_bf16(v1[0], v1[1]); w.w = cvt_pk_bf16(v1[2], v1[3]);
                    *(u32x4*)(rowp + bj * HALF) = w; }
                asm volatile("" ::: "memory"); }
    }
};
struct EpiGate {
    static constexpr bool PERM = false, AFTER_DRAIN = false;
    const float* rsp_in; const bf16_t* proj; const bf16_t* hb_in; bf16_t* hb_out; float* rsp_out;
    __device__ __forceinline__ void operator()(const f32x4 (&acc)[2][2][4][2], const Unit& u, int wr, int wc, int fr, int fq) const {
        const int col0 = u.pn * BM + wc * 32 + 4 * fq;
#pragma unroll
        for (int ai = 0; ai < 2; ++ai)
#pragma unroll
            for (int m = 0; m < 4; ++m) { const int row = u.pm * BM + ai * HALF + wr * 64 + m * 16 + fr;
                const float rstd = 1.0f / sqrtf(rs16(rsp_in + (size_t)row * 16) * (1.0f / 1024.0f) + 1e-6f);
                const bf16_t* ip = hb_in + (size_t)row * 1024; bf16_t* op = hb_out + (size_t)row * 1024; const bf16_t* pp = proj + (size_t)row * 1024; float s = 0.f;
#pragma unroll
                for (int bj = 0; bj < 2; ++bj)
#pragma unroll
                    for (int n = 0; n < 2; ++n) { const int c = col0 + bj * HALF + n * 16; const f32x4 a = acc[ai][bj][m][n] * rstd;
                        const u32x2 pw = *(const u32x2*)(pp + c), hw = *(const u32x2*)(ip + c);
                        f32x4 pr, h2; pr[0] = __uint_as_float(pw.x << 16); pr[1] = __uint_as_float(pw.x & 0xffff0000u); pr[2] = __uint_as_float(pw.y << 16); pr[3] = __uint_as_float(pw.y & 0xffff0000u);
                        h2[0] = __uint_as_float(hw.x << 16); h2[1] = __uint_as_float(hw.x & 0xffff0000u); h2[2] = __uint_as_float(hw.y << 16); h2[3] = __uint_as_float(hw.y & 0xffff0000u);
                        f32x4 g;
#pragma unroll
                        for (int e2 = 0; e2 < 4; ++e2) g[e2] = __builtin_amdgcn_rcpf(1.0f + __builtin_amdgcn_exp2f(-1.4426950408889634f * a[e2]));
                        const f32x4 v = h2 + g * pr;
                        s += (v[0] * v[0] + v[1] * v[1]) + (v[2] * v[2] + v[3] * v[3]);
                        u32x2 w; w.x = cvt_pk_bf16(v[0], v[1]); w.y = cvt_pk_bf16(v[2], v[3]); *(u32x2*)(op + c) = w; }
                s += __shfl_xor(s, 16); s += __shfl_xor(s, 32);
                if (fq == 0) rsp_out[(size_t)row * 16 + u.pn * 4 + wc] = s;
                asm volatile("" ::: "memory"); }
    }
};
template <class Epi, class Sched, bool ALIGN_EPI = false, bool SP2 = false>
__device__ __forceinline__ void gemm_phase(PG8_LAS unsigned char* lds, const Gemm g, const Sched& S, const Epi& E) {
    int tid_ = threadIdx.x; asm volatile("" : "+v"(tid_));
    const int tid = tid_, wid = __builtin_amdgcn_readfirstlane(tid >> 6), lane = tid & 63, wr = wid >> 2, wc = wid & 3, fr = lane & 15, fq = lane >> 4;
    const int K = g.K, nt = K / BK;
    unsigned voffA[2], voffB[2];
#pragma unroll
    for (int i = 0; i < 2; ++i) { int R, C; stage_rc(tid * 16 + i * 8192, R, C); const int Rb = Epi::PERM ? ((R & ~31) + perm32(R & 31)) : R;
        voffA[i] = (unsigned)(R * K + C) * 2u; voffB[i] = (unsigned)(Rb * K + C) * 2u; }
    const size_t kstep = (size_t)(BK * 2);
    const size_t hstep = (size_t)HALF * K * 2;
    const size_t tstep = 2 * hstep;
    const unsigned ldsw = (unsigned)wid * 1024u;
    const int aoff = lds_byte(wr * 64 + fr, fq * 8), boff = lds_byte(wc * 32 + fr, fq * 8);
#define PG8_SA(b, h) (((b) * 2 + (h)) * HTB)
#define PG8_SB(b, h) ((4 + (b) * 2 + (h)) * HTB)
#define PG8_STAGE(bufoff, gbase, voff) do { _Pragma("unroll") for (int _i = 0; _i < 2; ++_i) \
        __builtin_amdgcn_global_load_lds((const unsigned*)((const char*)(gbase) + (voff)[_i]), (PG8_LAS unsigned*)(lds + (bufoff) + ldsw + _i * 8192), 16, 0, 0); } while (0)
#define PG8_LDA(dst, b, h) do { _Pragma("unroll") for (int m = 0; m < 4; ++m) _Pragma("unroll") for (int k = 0; k < 2; ++k) dst[m][k] = *(const PG8_LAS bf16x8*)(lds + PG8_SA(b, h) + aoff + m * 2048 + k * 1024); } while (0)
#define PG8_LDB(dst, b, h) do { _Pragma("unroll") for (int n = 0; n < 2; ++n) _Pragma("unroll") for (int k = 0; k < 2; ++k) dst[n][k] = *(const PG8_LAS bf16x8*)(lds + PG8_SB(b, h) + boff + n * 2048 + k * 1024); } while (0)
#define PG8_MMA(ai, bj, At, Bt) do { __builtin_amdgcn_s_setprio(1); _Pragma("unroll") for (int m = 0; m < 4; ++m) _Pragma("unroll") for (int n = 0; n < 2; ++n) _Pragma("unroll") for (int k = 0; k < 2; ++k) \
        acc[ai][bj][m][n] = __builtin_amdgcn_mfma_f32_16x16x32_bf16(Bt[n][k], At[m][k], acc[ai][bj][m][n], 0, 0, 0); __builtin_amdgcn_s_setprio(0); } while (0)
#define PG8_WAIT_V(n) asm volatile("s_waitcnt vmcnt(" #n ")" ::: "memory")
#define PG8_WAIT_L(n) asm volatile("s_waitcnt lgkmcnt(" #n ")" ::: "memory")
#define PG8_BAR __builtin_amdgcn_s_barrier()
#define PG8_SCHED __builtin_amdgcn_sched_barrier(0)
    Unit cur, nxt; int ui = 0;
    if (!S.next(0, cur)) return;
    f32x4 acc[2][2][4][2];
#pragma unroll
    for (int a = 0; a < 2; ++a)
#pragma unroll
        for (int b = 0; b < 2; ++b)
#pragma unroll
            for (int m = 0; m < 4; ++m)
#pragma unroll
                for (int n = 0; n < 2; ++n) acc[a][b][m][n] = (f32x4){0.f, 0.f, 0.f, 0.f};
    bf16x8 At[4][2], B0[2][2], B1[2][2];
    const char* cA = (const char*)g.A + (size_t)cur.pm * tstep; const char* cB = (const char*)g.Bt + (size_t)cur.pn * tstep;
    S.a_ready(cur);
    if constexpr (SP2) {
        PG8_STAGE(PG8_SB(0, 0), cB, voffB); PG8_STAGE(PG8_SB(0, 1), cB + hstep, voffB); PG8_STAGE(PG8_SA(0, 0), cA, voffA); PG8_STAGE(PG8_SA(0, 1), cA + hstep, voffA);
        if (wr == 1) PG8_BAR;
        PG8_WAIT_V(2); PG8_BAR;
        PG8_STAGE(PG8_SB(1, 0), cB + kstep, voffB); PG8_STAGE(PG8_SA(1, 0), cA + kstep, voffA); PG8_STAGE(PG8_SB(1, 1), cB + hstep + kstep, voffB);
        PG8_WAIT_V(6); PG8_BAR;
    } else {
        PG8_STAGE(PG8_SB(0, 0), cB, voffB); PG8_STAGE(PG8_SA(0, 0), cA, voffA); PG8_STAGE(PG8_SB(0, 1), cB + hstep, voffB); PG8_STAGE(PG8_SA(0, 1), cA + hstep, voffA);
        if (wr == 1) PG8_BAR;
        PG8_WAIT_V(4); PG8_BAR;
        PG8_STAGE(PG8_SB(1, 0), cB + kstep, voffB); PG8_STAGE(PG8_SA(1, 0), cA + kstep, voffA); PG8_STAGE(PG8_SB(1, 1), cB + hstep + kstep, voffB);
        PG8_WAIT_V(6); PG8_BAR;
    }
    for (;;) {
        const bool has_next = S.next(ui + 1, nxt);
        const char* nA = has_next ? (const char*)g.A + (size_t)nxt.pm * tstep : cA; const char* nB = has_next ? (const char*)g.Bt + (size_t)nxt.pn * tstep : cB;
        for (int t = 0; t < nt; t += 2) {
            const bool last = (t == nt - 2);
            const char* a1 = cA + (size_t)(t + 1) * kstep;
            const char* a2 = last ? nA : cA + (size_t)(t + 2) * kstep; const char* b2 = last ? nB : cB + (size_t)(t + 2) * kstep;
            const char* a3 = a2 + kstep; const char* b3 = b2 + kstep;
            if (last && has_next) S.a_ready(nxt);
            if constexpr (SP2) {
            PG8_LDB(B0, 0, 0); PG8_LDB(B1, 0, 1); PG8_SCHED; PG8_LDA(At, 0, 0); PG8_STAGE(PG8_SA(1, 1), a1 + hstep, voffA);
            PG8_WAIT_V(8); PG8_WAIT_L(0); PG8_BAR; PG8_MMA(0, 0, At, B0); PG8_MMA(0, 1, At, B1); PG8_BAR; PG8_SCHED;
            PG8_LDA(At, 0, 1); PG8_STAGE(PG8_SB(0, 0), b2, voffB); PG8_STAGE(PG8_SB(0, 1), b2 + hstep, voffB); PG8_STAGE(PG8_SA(0, 0), a2, voffA);
            PG8_WAIT_V(8); PG8_WAIT_L(0); PG8_BAR; PG8_MMA(1, 0, At, B0); PG8_MMA(1, 1, At, B1); PG8_BAR; PG8_SCHED;
            PG8_LDB(B0, 1, 0); PG8_LDB(B1, 1, 1); PG8_SCHED; PG8_LDA(At, 1, 0); PG8_STAGE(PG8_SA(0, 1), a2 + hstep, voffA);
            PG8_WAIT_V(8); PG8_WAIT_L(0); PG8_BAR; PG8_MMA(0, 0, At, B0); PG8_MMA(0, 1, At, B1); PG8_BAR; PG8_SCHED;
            PG8_LDA(At, 1, 1); PG8_STAGE(PG8_SB(1, 0), b3, voffB); PG8_STAGE(PG8_SB(1, 1), b3 + hstep, voffB); PG8_STAGE(PG8_SA(1, 0), a3, voffA);
            PG8_WAIT_V(8); PG8_WAIT_L(0); PG8_BAR; PG8_MMA(1, 0, At, B0); PG8_MMA(1, 1, At, B1); PG8_BAR; PG8_SCHED;
            } else {
            PG8_LDB(B0, 0, 0); PG8_SCHED; PG8_LDA(At, 0, 0); PG8_STAGE(PG8_SA(1, 1), a1 + hstep, voffA);
            PG8_WAIT_L(8); PG8_BAR; PG8_WAIT_L(0); PG8_MMA(0, 0, At, B0); PG8_BAR; PG8_SCHED;
            PG8_LDB(B1, 0, 1); PG8_STAGE(PG8_SB(0, 0), b2, voffB);
            PG8_BAR; PG8_WAIT_L(0); PG8_MMA(0, 1, At, B1); PG8_BAR;
            PG8_LDA(At, 0, 1); PG8_STAGE(PG8_SA(0, 0), a2, voffA);
            PG8_BAR; PG8_WAIT_L(0); PG8_MMA(1, 0, At, B0); PG8_BAR; PG8_SCHED;
            PG8_STAGE(PG8_SB(0, 1), b2 + hstep, voffB);
            PG8_WAIT_V(6); PG8_BAR; PG8_MMA(1, 1, At, B1); PG8_BAR;
            PG8_LDB(B0, 1, 0); PG8_SCHED; PG8_LDA(At, 1, 0); PG8_STAGE(PG8_SA(0, 1), a2 + hstep, voffA);
            PG8_WAIT_L(8); PG8_BAR; PG8_WAIT_L(0); PG8_MMA(0, 0, At, B0); PG8_BAR; PG8_SCHED;
            PG8_LDB(B1, 1, 1); PG8_STAGE(PG8_SB(1, 0), b3, voffB);
            PG8_BAR; PG8_WAIT_L(0); PG8_MMA(0, 1, At, B1); PG8_BAR;
            PG8_LDA(At, 1, 1); PG8_STAGE(PG8_SA(1, 0), a3, voffA);
            PG8_BAR; PG8_WAIT_L(0); PG8_MMA(1, 0, At, B0); PG8_BAR; PG8_SCHED;
            PG8_STAGE(PG8_SB(1, 1), b3 + hstep, voffB);
            PG8_WAIT_V(6); PG8_BAR; PG8_MMA(1, 1, At, B1); PG8_BAR;
            }
        }
        if constexpr (ALIGN_EPI) { if (wr == 0) PG8_BAR; }
        if constexpr (!Epi::AFTER_DRAIN) { E(acc, cur, wr, wc, fr, fq); S.done(cur); }
        if (!has_next) break;
#pragma unroll
        for (int a = 0; a < 2; ++a)
#pragma unroll
            for (int b = 0; b < 2; ++b)
#pragma unroll
                for (int m = 0; m < 4; ++m)
#pragma unroll
                    for (int n = 0; n < 2; ++n) acc[a][b][m][n] = (f32x4){0.f, 0.f, 0.f, 0.f};
        cur = nxt; cA = nA; cB = nB; ++ui;
        if constexpr (ALIGN_EPI) { if (wr == 1) PG8_BAR; }
    }
    PG8_WAIT_V(0);
    if constexpr (!ALIGN_EPI) { if (wr == 0) PG8_BAR; }
    PG8_BAR;
    if constexpr (Epi::AFTER_DRAIN) { E.fused(acc, cur, wr, wc, fr, fq, lds, wid, lane); S.done(cur); }
#undef PG8_SA
#undef PG8_SB
#undef PG8_STAGE
#undef PG8_LDA
#undef PG8_LDB
#undef PG8_MMA
#undef PG8_WAIT_V
#undef PG8_WAIT_L
#undef PG8_BAR
#undef PG8_SCHED
}
}
namespace att {
typedef unsigned short bf16_t;
using bf16x8 = __attribute__((ext_vector_type(8))) short;
using s16x4  = __attribute__((ext_vector_type(4))) short;
using f32x16 = __attribute__((ext_vector_type(16))) float;
using u32x4  = __attribute__((ext_vector_type(4))) unsigned;
constexpr int LDZ = 2368;
constexpr int SHM_V = 16384, SHM_K = 8192;
constexpr int ATTN_LDS = 2 * SHM_V + 2 * SHM_K + 8 * 64 * 4;
constexpr float THR2 = 8.0f;
#define KSWZ64(row, colB) ((row) * 128 + ((colB) ^ ((((row) >> 1) & 7) << 4)))
#define SBAR() __builtin_amdgcn_sched_barrier(0)
__device__ __forceinline__ int crow(int r, int hi) { return (r & 3) + 8 * (r >> 2) + 4 * hi; }
__device__ __forceinline__ unsigned cvtpk(float lo, float hi) { unsigned r; asm volatile("v_cvt_pk_bf16_f32 %0, %1, %2" : "=v"(r) : "v"(lo), "v"(hi)); return r; }
__device__ __forceinline__ unsigned short f2bf(float f) { unsigned u = __builtin_bit_cast(unsigned, f); return (unsigned short)((u + 0x7fffu + ((u >> 16) & 1u)) >> 16); }

template <bool ALIBI>
__device__ __forceinline__ void partialSM(f32x16& p0, f32x16& p1, float& m_reg, float& alpha, float dq, float sl2) {
  if constexpr (ALIBI) {
#pragma unroll
    for (int r = 0; r < 16; ++r) { const float t0 = dq - (float)((r & 3) + 8 * (r >> 2)); const float t1 = t0 - 32.f;
      p0[r] = fmaf(-sl2, fabsf(t0), p0[r]); p1[r] = fmaf(-sl2, fabsf(t1), p1[r]); }
  }
  float pmax = p0[0];
#pragma unroll
  for (int r = 1; r < 16; ++r) pmax = fmaxf(pmax, p0[r]);
#pragma unroll
  for (int r = 0; r < 16; ++r) pmax = fmaxf(pmax, p1[r]);
  { auto rr = __builtin_amdgcn_permlane32_swap(__float_as_uint(pmax), __float_as_uint(pmax), false, false);
    pmax = fmaxf(__uint_as_float(rr[0]), __uint_as_float(rr[1])); }
  float mn;
  if (__builtin_expect(__all(pmax - m_reg <= THR2), 1)) { mn = m_reg; alpha = 1.f; }
  else { mn = fmaxf(m_reg, pmax); alpha = __builtin_amdgcn_exp2f(m_reg - mn); m_reg = mn; }
#pragma unroll
  for (int r = 0; r < 16; ++r) { p0[r] -= mn; p1[r] -= mn; }
#pragma unroll
  for (int r = 0; r < 16; ++r) p0[r] = __builtin_amdgcn_exp2f(p0[r]);
}
__device__ __forceinline__ void finishSM(f32x16& p0, f32x16& p1, float alpha, float& l_reg, bf16x8& pa0, bf16x8& pa1, bf16x8& pa2, bf16x8& pa3) {
#pragma unroll
  for (int r = 0; r < 16; ++r) p1[r] = __builtin_amdgcn_exp2f(p1[r]);
  float ps = 0;
#pragma unroll
  for (int r = 0; r < 16; ++r) ps += p0[r];
#pragma unroll
  for (int r = 0; r < 16; ++r) ps += p1[r];
  { auto rr = __builtin_amdgcn_permlane32_swap(__float_as_uint(ps), __float_as_uint(ps), false, false);
    ps = __uint_as_float(rr[0]) + __uint_as_float(rr[1]); }
  l_reg = l_reg * alpha + ps;
#define PK4(P, BASE, OUT) do { unsigned a0 = cvtpk(P[BASE + 0], P[BASE + 1]), a1 = cvtpk(P[BASE + 2], P[BASE + 3]);   \
    unsigned b0 = cvtpk(P[BASE + 4], P[BASE + 5]), b1 = cvtpk(P[BASE + 6], P[BASE + 7]);                              \
    auto r0 = __builtin_amdgcn_permlane32_swap(a0, b0, false, false); auto r1 = __builtin_amdgcn_permlane32_swap(a1, b1, false, false); \
    u32x4 w = {r0[0], r1[0], r0[1], r1[1]}; OUT = *reinterpret_cast<bf16x8*>(&w); } while (0)
  PK4(p0, 0, pa0); PK4(p0, 8, pa1); PK4(p1, 0, pa2); PK4(p1, 8, pa3);
#undef PK4
}
__device__ __forceinline__ void qkt(f32x16& p0, f32x16& p1, const char* Ks, const bf16x8* qr, int r32, int hi) {
  p0 = f32x16{}; p1 = f32x16{};
#pragma unroll
  for (int d0 = 0; d0 < 4; ++d0) { const int cb = (d0 * 16 + hi * 8) * 2;
    const bf16x8 b0 = *reinterpret_cast<const bf16x8*>(Ks + KSWZ64(r32, cb));
    const bf16x8 b1 = *reinterpret_cast<const bf16x8*>(Ks + 4096 + KSWZ64(r32, cb));
    p0 = __builtin_amdgcn_mfma_f32_32x32x16_bf16(b0, qr[d0], p0, 0, 0, 0);
    p1 = __builtin_amdgcn_mfma_f32_32x32x16_bf16(b1, qr[d0], p1, 0, 0, 0); }
}
template <int NCB> __device__ __forceinline__ int v_st(int k, int c) { const int kk = (k & ~0xC) | ((k & 4) << 1) | ((k & 8) >> 1); return ((kk >> 3) * NCB + (c >> 5)) * 512 + ((kk & 7) * 32 + (c & 31)) * 2; }
__device__ __forceinline__ int v_rd_base(int lane) { return ((lane & 3) << 3) | (((lane >> 2) & 3) << 6) | (((lane >> 4) & 1) << 5) | (((lane >> 5) & 1) << 8); }
template <int OFF> __device__ __forceinline__ s16x4 tr_read(int vb) {
  s16x4 r; asm volatile("ds_read_b64_tr_b16 %0, %1 offset:%2" : "=&v"(r) : "v"(vb), "i"(OFF) : "memory"); return r;
}
template <int NCB, int D0> __device__ __forceinline__ void pv_one(f32x16& od, int vb, bf16x8 pa0, bf16x8 pa1, bf16x8 pa2, bf16x8 pa3) {
  constexpr int KS = NCB * 1024, HF = NCB * 512, B0 = D0 * 512;
  const s16x4 l0 = tr_read<B0>(vb), h0 = tr_read<B0 + HF>(vb), l1 = tr_read<B0 + KS>(vb), h1 = tr_read<B0 + KS + HF>(vb);
  const s16x4 l2 = tr_read<B0 + 2 * KS>(vb), h2 = tr_read<B0 + 2 * KS + HF>(vb), l3 = tr_read<B0 + 3 * KS>(vb), h3 = tr_read<B0 + 3 * KS + HF>(vb);
  asm volatile("s_waitcnt lgkmcnt(0)" ::: "memory"); SBAR();
#define PK(L, H) (bf16x8){L[0], L[1], L[2], L[3], H[0], H[1], H[2], H[3]}
  od = __builtin_amdgcn_mfma_f32_32x32x16_bf16(pa0, PK(l0, h0), od, 0, 0, 0);
  od = __builtin_amdgcn_mfma_f32_32x32x16_bf16(pa1, PK(l1, h1), od, 0, 0, 0);
  od = __builtin_amdgcn_mfma_f32_32x32x16_bf16(pa2, PK(l2, h2), od, 0, 0, 0);
  od = __builtin_amdgcn_mfma_f32_32x32x16_bf16(pa3, PK(l3, h3), od, 0, 0, 0);
#undef PK
}
template <int NCB> __device__ __forceinline__ void pv_all(f32x16* o, int vb, bf16x8 pa0, bf16x8 pa1, bf16x8 pa2, bf16x8 pa3) {
  pv_one<NCB, 0>(o[0], vb, pa0, pa1, pa2, pa3); pv_one<NCB, 1>(o[1], vb, pa0, pa1, pa2, pa3);
  if constexpr (NCB == 4) { pv_one<NCB, 2>(o[2], vb, pa0, pa1, pa2, pa3); pv_one<NCB, 3>(o[3], vb, pa0, pa1, pa2, pa3); }
}
__device__ __forceinline__ void store_o(float* p, float v) { *p = v; }
__device__ __forceinline__ void store_o(bf16_t* p, float v) { *p = f2bf(v); }

template <int DV, bool ALIBI, typename TO>
__device__ __forceinline__ void attn_unit(const bf16_t* __restrict__ Qb, const bf16_t* __restrict__ Kh, const bf16_t* __restrict__ Vh, TO* __restrict__ Ob, int seq, int qpos0, float sl2, char* lds) {
  constexpr int NCB = DV / 32;
  const int tid = threadIdx.x, wid = tid >> 6, lane = tid & 63, r32 = lane & 31, hi = lane >> 5;
  char* V_lds = lds; char* K_lds = lds + 2 * SHM_V;
  float* ws = (float*)(lds + 2 * SHM_V + 2 * SHM_K) + wid * 64; float* li_l = ws; float* al_l = ws + 32;
  float m_reg = -1e30f, l_reg = 0; f32x16 o[NCB];
#pragma unroll
  for (int d = 0; d < NCB; ++d) o[d] = f32x16{};
  bf16x8 qr[4];
  const bf16_t* Qw = Qb + (long)(wid * 32 + r32) * LDZ + hi * 8;
#pragma unroll
  for (int d0 = 0; d0 < 4; ++d0) qr[d0] = *reinterpret_cast<const bf16x8*>(Qw + d0 * 16);
  const float dq0 = (float)(qpos0 + wid * 32 + r32 - 4 * hi);
  const int kr = tid >> 3, kc = (tid & 7) * 8, kst = KSWZ64(kr, kc * 2);
  const int sr = tid >> 4, sc = (tid & 15) * 8;
  const int vst0 = (DV == 128) ? v_st<NCB>(sr, sc) : v_st<NCB>(kr, kc), vst1 = v_st<NCB>(32 + sr, sc);
  const int vb0 = (int)(uintptr_t)V_lds + v_rd_base(lane);
  bf16x8 sv0[2], sv1[2], sk[2];
#define SLOAD(i, k0) do { if constexpr (DV == 128) { sv0[i] = *reinterpret_cast<const bf16x8*>(&Vh[(long)((k0) + sr) * LDZ + sc]); sv1[i] = *reinterpret_cast<const bf16x8*>(&Vh[(long)((k0) + 32 + sr) * LDZ + sc]); } \
    else { sv0[i] = *reinterpret_cast<const bf16x8*>(&Vh[(long)((k0) + kr) * LDZ + kc]); } \
    sk[i] = *reinterpret_cast<const bf16x8*>(&Kh[(long)((k0) + kr) * LDZ + kc]); } while (0)
#define SWRITE(b, i) do { *(bf16x8*)(V_lds + (b) * SHM_V + vst0) = sv0[i]; if constexpr (DV == 128) { *(bf16x8*)(V_lds + (b) * SHM_V + vst1) = sv1[i]; } \
    *(bf16x8*)(K_lds + (b) * SHM_K + kst) = sk[i]; } while (0)
#define SWAIT() do { if constexpr (DV == 128) asm volatile("s_waitcnt vmcnt(3)" ::: "memory"); else asm volatile("s_waitcnt vmcnt(2)" ::: "memory"); } while (0)
#define RESC(a) do { if (__any((a) < 1.f)) { if (hi == 0) al_l[r32] = (a); asm volatile("s_waitcnt lgkmcnt(0)" ::: "memory"); \
    _Pragma("unroll") for (int d = 0; d < NCB; ++d) _Pragma("unroll") for (int r = 0; r < 16; ++r) o[d][r] *= al_l[crow(r, hi)]; } } while (0)
  f32x16 pA0, pA1, pB0, pB1; float alA, alB; bf16x8 pa0, pa1, pa2, pa3; const int NT = seq / 64;
  SLOAD(0, 0); asm volatile("s_waitcnt vmcnt(0)" ::: "memory"); SWRITE(0, 0); __syncthreads();
  qkt(pA0, pA1, K_lds, qr, r32, hi); partialSM<ALIBI>(pA0, pA1, m_reg, alA, dq0, sl2);
  SLOAD(1, 64); if (2 < NT) SLOAD(0, 128);
  SWAIT(); SWRITE(1, 1); __syncthreads();
  for (int j = 1; j + 1 < NT; j += 2) {
    SBAR(); qkt(pB0, pB1, K_lds + SHM_K, qr, r32, hi);
    finishSM(pA0, pA1, alA, l_reg, pa0, pa1, pa2, pa3); SBAR();
    SLOAD(1, (j + 2) * 64); SBAR();
    pv_all<NCB>(o, vb0, pa0, pa1, pa2, pa3); partialSM<ALIBI>(pB0, pB1, m_reg, alB, dq0 - 64.f * (float)j, sl2);
    __syncthreads(); SWAIT(); SWRITE(0, 0);
    RESC(alB); __syncthreads();
    SBAR(); qkt(pA0, pA1, K_lds, qr, r32, hi);
    finishSM(pB0, pB1, alB, l_reg, pa0, pa1, pa2, pa3); SBAR();
    if (j + 3 < NT) SLOAD(0, (j + 3) * 64); SBAR();
    pv_all<NCB>(o, vb0 + SHM_V, pa0, pa1, pa2, pa3); partialSM<ALIBI>(pA0, pA1, m_reg, alA, dq0 - 64.f * (float)(j + 1), sl2);
    __syncthreads(); SWAIT(); SWRITE(1, 1);
    RESC(alA); __syncthreads();
  }
  SBAR(); qkt(pB0, pB1, K_lds + SHM_K, qr, r32, hi);
  finishSM(pA0, pA1, alA, l_reg, pa0, pa1, pa2, pa3); SBAR();
  pv_all<NCB>(o, vb0, pa0, pa1, pa2, pa3); partialSM<ALIBI>(pB0, pB1, m_reg, alB, dq0 - 64.f * (float)(NT - 1), sl2);
  __syncthreads(); RESC(alB);
  finishSM(pB0, pB1, alB, l_reg, pa0, pa1, pa2, pa3); SBAR();
  pv_all<NCB>(o, vb0 + SHM_V, pa0, pa1, pa2, pa3);
  if (hi == 0) li_l[r32] = l_reg; asm volatile("s_waitcnt lgkmcnt(0)" ::: "memory");
  float rli[16];
#pragma unroll
  for (int r = 0; r < 16; ++r) rli[r] = __builtin_amdgcn_rcpf(li_l[crow(r, hi)]);
  TO* Ow = Ob + (long)(wid * 32) * 1024;
#pragma unroll
  for (int r = 0; r < 16; ++r) { const int orow = crow(r, hi);
#pragma unroll
    for (int d0 = 0; d0 < NCB; ++d0) store_o(Ow + (long)orow * 1024 + d0 * 32 + r32, o[d0][r] * rli[r]); }
  __syncthreads();
#undef SLOAD
#undef SWRITE
#undef SWAIT
#undef RESC
}
#undef SBAR
}
namespace att {
#define ALAS __attribute__((address_space(3)))
__device__ __forceinline__ void qkt_l(f32x16& p0, f32x16& p1, const ALAS unsigned char* Ks, const bf16x8* qr, int r32, int hi) {
  p0 = f32x16{}; p1 = f32x16{};
#pragma unroll
  for (int d0 = 0; d0 < 4; ++d0) { const int cb = (d0 * 16 + hi * 8) * 2;
    const bf16x8 b0 = *reinterpret_cast<const ALAS bf16x8*>(Ks + KSWZ64(r32, cb));
    const bf16x8 b1 = *reinterpret_cast<const ALAS bf16x8*>(Ks + 4096 + KSWZ64(r32, cb));
    p0 = __builtin_amdgcn_mfma_f32_32x32x16_bf16(b0, qr[d0], p0, 0, 0, 0);
    p1 = __builtin_amdgcn_mfma_f32_32x32x16_bf16(b1, qr[d0], p1, 0, 0, 0); }
}
__device__ __forceinline__ void qkt_acc(f32x16& p0, f32x16& p1, const ALAS unsigned char* Ks, const bf16x8* qr, int r32, int hi) {
  bf16x8 kb0[4], kb1[4];
#pragma unroll
  for (int d0 = 0; d0 < 4; ++d0) { const int cb = (d0 * 16 + hi * 8) * 2;
    kb0[d0] = *reinterpret_cast<const ALAS bf16x8*>(Ks + KSWZ64(r32, cb)); kb1[d0] = *reinterpret_cast<const ALAS bf16x8*>(Ks + 4096 + KSWZ64(r32, cb)); }
  __builtin_amdgcn_sched_barrier(0);
#pragma unroll
  for (int d0 = 0; d0 < 4; ++d0) {
    p0 = __builtin_amdgcn_mfma_f32_32x32x16_bf16(kb0[d0], qr[d0], p0, 0, 0, 0);
    p1 = __builtin_amdgcn_mfma_f32_32x32x16_bf16(kb1[d0], qr[d0], p1, 0, 0, 0); }
}
__device__ __forceinline__ void qkt_c(f32x16& p0, f32x16& p1, const f32x16& negm, const ALAS unsigned char* Ks, const bf16x8* qr, int r32, int hi) {
  bf16x8 kb0[4], kb1[4];
#pragma unroll
  for (int d0 = 0; d0 < 4; ++d0) { const int cb = (d0 * 16 + hi * 8) * 2;
    kb0[d0] = *reinterpret_cast<const ALAS bf16x8*>(Ks + KSWZ64(r32, cb)); kb1[d0] = *reinterpret_cast<const ALAS bf16x8*>(Ks + 4096 + KSWZ64(r32, cb)); }
  __builtin_amdgcn_sched_barrier(0);
  p0 = __builtin_amdgcn_mfma_f32_32x32x16_bf16(kb0[0], qr[0], negm, 0, 0, 0); p1 = __builtin_amdgcn_mfma_f32_32x32x16_bf16(kb1[0], qr[0], negm, 0, 0, 0);
#pragma unroll
  for (int d0 = 1; d0 < 4; ++d0) {
    p0 = __builtin_amdgcn_mfma_f32_32x32x16_bf16(kb0[d0], qr[d0], p0, 0, 0, 0);
    p1 = __builtin_amdgcn_mfma_f32_32x32x16_bf16(kb1[d0], qr[d0], p1, 0, 0, 0); }
}
template <int NCB> __device__ __forceinline__ void pv_issue0(s16x4 (&vl)[4], s16x4 (&vh)[4], int vb) {
  constexpr int KS = NCB * 1024, HF = NCB * 512;
  vl[0] = tr_read<0>(vb); vh[0] = tr_read<HF>(vb); vl[1] = tr_read<KS>(vb); vh[1] = tr_read<KS + HF>(vb);
  vl[2] = tr_read<2 * KS>(vb); vh[2] = tr_read<2 * KS + HF>(vb); vl[3] = tr_read<3 * KS>(vb); vh[3] = tr_read<3 * KS + HF>(vb);
}
template <int NCB> __device__ __forceinline__ void pv_rest(f32x16* o, const s16x4 (&vl)[4], const s16x4 (&vh)[4], int vb, bf16x8 pa0, bf16x8 pa1, bf16x8 pa2, bf16x8 pa3) {
  asm volatile("s_waitcnt lgkmcnt(0)" ::: "memory"); __builtin_amdgcn_sched_barrier(0);
#define PK(L, H) (bf16x8){L[0], L[1], L[2], L[3], H[0], H[1], H[2], H[3]}
  o[0] = __builtin_amdgcn_mfma_f32_32x32x16_bf16(pa0, PK(vl[0], vh[0]), o[0], 0, 0, 0);
  o[0] = __builtin_amdgcn_mfma_f32_32x32x16_bf16(pa1, PK(vl[1], vh[1]), o[0], 0, 0, 0);
  o[0] = __builtin_amdgcn_mfma_f32_32x32x16_bf16(pa2, PK(vl[2], vh[2]), o[0], 0, 0, 0);
  o[0] = __builtin_amdgcn_mfma_f32_32x32x16_bf16(pa3, PK(vl[3], vh[3]), o[0], 0, 0, 0);
#undef PK
  pv_one<NCB, 1>(o[1], vb, pa0, pa1, pa2, pa3);
  if constexpr (NCB == 4) { pv_one<NCB, 2>(o[2], vb, pa0, pa1, pa2, pa3); pv_one<NCB, 3>(o[3], vb, pa0, pa1, pa2, pa3); }
}
constexpr int PP_NK = 4, PP_NV = 6;
constexpr int PP_KSLOT = 8192, PP_VSLOT = 16384, PP_LK = 0, PP_LV = PP_NK * PP_KSLOT, PP_LW = PP_LV + PP_NV * PP_VSLOT, PP_LDS = PP_LW + 8 * 64 * 4;
static_assert(PP_LDS <= 139264, "attention rings (the frame keeps its control words at byte 139264 of the 144 KiB)");
#define PP_BAR() do { asm volatile("s_waitcnt lgkmcnt(0)" ::: "memory"); __builtin_amdgcn_s_barrier(); asm volatile("" ::: "memory"); } while (0)
template <int DV, bool ALIBI, typename TO>
__device__ __forceinline__ void attn_unit_pp(const bf16_t* __restrict__ Qb, const bf16_t* __restrict__ Kh, const bf16_t* __restrict__ Vh, TO* __restrict__ Ob, int NT, int qpos0, float sl2, ALAS unsigned char* ldsl, float mref = -1.f) {
  constexpr int NCB = DV / 32, NVI = DV / 32;
  int tid_ = threadIdx.x; asm volatile("" : "+v"(tid_));
  const int tid = tid_, lane = tid & 63, r32 = lane & 31, hi = lane >> 5;
  const int wid = __builtin_amdgcn_readfirstlane(tid >> 6), g = wid >> 2, wq = wid & 3;
  ALAS float* li_l = (ALAS float*)(ldsl + PP_LW) + wid * 64; ALAS float* al_l = li_l + 32;
  bf16x8 qr[4];
  const bf16_t* Qw = Qb + (long)(wid * 32 + r32) * LDZ + hi * 8;
#pragma unroll
  for (int d0 = 0; d0 < 4; ++d0) qr[d0] = *reinterpret_cast<const bf16x8*>(Qw + d0 * 16);
  const float dq0 = (float)(qpos0 + wid * 32 + r32 - 8 * hi);
  unsigned doff[NVI];
#pragma unroll
  for (int i = 0; i < NVI; ++i) {
    const int Lk = (wq * 2 + (i & 1)) * 64 + lane, row = Lk >> 3, c = (Lk & 7) ^ ((row >> 1) & 7);
    const int Lv = (wq * NVI + i) * 64 + lane, st = Lv >> 5, wi = Lv & 31, kk = (st / NCB) * 8 + (wi >> 2), kv = (kk & ~0xC) | ((kk & 4) << 1) | ((kk & 8) >> 1);
    const int krow = (row & ~0xC) | ((row & 4) << 1) | ((row & 8) >> 1);
    doff[i] = g ? (unsigned)(krow * LDZ + c * 8) * 2u : (unsigned)(kv * LDZ + (st % NCB) * 32 + (wi & 3) * 8) * 2u; }
  const char* dbase = g ? (const char*)Kh : (const char*)Vh;
  const int dlds = g ? (PP_LK + wq * 2 * 1024) : (PP_LV + wq * NVI * 1024), dss = g ? PP_KSLOT : PP_VSLOT, ni = g ? 2 : NVI;
#define DMA_T(t, slot) do { const char* tb_ = dbase + (size_t)(t) * (64 * LDZ * 2); ALAS unsigned char* ld_ = ldsl + dlds + (slot) * dss; \
    _Pragma("unroll") for (int i_ = 0; i_ < NVI; ++i_) if (i_ < ni) __builtin_amdgcn_global_load_lds((const unsigned*)(tb_ + doff[i_]), (ALAS unsigned*)(ld_ + i_ * 1024), 16, 0, 0); } while (0)
  const int vbase = (int)(unsigned)(uintptr_t)(ldsl + PP_LV) + v_rd_base(lane);
  const bool mfree = __builtin_amdgcn_readfirstlane((int)(mref >= 0.f)) != 0;
  float m_reg = mfree ? mref : 0.f, l_reg = 0.f; f32x16 o[NCB];
  f32x16 negm = f32x16{}; const int qw = qpos0 + wid * 32;
#pragma unroll
  for (int d = 0; d < NCB; ++d) o[d] = f32x16{};
  f32x16 S0 = f32x16{}, S1 = f32x16{}; bf16x8 pa0 = bf16x8{}, pa1 = bf16x8{}, pa2 = bf16x8{}, pa3 = bf16x8{};
  if (g == 1) { _Pragma("unroll") for (int t = 0; t < PP_NK; ++t) DMA_T(t, t); asm volatile("s_waitcnt vmcnt(6)" ::: "memory"); static_assert(PP_NK == 4, "prologue wait = 2 * (NK - 1)"); }
  else { _Pragma("unroll") for (int t = 0; t < PP_NV - 2; ++t) DMA_T(t, t); }
  PP_BAR();
#define CRF(r) ((float)(((r) & 7) + 16 * ((r) >> 3)))
#define S_INIT(t) do { const int ti_ = (t); if (ALIBI && ti_ < NT) { const int kt0_ = 64 * ti_; const float dq_ = dq0 - (float)kt0_; \
        if (kt0_ + 63 <= qw || kt0_ >= qw + 31) {     \
          const float ssl_ = (kt0_ + 63 <= qw) ? sl2 : -sl2; const float e0_ = -m_reg - ssl_ * dq_, e1_ = e0_ + 32.f * ssl_; \
          _Pragma("unroll") for (int r = 0; r < 16; ++r) { S0[r] = fmaf(ssl_, CRF(r), e0_); S1[r] = fmaf(ssl_, CRF(r), e1_); } \
        } else { \
          _Pragma("unroll") for (int r = 0; r < 16; ++r) { const float t0_ = dq_ - CRF(r); S0[r] = fmaf(-sl2, fabsf(t0_), -m_reg); S1[r] = fmaf(-sl2, fabsf(t0_ - 32.f), -m_reg); } \
        } } } while (0)
#define M_STEP(k) do { const int k_ = (k); s16x4 vl_[4], vh_[4]; const int vb_ = vbase + ((k_ >= 0 ? k_ : 0) % PP_NV) * PP_VSLOT; \
    if (k_ >= 0) pv_issue0<NCB>(vl_, vh_, vb_); \
    if (k_ + 1 < NT) { const int ks_ = (k_ + 1) % PP_NK; \
      if constexpr (ALIBI) { if (k_ < 0) S_INIT(0); qkt_acc(S0, S1, ldsl + PP_LK + ks_ * PP_KSLOT, qr, r32, hi); \
      } else { qkt_c(S0, S1, negm, ldsl + PP_LK + ks_ * PP_KSLOT, qr, r32, hi); } } \
    if (k_ >= 0) pv_rest<NCB>(o, vl_, vh_, vb_, pa0, pa1, pa2, pa3); } while (0)
#define PKD(P, BASE, OUT) do { u32x4 w_ = {cvtpk(P[BASE + 0], P[BASE + 1]), cvtpk(P[BASE + 2], P[BASE + 3]), cvtpk(P[BASE + 4], P[BASE + 5]), cvtpk(P[BASE + 6], P[BASE + 7])}; OUT = *reinterpret_cast<bf16x8*>(&w_); } while (0)
#define PK4(P, BASE, OUT) do { unsigned a0 = cvtpk(P[BASE + 0], P[BASE + 1]), a1 = cvtpk(P[BASE + 2], P[BASE + 3]);   \
    unsigned b0 = cvtpk(P[BASE + 4], P[BASE + 5]), b1 = cvtpk(P[BASE + 6], P[BASE + 7]);                              \
    auto r0 = __builtin_amdgcn_permlane32_swap(a0, b0, false, false); auto r1 = __builtin_amdgcn_permlane32_swap(a1, b1, false, false); \
    u32x4 w = {r0[0], r1[0], r0[1], r1[1]}; OUT = *reinterpret_cast<bf16x8*>(&w); } while (0)
#define V_STEP(k) do { const int k_ = (k); \
    { const int tt_ = k_ + (g ? PP_NK : PP_NV - 2); if (tt_ < NT) DMA_T(tt_, g ? tt_ % PP_NK : tt_ % PP_NV); } \
    if (!mfree) { float pmax = S0[0]; \
    _Pragma("unroll") for (int r = 1; r < 16; ++r) pmax = fmaxf(pmax, S0[r]); \
    _Pragma("unroll") for (int r = 0; r < 16; ++r) pmax = fmaxf(pmax, S1[r]); \
    { auto rr = __builtin_amdgcn_permlane32_swap(__float_as_uint(pmax), __float_as_uint(pmax), false, false); \
      pmax = fmaxf(__uint_as_float(rr[0]), __uint_as_float(rr[1])); } \
    if (k_ == 0 || !__builtin_expect(__all(pmax <= THR2), 1)) {       \
      const float dl = (k_ == 0) ? pmax : fmaxf(pmax, 0.f); m_reg += dl; \
      _Pragma("unroll") for (int r = 0; r < 16; ++r) { S0[r] -= dl; S1[r] -= dl; } \
      if constexpr (!ALIBI) { _Pragma("unroll") for (int r = 0; r < 16; ++r) negm[r] = -m_reg; } \
      if (k_ != 0) { const float alpha = __builtin_amdgcn_exp2f(-dl); l_reg *= alpha; \
        if (hi == 0) al_l[r32] = alpha; \
        asm volatile("s_waitcnt lgkmcnt(0)" ::: "memory"); \
        _Pragma("unroll") for (int d = 0; d < NCB; ++d) _Pragma("unroll") for (int r = 0; r < 16; ++r) o[d][r] *= al_l[crow(r, hi)]; } } } \
    _Pragma("unroll") for (int r = 0; r < 16; ++r) { S0[r] = __builtin_amdgcn_exp2f(S0[r]); S1[r] = __builtin_amdgcn_exp2f(S1[r]); } \
    float ps = 0.f, ps1 = 0.f, ps2 = 0.f, ps3 = 0.f; \
    _Pragma("unroll") for (int r = 0; r < 16; r += 2) { ps += S0[r]; ps1 += S0[r + 1]; ps2 += S1[r]; ps3 += S1[r + 1]; } \
    ps = (ps + ps1) + (ps2 + ps3); \
    { auto rr = __builtin_amdgcn_permlane32_swap(__float_as_uint(ps), __float_as_uint(ps), false, false); \
      ps = __uint_as_float(rr[0]) + __uint_as_float(rr[1]); } \
    l_reg += ps; \
    PKD(S0, 0, pa0); PKD(S0, 8, pa1); PKD(S1, 0, pa2); PKD(S1, 8, pa3); S_INIT(k_ + 1); } while (0)
#define WAIT_V(n) asm volatile("s_waitcnt vmcnt(" #n ")" ::: "memory")
  if (g == 0) {
    M_STEP(-1); PP_BAR();
    for (int k = 0; k < NT; ++k) {
      V_STEP(k);
      { const int no_ = NT - 1 - k;
        static_assert(PP_NV == 6, "up to NV - 2 = 4 later V tiles in flight");
        if (no_ >= 4) { if constexpr (NVI == 4) WAIT_V(16); else WAIT_V(8); } else if (no_ == 3) { if constexpr (NVI == 4) WAIT_V(12); else WAIT_V(6); }
        else if (no_ == 2) { if constexpr (NVI == 4) WAIT_V(8); else WAIT_V(4); } else if (no_ == 1) { if constexpr (NVI == 4) WAIT_V(4); else WAIT_V(2); } else WAIT_V(0); }
      PP_BAR();
      M_STEP(k); PP_BAR();
    }
    PP_BAR();
  } else {
    PP_BAR();
    for (int k = 0; k < NT; ++k) {
      M_STEP(k - 1);
      { const int no_ = NT - 2 - k;
        if (no_ >= 2) WAIT_V(4); else if (no_ == 1) WAIT_V(2); else WAIT_V(0); }
      PP_BAR();
      V_STEP(k); PP_BAR();
    }
    M_STEP(NT - 1); PP_BAR();
  }
#undef M_STEP
#undef S_INIT
#undef CRF
#undef V_STEP
#undef PK4
#undef PKD
#undef WAIT_V
  if (hi == 0) li_l[r32] = l_reg; asm volatile("s_waitcnt lgkmcnt(0)" ::: "memory");
  float rli[16];
#pragma unroll
  for (int r = 0; r < 16; ++r) rli[r] = __builtin_amdgcn_rcpf(li_l[crow(r, hi)]);
  TO* Ow = Ob + (long)(wid * 32) * 1024;
#pragma unroll
  for (int r = 0; r < 16; ++r) { const int orow = crow(r, hi);
#pragma unroll
    for (int d0 = 0; d0 < NCB; ++d0) store_o(Ow + (long)orow * 1024 + d0 * 32 + r32, o[d0][r] * rli[r]); }
#undef DMA_T
}
#undef ALAS
}
namespace attn_body {
using bf16=__hip_bfloat16;
using bf16x8=__attribute__((ext_vector_type(8)))short;
using s16x4=__attribute__((ext_vector_type(4)))short;
using f32x16=__attribute__((ext_vector_type(16)))float;
using u32x4=__attribute__((ext_vector_type(4)))unsigned;
constexpr int D=64,DMQ=2368,DMK=2368,DMV=2368,DMO=1024;
constexpr int NW=8,QBLK=32,QB=QBLK*NW,KVBLK=64;
__device__ __forceinline__ int crow(int r,int hi){return (r&3)+8*(r>>2)+4*hi;}
#define SBAR() __builtin_amdgcn_sched_barrier(0)
__device__ __forceinline__ void cmask(f32x16&p0,f32x16&p1,int jb,int qrel,int hi){
  const float NEG=-INFINITY; int kb=64*jb+4*hi;
  #pragma unroll
  for(int r=0;r<16;++r){int kv=kb+(r&3)+8*(r>>2); if(kv>qrel)p0[r]=NEG; if(kv+32>qrel)p1[r]=NEG;}
}

constexpr int NSLOT=3, SLOTB=8192;
constexpr int LDS_K=0, LDS_V=NSLOT*SLOTB, LDS_WS=2*NSLOT*SLOTB, LDS_OST=LDS_WS+NW*64*4, LDS_BYTES=LDS_OST+NW*4096;
constexpr float C2=0.125f*1.4426950408889634f;
__device__ __forceinline__ void glds16(const void*gsrc,unsigned lds_dst){unsigned keep;
  asm volatile("s_mov_b32 %0, m0\n\ts_mov_b32 m0, %2\n\ts_nop 0\n\tglobal_load_lds_dwordx4 %1, off\n\ts_mov_b32 m0, %0":"=&s"(keep):"v"(gsrc),"s"(lds_dst):"memory");}
__device__ __forceinline__ float max3f(float a,float b,float c){float r;asm("v_max3_f32 %0, %1, %2, %3":"=v"(r):"v"(a),"v"(b),"v"(c));return r;}
__device__ __forceinline__ float max2f(float a,float b){float r;asm("v_max_f32_e32 %0, %1, %2":"=v"(r):"v"(a),"v"(b));return r;}
__device__ __forceinline__ float fadd_s(float a,float b){float r;asm("v_add_f32_e32 %0, %1, %2":"=v"(r):"v"(a),"v"(b));return r;}
__device__ __forceinline__ float fsub_s(float a,float b){float r;asm("v_sub_f32_e32 %0, %1, %2":"=v"(r):"v"(a),"v"(b));return r;}
typedef float f32x2_t __attribute__((ext_vector_type(2))); typedef __bf16 bf16x2_t __attribute__((ext_vector_type(2)));
__device__ __forceinline__ unsigned cvtpk_s(float lo,float hi){f32x2_t v={lo,hi};bf16x2_t b=__builtin_convertvector(v,bf16x2_t);return __builtin_bit_cast(unsigned,b);}
#define WAIT_BAR(N) asm volatile("s_waitcnt vmcnt(" #N ") lgkmcnt(0)\n\ts_barrier":::"memory")

__device__ __forceinline__ void qkt(f32x16&p0,f32x16&p1,const char*Kslot,const bf16x8*qr,const f32x16&negm,int r32,int hi){
  const char*kb=Kslot+hi*1024+r32*16;
  #pragma unroll
  for(int d0=0;d0<4;++d0){
    const bf16x8 b0=*reinterpret_cast<const bf16x8*>(kb+d0*2048);
    const bf16x8 b1=*reinterpret_cast<const bf16x8*>(kb+d0*2048+512);
    if(d0==0){p0=__builtin_amdgcn_mfma_f32_32x32x16_bf16(b0,qr[0],negm,0,0,0);p1=__builtin_amdgcn_mfma_f32_32x32x16_bf16(b1,qr[0],negm,0,0,0);}
    else{p0=__builtin_amdgcn_mfma_f32_32x32x16_bf16(b0,qr[d0],p0,0,0,0);p1=__builtin_amdgcn_mfma_f32_32x32x16_bf16(b1,qr[d0],p1,0,0,0);}}
}
typedef __attribute__((address_space(3))) const char* lds_cptr;
typedef short v4i16_t __attribute__((ext_vector_type(4)));
__device__ __forceinline__ void kload8(bf16x8*kf,lds_cptr kp){
  kf[0]=*(const __attribute__((address_space(3))) bf16x8*)(kp);      kf[1]=*(const __attribute__((address_space(3))) bf16x8*)(kp+512);
  kf[2]=*(const __attribute__((address_space(3))) bf16x8*)(kp+2048); kf[3]=*(const __attribute__((address_space(3))) bf16x8*)(kp+2560);
  kf[4]=*(const __attribute__((address_space(3))) bf16x8*)(kp+4096); kf[5]=*(const __attribute__((address_space(3))) bf16x8*)(kp+4608);
  kf[6]=*(const __attribute__((address_space(3))) bf16x8*)(kp+6144); kf[7]=*(const __attribute__((address_space(3))) bf16x8*)(kp+6656);
}
__device__ __forceinline__ void kload2(bf16x8*kf,lds_cptr kp,int j){ kf[2*j]=*(const __attribute__((address_space(3))) bf16x8*)(kp+j*2048); kf[2*j+1]=*(const __attribute__((address_space(3))) bf16x8*)(kp+j*2048+512); }
__device__ __forceinline__ s16x4 vtr(lds_cptr p){ return __builtin_bit_cast(s16x4,__builtin_amdgcn_ds_read_tr16_b64_v4i16((__attribute__((address_space(3))) v4i16_t*)p)); }
__device__ __forceinline__ float rowmax(const f32x16&p0,const f32x16&p1){
  float a=max3f(p0[0],p0[1],p1[0]),b=max3f(p0[2],p0[3],p1[1]);a=max3f(a,p1[2],p1[3]);
  #pragma unroll
  for(int r=4;r<16;r+=4){a=max3f(a,p0[r],p0[r+1]);b=max3f(b,p0[r+2],p0[r+3]);a=max3f(a,p1[r],p1[r+1]);b=max3f(b,p1[r+2],p1[r+3]);}
  const float m=max2f(a,b);
  auto rr=__builtin_amdgcn_permlane32_swap(__float_as_uint(m),__float_as_uint(m),false,false);
  return max2f(__uint_as_float(rr[0]),__uint_as_float(rr[1]));
}
__device__ __forceinline__ void pv(f32x16*o,int vb,bf16x8 pa0,bf16x8 pa1,bf16x8 pa2,bf16x8 pa3){
  #pragma unroll
  for(int d0=0;d0<2;++d0){s16x4 lo[4],hi[4];
    #pragma unroll
    for(int ks=0;ks<4;++ks){
      asm volatile("ds_read_b64_tr_b16 %0,%1 offset:%c2":"=&v"(lo[ks]):"v"(vb),"i"(d0*4096+ks*1024):"memory");
      asm volatile("ds_read_b64_tr_b16 %0,%1 offset:%c2":"=&v"(hi[ks]):"v"(vb),"i"(d0*4096+ks*1024+512):"memory");}
    asm volatile("s_waitcnt lgkmcnt(0)":::"memory");SBAR();
    #define PK(k) (bf16x8){lo[k][0],lo[k][1],lo[k][2],lo[k][3],hi[k][0],hi[k][1],hi[k][2],hi[k][3]}
    o[d0]=__builtin_amdgcn_mfma_f32_32x32x16_bf16(pa0,PK(0),o[d0],0,0,0);
    o[d0]=__builtin_amdgcn_mfma_f32_32x32x16_bf16(pa1,PK(1),o[d0],0,0,0);
    o[d0]=__builtin_amdgcn_mfma_f32_32x32x16_bf16(pa2,PK(2),o[d0],0,0,0);
    o[d0]=__builtin_amdgcn_mfma_f32_32x32x16_bf16(pa3,PK(3),o[d0],0,0,0);
    #undef PK
  }
}

#ifndef ATTN_STORE16
#define ATTN_STORE16(p,v) (*(u32x4*)(p)=(v))
#endif
template<int THRL> __device__ __forceinline__ void attn_unit(const bf16*Qb,const bf16*__restrict__ Kh,const bf16*__restrict__ Vh,bf16*Ob,const int NT,char*shm,const float sbound=0.f){
  const int tid=threadIdx.x,lane=tid&63,r32=lane&31,hi=lane>>5; const int wid=__builtin_amdgcn_readfirstlane(tid>>6);
  const bf16*Qw=Qb+(long)(wid*QBLK)*DMQ;
  const unsigned lds0=(unsigned)(uintptr_t)shm;
  float*wsf=(float*)(shm+LDS_WS)+wid*64;
  const bf16*ksrc=Kh+(long)lane*DMK+wid*8;
  const bf16*vsrc=Vh+(long)(16*(wid&3)+(lane>>2))*DMV+(wid>>2)*32+(lane&3)*8;
  const unsigned kdst=lds0+LDS_K+wid*1024, vdst=lds0+LDS_V+wid*1024;
  #define DMA_K(t,slot) glds16(ksrc+(long)(t)*KVBLK*DMK,(unsigned)__builtin_amdgcn_readfirstlane(kdst+(slot)))
  #define DMA_V(t,slot) glds16(vsrc+(long)(t)*KVBLK*DMV,(unsigned)__builtin_amdgcn_readfirstlane(vdst+(slot)))
  const int vb0=(int)(lds0+LDS_V)+((lane>>4)&1)*32+(lane&3)*8+(4*hi+((lane&15)>>2))*64;
  const char*Kbase=shm+LDS_K; bf16x8 kf[8];
  const lds_cptr shm3=(lds_cptr)shm; const lds_cptr kp0=shm3+LDS_K+hi*1024+r32*16; const lds_cptr vp0=shm3+LDS_V+((lane>>4)&1)*32+(lane&3)*8+(4*hi+((lane&15)>>2))*64;
  DMA_K(0,0);DMA_V(0,0);DMA_K(1,SLOTB);
  bf16x8 qr[4];
  #pragma unroll
  for(int d0=0;d0<4;++d0)qr[d0]=*reinterpret_cast<const bf16x8*>(&Qw[(long)r32*DMQ+d0*16+hi*8]);
  float sb_=sbound; asm volatile("":"+v"(sb_));
  float mhat=(THRL>=1000)?sb_:0.f,l_reg=0.f;f32x16 o[2];o[0]=f32x16{};o[1]=f32x16{};f32x16 negm;
  _Pragma("unroll") for(int r=0;r<16;++r)negm[r]=-mhat; asm volatile("":"+v"(negm));
  #define CMASK(P0,P1,t) do{}while(0)
  bool resc=false;
  #define START(P0,P1) do{ resc=false; if constexpr(THRL<1000) { const float rm=rowmax(P0,P1); \
      const float dl=rm; mhat=fadd_s(mhat,dl); \
      _Pragma("unroll") for(int r=0;r<16;++r){P0[r]=fsub_s(P0[r],dl);P1[r]=fsub_s(P1[r],dl);} \
      _Pragma("unroll") for(int r=0;r<16;++r)negm[r]=-mhat; asm volatile("":"+v"(negm)); } \
    _Pragma("unroll") for(int r=0;r<16;++r)P0[r]=__builtin_amdgcn_exp2f(P0[r]); }while(0)
  #define RESC() do{ if(resc){ asm volatile("s_waitcnt lgkmcnt(0)":::"memory"); \
      _Pragma("unroll") for(int d_=0;d_<2;++d_) _Pragma("unroll") for(int r=0;r<16;++r)o[d_][r]*=wsf[crow(r,hi)]; } }while(0)
  f32x16 pA0,pA1,pB0,pB1;
  int sl_prev=0,sl_cur=0,sl_next=SLOTB;
  #define ROT() do{sl_prev=sl_cur;sl_cur=sl_next;sl_next=(sl_next==(NSLOT-1)*SLOTB)?0:sl_next+SLOTB;}while(0)
  DMA_K(2,2*SLOTB);
  WAIT_BAR(3);
  qkt(pA0,pA1,Kbase,qr,negm,r32,hi);asm volatile("s_nop 15\n\ts_nop 7":"+v"(pA0),"+v"(pA1));CMASK(pA0,pA1,0);
  START(pA0,pA1);
  _Pragma("unroll") for(int r=0;r<16;++r)pA1[r]=__builtin_amdgcn_exp2f(pA1[r]);
  WAIT_BAR(0);
  DMA_K(3,0);DMA_V(1,SLOTB);
  ROT();
  kload8(kf,kp0+sl_cur);
  WAIT_BAR(2);
  s16x4 vlo[8],vhi[8]; u32x4 pw0,pw1,pw2,pw3;
  #define PKW(P,B) cvtpk_s(P[B],P[B+1])
  #define PAF(k) __builtin_bit_cast(bf16x8,pw##k)
  #define VFR(i) (bf16x8){vlo[i][0],vlo[i][1],vlo[i][2],vlo[i][3],vhi[i][0],vhi[i][1],vhi[i][2],vhi[i][3]}
  #define PIN(x) asm volatile("":"+v"(x))
  #define MX3(a,b,c) __builtin_fmaxf(__builtin_fmaxf((a),(b)),(c))
  #define GAPA(MF,A0,A1,A2,A3,W0,W1,PW) do{ MF; sacc+=A0; sacc+=A1; sacc+=A2; sacc+=A3; PIN(sacc); W0; W1; PIN(PW); SBAR(); }while(0)
  #define EX(v) __builtin_amdgcn_exp2f(v)
  #define GAPB(MF,X,B) do{ MF; X[B]=EX(X[B]); X[B+1]=EX(X[B+1]); X[B+2]=EX(X[B+2]); X[B+3]=EX(X[B+3]); PIN(X); SBAR(); }while(0)
  #define VRD(i) do{ vlo[i]=vtr(vp_+(((i)>>2)*4096+((i)&3)*1024)); vhi[i]=vtr(vp_+(((i)>>2)*4096+((i)&3)*1024+512)); }while(0)
  #define KRD(G,j) do{ if(G){ kload2(kf,kp0+sl_next,j); SBAR(); } }while(0)
  #define STEP(C0,C1,P0,P1,t,GK,GV,GL) do{ SBAR(); \
    const lds_cptr vp_=vp0+sl_prev; \
    VRD(0); SBAR(); float sacc=(P0[0]+P0[1]); \
    GAPA(C0=__builtin_amdgcn_mfma_f32_32x32x16_bf16(kf[0],qr[0],negm,0,0,0), P0[2],P0[3],P0[4],P0[5],     pw0[0]=PKW(P0,0), pw0[1]=PKW(P0,2), pw0); \
    VRD(4); SBAR(); GAPA(C1=__builtin_amdgcn_mfma_f32_32x32x16_bf16(kf[1],qr[0],negm,0,0,0), P0[6],P0[7],P0[8],P0[9],     pw0[2]=PKW(P0,4), pw0[3]=PKW(P0,6), pw0); \
    VRD(1); SBAR(); GAPA(C0=__builtin_amdgcn_mfma_f32_32x32x16_bf16(kf[2],qr[1],C0,0,0,0),   P0[10],P0[11],P0[12],P0[13], pw1[0]=PKW(P0,8), pw1[1]=PKW(P0,10), pw1); \
    VRD(5); SBAR(); GAPA(C1=__builtin_amdgcn_mfma_f32_32x32x16_bf16(kf[3],qr[1],C1,0,0,0),   P0[14],P0[15],P1[0],P1[1],   pw1[2]=PKW(P0,12),pw1[3]=PKW(P0,14), pw1); \
    VRD(2); SBAR(); GAPA(C0=__builtin_amdgcn_mfma_f32_32x32x16_bf16(kf[4],qr[2],C0,0,0,0),   P1[2],P1[3],P1[4],P1[5],     pw2[0]=PKW(P1,0), pw2[1]=PKW(P1,2), pw2); \
    VRD(6); SBAR(); GAPA(C1=__builtin_amdgcn_mfma_f32_32x32x16_bf16(kf[5],qr[2],C1,0,0,0),   P1[6],P1[7],P1[8],P1[9],     pw2[2]=PKW(P1,4), pw2[3]=PKW(P1,6), pw2); \
    VRD(3); SBAR(); GAPA(C0=__builtin_amdgcn_mfma_f32_32x32x16_bf16(kf[6],qr[3],C0,0,0,0),   P1[10],P1[11],P1[12],P1[13], pw3[0]=PKW(P1,8), pw3[1]=PKW(P1,10), pw3); \
    VRD(7); SBAR(); GAPA(C1=__builtin_amdgcn_mfma_f32_32x32x16_bf16(kf[7],qr[3],C1,0,0,0),   P1[14],P1[15],0.f,0.f,       pw3[2]=PKW(P1,12),pw3[3]=PKW(P1,14), pw3); \
    l_reg+=sacc; \
    if(GK){DMA_K((t)+3,sl_cur);} if(GV){DMA_V((t)+1,sl_next);} \
    CMASK(C0,C1,t); \
    resc=false; if constexpr(THRL<1000) { float a=MX3(C0[0],C0[1],C1[0]),b=MX3(C0[2],C0[3],C1[1]); a=MX3(a,C1[2],C1[3]); \
      _Pragma("unroll") for(int r=4;r<16;r+=4){a=MX3(a,C0[r],C0[r+1]);b=MX3(b,C0[r+2],C0[r+3]);a=MX3(a,C1[r],C1[r+1]);b=MX3(b,C1[r+2],C1[r+3]);} \
      float rm=__builtin_fmaxf(a,b); { auto rr=__builtin_amdgcn_permlane32_swap(__float_as_uint(rm),__float_as_uint(rm),false,false); rm=__builtin_fmaxf(__uint_as_float(rr[0]),__uint_as_float(rr[1])); } \
      resc=false; \
      if(__builtin_expect(__any(rm>(float)THRL),0)){ const float dl=__builtin_fmaxf(rm,0.f); mhat+=dl; \
        _Pragma("unroll") for(int r=0;r<16;++r){C0[r]-=dl;C1[r]-=dl;} \
        _Pragma("unroll") for(int r=0;r<16;++r)negm[r]=-mhat; asm volatile("":"+v"(negm)); \
        const float f=__builtin_amdgcn_exp2f(-dl); l_reg*=f; if(hi==0)wsf[r32]=f; resc=true; } } \
    SBAR(); \
    GAPB(o[0]=__builtin_amdgcn_mfma_f32_32x32x16_bf16(PAF(0),VFR(0),o[0],0,0,0), C0,0); \
    GAPB(o[1]=__builtin_amdgcn_mfma_f32_32x32x16_bf16(PAF(0),VFR(4),o[1],0,0,0), C0,4); \
    KRD(GL,0); GAPB(o[0]=__builtin_amdgcn_mfma_f32_32x32x16_bf16(PAF(1),VFR(1),o[0],0,0,0), C0,8); \
    KRD(GL,1); GAPB(o[1]=__builtin_amdgcn_mfma_f32_32x32x16_bf16(PAF(1),VFR(5),o[1],0,0,0), C0,12); \
    KRD(GL,2); GAPB(o[0]=__builtin_amdgcn_mfma_f32_32x32x16_bf16(PAF(2),VFR(2),o[0],0,0,0), C1,0); \
    KRD(GL,3); GAPB(o[1]=__builtin_amdgcn_mfma_f32_32x32x16_bf16(PAF(2),VFR(6),o[1],0,0,0), C1,4); \
    GAPB(o[0]=__builtin_amdgcn_mfma_f32_32x32x16_bf16(PAF(3),VFR(3),o[0],0,0,0), C1,8); \
    GAPB(o[1]=__builtin_amdgcn_mfma_f32_32x32x16_bf16(PAF(3),VFR(7),o[1],0,0,0), C1,12); \
    }while(0)
  int t=1;
  #undef CMASK
  #define CMASK(P0,P1,t) do{}while(0)
  for(;t+5<NT;t+=2){
    STEP(pB0,pB1,pA0,pA1,t,true,true,true);     WAIT_BAR(2); RESC(); ROT();
    STEP(pA0,pA1,pB0,pB1,t+1,true,true,true);   WAIT_BAR(2); RESC(); ROT();
  }
  #undef CMASK
  #define CMASK(P0,P1,t) do{}while(0)
  #define ENDW(tt) do{ if((tt)+3<NT){WAIT_BAR(2);} else if((tt)+2<NT){WAIT_BAR(1);} else {WAIT_BAR(0);} }while(0)
  for(;t+1<NT;t+=2){
    STEP(pB0,pB1,pA0,pA1,t,(t+3<NT),(t+1<NT),(t+1<NT));       ENDW(t);   RESC(); ROT();
    STEP(pA0,pA1,pB0,pB1,t+1,(t+4<NT),(t+2<NT),(t+2<NT));     ENDW(t+1); RESC(); ROT();
  }
  STEP(pB0,pB1,pA0,pA1,NT-1,false,false,false); RESC();
  { float sacc=pB0[0]+pB0[1]; _Pragma("unroll") for(int r=2;r<16;++r)sacc+=pB0[r]; _Pragma("unroll") for(int r=0;r<16;++r)sacc+=pB1[r]; l_reg+=sacc;
    pw0=(u32x4){PKW(pB0,0),PKW(pB0,2),PKW(pB0,4),PKW(pB0,6)};pw1=(u32x4){PKW(pB0,8),PKW(pB0,10),PKW(pB0,12),PKW(pB0,14)};pw2=(u32x4){PKW(pB1,0),PKW(pB1,2),PKW(pB1,4),PKW(pB1,6)};pw3=(u32x4){PKW(pB1,8),PKW(pB1,10),PKW(pB1,12),PKW(pB1,14)};
    SBAR(); pv(o,vb0+sl_cur,PAF(0),PAF(1),PAF(2),PAF(3)); }
  #undef PKW
  #undef PAF
  #undef VFR
  #undef PIN
  #undef MX3
  #undef GAPA
  #undef GAPB
  #undef EX
  #undef VRD
  #undef KRD
  #undef STEP
  #undef ENDW
  {auto rr=__builtin_amdgcn_permlane32_swap(__float_as_uint(l_reg),__float_as_uint(l_reg),false,false);l_reg=__uint_as_float(rr[0])+__uint_as_float(rr[1]);}
  if(hi==0)wsf[32+r32]=l_reg;asm volatile("s_waitcnt lgkmcnt(0)":::"memory");
  float rli[16];
  #pragma unroll
  for(int r=0;r<16;++r)rli[r]=__builtin_amdgcn_rcpf(wsf[32+crow(r,hi)]);
  bf16*Ow=Ob+(long)(wid*QBLK)*DMO;
  { bf16*stg=(bf16*)(shm+LDS_OST)+wid*2048;
    #pragma unroll
    for(int r=0;r<16;++r){const int orow=crow(r,hi);
      #pragma unroll
      for(int d0=0;d0<2;++d0)stg[orow*64+d0*32+r32]=__float2bfloat16(o[d0][r]*rli[r]);}
    asm volatile("s_waitcnt lgkmcnt(0)":::"memory");
    #pragma unroll
    for(int i=0;i<4;++i){const int row=i*8+(lane>>3),ch=lane&7; const u32x4 v=*(const u32x4*)(stg+row*64+ch*8); ATTN_STORE16(Ow+(long)row*DMO+ch*8,v);} }
  asm volatile("s_waitcnt lgkmcnt(0)\n\ts_barrier":::"memory");
  #undef DMA_K
  #undef DMA_V
  #undef CMASK
  #undef START
  #undef RESC
  #undef ROT
}
constexpr int ATTN_LDS_BYTES=LDS_BYTES;
#undef SBAR
#undef WAIT_BAR
}
typedef unsigned short bf16;
typedef unsigned v4u __attribute__((ext_vector_type(4)));
typedef float f32x4 __attribute__((ext_vector_type(4)));
#define LAS __attribute__((address_space(3)))
constexpr int NWAVES = 8;
constexpr int D = 1024, FF = 4096, NIN = 2304, PLE = 256;
constexpr int ZP = att::LDZ;
constexpr int MP = 4 * 8192, MS = 8 * 2048, M = MP + MS;
constexpr int SEQ_P = 8192, SEQ_S = 2048;
constexpr float C2 = 0.125f * 1.4426950408889634f;
constexpr float LOG2E = 1.4426950408889634f;
constexpr size_t MiB = 1u << 20;
constexpr size_t WS_RSP1 = 1 * MiB, WS_RSP2 = 4 * MiB, WS_RSP3 = 7 * MiB;
constexpr size_t WS_WIN = 10 * MiB, WS_WOUT = 15 * MiB, WS_W1 = 17 * MiB, WS_W2 = 25 * MiB, WS_WG = 33 * MiB, WS_WP = 35 * MiB;
constexpr size_t WS_PB = 36 * MiB;
constexpr size_t WS_PROJ = 60 * MiB;
constexpr size_t WS_Z = 156 * MiB;
constexpr size_t WS_HB = 156 * MiB;
constexpr size_t WS_XN = 380 * MiB;
constexpr size_t WS_H = 252 * MiB;
constexpr size_t WS_END = 512 * MiB;
static_assert(WS_XN + (size_t)M * D * 2 <= WS_END && WS_Z + (size_t)M * ZP * 2 <= WS_XN && WS_H + (size_t)16384 * FF * 2 <= WS_END && WS_HB + (size_t)M * D * 2 <= WS_H, "d_ws map");
constexpr int CW_QMAX = 3584, CW_KMAX = 3648, CW_DNEG = 3616, CW_QUEUE = 3712;
constexpr int CTL_BYTES = 32768;
constexpr float SKIP_T = 32.0f;
constexpr int LDS_BYTES = 147456;
static_assert(att::ATTN_LDS <= 131072 && attn_body::ATTN_LDS_BYTES <= 131072 && attn_body::DMQ == ZP, "attention LDS / pitches");

__device__ __forceinline__ unsigned f2bf(float f) { unsigned u = __builtin_bit_cast(unsigned, f); return (u + 0x7fffu + ((u >> 16) & 1u)) >> 16; }
__device__ __forceinline__ unsigned pk2(float lo, float hi) { return f2bf(lo) | (f2bf(hi) << 16); }
__device__ __forceinline__ float wave_sum(float v) {
#pragma unroll
    for (int o = 1; o < 64; o <<= 1) v += __shfl_xor(v, o);
    return v;
}
__device__ __forceinline__ void transpose_item(const float* W, int K, int N, const float* g, bf16* WT, LAS float* scr, int item, int lane) {
    const int nblk = N / 32, kb = item / nblk, nb = item % nblk, k0 = 64 * kb, n0 = 32 * nb;
#pragma unroll 8
    for (int i = 0; i < 32; ++i) { const int kk = 2 * i + (lane >> 5); const float gs = g ? g[k0 + kk] : 1.f; scr[kk * 33 + (lane & 31)] = W[(size_t)(k0 + kk) * N + n0 + (lane & 31)] * gs; }
    asm volatile("s_waitcnt lgkmcnt(0)" ::: "memory");
    const int c = lane & 7;
#pragma unroll
    for (int j = 0; j < 4; ++j) { const int n = (lane >> 3) + 8 * j; const LAS float* s = scr + (8 * c) * 33 + n;
        v4u o; o.x = pk2(s[0 * 33], s[1 * 33]); o.y = pk2(s[2 * 33], s[3 * 33]); o.z = pk2(s[4 * 33], s[5 * 33]); o.w = pk2(s[6 * 33], s[7 * 33]);
        *(v4u*)(WT + (size_t)(n0 + n) * K + k0 + 8 * c) = o; }
    asm volatile("s_waitcnt lgkmcnt(0)" ::: "memory");
}

#define XB_TMO      128
#define XB_XCNT(j)  (256  + 64 * (j))
#define XB_XSUB(j)  (1280 + 64 * (j))
#define XB_XGEN(j)  (2304 + 64 * (j))
#define XB_TOP      3328
#define XB_TOPGEN   3392
#define XCD_BAR_WORDS 3456
#define XB_SPIN_CAP (1u << 22)

__device__ __forceinline__ unsigned xb_ld(unsigned* p)              { return __hip_atomic_load(p, __ATOMIC_RELAXED, __HIP_MEMORY_SCOPE_AGENT); }
__device__ __forceinline__ unsigned xb_add(unsigned* p, unsigned v) { return __hip_atomic_fetch_add(p, v, __ATOMIC_RELAXED, __HIP_MEMORY_SCOPE_AGENT); }
__device__ __forceinline__ unsigned xb_xcc_id() { return (unsigned)__builtin_amdgcn_s_getreg((3 << 11) | 20) & 0xFu; }
#define XB_SPIN(cond, bar) do { unsigned _sp = 0; while (cond) { __builtin_amdgcn_s_sleep(1); \
    if ((++_sp & 255u) == 0u) { if (xb_ld(&(bar)[XB_TMO])) break; if (_sp > XB_SPIN_CAP) { atomicAdd(&(bar)[XB_TMO], 1u); break; } } } } while (0)

struct XcdBarrier {
    unsigned* bar; unsigned x;
    volatile LAS unsigned* st;
};

__device__ __forceinline__ XcdBarrier xcd_barrier_post(unsigned* bar, volatile LAS unsigned* st) {
    XcdBarrier b; b.bar = bar; b.x = xb_xcc_id(); b.st = st;
    if (threadIdx.x == 0) (void)xb_add(&bar[XB_XCNT(b.x)], 1u);
    return b;
}
__device__ __forceinline__ void xcd_barrier_complete(unsigned* bar, unsigned x, unsigned& nloc, unsigned& nx) {
    const unsigned G = gridDim.x * gridDim.y * gridDim.z;
    unsigned sum, cnt, mine, sp = 0u;
    for (;;) {
        sum = 0u; cnt = 0u; mine = 0u;
#pragma unroll
        for (unsigned j = 0; j < 16; ++j) { const unsigned c = xb_ld(&bar[XB_XCNT(j)]); sum += c; cnt += (c > 0u) ? 1u : 0u; mine = (j == x) ? c : mine; }
        if (sum == G) break;
        __builtin_amdgcn_s_sleep(1);
        if ((++sp & 255u) == 0u) { if (xb_ld(&bar[XB_TMO])) break; if (sp > XB_SPIN_CAP) { atomicAdd(&bar[XB_TMO], 1u); break; } }
    }
    nloc = mine > 0u ? mine : 1u; nx = cnt > 0u ? cnt : 1u;
}

__device__ __forceinline__ void xcd_barrier(const XcdBarrier& b) {
    asm volatile("s_waitcnt vmcnt(0)" ::: "memory");
    __syncthreads();
    if (threadIdx.x == 0) {
        unsigned* bar = b.bar;
        __builtin_amdgcn_s_waitcnt(0);
        unsigned nloc = b.st[0], nx = b.st[1];
        if (nloc == 0u) { xcd_barrier_complete(bar, b.x, nloc, nx); b.st[0] = nloc; b.st[1] = nx; }
        const unsigned old = xb_add(&bar[XB_XSUB(b.x)], 1u);
        const unsigned gen = old / nloc;
        if (old + 1u == (gen + 1u) * nloc) {
            __builtin_amdgcn_fence(__ATOMIC_RELEASE, "agent");
            asm volatile("s_waitcnt vmcnt(0)" ::: "memory");
            const unsigned og = xb_add(&bar[XB_TOP], 1u);
            const unsigned tg = og / nx;
            if (og + 1u == (tg + 1u) * nx) xb_add(&bar[XB_TOPGEN], 1u);
            else XB_SPIN(xb_ld(&bar[XB_TOPGEN]) == tg, bar);
            __builtin_amdgcn_fence(__ATOMIC_ACQUIRE, "agent");
            xb_add(&bar[XB_XGEN(b.x)], 1u);
            asm volatile("s_waitcnt vmcnt(0)" ::: "memory");
        } else {
            XB_SPIN(xb_ld(&bar[XB_XGEN(b.x)]) == gen, bar);
            __builtin_amdgcn_fence(__ATOMIC_ACQUIRE, "agent");
            asm volatile("s_waitcnt vmcnt(0)" ::: "memory");
        }
    }
    __syncthreads();
}

struct Args { const float* in[21]; float* out; unsigned char* ws; };

__global__ void __launch_bounds__(NWAVES * 64, 2) fwd_mega(Args args) {
    extern __shared__ __attribute__((aligned(16))) unsigned char lds[];
    cg::grid_group grid = cg::this_grid();
#define PHASE_IDS() int tid_p = threadIdx.x; asm volatile("" : "+v"(tid_p)); const int tid = tid_p, lane = tid & 63, wave = __builtin_amdgcn_readfirstlane(tid >> 6); const int gw = bx * NWAVES + wave; (void)lane; (void)gw; (void)tid
    const int G = gridDim.x, bx = blockIdx.x;
    const int NGW = G * NWAVES;
    unsigned char* ws = args.ws;
    const float* x_p = args.in[0]; const float* x_s = args.in[1]; const float* p_p = args.in[2]; const float* p_s = args.in[3];
    const float* w_in = args.in[4]; const float* g_mix = args.in[5];
    const float* lq1 = args.in[6]; const float* lk1 = args.in[7]; const float* lq2 = args.in[8]; const float* lk2 = args.in[9];
    const float* g_subln = args.in[10]; const float* g_qn = args.in[11]; const float* g_kn = args.in[12];
    const float* w_out = args.in[13]; const float* g_mlp = args.in[14]; const float* w_ff1 = args.in[15]; const float* w_ff2 = args.in[16];
    const float* g_ple = args.in[17]; const float* w_gate = args.in[18]; const float* w_proj = args.in[19]; const float* g_final = args.in[20];
    float* out = args.out;
    float* RSP1 = (float*)(ws + WS_RSP1); float* RSP2 = (float*)(ws + WS_RSP2); float* RSP3 = (float*)(ws + WS_RSP3);
    bf16* WinT = (bf16*)(ws + WS_WIN); bf16* WoutT = (bf16*)(ws + WS_WOUT); bf16* W1T = (bf16*)(ws + WS_W1); bf16* W2T = (bf16*)(ws + WS_W2); bf16* WgT = (bf16*)(ws + WS_WG); bf16* WpT = (bf16*)(ws + WS_WP);
    bf16* PB = (bf16*)(ws + WS_PB); bf16* PROJ = (bf16*)(ws + WS_PROJ); bf16* Z = (bf16*)(ws + WS_Z); bf16* HB = (bf16*)(ws + WS_HB);
    bf16* XN = (bf16*)(ws + WS_XN); bf16* MIX = XN; bf16* HH = (bf16*)(ws + WS_H);
    LAS unsigned char* ldsl = (LAS unsigned char*)lds;
    volatile LAS unsigned* bst = (volatile LAS unsigned*)(ldsl + 139264);
    if (threadIdx.x < 2) bst[threadIdx.x] = 0u;
    __syncthreads();
    const XcdBarrier bar = xcd_barrier_post((unsigned*)ws, bst);
    if (ws == nullptr) grid.sync();

#ifndef NO_P0
#ifdef PROBE_EW2
    for (int rep = 0; rep < 2; ++rep)
#endif
    {
        PHASE_IDS();
        LAS float* scr = (LAS float*)(ldsl + wave * 16384);
        constexpr int I_IN = (D / 64) * (NIN / 32), I_OUT = (D / 64) * (D / 32), I_1 = (D / 64) * (FF / 32), I_2 = (FF / 64) * (D / 32), I_G = I_OUT, I_P = (PLE / 64) * (D / 32);
        constexpr int NITEMS = I_IN + I_OUT + I_1 + I_2 + I_G + I_P;
        for (int it = gw; it < NITEMS; it += NGW) {
            int r = it;
            if (r < I_IN) { transpose_item(w_in, D, NIN, nullptr, WinT, scr, r, lane); continue; } r -= I_IN;
            if (r < I_OUT) { transpose_item(w_out, D, D, nullptr, WoutT, scr, r, lane); continue; } r -= I_OUT;
            if (r < I_1) { transpose_item(w_ff1, D, FF, g_mlp, W1T, scr, r, lane); continue; } r -= I_1;
            if (r < I_2) { transpose_item(w_ff2, FF, D, nullptr, W2T, scr, r, lane); continue; } r -= I_2;
            if (r < I_G) { transpose_item(w_gate, D, D, g_ple, WgT, scr, r, lane); continue; } r -= I_G;
            transpose_item(w_proj, PLE, D, nullptr, WpT, scr, r, lane);
        }
        f32x4 gv[4];
#pragma unroll
        for (int j = 0; j < 4; ++j) gv[j] = *((const f32x4*)g_mix + lane + 64 * j);
        for (int m0 = gw * 2; m0 < M; m0 += NGW * 2) {
            f32x4 v[2][4], pv[2];
#pragma unroll
            for (int r = 0; r < 2; ++r) { const int m = m0 + r;
                const float* xrow = m < MP ? x_p + (size_t)m * D : x_s + (size_t)(m - MP) * D;
                const float* prow = m < MP ? p_p + (size_t)m * PLE : p_s + (size_t)(m - MP) * PLE;
#pragma unroll
                for (int j = 0; j < 4; ++j) v[r][j] = *((const f32x4*)xrow + lane + 64 * j);
                pv[r] = *((const f32x4*)prow + lane); }
#pragma unroll
            for (int r = 0; r < 2; ++r) { const int m = m0 + r; float s = 0.f;
#pragma unroll
                for (int j = 0; j < 4; ++j) s += (v[r][j].x * v[r][j].x + v[r][j].y * v[r][j].y) + (v[r][j].z * v[r][j].z + v[r][j].w * v[r][j].w);
                const float rstd = 1.0f / sqrtf(wave_sum(s) * (1.0f / D) + 1e-6f);
                unsigned long long* o8 = (unsigned long long*)(XN + (size_t)m * D) + lane;
#pragma unroll
                for (int j = 0; j < 4; ++j) { const f32x4 y = v[r][j] * rstd * gv[j]; o8[64 * j] = (unsigned long long)pk2(y.x, y.y) | ((unsigned long long)pk2(y.z, y.w) << 32); }
                *((unsigned long long*)(PB + (size_t)m * PLE) + lane) = (unsigned long long)pk2(pv[r].x, pv[r].y) | ((unsigned long long)pk2(pv[r].z, pv[r].w) << 32); }
        }
    }
#endif
    xcd_barrier(bar);

#ifndef NO_P1
#ifdef PROBE_GEMM2
    for (int rep = 0; rep < 2; ++rep)
#endif
    {
        pg8::Gemm g{XN, WinT, M, NIN, D}; pg8::StaticOrder S; S.init(M, NIN, G, bx);
        pg8::EpiBf E{Z, ZP, C2, 2};
        pg8::gemm_phase<pg8::EpiBf, pg8::StaticOrder, true, true>(ldsl, g, S, E);
    }
    {
        pg8::Gemm g{PB, WpT, M, D, PLE}; pg8::StaticOrder S; S.init(M, D, G, bx);
        pg8::EpiBf E{PROJ, D, 1.f, 0};
        pg8::gemm_phase<pg8::EpiBf, pg8::StaticOrder, true, true>(ldsl, g, S, E);
    }
#endif
    xcd_barrier(bar);

#ifndef NO_P1B
    {
        int tl = threadIdx.x; asm volatile("" : "+v"(tl));
        const long nth = (long)G * 512;
        const int j4 = (tl & 3) * 4;
        {
            float mq = 0.f, mk = 0.f, md = 0.f;
            for (long it = (long)bx * 512 + tl; it < (long)M * 32; it += nth) {
                const long item = it >> 2; const int m = (int)(item >> 3), hc = (int)(item & 7);
                const bf16* p = Z + (size_t)m * ZP + hc * 64 + j4; float sq = 0.f, sk = 0.f, sd = 0.f;
#pragma unroll
                for (int q = 0; q < 4; ++q) { const unsigned long long w = *(const unsigned long long*)(p + 16 * q), wk = *(const unsigned long long*)(p + 512 + 16 * q);
                    const unsigned lo = (unsigned)w, hi = (unsigned)(w >> 32), klo = (unsigned)wk, khi = (unsigned)(wk >> 32);
                    const float a = __uint_as_float(lo << 16), b = __uint_as_float(lo & 0xffff0000u), c = __uint_as_float(hi << 16), d = __uint_as_float(hi & 0xffff0000u);
                    const float ka = __uint_as_float(klo << 16), kb = __uint_as_float(klo & 0xffff0000u), kc = __uint_as_float(khi << 16), kd = __uint_as_float(khi & 0xffff0000u);
                    sq += (a * a + b * b) + (c * c + d * d); sk += (ka * ka + kb * kb) + (kc * kc + kd * kd); sd += (a * ka + b * kb) + (c * kc + d * kd); }
                sq += __shfl_xor(sq, 1); sq += __shfl_xor(sq, 2); sk += __shfl_xor(sk, 1); sk += __shfl_xor(sk, 2); sd += __shfl_xor(sd, 1); sd += __shfl_xor(sd, 2);
                mq = fmaxf(mq, sq); mk = fmaxf(mk, sk); md = fmaxf(md, -sd);
            }
#pragma unroll
            for (int o = 1; o < 64; o <<= 1) { mq = fmaxf(mq, __shfl_xor(mq, o)); mk = fmaxf(mk, __shfl_xor(mk, o)); md = fmaxf(md, __shfl_xor(md, o)); }
            if ((tl & 63) == 0) { atomicMax((unsigned*)ws + CW_QMAX, __float_as_uint(sqrtf(mq) * 1.0001f)); atomicMax((unsigned*)ws + CW_KMAX, __float_as_uint(sqrtf(mk) * 1.0001f));
                                  atomicMax((unsigned*)ws + CW_DNEG, __float_as_uint(md * 1.0001f + 1e-3f)); }
        }
        for (long it = (long)bx * 512 + tl; it < (long)M * 40; it += nth) {
            const long item = it >> 2;
            const int m = (int)(item / 10), hh = (int)(item % 10);
            const int t = m < MP ? (m & (SEQ_P - 1)) : ((m - MP) & (SEQ_S - 1));
            bf16* p = Z + (size_t)m * ZP + 1536 + hh * 64 + j4;
            const float* gg = (hh < 8 ? g_qn : g_kn) + j4;
            float v[4][4]; float ss = 0.f;
#pragma unroll
            for (int q = 0; q < 4; ++q) { const unsigned long long w = *(const unsigned long long*)(p + 16 * q); const unsigned lo = (unsigned)w, hi = (unsigned)(w >> 32);
                v[q][0] = __uint_as_float(lo << 16); v[q][1] = __uint_as_float(lo & 0xffff0000u); v[q][2] = __uint_as_float(hi << 16); v[q][3] = __uint_as_float(hi & 0xffff0000u);
                ss += (v[q][0] * v[q][0] + v[q][1] * v[q][1]) + (v[q][2] * v[q][2] + v[q][3] * v[q][3]); }
            ss += __shfl_xor(ss, 1); ss += __shfl_xor(ss, 2);
            const float rstd = 1.0f / sqrtf(ss * (1.0f / 64.0f) + 1e-6f);
#pragma unroll
            for (int q = 0; q < 4; ++q) { const f32x4 g4 = *(const f32x4*)(gg + 16 * q);
#pragma unroll
                for (int e = 0; e < 4; ++e) v[q][e] = v[q][e] * rstd * g4[e]; }
            const float fr = (float)(t >> 6), fc = (float)(t & 63), osc = hh < 8 ? C2 : 1.f;
#pragma unroll
            for (int e = 0; e < 4; ++e) {
                const float invf = __builtin_amdgcn_exp2f(-(float)(j4 + e) * (13.287712379549449f / 16.0f));
                const float ar = fr * invf, ac = fc * invf;
                const float cr = __cosf(ar), sr = __sinf(ar), cc = __cosf(ac), sc = __sinf(ac);
                const float a1 = v[0][e], a2 = v[1][e]; v[0][e] = (a1 * cr - a2 * sr) * osc; v[1][e] = (a1 * sr + a2 * cr) * osc;
                const float b1 = v[2][e], b2 = v[3][e]; v[2][e] = (b1 * cc - b2 * sc) * osc; v[3][e] = (b1 * sc + b2 * cc) * osc;
            }
#pragma unroll
            for (int q = 0; q < 4; ++q) *(unsigned long long*)(p + 16 * q) = (unsigned long long)pk2(v[q][0], v[q][1]) | ((unsigned long long)pk2(v[q][2], v[q][3]) << 32);
        }
    }
#endif
    xcd_barrier(bar);

#ifndef NO_P2
    {
        const float qkb = __uint_as_float(((const unsigned*)ws)[CW_QMAX]) * __uint_as_float(((const unsigned*)ws)[CW_KMAX]) + __uint_as_float(((const unsigned*)ws)[CW_DNEG]) + SKIP_T;
        PHASE_IDS();
        volatile LAS int* qslot = (volatile LAS int*)(ldsl + 139280);
        const float aqk_ = __uint_as_float(((const unsigned*)ws)[CW_QMAX]) * __uint_as_float(((const unsigned*)ws)[CW_KMAX]);
        const float amref = (aqk_ + __uint_as_float(((const unsigned*)ws)[CW_DNEG]) < 90.0f) ? aqk_ : -1.f;
        float gq_ = fabsf(g_qn[lane]), gk_ = fabsf(g_kn[lane]);
#pragma unroll
        for (int o = 1; o < 64; o <<= 1) { gq_ = fmaxf(gq_, __shfl_xor(gq_, o)); gk_ = fmaxf(gk_, __shfl_xor(gk_, o)); }
        const float bbound = 64.0f * C2 * 1.03f * gq_ * gk_;
        const bool bmaxfree = __builtin_amdgcn_readfirstlane((int)(bbound < 40.0f)) != 0;
        const int x0 = (int)(bar.x & 7u);
        for (int dx = 0; dx < 8; ++dx) {
            const int x = (x0 + dx) & 7;
            for (;;) {
                if (tid == 0) *qslot = (int)__hip_atomic_fetch_add((unsigned*)ws + CW_QUEUE + 64 * x, 1u, __ATOMIC_RELAXED, __HIP_MEMORY_SCOPE_AGENT);
                __syncthreads();
                const int i = *qslot;
                __syncthreads();
                if (i >= 384) break;
                int kind, h = 0, c = 0, head = 0, qb;
                if (i < 32) { kind = 0; h = 3; qb = i; }
                else if (i < 64) { kind = 0; h = 2; qb = i - 32; }
                else if (i < 192) { kind = 1; head = (x & 1) * 4 + ((i - 64) >> 5); qb = (i - 64) & 31; }
                else if (i < 224) { kind = 0; h = 1; qb = i - 192; }
                else if (i < 256) { kind = 2; h = 3 - ((i - 224) >> 4); c = ((i - 224) & 15) >> 3; qb = (i - 224) & 7; }
                else if (i < 320) { kind = 3; head = (i - 256) >> 3; qb = (i - 256) & 7; }
                else if (i < 336) { kind = 2; h = 1; c = (i - 320) >> 3; qb = (i - 320) & 7; }
                else if (i < 368) { kind = 0; h = 0; qb = i - 336; }
                else { kind = 2; h = 0; c = (i - 368) >> 3; qb = (i - 368) & 7; }
                const bool prompt = kind < 2;
                const int b = prompt ? (x >> 1) : x; if (kind == 0) c = x & 1;
                const int S = prompt ? SEQ_P : SEQ_S; const long rowbase = prompt ? (long)b * SEQ_P : (long)MP + (long)b * SEQ_S;
                const int q0 = qb * 256, NT = S / 64;
                const bf16* Zb = Z + rowbase * ZP;
                if (!(kind & 1)) {
                    const float slope = (h == 0 ? 0.25f : h == 1 ? 0.0625f : h == 2 ? 0.015625f : 0.00390625f), sl2 = LOG2E * slope;
                    const float W = qkb / sl2;
                    int t_lo = (int)floorf(fmaxf((float)q0 - W, 0.f) * (1.0f / 64.0f));
                    int t_hi = (int)fminf(floorf(((float)(q0 + 255) + W) * (1.0f / 64.0f)) + 1.0f, (float)NT);
                    if ((t_hi - t_lo) & 1) { if (t_lo > 0) --t_lo; else ++t_hi; }
                    const int hd = h * 2 + c;
                    att::attn_unit_pp<128, true, bf16>(Zb + (long)q0 * ZP + h * 128 + c * 64, Zb + (long)t_lo * 64 * ZP + 512 + h * 128 + c * 64, Zb + (long)t_lo * 64 * ZP + 1024 + h * 128,
                                                     (bf16*)out + (rowbase + q0) * 1024 + hd * 128, t_hi - t_lo, q0 - t_lo * 64, sl2, ldsl, amref);
                } else {
                    if (bmaxfree)
                        attn_body::attn_unit<1000>((const attn_body::bf16*)(Zb + (long)q0 * ZP + 1536 + head * 64), (const attn_body::bf16*)(Zb + 2048 + (head >> 2) * 64), (const attn_body::bf16*)(Zb + 2176 + (head >> 2) * 64),
                                                   (attn_body::bf16*)(MIX + (rowbase + q0) * 1024 + 512 + head * 64), NT, (char*)lds, bbound);
                    else
                        attn_body::attn_unit<8>((const attn_body::bf16*)(Zb + (long)q0 * ZP + 1536 + head * 64), (const attn_body::bf16*)(Zb + 2048 + (head >> 2) * 64), (const attn_body::bf16*)(Zb + 2176 + (head >> 2) * 64),
                                                (attn_body::bf16*)(MIX + (rowbase + q0) * 1024 + 512 + head * 64), NT, (char*)lds);
                }
            }
        }
    }
#endif
    xcd_barrier(bar);

#ifndef NO_P2B
#ifdef PROBE_EW2
    for (int rep = 0; rep < 2; ++rep)
#endif
    {
        PHASE_IDS();
        const float d1 = wave_sum(lq1[lane] * lk1[lane]), d2 = wave_sum(lq2[lane] * lk2[lane]);
        const float lam = expf(d1) - expf(d2) + 0.2f;
        const int h = lane >> 4, e0 = (lane & 15) * 8;
        const f32x4 g0 = *(const f32x4*)(g_subln + e0), g1 = *(const f32x4*)(g_subln + e0 + 4);
        for (int m0 = gw * 4; m0 < M; m0 += NGW * 4) {
            v4u wa[4], wb[4];
#pragma unroll
            for (int r = 0; r < 4; ++r) { const bf16* o0 = (const bf16*)out + (size_t)(m0 + r) * 1024 + (h * 2) * 128 + e0; wa[r] = *(const v4u*)o0; wb[r] = *(const v4u*)(o0 + 128); }
#pragma unroll
            for (int r = 0; r < 4; ++r) {
                f32x4 a0, a1, b0, b1;
                a0.x = __uint_as_float(wa[r].x << 16); a0.y = __uint_as_float(wa[r].x & 0xffff0000u); a0.z = __uint_as_float(wa[r].y << 16); a0.w = __uint_as_float(wa[r].y & 0xffff0000u);
                a1.x = __uint_as_float(wa[r].z << 16); a1.y = __uint_as_float(wa[r].z & 0xffff0000u); a1.z = __uint_as_float(wa[r].w << 16); a1.w = __uint_as_float(wa[r].w & 0xffff0000u);
                b0.x = __uint_as_float(wb[r].x << 16); b0.y = __uint_as_float(wb[r].x & 0xffff0000u); b0.z = __uint_as_float(wb[r].y << 16); b0.w = __uint_as_float(wb[r].y & 0xffff0000u);
                b1.x = __uint_as_float(wb[r].z << 16); b1.y = __uint_as_float(wb[r].z & 0xffff0000u); b1.z = __uint_as_float(wb[r].w << 16); b1.w = __uint_as_float(wb[r].w & 0xffff0000u);
                a0 = a0 - lam * b0; a1 = a1 - lam * b1;
                float s2 = ((a0.x * a0.x + a0.y * a0.y) + (a0.z * a0.z + a0.w * a0.w)) + ((a1.x * a1.x + a1.y * a1.y) + (a1.z * a1.z + a1.w * a1.w));
                s2 += __shfl_xor(s2, 1); s2 += __shfl_xor(s2, 2); s2 += __shfl_xor(s2, 4); s2 += __shfl_xor(s2, 8);
                const float rstd = 0.8f / sqrtf(s2 * (1.0f / 128.0f) + 1e-5f);
                a0 = a0 * rstd * g0; a1 = a1 * rstd * g1;
                v4u w; w.x = pk2(a0.x, a0.y); w.y = pk2(a0.z, a0.w); w.z = pk2(a1.x, a1.y); w.w = pk2(a1.z, a1.w);
                *(v4u*)(MIX + (size_t)(m0 + r) * 1024 + h * 128 + e0) = w; }
        }
    }
#endif
    xcd_barrier(bar);

#ifndef NO_P3
#ifdef PROBE_GEMM2
    for (int rep = 0; rep < 2; ++rep)
#endif
    {
        pg8::Gemm g{MIX, WoutT, M, D, D}; pg8::StaticOrder S; S.init(M, D, G, bx);
        pg8::EpiRes<false> E{x_p, x_s, MP, HB, RSP1, 0};
        pg8::gemm_phase<pg8::EpiRes<false>, pg8::StaticOrder, true, true>(ldsl, g, S, E);
    }
#endif
    xcd_barrier(bar);

#ifndef NO_P45
    for (int ch = 0; ch < 3; ++ch) {
        const int r0 = ch * 16384;
#ifndef NO_FF1
#ifdef PROBE_GEMM2
        for (int rep = 0; rep < 2; ++rep)
#endif
        {
            pg8::Gemm g{HB + (size_t)r0 * D, W1T, 16384, FF, D}; pg8::StaticOrder S; S.init(16384, FF, G, bx);
            pg8::EpiFF1 E{RSP1, HH, r0};
            pg8::gemm_phase<pg8::EpiFF1, pg8::StaticOrder, true, true>(ldsl, g, S, E);
        }
#endif
        xcd_barrier(bar);
#ifndef NO_FF2
        {
            pg8::Gemm g{HH, W2T, 16384, D, FF}; pg8::StaticOrder S; S.init(16384, D, G, bx);
            pg8::EpiRes<true> E{nullptr, nullptr, 0, HB, RSP2, r0};
            pg8::gemm_phase<pg8::EpiRes<true>, pg8::StaticOrder, true, true>(ldsl, g, S, E);
        }
#endif
        xcd_barrier(bar);
    }

#endif
#ifndef NO_P6
    {
        pg8::Gemm g{HB, WgT, M, D, D}; pg8::StaticOrder S; S.init(M, D, G, bx);
        pg8::EpiGate E{RSP2, PROJ, HB, XN, RSP3};
        pg8::gemm_phase<pg8::EpiGate, pg8::StaticOrder, true, true>(ldsl, g, S, E);
    }
#endif
    xcd_barrier(bar);

#ifndef NO_P7
    {
        PHASE_IDS();
        f32x4 gv[4];
#pragma unroll
        for (int j = 0; j < 4; ++j) gv[j] = *((const f32x4*)g_final + lane + 64 * j);
        for (int m0 = gw * 4; m0 < M; m0 += NGW * 4) {
            unsigned long long w[4][4]; float rstd[4];
#pragma unroll
            for (int r = 0; r < 4; ++r) { const unsigned long long* hr = (const unsigned long long*)(XN + (size_t)(m0 + r) * D) + lane;
#pragma unroll
                for (int j = 0; j < 4; ++j) w[r][j] = hr[64 * j];
                rstd[r] = 1.0f / sqrtf(pg8::rs16(RSP3 + (size_t)(m0 + r) * 16) * (1.0f / D) + 1e-6f); }
#pragma unroll
            for (int r = 0; r < 4; ++r) { f32x4* xr = (f32x4*)(out + (size_t)(m0 + r) * D) + lane;
#pragma unroll
                for (int j = 0; j < 4; ++j) { const unsigned lo = (unsigned)w[r][j], hi2 = (unsigned)(w[r][j] >> 32);
                    f32x4 hv; hv.x = __uint_as_float(lo << 16); hv.y = __uint_as_float(lo & 0xffff0000u); hv.z = __uint_as_float(hi2 << 16); hv.w = __uint_as_float(hi2 & 0xffff0000u);
                    xr[64 * j] = hv * rstd[r] * gv[j]; } }
        }
    }
#endif
}

extern "C" void kernel_launch(void* const* d_in, const int* in_sizes, int n_in, void* d_out, int out_size, void* d_ws, size_t ws_size, hipStream_t stream) {
    static int grid = 0;
    if (grid == 0) {
        if (n_in != 21 || out_size != M * D || ws_size < WS_END) { fprintf(stderr, "kernel_launch: unexpected shapes (n_in %d out %d ws %zu)\n", n_in, out_size, ws_size); grid = -1; return; }
        int dev = 0, cus = 0, per_cu = 0;
        hipGetDevice(&dev); hipDeviceGetAttribute(&cus, hipDeviceAttributeMultiprocessorCount, dev);
        if (hipFuncSetAttribute((const void*)fwd_mega, hipFuncAttributeMaxDynamicSharedMemorySize, LDS_BYTES) != hipSuccess) { fprintf(stderr, "kernel_launch: hipFuncSetAttribute failed\n"); grid = -1; return; }
        if (hipOccupancyMaxActiveBlocksPerMultiprocessor(&per_cu, (const void*)fwd_mega, NWAVES * 64, LDS_BYTES) != hipSuccess || per_cu < 1) { fprintf(stderr, "kernel_launch: occupancy query gave %d\n", per_cu); per_cu = 1; }
        (void)hipGetLastError();
        grid = cus * per_cu;
    }
    if (grid < 0) return;
    if (hipMemsetAsync(d_ws, 0, CTL_BYTES, stream) != hipSuccess) { fprintf(stderr, "kernel_launch: memset failed\n"); return; }
    Args a{};
    for (int i = 0; i < 21; ++i) a.in[i] = (const float*)d_in[i];
    a.out = (float*)d_out; a.ws = (unsigned char*)d_ws;
    void* kargs[] = {&a};
    hipError_t e = hipLaunchCooperativeKernel((const void*)fwd_mega, dim3(grid), dim3(NWAVES * 64), kargs, LDS_BYTES, stream);
    if (e != hipSuccess) fprintf(stderr, "cooperative launch failed: %s (grid %d)\n", hipGetErrorString(e), grid);
}
```
